# Optimizing an MI355X kernel written in HIP

```python
import math
import jax, jax.numpy as jnp
from jax import lax
import numpy as np


D_MODEL = 1024
BATCH = 2
SEQ = 16384
DEPTH = 2
DEC_BATCH = 8
DEC_SEQ = 2048
PAST_LEN = 128

N_MIXERS = 2
N_A_LAYERS = (DEPTH + N_MIXERS - 1) // N_MIXERS
N_B_LAYERS = DEPTH // N_MIXERS
S5_GROUP = 16
S5_GROUPS = D_MODEL // S5_GROUP
S5_STATE = 64
S5_CHUNK = 128
GLA_HEADS = 4
GLA_DK = D_MODEL // 2
GLA_DV = D_MODEL
GLA_HEAD_K = GLA_DK // GLA_HEADS
GLA_HEAD_V = GLA_DV // GLA_HEADS
GLA_GATE_RANK = 16
GLA_GATE_TAU = 16.0
GLA_CHUNK = 64
D_FF = 4 * D_MODEL
N_MOD = 6
EPS = 1e-6

kernel_name = 'hybrid_s5_gla_encoder'


def rmsnorm(x, g):
    xf = x.astype(jnp.float32)
    y = xf * lax.rsqrt(jnp.mean(xf * xf, axis=-1, keepdims=True) + EPS)
    return (y * g.astype(jnp.float32)).astype(x.dtype)


def _cplx_combine(left, right):
    a1r, a1i, b1r, b1i = left
    a2r, a2i, b2r, b2i = right
    return (a2r * a1r - a2i * a1i, a2r * a1i + a2i * a1r,
            a2r * b1r - a2i * b1i + b2r, a2r * b1i + a2i * b1r + b2i)


def s5_direction(u, lam_re, lam_im, log_dt, b_re, b_im, c_re, c_im):
    f32 = jnp.float32
    bsz, L = u.shape[0], u.shape[1]
    dt = jnp.exp(log_dt.astype(f32))[:, None]
    lr, li = lam_re.astype(f32), lam_im.astype(f32)
    mag = jnp.exp(lr * dt)
    ab_re, ab_im = mag * jnp.cos(li * dt), mag * jnp.sin(li * dt)
    den = lr * lr + li * li
    z_re = ((ab_re - 1.0) * lr + ab_im * li) / den
    z_im = (ab_im * lr - (ab_re - 1.0) * li) / den
    br, bi = b_re.astype(f32), b_im.astype(f32)
    bb_re = z_re[..., None] * br - z_im[..., None] * bi
    bb_im = z_re[..., None] * bi + z_im[..., None] * br
    cr, ci = c_re.astype(f32), c_im.astype(f32)
    n_chunks = L // S5_CHUNK
    uc = u.astype(f32).reshape(bsz, n_chunks, S5_CHUNK, S5_GROUPS, S5_GROUP).transpose(1, 0, 2, 3, 4)
    a_re = jnp.broadcast_to(ab_re, (bsz, S5_CHUNK, S5_GROUPS, S5_STATE))
    a_im = jnp.broadcast_to(ab_im, (bsz, S5_CHUNK, S5_GROUPS, S5_STATE))

    def step(carry, u_c):
        h_re, h_im = carry
        bu_re = jnp.einsum('bcgh,gph->bcgp', u_c, bb_re)
        bu_im = jnp.einsum('bcgh,gph->bcgp', u_c, bb_im)
        pr, pim, sr, si = lax.associative_scan(_cplx_combine, (a_re, a_im, bu_re, bu_im), axis=1)
        hr = pr * h_re[:, None] - pim * h_im[:, None] + sr
        hi = pr * h_im[:, None] + pim * h_re[:, None] + si
        y = jnp.einsum('bcgp,ghp->bcgh', hr, cr) - jnp.einsum('bcgp,ghp->bcgh', hi, ci)
        return (hr[:, -1], hi[:, -1]), y

    h0 = jnp.zeros((bsz, S5_GROUPS, S5_STATE), f32)
    _, ys = lax.scan(step, (h0, h0), uc)
    return ys.transpose(1, 0, 2, 3, 4).reshape(bsz, L, S5_GROUPS, S5_GROUP)


def s5_mixer(h, lam_re, lam_im, log_dt, b_re, b_im, c_re, c_im, d_skip, w_glu):
    bsz, L, _ = h.shape
    u = h.reshape(bsz, L, S5_GROUPS, S5_GROUP)
    y_f = s5_direction(u, lam_re[0], lam_im[0], log_dt[0], b_re[0], b_im[0], c_re[0], c_im[0])
    y_b = s5_direction(u[:, ::-1], lam_re[1], lam_im[1], log_dt[1], b_re[1], b_im[1], c_re[1], c_im[1])[:, ::-1]
    y = (y_f + y_b).reshape(bsz, L, D_MODEL).astype(h.dtype) + d_skip * h
    g = jax.nn.gelu(y)
    val, gate = jnp.split(g @ w_glu, 2, axis=-1)
    return val * jax.nn.sigmoid(gate)


def gla_direction(q, k, v, g):
    bsz, H, L, dk = q.shape
    dv = v.shape[-1]
    n = L // GLA_CHUNK

    def chunks(t):
        return t.reshape(bsz, H, n, GLA_CHUNK, t.shape[-1]).transpose(2, 0, 1, 3, 4)

    mask = jnp.tril(jnp.ones((GLA_CHUNK, GLA_CHUNK), dtype=bool))

    def step(S, inp):
        qc, kc, vc, gc = inp
        bcum = jnp.cumsum(gc, axis=2)
        b_last = bcum[:, :, -1:]
        q_dec = qc * jnp.exp(bcum)
        k_dec = kc * jnp.exp(-bcum)
        scores = jnp.where(mask, jnp.einsum('bhcd,bhsd->bhcs', q_dec, k_dec), 0.0)
        o = jnp.einsum('bhcs,bhsv->bhcv', scores, vc) + jnp.einsum('bhcd,bhdv->bhcv', q_dec, S)
        k_tail = kc * jnp.exp(b_last - bcum)
        S_new = jnp.exp(b_last[:, :, 0])[..., None] * S + jnp.einsum('bhcd,bhcv->bhdv', k_tail, vc)
        return S_new, o

    S0 = jnp.zeros((bsz, H, dk, dv), jnp.float32)
    _, o = lax.scan(step, S0, (chunks(q), chunks(k), chunks(v), chunks(g)))
    return o.transpose(1, 2, 0, 3, 4).reshape(bsz, H, L, dv)


def gla_mixer(h, w_in, w_a1, w_a2, b_a, norm_g, w_out):
    f32 = jnp.float32
    bsz, L, _ = h.shape
    proj = h @ w_in
    q, k, v, r = jnp.split(proj, [GLA_DK, 2 * GLA_DK, 2 * GLA_DK + GLA_DV], axis=-1)

    def heads(t, d):
        return t.reshape(bsz, L, GLA_HEADS, d).transpose(0, 2, 1, 3).astype(f32)

    q = heads(q, GLA_HEAD_K) * (GLA_HEAD_K ** -0.5)
    k = heads(k, GLA_HEAD_K)
    v = heads(v, GLA_HEAD_V)

    def log_gate(j):
        z = (h @ w_a1[j]) @ w_a2[j] + b_a[j]
        return heads(jax.nn.log_sigmoid(z.astype(f32)) / GLA_GATE_TAU, GLA_HEAD_K)

    def flip(t):
        return t[:, :, ::-1]

    o_f = gla_direction(q, k, v, log_gate(0))
    o_b = flip(gla_direction(flip(q), flip(k), flip(v), flip(log_gate(1))))
    o = o_f + o_b
    o = o * lax.rsqrt(jnp.mean(o * o, axis=-1, keepdims=True) + EPS)
    o = o.transpose(0, 2, 1, 3).reshape(bsz, L, GLA_DV) * norm_g.astype(f32)
    o = o.astype(h.dtype) * jax.nn.silu(r)
    return o @ w_out


def trunk(x, c, ada_w, ada_b, norm1_g, norm2_g,
          s5_lam_re, s5_lam_im, s5_log_dt, s5_b_re, s5_b_im, s5_c_re, s5_c_im, s5_d, s5_w_glu,
          gla_w_in, gla_w_a1, gla_w_a2, gla_b_a, gla_norm_g, gla_w_out,
          mlp_w1, mlp_w2, final_g):
    mod_all = jnp.einsum('bd,ldm->lbm', jax.nn.silu(c), ada_w) + ada_b[:, None]
    for i in range(DEPTH):
        shift1, scale1, gate1, shift2, scale2, gate2 = jnp.split(mod_all[i][:, None, :], N_MOD, axis=-1)
        h = rmsnorm(x, norm1_g[i]) * (1.0 + scale1) + shift1
        j = i // N_MIXERS
        if i % N_MIXERS == 0:
            m = s5_mixer(h, s5_lam_re[j], s5_lam_im[j], s5_log_dt[j], s5_b_re[j], s5_b_im[j],
                         s5_c_re[j], s5_c_im[j], s5_d[j], s5_w_glu[j])
        else:
            m = gla_mixer(h, gla_w_in[j], gla_w_a1[j], gla_w_a2[j], gla_b_a[j], gla_norm_g[j], gla_w_out[j])
        x = x + gate1 * m
        h = rmsnorm(x, norm2_g[i]) * (1.0 + scale2) + shift2
        x = x + gate2 * (jnp.square(jax.nn.relu(h @ mlp_w1[i])) @ mlp_w2[i])
    return rmsnorm(x, final_g)


def setup_inputs(seed: int = 0) -> dict:
    key = jax.random.key(seed)
    ks = iter(jax.random.split(key, 32))
    f32 = jnp.float32

    def nrm(shape, std):
        return std * jax.random.normal(next(ks), shape, f32)

    sa = (N_A_LAYERS, 2, S5_GROUPS, S5_STATE)
    return {
        'x_prompt': nrm((BATCH, SEQ, D_MODEL), 1.0),
        'x_sample': nrm((DEC_BATCH, DEC_SEQ, D_MODEL), 1.0),
        'c_prompt': nrm((BATCH, D_MODEL), 1.0),
        'c_sample': nrm((DEC_BATCH, D_MODEL), 1.0),
        'ada_w': nrm((DEPTH, D_MODEL, N_MOD * D_MODEL), 0.5 * D_MODEL ** -0.5),
        'ada_b': nrm((DEPTH, N_MOD * D_MODEL), 0.02),
        'norm1_g': 1.0 + nrm((DEPTH, D_MODEL), 0.02),
        'norm2_g': 1.0 + nrm((DEPTH, D_MODEL), 0.02),
        's5_lam_re': -0.5 + nrm(sa, 0.01),
        's5_lam_im': math.pi * jnp.arange(S5_STATE, dtype=f32) + nrm(sa, 0.01),
        's5_log_dt': jax.random.uniform(next(ks), (N_A_LAYERS, 2, S5_GROUPS), f32,
                                        math.log(1e-3), math.log(1e-1)),
        's5_b_re': nrm((N_A_LAYERS, 2, S5_GROUPS, S5_STATE, S5_GROUP), (2 * S5_GROUP) ** -0.5),
        's5_b_im': nrm((N_A_LAYERS, 2, S5_GROUPS, S5_STATE, S5_GROUP), (2 * S5_GROUP) ** -0.5),
        's5_c_re': nrm((N_A_LAYERS, 2, S5_GROUPS, S5_GROUP, S5_STATE), 0.7),
        's5_c_im': nrm((N_A_LAYERS, 2, S5_GROUPS, S5_GROUP, S5_STATE), 0.7),
        's5_d': nrm((N_A_LAYERS, D_MODEL), 1.0),
        's5_w_glu': nrm((N_A_LAYERS, D_MODEL, 2 * D_MODEL), D_MODEL ** -0.5),
        'gla_w_in': nrm((N_B_LAYERS, D_MODEL, 2 * GLA_DK + 2 * GLA_DV), D_MODEL ** -0.5),
        'gla_w_a1': nrm((N_B_LAYERS, 2, D_MODEL, GLA_GATE_RANK), D_MODEL ** -0.5),
        'gla_w_a2': nrm((N_B_LAYERS, 2, GLA_GATE_RANK, GLA_DK), GLA_GATE_RANK ** -0.5),
        'gla_b_a': nrm((N_B_LAYERS, 2, GLA_DK), 0.01),
        'gla_norm_g': 1.0 + nrm((N_B_LAYERS, GLA_DV), 0.02),
        'gla_w_out': nrm((N_B_LAYERS, GLA_DV, D_MODEL), GLA_DV ** -0.5),
        'mlp_w1': nrm((DEPTH, D_MODEL, D_FF), D_MODEL ** -0.5),
        'mlp_w2': nrm((DEPTH, D_FF, D_MODEL), D_FF ** -0.5),
        'final_g': 1.0 + nrm((D_MODEL,), 0.02),
    }


def reference(x_prompt, x_sample, c_prompt, c_sample, ada_w, ada_b, norm1_g, norm2_g,
              s5_lam_re, s5_lam_im, s5_log_dt, s5_b_re, s5_b_im, s5_c_re, s5_c_im, s5_d, s5_w_glu,
              gla_w_in, gla_w_a1, gla_w_a2, gla_b_a, gla_norm_g, gla_w_out,
              mlp_w1, mlp_w2, final_g):
    y_prompt = trunk(x_prompt, c_prompt, ada_w, ada_b, norm1_g, norm2_g,
                     s5_lam_re, s5_lam_im, s5_log_dt, s5_b_re, s5_b_im, s5_c_re, s5_c_im, s5_d, s5_w_glu,
                     gla_w_in, gla_w_a1, gla_w_a2, gla_b_a, gla_norm_g, gla_w_out,
                     mlp_w1, mlp_w2, final_g)
    y_sample = trunk(x_sample, c_sample, ada_w, ada_b, norm1_g, norm2_g,
                     s5_lam_re, s5_lam_im, s5_log_dt, s5_b_re, s5_b_im, s5_c_re, s5_c_im, s5_d, s5_w_glu,
                     gla_w_in, gla_w_a1, gla_w_a2, gla_b_a, gla_norm_g, gla_w_out,
                     mlp_w1, mlp_w2, final_g)
    return (y_prompt, y_sample)
```

```cpp
#include <hip/hip_runtime.h>
#include <hip/hip_cooperative_groups.h>
#include <cstdio>
namespace cg = cooperative_groups;

namespace pg8 {
#define PG8_LAS __attribute__((address_space(3)))
typedef unsigned short bf16_t;
typedef short bf16x8 __attribute__((ext_vector_type(8)));
typedef float f32x4 __attribute__((ext_vector_type(4)));
typedef unsigned u32x4 __attribute__((ext_vector_type(4)));
constexpr int BM = 256, BK = 64, HALF = 128, HTB = HALF * BK * 2  , STAGE_BYTES = 8 * HTB, NXCD = 8, WGM = 8;

__host__ __device__ __forceinline__ int lds_byte(int r, int c) { const int st = (r >> 4) * 2 + (c >> 5), rr = r & 15, cc = c & 31, ob = rr * 64 + cc * 2; return st * 1024 + (ob ^ (((ob >> 9) & 1) << 5)); }
__host__ __device__ __forceinline__ void stage_rc(int b, int& R, int& C) { const int st = b / 1024, sb = b % 1024, swz = sb ^ (((sb >> 9) & 1) << 5); R = (st >> 1) * 16 + swz / 64; C = (st & 1) * 32 + (swz % 64) / 2; }
__host__ __device__ __forceinline__ int perm32(int rho) { const int n = rho >> 4, i = rho & 15; return 8 * (i >> 2) + 4 * n + (i & 3); }

struct Unit { int pm, pn; };
struct Gemm { const bf16_t* A; const bf16_t* Bt; int M, N, K; };

struct StaticOrder {
    int nM, nN, nwg, G, c;
    __host__ __device__ void init(int M, int N, int G_, int c_) { nM = M / BM; nN = N / BM; nwg = nM * nN; G = G_; c = c_; }
    __host__ __device__ bool next(int i, Unit& u) const {
        const long L = (long)i * G + c; if (L >= nwg) return false;
        int wgid = (int)L; { const int q = nwg / NXCD, r = nwg % NXCD, xcd = wgid % NXCD, off = wgid / NXCD; wgid = (xcd < r ? xcd * (q + 1) : r * (q + 1) + (xcd - r) * q) + off; }
        const int nig = WGM * nN, gid = wgid / nig, fm = gid * WGM, gsz = (nM - fm) < WGM ? (nM - fm) : WGM;
        u.pm = fm + ((wgid % nig) % gsz); u.pn = (wgid % nig) / gsz; return true;
    }
    __device__ __forceinline__ void a_ready(const Unit&) const {}
    __device__ __forceinline__ void done(const Unit&) const {}
};


template <class Epi, class Sched, bool STAMP = false>
__device__ __forceinline__ void gemm_phase(PG8_LAS unsigned char* lds, const Gemm g, const Sched& S, const Epi& E, unsigned long long* stamps) {
    const int tid = threadIdx.x, wid = __builtin_amdgcn_readfirstlane(tid >> 6), lane = tid & 63, wr = wid >> 2, wc = wid & 3, fr = lane & 15, fq = lane >> 4;
    const int K = g.K, nt = K / BK;
    int ts_lo = 0, ts_hi = 0, nts = 0; const unsigned long long rt_entry = STAMP ? (unsigned long long)wall_clock64() : 0ull;
#define PG8_STAMP() do { if (STAMP && wid == 0 && nts < 64) { const unsigned long long _c = (unsigned long long)clock64(); \
        ts_lo = (lane == nts) ? (int)(unsigned)_c : ts_lo; ts_hi = (lane == nts) ? (int)(unsigned)(_c >> 32) : ts_hi; ++nts; } } while (0)
    PG8_STAMP();
    unsigned voffA[2], voffB[2];
#pragma unroll
    for (int i = 0; i < 2; ++i) { int R, C; stage_rc(tid * 16 + i * 8192, R, C); const int Rb = Epi::PERM ? ((R & ~31) + perm32(R & 31)) : R;
        voffA[i] = (unsigned)(R * K + C) * 2u; voffB[i] = (unsigned)(Rb * K + C) * 2u; }
    const size_t kstep = (size_t)(BK * 2);
    const size_t hstep = (size_t)HALF * K * 2;
    const size_t tstep = 2 * hstep;
    const unsigned ldsw = (unsigned)wid * 1024u;
    const int aoff = lds_byte(wr * 64 + fr, fq * 8), boff = lds_byte(wc * 32 + fr, fq * 8);
#define PG8_SA(b, h) (((b) * 2 + (h)) * HTB)
#define PG8_SB(b, h) ((4 + (b) * 2 + (h)) * HTB)
#define PG8_STAGE(bufoff, gbase, voff) do { _Pragma("unroll") for (int _i = 0; _i < 2; ++_i) \
        __builtin_amdgcn_global_load_lds((const unsigned*)((const char*)(gbase) + (voff)[_i]), (PG8_LAS unsigned*)(lds + (bufoff) + ldsw + _i * 8192), 16, 0, 0); } while (0)
#define PG8_LDA(dst, b, h) do { _Pragma("unroll") for (int m = 0; m < 4; ++m) _Pragma("unroll") for (int k = 0; k < 2; ++k) dst[m][k] = *(const PG8_LAS bf16x8*)(lds + PG8_SA(b, h) + aoff + m * 2048 + k * 1024); } while (0)
#define PG8_LDB(dst, b, h) do { _Pragma("unroll") for (int n = 0; n < 2; ++n) _Pragma("unroll") for (int k = 0; k < 2; ++k) dst[n][k] = *(const PG8_LAS bf16x8*)(lds + PG8_SB(b, h) + boff + n * 2048 + k * 1024); } while (0)
#define PG8_MMA(ai, bj, At, Bt) do { __builtin_amdgcn_s_setprio(1); _Pragma("unroll") for (int m = 0; m < 4; ++m) _Pragma("unroll") for (int n = 0; n < 2; ++n) _Pragma("unroll") for (int k = 0; k < 2; ++k) \
        acc[ai][bj][m][n] = __builtin_amdgcn_mfma_f32_16x16x32_bf16(Bt[n][k], At[m][k], acc[ai][bj][m][n], 0, 0, 0); __builtin_amdgcn_s_setprio(0); } while (0)
#define PG8_WAIT_V(n) asm volatile("s_waitcnt vmcnt(" #n ")" ::: "memory")
#define PG8_WAIT_L(n) asm volatile("s_waitcnt lgkmcnt(" #n ")" ::: "memory")
#define PG8_BAR __builtin_amdgcn_s_barrier()
#define PG8_SCHED __builtin_amdgcn_sched_barrier(0)
    Unit cur, nxt; int ui = 0;
    if (!S.next(0, cur)) return;
    f32x4 acc[2][2][4][2];
#pragma unroll
    for (int a = 0; a < 2; ++a)
#pragma unroll
        for (int b = 0; b < 2; ++b)
#pragma unroll
            for (int m = 0; m < 4; ++m)
#pragma unroll
                for (int n = 0; n < 2; ++n) acc[a][b][m][n] = (f32x4){0.f, 0.f, 0.f, 0.f};
    bf16x8 At[4][2], B0[2][2], B1[2][2];
    const char* cA = (const char*)g.A + (size_t)cur.pm * tstep; const char* cB = (const char*)g.Bt + (size_t)cur.pn * tstep;
    S.a_ready(cur);
    PG8_STAGE(PG8_SB(0, 0), cB, voffB); PG8_STAGE(PG8_SA(0, 0), cA, voffA); PG8_STAGE(PG8_SB(0, 1), cB + hstep, voffB); PG8_STAGE(PG8_SA(0, 1), cA + hstep, voffA);
    if (wr == 1) PG8_BAR;
    PG8_WAIT_V(4); PG8_BAR;
    PG8_STAGE(PG8_SB(1, 0), cB + kstep, voffB); PG8_STAGE(PG8_SA(1, 0), cA + kstep, voffA); PG8_STAGE(PG8_SB(1, 1), cB + hstep + kstep, voffB);
    PG8_WAIT_V(6); PG8_BAR;
    PG8_STAMP();
    for (;;) {
        const bool has_next = S.next(ui + 1, nxt);
        const char* nA = has_next ? (const char*)g.A + (size_t)nxt.pm * tstep : cA; const char* nB = has_next ? (const char*)g.Bt + (size_t)nxt.pn * tstep : cB;
        for (int t = 0; t < nt; t += 2) {
            const bool last = (t == nt - 2);
            const char* a1 = cA + (size_t)(t + 1) * kstep;
            const char* a2 = last ? nA : cA + (size_t)(t + 2) * kstep; const char* b2 = last ? nB : cB + (size_t)(t + 2) * kstep;
            const char* a3 = a2 + kstep; const char* b3 = b2 + kstep;
            if (last && has_next) S.a_ready(nxt);
            PG8_LDB(B0, 0, 0); PG8_SCHED; PG8_LDA(At, 0, 0); PG8_STAGE(PG8_SA(1, 1), a1 + hstep, voffA);
            PG8_WAIT_L(8); PG8_BAR; PG8_WAIT_L(0); PG8_MMA(0, 0, At, B0); PG8_BAR; PG8_SCHED;
            PG8_LDB(B1, 0, 1); PG8_STAGE(PG8_SB(0, 0), b2, voffB);
            PG8_BAR; PG8_WAIT_L(0); PG8_MMA(0, 1, At, B1); PG8_BAR;
            PG8_LDA(At, 0, 1); PG8_STAGE(PG8_SA(0, 0), a2, voffA);
            PG8_BAR; PG8_WAIT_L(0); PG8_MMA(1, 0, At, B0); PG8_BAR; PG8_SCHED;
            PG8_STAGE(PG8_SB(0, 1), b2 + hstep, voffB);
            PG8_WAIT_V(6); PG8_BAR; PG8_MMA(1, 1, At, B1); PG8_BAR;
            PG8_LDB(B0, 1, 0); PG8_SCHED; PG8_LDA(At, 1, 0); PG8_STAGE(PG8_SA(0, 1), a2 + hstep, voffA);
            PG8_WAIT_L(8); PG8_BAR; PG8_WAIT_L(0); PG8_MMA(0, 0, At, B0); PG8_BAR; PG8_SCHED;
            PG8_LDB(B1, 1, 1); PG8_STAGE(PG8_SB(1, 0), b3, voffB);
            PG8_BAR; PG8_WAIT_L(0); PG8_MMA(0, 1, At, B1); PG8_BAR;
            PG8_LDA(At, 1, 1); PG8_STAGE(PG8_SA(1, 0), a3, voffA);
            PG8_BAR; PG8_WAIT_L(0); PG8_MMA(1, 0, At, B0); PG8_BAR; PG8_SCHED;
            PG8_STAGE(PG8_SB(1, 1), b3 + hstep, voffB);
            PG8_WAIT_V(6); PG8_BAR; PG8_MMA(1, 1, At, B1); PG8_BAR;
        }
        PG8_STAMP();
        if constexpr (!Epi::AFTER_DRAIN) { E(acc, cur, wr, wc, fr, fq); S.done(cur); }
        PG8_STAMP();
        if (!has_next) break;
#pragma unroll
        for (int a = 0; a < 2; ++a)
#pragma unroll
            for (int b = 0; b < 2; ++b)
#pragma unroll
                for (int m = 0; m < 4; ++m)
#pragma unroll
                    for (int n = 0; n < 2; ++n) acc[a][b][m][n] = (f32x4){0.f, 0.f, 0.f, 0.f};
        cur = nxt; cA = nA; cB = nB; ++ui;
    }
    PG8_WAIT_V(0);
    if (wr == 0) PG8_BAR;
    PG8_BAR;
    if constexpr (Epi::AFTER_DRAIN) { E.fused(acc, cur, wr, wc, fr, fq, lds, wid, lane); S.done(cur); }
    PG8_STAMP();
    if (STAMP && wid == 0) { stamps[lane] = lane < nts ? (((unsigned long long)(unsigned)ts_hi << 32) | (unsigned)ts_lo) : 0ull;
        if (lane == 62) stamps[62] = rt_entry; if (lane == 63) stamps[63] = (unsigned long long)wall_clock64(); }
#undef PG8_STAMP
#undef PG8_SA
#undef PG8_SB
#undef PG8_STAGE
#undef PG8_LDA
#undef PG8_LDB
#undef PG8_MMA
#undef PG8_WAIT_V
#undef PG8_WAIT_L
#undef PG8_BAR
#undef PG8_SCHED
}
}


#define LAS __attribute__((address_space(3)))
typedef unsigned short bf16_t;
typedef short bf16x8 __attribute__((ext_vector_type(8)));
typedef short bf16x4 __attribute__((ext_vector_type(4)));
typedef float f32x4 __attribute__((ext_vector_type(4)));
typedef float f32x16 __attribute__((ext_vector_type(16)));
typedef unsigned u32x4 __attribute__((ext_vector_type(4)));
typedef unsigned u32x2 __attribute__((ext_vector_type(2)));

constexpr int D = 1024, T = 49152, NSEQ = 10, NMODC = 6144, FF = 4096;
constexpr int T_PROMPT = 32768;
constexpr float EPS = 1e-6f;
#ifndef PH
#define PH 16383
#endif
constexpr int NWAVES = 8, NTHREADS = 512;
constexpr int LDS_BYTES = 139264;
constexpr int WIN_N = 3328;
constexpr int PROJ_N = 3072;

constexpr size_t MiB = 1u << 20;
constexpr size_t WS_MOD = 0;
constexpr size_t WS_ABAR = 512 * 1024;
constexpr size_t WS_BBT = 1 * MiB;
constexpr size_t WS_CT = 1 * MiB + 512 * 1024;
constexpr size_t WS_DTOT = 2 * MiB;
constexpr size_t WS_A1 = 3 * MiB;
constexpr size_t WS_WIN = 10 * MiB;
constexpr size_t WS_WOUT = WS_WIN + (size_t)WIN_N * D * 2;
constexpr size_t WS_W1B = WS_WOUT + (size_t)D * D * 2;
constexpr size_t WS_W2B = WS_W1B + (size_t)FF * D * 2;
constexpr size_t WS_HBUF = 35 * MiB;
constexpr size_t WS_BIG = 131 * MiB;
constexpr size_t WS_S5E = WS_BIG + 96 * MiB;
constexpr size_t WS_X = 419 * MiB;
constexpr size_t WS_WGLU = WS_X;
constexpr size_t WS_W1A = WS_X + 4 * MiB;
constexpr size_t WS_W2A = WS_X + 12 * MiB;
constexpr size_t WS_SBUF = WS_X;
constexpr size_t WS_END = 467 * MiB;
static_assert(WS_W2B + (size_t)FF * D * 2 <= WS_HBUF, "ws map");

struct P { const float* in[26]; float* out; unsigned char* ws; };

typedef __bf16 bf16n2 __attribute__((ext_vector_type(2)));
typedef float f32x2n __attribute__((ext_vector_type(2)));
__device__ __forceinline__ unsigned pk_bf16(float lo, float hi) { const f32x2n f = {lo, hi}; const bf16n2 v = __builtin_convertvector(f, bf16n2); return __builtin_bit_cast(unsigned, v); }
__device__ __forceinline__ bf16_t f2bf(float f) { return (bf16_t)(pk_bf16(f, 0.f) & 0xffffu); }
__device__ __forceinline__ float bf2f(bf16_t b) { return __uint_as_float(((unsigned)b) << 16); }
__device__ __forceinline__ float wave_sum(float v) {
#pragma unroll
    for (int o = 1; o < 64; o <<= 1) v += __shfl_xor(v, o);
    return v;
}
__device__ __forceinline__ int row_seq(int row) { return row < T_PROMPT ? (row >> 14) : 2 + ((row - T_PROMPT) >> 11); }
__device__ __forceinline__ float sigmoidf_(float x) { return 1.0f / (1.0f + __expf(-x)); }
__device__ __forceinline__ float gelu_tanh(float y) {
    const float a = 0.7978845608028654f * (y + 0.044715f * y * y * y);
    const float th = 1.0f - 2.0f / (__expf(2.0f * a) + 1.0f);
    return 0.5f * y * (1.0f + th);
}
#define CFENCE() asm volatile("" ::: "memory")
#define LDS_WAIT() asm volatile("s_waitcnt lgkmcnt(0)" ::: "memory")

struct EpiRes {
    static constexpr bool PERM = false, AFTER_DRAIN = false;
    float* x; const float* gate; int row_off;
    __device__ __forceinline__ void operator()(const pg8::f32x4 (&acc)[2][2][4][2], const pg8::Unit& u, int wr, int wc, int fr, int fq) const {
        const int row0 = row_off + u.pm * 256 + wr * 64 + fr, col0 = u.pn * 256 + wc * 32 + 4 * fq;
        const float* gp = gate + (size_t)row_seq(row_off + u.pm * 256) * NMODC;
        pg8::f32x4 gv[2][2];
#pragma unroll
        for (int bj = 0; bj < 2; ++bj)
#pragma unroll
            for (int n = 0; n < 2; ++n) gv[bj][n] = *(const pg8::f32x4*)(gp + col0 + bj * 128 + n * 16);
#pragma unroll
        for (int ai = 0; ai < 2; ++ai)
#pragma unroll
            for (int m = 0; m < 4; ++m) { float* rowp = x + (size_t)(row0 + ai * 128 + m * 16) * D + col0;
#pragma unroll
                for (int bj = 0; bj < 2; ++bj)
#pragma unroll
                    for (int n = 0; n < 2; ++n) { pg8::f32x4* q = (pg8::f32x4*)(rowp + bj * 128 + n * 16); *q = *q + gv[bj][n] * acc[ai][bj][m][n]; }
                asm volatile("" ::: "memory"); }
    }
};
struct EpiGlu {
    static constexpr bool PERM = false, AFTER_DRAIN = false;
    const float* xp; const float* xs; float* out; const float* gate;
    __device__ __forceinline__ void operator()(const pg8::f32x4 (&acc)[2][2][4][2], const pg8::Unit& u, int wr, int wc, int fr, int fq) const {
        const int row0 = u.pm * 256 + wr * 64 + fr, col0 = u.pn * 128 + wc * 32 + 4 * fq;
        const float* gp = gate + (size_t)row_seq(u.pm * 256) * NMODC;
        pg8::f32x4 gv[2];
#pragma unroll
        for (int n = 0; n < 2; ++n) gv[n] = *(const pg8::f32x4*)(gp + col0 + n * 16);
#pragma unroll
        for (int ai = 0; ai < 2; ++ai)
#pragma unroll
            for (int m = 0; m < 4; ++m) { const int row = row0 + ai * 128 + m * 16;
                const float* xin = row < T_PROMPT ? xp + (size_t)row * D : xs + (size_t)(row - T_PROMPT) * D;
#pragma unroll
                for (int n = 0; n < 2; ++n) { const pg8::f32x4 val = acc[ai][0][m][n], gt = acc[ai][1][m][n]; pg8::f32x4 sg;
                    sg[0] = sigmoidf_(gt[0]); sg[1] = sigmoidf_(gt[1]); sg[2] = sigmoidf_(gt[2]); sg[3] = sigmoidf_(gt[3]);
                    const pg8::f32x4 xv = *(const pg8::f32x4*)(xin + col0 + n * 16);
                    *(pg8::f32x4*)(out + (size_t)row * D + col0 + n * 16) = xv + gv[n] * val * sg; }
                asm volatile("" ::: "memory"); }
    }
};
template <int ACT> struct EpiBf {
    static constexpr bool PERM = true, AFTER_DRAIN = false;
    bf16_t* O; int ldc; float* a1;
    __device__ __forceinline__ void operator()(const pg8::f32x4 (&acc)[2][2][4][2], const pg8::Unit& u, int wr, int wc, int fr, int fq) const {
        const int row0 = u.pm * 256 + wr * 64 + fr;
        if (ACT == 0 && u.pn == 12) {
            if (wc == 0) {
#pragma unroll
                for (int ai = 0; ai < 2; ++ai)
#pragma unroll
                    for (int m = 0; m < 4; ++m) { float* rp = a1 + (size_t)(row0 + ai * 128 + m * 16) * 32 + 8 * fq;
                        *(pg8::f32x4*)rp = acc[ai][0][m][0]; *(pg8::f32x4*)(rp + 4) = acc[ai][0][m][1]; }
            }
            return;
        }
        const int col0 = u.pn * 256 + wc * 32 + 8 * fq;
#pragma unroll
        for (int ai = 0; ai < 2; ++ai)
#pragma unroll
            for (int m = 0; m < 4; ++m) { bf16_t* rowp = O + (size_t)(row0 + ai * 128 + m * 16) * ldc + col0;
#pragma unroll
                for (int bj = 0; bj < 2; ++bj) { pg8::f32x4 v0 = acc[ai][bj][m][0], v1 = acc[ai][bj][m][1];
                    if (ACT == 1) {
#pragma unroll
                        for (int e = 0; e < 4; ++e) { const float a = fmaxf(v0[e], 0.f), b = fmaxf(v1[e], 0.f); v0[e] = a * a; v1[e] = b * b; } }
                    pg8::u32x4 wv; wv.x = pk_bf16(v0[0], v0[1]); wv.y = pk_bf16(v0[2], v0[3]); wv.z = pk_bf16(v1[0], v1[1]); wv.w = pk_bf16(v1[2], v1[3]);
                    *(pg8::u32x4*)(rowp + bj * 128) = wv; } }
    }
};

__device__ __forceinline__ void transpose_item(const float* W, int K, int N, int srccol0, bf16_t* WT, int dstrow0, int k0, LAS float* scr, int lane) {
#pragma unroll 8
    for (int i = 0; i < 32; ++i) { const int kk = 2 * i + (lane >> 5); scr[kk * 33 + (lane & 31)] = W[(size_t)(k0 + kk) * N + srccol0 + (lane & 31)]; }
    LDS_WAIT();
    const int c = lane & 7;
#pragma unroll
    for (int j = 0; j < 4; ++j) { const int n = (lane >> 3) + 8 * j; const LAS float* s = scr + (8 * c) * 33 + n;
        u32x4 o; o.x = pk_bf16(s[0 * 33], s[1 * 33]); o.y = pk_bf16(s[2 * 33], s[3 * 33]); o.z = pk_bf16(s[4 * 33], s[5 * 33]); o.w = pk_bf16(s[6 * 33], s[7 * 33]);
        *(u32x4*)(WT + (size_t)(dstrow0 + n) * K + k0 + 8 * c) = o; }
    LDS_WAIT();
}

__device__ __forceinline__ void p0_prep(const P& p, LAS unsigned char* lds) {
    const int tid = threadIdx.x, lane = tid & 63, w = tid >> 6;
    unsigned char* ws = p.ws;
    if ((int)blockIdx.x < 192) {
        LAS float* sc = (LAS float*)lds;
        LAS float* red = (LAS float*)(lds + 40960);
        for (int i = tid; i < NSEQ * D; i += NTHREADS) { const int s = i >> 10, d = i & 1023; const float c = s < 2 ? p.in[2][s * D + d] : p.in[3][(s - 2) * D + d]; sc[i] = c * sigmoidf_(c); }
        __syncthreads();
        for (int it = blockIdx.x; it < 192; it += gridDim.x) {
            const int l = it / 96, col0 = (it % 96) * 64, col = tid & 63, ks = w;
            float acc[NSEQ];
#pragma unroll
            for (int s = 0; s < NSEQ; ++s) acc[s] = 0.f;
            const float* wp = p.in[4] + ((size_t)l * D + ks * 128) * NMODC + col0 + col;
#pragma unroll 4
            for (int k = 0; k < 128; ++k) { const float wv = wp[(size_t)k * NMODC];
#pragma unroll
                for (int s = 0; s < NSEQ; ++s) acc[s] += sc[s * D + ks * 128 + k] * wv; }
#pragma unroll
            for (int s = 0; s < NSEQ; ++s) red[(ks * NSEQ + s) * 64 + col] = acc[s];
            __syncthreads();
            for (int i = tid; i < NSEQ * 64; i += NTHREADS) { const int s = i >> 6, cc = i & 63; float v = 0.f;
#pragma unroll
                for (int k8 = 0; k8 < 8; ++k8) v += red[(k8 * NSEQ + s) * 64 + cc];
                ((float*)(ws + WS_MOD))[((size_t)l * NSEQ + s) * NMODC + col0 + cc] = v + p.in[5][l * NMODC + col0 + cc]; }
            __syncthreads();
        }
    }
    __syncthreads();
    {
        LAS float* scr = (LAS float*)(lds + w * 16384);
        const int gw = blockIdx.x * NWAVES + w, NGW = gridDim.x * NWAVES;
        constexpr int I_GLU = 16 * 64, I_WIN = 16 * 96, I_WOUT = 16 * 32, I_W1 = 16 * 128, I_W2 = 64 * 32;
        constexpr int NITEMS = I_GLU + I_WIN + I_WOUT + 2 * I_W1 + 2 * I_W2;
        for (int it = gw; it < NITEMS; it += NGW) {
            int r = it;
            if (r < I_GLU) { const int kb = r / 64, nb = r % 64, n0 = nb * 32, pn = n0 >> 8, bj = (n0 >> 7) & 1, r0 = n0 & 127;
                transpose_item(p.in[16], D, 2 * D, bj * D + pn * 128 + r0, (bf16_t*)(ws + WS_WGLU), n0, kb * 64, scr, lane); continue; }
            r -= I_GLU;
            if (r < I_WIN) { const int kb = r / 96, nb = r % 96; transpose_item(p.in[17], D, PROJ_N, nb * 32, (bf16_t*)(ws + WS_WIN), nb * 32, kb * 64, scr, lane); continue; }
            r -= I_WIN;
            if (r < I_WOUT) { const int kb = r / 32, nb = r % 32; transpose_item(p.in[22], D, D, nb * 32, (bf16_t*)(ws + WS_WOUT), nb * 32, kb * 64, scr, lane); continue; }
            r -= I_WOUT;
            if (r < 2 * I_W1) { const int l = r / I_W1, q = r % I_W1, kb = q / 128, nb = q % 128;
                transpose_item(p.in[23] + (size_t)l * D * FF, D, FF, nb * 32, (bf16_t*)(ws + (l ? WS_W1B : WS_W1A)), nb * 32, kb * 64, scr, lane); continue; }
            r -= 2 * I_W1;
            { const int l = r / I_W2, q = r % I_W2, kb = q / 32, nb = q % 32;
                transpose_item(p.in[24] + (size_t)l * FF * D, FF, D, nb * 32, (bf16_t*)(ws + (l ? WS_W2B : WS_W2A)), nb * 32, kb * 64, scr, lane); }
        }
        bf16_t* wt = (bf16_t*)(ws + WS_WIN);
        for (int i = blockIdx.x * NTHREADS + tid; i < 256 * D; i += gridDim.x * NTHREADS) { const int r = i >> 10, k = i & 1023;
            const float v = r < 32 ? p.in[18][((size_t)(r >> 4) * D + k) * 16 + (r & 15)] : 0.f;
            wt[(size_t)(PROJ_N + r) * D + k] = f2bf(v); }
    }
    for (int i = blockIdx.x * NTHREADS + tid; i < 2 * 64 * 64; i += gridDim.x * NTHREADS) {
        const int pp = i & 63, dg = i >> 6;
        const float lr = p.in[8][i], li = p.in[9][i], dt = __expf(p.in[10][dg]);
        const float mag = __expf(lr * dt); float sn, cs; sincosf(li * dt, &sn, &cs);
        const float abr = mag * cs, abi = mag * sn, den = lr * lr + li * li;
        const float zr = ((abr - 1.0f) * lr + abi * li) / den, zi = (abi * lr - (abr - 1.0f) * li) / den;
        float* ab = (float*)(ws + WS_ABAR); ab[2 * i] = abr; ab[2 * i + 1] = abi;
        bf16_t* bbt = (bf16_t*)(ws + WS_BBT); bf16_t* ct = (bf16_t*)(ws + WS_CT);
#pragma unroll
        for (int h = 0; h < 16; ++h) {
            const float br = p.in[11][(size_t)i * 16 + h], bi = p.in[12][(size_t)i * 16 + h];
            bbt[((size_t)dg * 128 + pp) * 16 + h] = f2bf(zr * br - zi * bi);
            bbt[((size_t)dg * 128 + 64 + pp) * 16 + h] = f2bf(zr * bi + zi * br);
            ct[((size_t)dg * 16 + h) * 128 + pp] = f2bf(p.in[13][((size_t)dg * 16 + h) * 64 + pp]);
            ct[((size_t)dg * 16 + h) * 128 + 64 + pp] = f2bf(-p.in[14][((size_t)dg * 16 + h) * 64 + pp]);
        }
    }
}

template <int SRC, bool FINAL>
__device__ __forceinline__ void norm_phase(const P& p, const float* gvec, const float* shift, const float* scale) {
    const int tid = threadIdx.x, lane = tid & 63, w = tid >> 6;
    const int gw = blockIdx.x * NWAVES + w, NGW = gridDim.x * NWAVES;
    bf16_t* hb = (bf16_t*)(p.ws + WS_HBUF);
    f32x4 gq[4];
#pragma unroll
    for (int j = 0; j < 4; ++j) gq[j] = *(const f32x4*)(gvec + 4 * lane + 256 * j);
    for (int row = gw; row < T; row += NGW) {
        const float* xr = SRC == 0 ? (row < T_PROMPT ? p.in[0] + (size_t)row * D : p.in[1] + (size_t)(row - T_PROMPT) * D) : p.out + (size_t)row * D;
        f32x4 v[4]; float ss = 0.f;
#pragma unroll
        for (int j = 0; j < 4; ++j) { v[j] = *(const f32x4*)(xr + 4 * lane + 256 * j); ss += (v[j][0] * v[j][0] + v[j][1] * v[j][1]) + (v[j][2] * v[j][2] + v[j][3] * v[j][3]); }
        const float rstd = rsqrtf(wave_sum(ss) * (1.0f / D) + EPS);
        if (FINAL) {
#pragma unroll
            for (int j = 0; j < 4; ++j) *(f32x4*)(p.out + (size_t)row * D + 4 * lane + 256 * j) = v[j] * rstd * gq[j];
        } else {
            const int s = row_seq(row);
#pragma unroll
            for (int j = 0; j < 4; ++j) { const f32x4 sh = *(const f32x4*)(shift + (size_t)s * NMODC + 4 * lane + 256 * j), sc = *(const f32x4*)(scale + (size_t)s * NMODC + 4 * lane + 256 * j);
                const f32x4 o = (v[j] * rstd * gq[j]) * (sc + 1.0f) + sh;
                u32x2 wv; wv.x = pk_bf16(o[0], o[1]); wv.y = pk_bf16(o[2], o[3]);
                *(u32x2*)(hb + (size_t)row * D + 4 * lane + 256 * j) = wv; }
        }
    }
}

constexpr int S5_NCH = 384, S5_ROW = 132, S5_WAVE_LDS = 32 * S5_ROW * 4;
template <bool PC>
__device__ __forceinline__ void s5_pass(const P& p, LAS unsigned char* lds) {
    const int tid = threadIdx.x, lane = tid & 63, w = __builtin_amdgcn_readfirstlane(tid >> 6);
    const int b = blockIdx.x, g = (b & 7) * 8 + w;
    const int hh = lane >> 5, l32 = lane & 31, l16 = lane & 15, q16 = lane >> 4;
    LAS float* L = (LAS float*)(lds + w * S5_WAVE_LDS);
    const bf16_t* hb = (const bf16_t*)(p.ws + WS_HBUF);
    bf16_t* gout = (bf16_t*)(p.ws + WS_BIG);
    float* E = (float*)(p.ws + WS_S5E);
    const bf16_t* bbt = (const bf16_t*)(p.ws + WS_BBT); const bf16_t* ct = (const bf16_t*)(p.ws + WS_CT); const float* ab = (const float*)(p.ws + WS_ABAR);
    const float dsk = p.in[15][g * 16 + l16];
    for (int c = b >> 3; c < S5_NCH; c += (int)(gridDim.x >> 3)) {
        const int tok0 = c * 128;
        f32x4 yacc[8];
#pragma unroll
        for (int j = 0; j < 8; ++j) yacc[j] = (f32x4){0.f, 0.f, 0.f, 0.f};
#pragma unroll
        for (int dir = 0; dir < 2; ++dir) {
            const size_t eoff = (((size_t)dir * S5_NCH + c) * 64 + g) * 128;
            const int dg = dir * 64 + g;
            bf16x8 Bf[4], Cf[4];
#pragma unroll
            for (int nb = 0; nb < 4; ++nb) Bf[nb] = *(const bf16x8*)(bbt + ((size_t)dg * 128 + nb * 32 + l32) * 16 + 8 * hh);
            const float ar = ab[(dg * 64 + lane) * 2], ai = ab[(dg * 64 + lane) * 2 + 1];
#pragma unroll
            for (int ks = 0; ks < 4; ++ks) Cf[ks] = PC ? *(const bf16x8*)(ct + ((size_t)dg * 16 + l16) * 128 + 32 * ks + 8 * q16) : (bf16x8){0, 0, 0, 0, 0, 0, 0, 0};
            float hr = 0.f, hi = 0.f;
            if (PC) { hr = E[eoff + lane]; hi = E[eoff + 64 + lane]; }
#pragma unroll
            for (int sbi = 0; sbi < 4; ++sbi) {
                const int sb = dir == 0 ? sbi : 3 - sbi;
                const bf16x8 a = *(const bf16x8*)(hb + (size_t)(tok0 + sb * 32 + l32) * D + g * 16 + 8 * hh);
#pragma unroll
                for (int nb = 0; nb < 4; ++nb) {
                    f32x16 acc;
#pragma unroll
                    for (int i = 0; i < 16; ++i) acc[i] = 0.f;
                    acc = __builtin_amdgcn_mfma_f32_32x32x16_bf16(a, Bf[nb], acc, 0, 0, 0);
#pragma unroll
                    for (int i = 0; i < 16; ++i) L[(8 * (i >> 2) + 4 * hh + (i & 3)) * S5_ROW + nb * 32 + l32] = acc[i];
                }
                CFENCE(); LDS_WAIT(); CFENCE();
#pragma unroll 4
                for (int tt = 0; tt < 32; ++tt) {
                    const int t = dir == 0 ? tt : 31 - tt;
                    const float br = L[t * S5_ROW + lane], bi = L[t * S5_ROW + 64 + lane];
                    const float nhr = ar * hr - ai * hi + br, nhi = ar * hi + ai * hr + bi;
                    hr = nhr; hi = nhi;
                    if (PC) { CFENCE(); LAS bf16_t* hrow = (LAS bf16_t*)(L + t * S5_ROW); hrow[lane] = f2bf(hr); hrow[64 + lane] = f2bf(hi); CFENCE(); }
                }
                CFENCE(); LDS_WAIT(); CFENCE();
                if (PC) {
#pragma unroll
                    for (int mb = 0; mb < 2; ++mb)
#pragma unroll
                        for (int ks = 0; ks < 4; ++ks) {
                            const bf16x8 af = *(const LAS bf16x8*)((const LAS unsigned char*)L + (mb * 16 + l16) * (S5_ROW * 4) + (32 * ks + 8 * q16) * 2);
                            yacc[sb * 2 + mb] = __builtin_amdgcn_mfma_f32_16x16x32_bf16(af, Cf[ks], yacc[sb * 2 + mb], 0, 0, 0);
                        }
                    CFENCE(); LDS_WAIT(); CFENCE();
                }
            }
            if (!PC) { E[eoff + lane] = hr; E[eoff + 64 + lane] = hi; }
        }
        if (PC) {
#pragma unroll
            for (int j = 0; j < 8; ++j)
#pragma unroll
                for (int i = 0; i < 4; ++i) { const size_t o = (size_t)(tok0 + j * 16 + i) * D + g * 16; const int vo = 4 * q16 * D + l16;
                    const float y = yacc[j][i] + dsk * bf2f((hb + o)[vo]); (gout + o)[vo] = f2bf(gelu_tanh(y)); if (i == 3) CFENCE(); }
        }
    }
}
__device__ __forceinline__ void s5_carry(const P& p) {
    const int idx = blockIdx.x * NTHREADS + threadIdx.x;
    if (idx >= 2 * NSEQ * 64 * 64) return;
    const int pp = idx & 63, g = (idx >> 6) & 63, s = (idx >> 12) % NSEQ, dir = idx / (NSEQ * 4096);
    const float* ab = (const float*)(p.ws + WS_ABAR);
    float Ar = ab[((dir * 64 + g) * 64 + pp) * 2], Ai = ab[((dir * 64 + g) * 64 + pp) * 2 + 1];
#pragma unroll
    for (int k = 0; k < 7; ++k) { const float nr = Ar * Ar - Ai * Ai, ni = 2.0f * Ar * Ai; Ar = nr; Ai = ni; }
    const int c0 = s < 2 ? s * 128 : 256 + (s - 2) * 16, n = s < 2 ? 128 : 16;
    float* E = (float*)(p.ws + WS_S5E);
    float rr = 0.f, ri = 0.f;
    for (int i0 = 0; i0 < n; i0 += 8) {
        float er[8], ei[8]; size_t ad[8];
#pragma unroll
        for (int k = 0; k < 8; ++k) { const int i = i0 + k, c = dir == 0 ? c0 + i : c0 + n - 1 - i; ad[k] = (((size_t)dir * S5_NCH + c) * 64 + g) * 128 + pp; er[k] = E[ad[k]]; ei[k] = E[ad[k] + 64]; }
#pragma unroll
        for (int k = 0; k < 8; ++k) { E[ad[k]] = rr; E[ad[k] + 64] = ri; const float nr = Ar * rr - Ai * ri + er[k], ni = Ar * ri + Ai * rr + ei[k]; rr = nr; ri = ni; }
    }
}

constexpr int GQ = 0, GK = 17408, GKT = 34816, GVT = 53248, GSC = 90112, GA1 = 99328, GSUM = 103424, GEL = 105472, GRMS = 105984, GRSTD = 108032, GW2 = 108288;
constexpr int QST = 272, TST = 144;
__device__ __forceinline__ void gla_item_coords(int j, int& hd, int& tokbase) {
    hd = j & 3; const int q = j >> 2;
    if (q < 32) tokbase = (q >> 4) * 16384 + (q & 15) * 1024; else tokbase = T_PROMPT + ((q - 32) >> 1) * 2048 + ((q - 32) & 1) * 1024;
}
template <int MODE>
__device__ __forceinline__ void gla_phase(const P& p, LAS unsigned char* lds) {
    const int tid = threadIdx.x, lane = tid & 63, w = __builtin_amdgcn_readfirstlane(tid >> 6), hh = lane >> 5, l32 = lane & 31;
    const int chan = tid & 127, tg = w >> 1;
    const bf16_t* proj = (const bf16_t*)(p.ws + WS_BIG);
    const float* a1b = (const float*)(p.ws + WS_A1);
    bf16_t* hb = (bf16_t*)(p.ws + WS_HBUF);
    float* sbuf = (float*)(p.ws + WS_SBUF); float* dtot = (float*)(p.ws + WS_DTOT);
    LAS unsigned char* const qfrag = lds + GQ + l32 * QST + 16 * hh;
    LAS unsigned char* const kfrag = lds + GK + l32 * QST + 16 * hh;
    LAS unsigned char* const qperm = lds + GQ + l32 * QST + 8 * hh;
    LAS unsigned char* const ktfrag = lds + GKT + l32 * TST + 16 * hh;
    LAS unsigned char* const vtfrag = lds + GVT + (32 * w + l32) * TST + 16 * hh;
    LAS unsigned char* const scfrag = lds + GSC + l32 * TST + 16 * hh;
    LAS unsigned char* const scst = lds + GSC + (4 * hh) * TST + l32 * 2;
    LAS unsigned char* const elrd = lds + GEL + 16 * hh;
    LAS unsigned char* const rmsw = lds + GRMS + (4 * hh) * 32 + w * 4;
    LAS unsigned char* const rstdr = lds + GRSTD + (4 * hh) * 4;
    LAS unsigned char* const qprep = lds + GQ + (16 * tg) * QST + chan * 2;
    LAS unsigned char* const kprep = lds + GK + (16 * tg) * QST + chan * 2;
    LAS unsigned char* const a1rd = lds + GA1 + (16 * tg) * 64;
    const LAS float* const w2p = (const LAS float*)(lds + GW2) + chan;
    const int nitems = MODE == 0 ? 384 : 192;
    for (int it = blockIdx.x; it < nitems; it += gridDim.x) {
        const int dir = MODE == 0 ? it / 192 : (MODE == 1 ? 0 : 1);
        const int j = MODE == 0 ? it % 192 : it, full = dir * 192 + j;
        int hd, tokbase; gla_item_coords(j, hd, tokbase);
        __syncthreads();
        for (int i = tid; i < 16 * 128; i += NTHREADS) ((LAS float*)(lds + GW2))[i] = p.in[19][(size_t)(dir * 16 + (i >> 7)) * 512 + hd * 128 + (i & 127)];
        const float bias = p.in[20][dir * 512 + hd * 128 + chan];
        f32x16 S[4];
        float* const sb0 = sbuf + (size_t)full * 32768 + 32 * w; const int svo = (4 * hh) * 256 + l32;
#pragma unroll
        for (int cb = 0; cb < 4; ++cb)
#pragma unroll
            for (int i = 0; i < 16; ++i) S[cb][i] = MODE == 0 ? 0.f : (sb0 + (32 * cb + 8 * (i >> 2) + (i & 3)) * 256)[svo];
        float dsum = 0.f;
        float ng = 0.f; if (MODE == 2) ng = p.in[21][hd * 256 + 32 * w + l32];
        u32x4 pq[2], pk[2]; f32x4 pa = (f32x4){0.f, 0.f, 0.f, 0.f};
        const int qko = (tid >> 4) * PROJ_N + hd * 128 + (tid & 15) * 8;
        const int vo = (tid >> 5) * PROJ_N + 1024 + hd * 256 + (tid & 31) * 8;
        const int ao = (tid >> 2) * 32 + dir * 16 + (tid & 3) * 4;
#define GLA_LOAD(tbx) do { const bf16_t* pb_ = proj + (size_t)(tbx) * PROJ_N; \
            _Pragma("unroll") for (int i = 0; i < 2; ++i) { pq[i] = *(const u32x4*)(pb_ + (size_t)i * 32 * PROJ_N + qko); pk[i] = *(const u32x4*)(pb_ + (size_t)i * 32 * PROJ_N + 512 + qko); } \
            if (tid < 256) pa = *(const f32x4*)(a1b + (size_t)(tbx) * 32 + ao); } while (0)
        { int tb0 = tokbase + (dir == 0 ? 0 : 15) * 64; GLA_LOAD(tb0); }
        for (int ci = 0; ci < 16; ++ci) {
            int tb = tokbase + (dir == 0 ? ci : 15 - ci) * 64; asm volatile("" : "+s"(tb));
            int tbn = tokbase + (dir == 0 ? ci + 1 : 14 - ci) * 64; asm volatile("" : "+s"(tbn));
            { LAS unsigned char* const qs = lds + GQ + (tid >> 4) * QST + (tid & 15) * 16;
#pragma unroll
              for (int i = 0; i < 2; ++i) { *(LAS u32x4*)(qs + i * 32 * QST) = pq[i]; *(LAS u32x4*)(qs + (GK - GQ) + i * 32 * QST) = pk[i]; } }
            { const bf16_t* vb = proj + (size_t)tb * PROJ_N; LAS unsigned char* const vs = lds + GVT + ((tid & 31) * 8) * TST + (tid >> 5) * 2;
#pragma unroll
              for (int i = 0; i < 4; ++i) { const u32x4 pvv = *(const u32x4*)(vb + (size_t)i * 16 * PROJ_N + vo);
#pragma unroll
                for (int e = 0; e < 4; ++e) { const unsigned v2 = pvv[e];
                    *(LAS bf16_t*)(vs + (2 * e) * TST + i * 32) = (bf16_t)(v2 & 0xffffu);
                    *(LAS bf16_t*)(vs + (2 * e + 1) * TST + i * 32) = (bf16_t)(v2 >> 16); } } }
            if (tid < 256) *(LAS f32x4*)(lds + GA1 + (tid >> 2) * 64 + (tid & 3) * 16) = pa;
            __syncthreads();
            if (ci + 1 < 16) GLA_LOAD(tbn);
            float zc[16];
#pragma unroll
            for (int i = 0; i < 16; ++i) { const LAS f32x4* ap = (const LAS f32x4*)(a1rd + i * 64);
                float z = bias;
#pragma unroll
                for (int r4 = 0; r4 < 4; ++r4) { const f32x4 av = ap[r4]; z += av[0] * w2p[(4 * r4) * 128] + av[1] * w2p[(4 * r4 + 1) * 128] + av[2] * w2p[(4 * r4 + 2) * 128] + av[3] * w2p[(4 * r4 + 3) * 128]; }
                zc[i] = (fminf(z, 0.f) - __logf(1.0f + __expf(-fabsf(z)))) * (1.0f / 16.0f); }
            if (dir == 0) {
#pragma unroll
                for (int i = 1; i < 16; ++i) zc[i] += zc[i - 1];
            } else {
#pragma unroll
                for (int i = 14; i >= 0; --i) zc[i] += zc[i + 1];
            }
            ((LAS float*)(lds + GSUM))[tg * 128 + chan] = dir == 0 ? zc[15] : zc[0];
            __syncthreads();
            float blast, off;
            { const LAS float* gs = (const LAS float*)(lds + GSUM) + chan; const float g0 = gs[0], g1 = gs[128], g2 = gs[256], g3 = gs[384];
                blast = (g0 + g1) + (g2 + g3);
                if (dir == 0) off = (tg > 0 ? g0 : 0.f) + (tg > 1 ? g1 : 0.f) + (tg > 2 ? g2 : 0.f);
                else off = (tg < 3 ? g3 : 0.f) + (tg < 2 ? g2 : 0.f) + (tg < 1 ? g1 : 0.f); }
            {
                float kt[16];
#pragma unroll
                for (int i = 0; i < 16; ++i) { const float bc = zc[i] + off;
                    LAS bf16_t* qp = (LAS bf16_t*)(qprep + i * QST); LAS bf16_t* kp = (LAS bf16_t*)(kprep + i * QST);
                    const float qv = bf2f(*qp), kv = bf2f(*kp);
                    *qp = f2bf(qv * __expf(bc) * 0.08838834764831845f); *kp = f2bf(kv * __expf(-bc)); kt[i] = kv * __expf(blast - bc); }
                u32x4 k0, k1; k0.x = pk_bf16(kt[0], kt[1]); k0.y = pk_bf16(kt[2], kt[3]); k0.z = pk_bf16(kt[4], kt[5]); k0.w = pk_bf16(kt[6], kt[7]);
                k1.x = pk_bf16(kt[8], kt[9]); k1.y = pk_bf16(kt[10], kt[11]); k1.z = pk_bf16(kt[12], kt[13]); k1.w = pk_bf16(kt[14], kt[15]);
                *(LAS u32x4*)(lds + GKT + chan * TST + tg * 32) = k0; *(LAS u32x4*)(lds + GKT + chan * TST + tg * 32 + 16) = k1;
            }
            if (tg == 0) { ((LAS float*)(lds + GEL))[chan] = __expf(blast); dsum += blast; }
            __syncthreads();
            if (MODE != 0) {
                if (w < 4) { const int mb = w >> 1, nb = w & 1; f32x16 sc;
#pragma unroll
                    for (int i = 0; i < 16; ++i) sc[i] = 0.f;
#pragma unroll
                    for (int ks = 0; ks < 8; ++ks) { const bf16x8 a = *(const LAS bf16x8*)(qfrag + mb * 32 * QST + 32 * ks), bq = *(const LAS bf16x8*)(kfrag + nb * 32 * QST + 32 * ks);
                        sc = __builtin_amdgcn_mfma_f32_32x32x16_bf16(a, bq, sc, 0, 0, 0); }
                    const int dlt = (nb - mb) * 32 + l32 - 4 * hh;
                    LAS unsigned char* const sw = scst + mb * 32 * TST + nb * 64;
#pragma unroll
                    for (int i = 0; i < 16; ++i) { const int cst = 8 * (i >> 2) + (i & 3); const bool keep = dir == 0 ? (dlt <= cst) : (dlt >= cst);
                        *(LAS bf16_t*)(sw + cst * TST) = f2bf(keep ? sc[i] : 0.f); }
                }
                __syncthreads();
            }
            bf16x8 vf[4];
#pragma unroll
            for (int ks = 0; ks < 4; ++ks) vf[ks] = *(const LAS bf16x8*)(vtfrag + 32 * ks);
            if (MODE != 0) {
#pragma unroll
                for (int mb = 0; mb < 2; ++mb) {
                    f32x16 o;
#pragma unroll
                    for (int i = 0; i < 16; ++i) o[i] = 0.f;
#pragma unroll
                    for (int ks = 0; ks < 4; ++ks) { const bf16x8 a = *(const LAS bf16x8*)(scfrag + mb * 32 * TST + 32 * ks);
                        o = __builtin_amdgcn_mfma_f32_32x32x16_bf16(a, vf[ks], o, 0, 0, 0); }
#pragma unroll
                    for (int cb = 0; cb < 4; ++cb)
#pragma unroll
                        for (int h2 = 0; h2 < 2; ++h2) {
                            union { u32x4 u; bf16x8 v; } sb_;
                            sb_.u.x = pk_bf16(S[cb][8 * h2 + 0], S[cb][8 * h2 + 1]); sb_.u.y = pk_bf16(S[cb][8 * h2 + 2], S[cb][8 * h2 + 3]);
                            sb_.u.z = pk_bf16(S[cb][8 * h2 + 4], S[cb][8 * h2 + 5]); sb_.u.w = pk_bf16(S[cb][8 * h2 + 6], S[cb][8 * h2 + 7]);
                            const LAS unsigned char* base = qperm + mb * 32 * QST + (32 * cb + 16 * h2) * 2;
                            union { struct { u32x2 lo, hi; } s; bf16x8 v; } qa; qa.s.lo = *(const LAS u32x2*)base; qa.s.hi = *(const LAS u32x2*)(base + 16);
                            o = __builtin_amdgcn_mfma_f32_32x32x16_bf16(qa.v, sb_.v, o, 0, 0, 0);
                        }
                    bf16_t* orow = hb + (size_t)(tb + 32 * mb) * D + hd * 256 + 32 * w; const int ovo = 4 * hh * D + l32;
                    if (MODE == 1) {
#pragma unroll
                        for (int i = 0; i < 16; ++i) (orow + (size_t)(8 * (i >> 2) + (i & 3)) * D)[ovo] = f2bf(o[i]);
                    } else {
#pragma unroll
                        for (int i = 0; i < 16; ++i) { const int cst = 8 * (i >> 2) + (i & 3);
                            const float ov = o[i] + bf2f((orow + (size_t)cst * D)[ovo]); o[i] = ov;
                            float sq = ov * ov;
#pragma unroll
                            for (int sh = 1; sh < 32; sh <<= 1) sq += __shfl_xor(sq, sh);
                            if (l32 == 0) *(LAS float*)(rmsw + (32 * mb + cst) * 32) = sq; }
                        __syncthreads();
                        if (tid < 32) { const int tok = 32 * mb + tid; const LAS f32x4* rp = (const LAS f32x4*)(lds + GRMS + tok * 32); const f32x4 a = rp[0], bq = rp[1];
                            ((LAS float*)(lds + GRSTD))[tok] = rsqrtf(((a[0] + a[1]) + (a[2] + a[3]) + (bq[0] + bq[1]) + (bq[2] + bq[3])) * (1.0f / 256.0f) + EPS); }
                        __syncthreads();
                        const bf16_t* rrow = proj + (size_t)(tb + 32 * mb) * PROJ_N + 2048 + hd * 256 + 32 * w; const int rvo = 4 * hh * PROJ_N + l32;
#pragma unroll
                        for (int i = 0; i < 16; ++i) { const int cst = 8 * (i >> 2) + (i & 3);
                            const float rs = *(const LAS float*)(rstdr + (32 * mb + cst) * 4);
                            const float rv = bf2f((rrow + (size_t)cst * PROJ_N)[rvo]);
                            (orow + (size_t)cst * D)[ovo] = f2bf(o[i] * rs * ng * (rv * sigmoidf_(rv))); }
                    }
                    CFENCE();
                }
            }
#pragma unroll
            for (int cb = 0; cb < 4; ++cb) {
#pragma unroll
                for (int i4 = 0; i4 < 4; ++i4) { const f32x4 e = *(const LAS f32x4*)(elrd + (32 * cb + 8 * i4) * 4);
                    S[cb][4 * i4 + 0] *= e[0]; S[cb][4 * i4 + 1] *= e[1]; S[cb][4 * i4 + 2] *= e[2]; S[cb][4 * i4 + 3] *= e[3]; }
#pragma unroll
                for (int ks = 0; ks < 4; ++ks) { const bf16x8 a = *(const LAS bf16x8*)(ktfrag + cb * 32 * TST + 32 * ks);
                    S[cb] = __builtin_amdgcn_mfma_f32_32x32x16_bf16(a, vf[ks], S[cb], 0, 0, 0); }
            }
            __syncthreads();
        }
#undef GLA_LOAD
        if (MODE == 0) {
#pragma unroll
            for (int cb = 0; cb < 4; ++cb)
#pragma unroll
                for (int i = 0; i < 16; ++i) (sb0 + (32 * cb + 8 * (i >> 2) + (i & 3)) * 256)[svo] = S[cb][i];
            if (tg == 0) dtot[full * 128 + chan] = dsum;
        }
    }
}
__device__ __forceinline__ void gla_carry(const P& p) {
    float* sbuf = (float*)(p.ws + WS_SBUF); const float* dtot = (const float*)(p.ws + WS_DTOT);
    const int total = 80 * 8192;
    for (int e = blockIdx.x * NTHREADS + threadIdx.x; e < total; e += gridDim.x * NTHREADS) {
        const int e4 = e & 8191, ch = e >> 13, hd = ch & 3, s = (ch >> 2) % NSEQ, dir = ch / (4 * NSEQ);
        const int n = s < 2 ? 16 : 2, q0 = s < 2 ? s * 16 : 32 + (s - 2) * 2, chan = e4 >> 6;
        f32x4 run = (f32x4){0.f, 0.f, 0.f, 0.f};
        for (int i = 0; i < n; ++i) { const int sc = dir == 0 ? i : n - 1 - i, full = dir * 192 + (q0 + sc) * 4 + hd;
            f32x4* ptr = (f32x4*)(sbuf + (size_t)full * 32768) + e4; const float dcy = __expf(dtot[full * 128 + chan]);
            const f32x4 tmp = *ptr; *ptr = run; run = run * dcy + tmp; }
    }
}

template <int L, int SL>
__device__ __forceinline__ void mlp_slab(const P& p, LAS unsigned char* lds, cg::grid_group& grid) {
    unsigned char* ws = p.ws;
    const float* ml = (const float*)(ws + WS_MOD) + (size_t)L * NSEQ * NMODC;
    bf16_t* hb = (bf16_t*)(ws + WS_HBUF); bf16_t* big = (bf16_t*)(ws + WS_BIG);
    const bf16_t* w1 = (const bf16_t*)(ws + (L ? WS_W1B : WS_W1A)); const bf16_t* w2 = (const bf16_t*)(ws + (L ? WS_W2B : WS_W2A));
    { pg8::Gemm g{hb + (size_t)SL * 16384 * D, w1, 16384, FF, D}; pg8::StaticOrder S; S.init(16384, FF, gridDim.x, blockIdx.x);
      EpiBf<1> E{big, FF, nullptr};
      if (PH & 4096) pg8::gemm_phase<EpiBf<1>, pg8::StaticOrder>(lds, g, S, E, nullptr); }
    grid.sync();
    { pg8::Gemm g{big, w2, 16384, D, FF}; pg8::StaticOrder S; S.init(16384, D, gridDim.x, blockIdx.x);
      EpiRes E{p.out, ml + 5 * D, SL * 16384};
      if (PH & 8192) pg8::gemm_phase<EpiRes, pg8::StaticOrder>(lds, g, S, E, nullptr); }
    grid.sync();
}
template <int L>
__device__ __forceinline__ void mlp_block(const P& p, LAS unsigned char* lds, cg::grid_group& grid) {
    const float* ml = (const float*)(p.ws + WS_MOD) + (size_t)L * NSEQ * NMODC;
    norm_phase<1, false>(p, p.in[7] + L * D, ml + 3 * D, ml + 4 * D);
    grid.sync();
    mlp_slab<L, 0>(p, lds, grid); mlp_slab<L, 1>(p, lds, grid); mlp_slab<L, 2>(p, lds, grid);
}

__global__ void __launch_bounds__(NTHREADS, 2) hybrid_fwd(P p) {
    extern __shared__ __attribute__((aligned(16))) unsigned char lds_raw[];
    LAS unsigned char* lds = (LAS unsigned char*)lds_raw;
    cg::grid_group grid = cg::this_grid();
    unsigned char* ws = p.ws;
    const float* mod = (const float*)(ws + WS_MOD);
    bf16_t* hb = (bf16_t*)(ws + WS_HBUF);
    bf16_t* big = (bf16_t*)(ws + WS_BIG);

    if (PH & 1) p0_prep(p, lds);
    grid.sync();
    if (PH & 2) norm_phase<0, false>(p, p.in[6], mod + 0 * D, mod + 1 * D);
    grid.sync();
    if (PH & 4) s5_pass<false>(p, lds);
    grid.sync();
    if (PH & 8) s5_carry(p);
    grid.sync();
    if (PH & 16) s5_pass<true>(p, lds);
    grid.sync();
    { pg8::Gemm g{big, (const bf16_t*)(ws + WS_WGLU), T, 2 * D, D}; pg8::StaticOrder S; S.init(T, 2 * D, gridDim.x, blockIdx.x);
      EpiGlu E{p.in[0], p.in[1], p.out, mod + 2 * D};
      if (PH & 512) pg8::gemm_phase<EpiGlu, pg8::StaticOrder>(lds, g, S, E, nullptr); }
    grid.sync();
    mlp_block<0>(p, lds, grid);
    norm_phase<1, false>(p, p.in[6] + D, mod + (size_t)NSEQ * NMODC + 0 * D, mod + (size_t)NSEQ * NMODC + 1 * D);
    grid.sync();
    { pg8::Gemm g{hb, (const bf16_t*)(ws + WS_WIN), T, WIN_N, D}; pg8::StaticOrder S; S.init(T, WIN_N, gridDim.x, blockIdx.x);
      EpiBf<0> E{big, PROJ_N, (float*)(ws + WS_A1)};
      if (PH & 1024) pg8::gemm_phase<EpiBf<0>, pg8::StaticOrder>(lds, g, S, E, nullptr); }
    grid.sync();
    if (PH & 32) gla_phase<0>(p, lds);
    grid.sync();
    if (PH & 64) gla_carry(p);
    grid.sync();
    if (PH & 128) gla_phase<1>(p, lds);
    grid.sync();
    if (PH & 256) gla_phase<2>(p, lds);
    grid.sync();
    { pg8::Gemm g{hb, (const bf16_t*)(ws + WS_WOUT), T, D, D}; pg8::StaticOrder S; S.init(T, D, gridDim.x, blockIdx.x);
      EpiRes E{p.out, mod + (size_t)NSEQ * NMODC + 2 * D, 0};
      if (PH & 2048) pg8::gemm_phase<EpiRes, pg8::StaticOrder>(lds, g, S, E, nullptr); }
    grid.sync();
    mlp_block<1>(p, lds, grid);
    if (PH == 0) norm_phase<0, true>(p, p.in[25], nullptr, nullptr); else norm_phase<1, true>(p, p.in[25], nullptr, nullptr);
}

extern "C" void kernel_launch(void* const* d_in, const int* in_sizes, int n_in, void* d_out, int out_size, void* d_ws, size_t ws_size, hipStream_t stream) {
    static int grid_blocks = 0;
    if (grid_blocks == 0) {
        if (n_in != 26 || out_size != T * D || ws_size < WS_END) { fprintf(stderr, "kernel_launch: unexpected sizes n_in %d out %d ws %zu\n", n_in, out_size, ws_size); grid_blocks = -1; return; }
        int dev = 0, cus = 0, per_cu = 0;
        hipGetDevice(&dev);
        hipDeviceGetAttribute(&cus, hipDeviceAttributeMultiprocessorCount, dev);
        hipFuncSetAttribute((const void*)hybrid_fwd, hipFuncAttributeMaxDynamicSharedMemorySize, LDS_BYTES);
        hipOccupancyMaxActiveBlocksPerMultiprocessor(&per_cu, (const void*)hybrid_fwd, NTHREADS, LDS_BYTES);
        if (per_cu < 1) { fprintf(stderr, "kernel_launch: occupancy query says %d blocks per CU\n", per_cu); grid_blocks = -1; return; }
        grid_blocks = cus;
        if (grid_blocks % 8) grid_blocks -= grid_blocks % 8;
    }
    if (grid_blocks < 0) return;
    P p{};
    for (int i = 0; i < 26; ++i) p.in[i] = (const float*)d_in[i];
    p.out = (float*)d_out; p.ws = (unsigned char*)d_ws;
    void* args[] = {&p};
    hipError_t e = hipLaunchCooperativeKernel((const void*)hybrid_fwd, dim3(grid_blocks), dim3(NTHREADS), args, LDS_BYTES, stream);
    if (e != hipSuccess) fprintf(stderr, "cooperative launch failed: %s (grid %d)\n", hipGetErrorString(e), grid_blocks);
}
```

```cpp
#include <hip/hip_runtime.h>
#include <hip/hip_cooperative_groups.h>
#include <cstdio>
namespace cg = cooperative_groups;

namespace pg8 {
#define PG8_LAS __attribute__((address_space(3)))
typedef unsigned short bf16_t;
typedef short bf16x8 __attribute__((ext_vector_type(8)));
typedef float f32x4 __attribute__((ext_vector_type(4)));
typedef unsigned u32x4 __attribute__((ext_vector_type(4)));
constexpr int BM = 256, BK = 64, HALF = 128, HTB = HALF * BK * 2  , STAGE_BYTES = 8 * HTB, NXCD = 8, WGM = 8;

__host__ __device__ __forceinline__ int lds_byte(int r, int c) { const int st = (r >> 4) * 2 + (c >> 5), rr = r & 15, cc = c & 31, ob = rr * 64 + cc * 2; return st * 1024 + (ob ^ (((ob >> 9) & 1) << 5)); }
__host__ __device__ __forceinline__ void stage_rc(int b, int& R, int& C) { const int st = b / 1024, sb = b % 1024, swz = sb ^ (((sb >> 9) & 1) << 5); R = (st >> 1) * 16 + swz / 64; C = (st & 1) * 32 + (swz % 64) / 2; }
__host__ __device__ __forceinline__ int perm32(int rho) { const int n = rho >> 4, i = rho & 15; return 8 * (i >> 2) + 4 * n + (i & 3); }

struct Unit { int pm, pn; };
struct Gemm { const bf16_t* A; const bf16_t* Bt; int M, N, K; };

struct StaticOrder {
    int nM, nN, nwg, G, c;
    __host__ __device__ void init(int M, int N, int G_, int c_) { nM = M / BM; nN = N / BM; nwg = nM * nN; G = G_; c = c_; }
    __host__ __device__ bool next(int i, Unit& u) const {
        const long L = (long)i * G + c; if (L >= nwg) return false;
        int wgid = (int)L; { const int q = nwg / NXCD, r = nwg % NXCD, xcd = wgid % NXCD, off = wgid / NXCD; wgid = (xcd < r ? xcd * (q + 1) : r * (q + 1) + (xcd - r) * q) + off; }
        const int nig = WGM * nN, gid = wgid / nig, fm = gid * WGM, gsz = (nM - fm) < WGM ? (nM - fm) : WGM;
        u.pm = fm + ((wgid % nig) % gsz); u.pn = (wgid % nig) / gsz; return true;
    }
    __device__ __forceinline__ void a_ready(const Unit&) const {}
    __device__ __forceinline__ void done(const Unit&) const {}
};


template <class Epi, class Sched, bool STAMP = false>
__device__ __forceinline__ void gemm_phase(PG8_LAS unsigned char* lds, const Gemm g, const Sched& S, const Epi& E, unsigned long long* stamps) {
    const int tid = threadIdx.x, wid = __builtin_amdgcn_readfirstlane(tid >> 6), lane = tid & 63, wr = wid >> 2, wc = wid & 3, fr = lane & 15, fq = lane >> 4;
    const int K = g.K, nt = K / BK;
    int ts_lo = 0, ts_hi = 0, nts = 0; const unsigned long long rt_entry = STAMP ? (unsigned long long)wall_clock64() : 0ull;
#define PG8_STAMP() do { if (STAMP && wid == 0 && nts < 64) { const unsigned long long _c = (unsigned long long)clock64(); \
        ts_lo = (lane == nts) ? (int)(unsigned)_c : ts_lo; ts_hi = (lane == nts) ? (int)(unsigned)(_c >> 32) : ts_hi; ++nts; } } while (0)
    PG8_STAMP();
    unsigned voffA[2], voffB[2];
#pragma unroll
    for (int i = 0; i < 2; ++i) { int R, C; stage_rc(tid * 16 + i * 8192, R, C); const int Rb = Epi::PERM ? ((R & ~31) + perm32(R & 31)) : R;
        voffA[i] = (unsigned)(R * K + C) * 2u; voffB[i] = (unsigned)(Rb * K + C) * 2u; }
    const size_t kstep = (size_t)(BK * 2);
    const size_t hstep = (size_t)HALF * K * 2;
    const size_t tstep = 2 * hstep;
    const unsigned ldsw = (unsigned)wid * 1024u;
    const int aoff = lds_byte(wr * 64 + fr, fq * 8), boff = lds_byte(wc * 32 + fr, fq * 8);
#define PG8_SA(b, h) (((b) * 2 + (h)) * HTB)
#define PG8_SB(b, h) ((4 + (b) * 2 + (h)) * HTB)
#define PG8_STAGE(bufoff, gbase, voff) do { _Pragma("unroll") for (int _i = 0; _i < 2; ++_i) \
        __builtin_amdgcn_global_load_lds((const unsigned*)((const char*)(gbase) + (voff)[_i]), (PG8_LAS unsigned*)(lds + (bufoff) + ldsw + _i * 8192), 16, 0, 0); } while (0)
#define PG8_LDA(dst, b, h) do { _Pragma("unroll") for (int m = 0; m < 4; ++m) _Pragma("unroll") for (int k = 0; k < 2; ++k) dst[m][k] = *(const PG8_LAS bf16x8*)(lds + PG8_SA(b, h) + aoff + m * 2048 + k * 1024); } while (0)
#define PG8_LDB(dst, b, h) do { _Pragma("unroll") for (int n = 0; n < 2; ++n) _Pragma("unroll") for (int k = 0; k < 2; ++k) dst[n][k] = *(const PG8_LAS bf16x8*)(lds + PG8_SB(b, h) + boff + n * 2048 + k * 1024); } while (0)
#define PG8_MMA(ai, bj, At, Bt) do { __builtin_amdgcn_s_setprio(1); _Pragma("unroll") for (int m = 0; m < 4; ++m) _Pragma("unroll") for (int n = 0; n < 2; ++n) _Pragma("unroll") for (int k = 0; k < 2; ++k) \
        acc[ai][bj][m][n] = __builtin_amdgcn_mfma_f32_16x16x32_bf16(Bt[n][k], At[m][k], acc[ai][bj][m][n], 0, 0, 0); __builtin_amdgcn_s_setprio(0); } while (0)
#define PG8_WAIT_V(n) asm volatile("s_waitcnt vmcnt(" #n ")" ::: "memory")
#define PG8_WAIT_L(n) asm volatile("s_waitcnt lgkmcnt(" #n ")" ::: "memory")
#define PG8_BAR __builtin_amdgcn_s_barrier()
#define PG8_SCHED __builtin_amdgcn_sched_barrier(0)
    Unit cur, nxt; int ui = 0;
    if (!S.next(0, cur)) return;
    f32x4 acc[2][2][4][2];
#pragma unroll
    for (int a = 0; a < 2; ++a)
#pragma unroll
        for (int b = 0; b < 2; ++b)
#pragma unroll
            for (int m = 0; m < 4; ++m)
#pragma unroll
                for (int n = 0; n < 2; ++n) acc[a][b][m][n] = (f32x4){0.f, 0.f, 0.f, 0.f};
    bf16x8 At[4][2], B0[2][2], B1[2][2];
    const char* cA = (const char*)g.A + (size_t)cur.pm * tstep; const char* cB = (const char*)g.Bt + (size_t)cur.pn * tstep;
    S.a_ready(cur);
    PG8_STAGE(PG8_SB(0, 0), cB, voffB); PG8_STAGE(PG8_SA(0, 0), cA, voffA); PG8_STAGE(PG8_SB(0, 1), cB + hstep, voffB); PG8_STAGE(PG8_SA(0, 1), cA + hstep, voffA);
    if (wr == 1) PG8_BAR;
    PG8_WAIT_V(4); PG8_BAR;
    PG8_STAGE(PG8_SB(1, 0), cB + kstep, voffB); PG8_STAGE(PG8_SA(1, 0), cA + kstep, voffA); PG8_STAGE(PG8_SB(1, 1), cB + hstep + kstep, voffB);
    PG8_WAIT_V(6); PG8_BAR;
    PG8_STAMP();
    for (;;) {
        const bool has_next = S.next(ui + 1, nxt);
        const char* nA = has_next ? (const char*)g.A + (size_t)nxt.pm * tstep : cA; const char* nB = has_next ? (const char*)g.Bt + (size_t)nxt.pn * tstep : cB;
        for (int t = 0; t < nt; t += 2) {
            const bool last = (t == nt - 2);
            const char* a1 = cA + (size_t)(t + 1) * kstep;
            const char* a2 = last ? nA : cA + (size_t)(t + 2) * kstep; const char* b2 = last ? nB : cB + (size_t)(t + 2) * kstep;
            const char* a3 = a2 + kstep; const char* b3 = b2 + kstep;
            if (last && has_next) S.a_ready(nxt);
            PG8_LDB(B0, 0, 0); PG8_SCHED; PG8_LDA(At, 0, 0); PG8_STAGE(PG8_SA(1, 1), a1 + hstep, voffA);
            PG8_WAIT_L(8); PG8_BAR; PG8_WAIT_L(0); PG8_MMA(0, 0, At, B0); PG8_BAR; PG8_SCHED;
            PG8_LDB(B1, 0, 1); PG8_STAGE(PG8_SB(0, 0), b2, voffB);
            PG8_BAR; PG8_WAIT_L(0); PG8_MMA(0, 1, At, B1); PG8_BAR;
            PG8_LDA(At, 0, 1); PG8_STAGE(PG8_SA(0, 0), a2, voffA);
            PG8_BAR; PG8_WAIT_L(0); PG8_MMA(1, 0, At, B0); PG8_BAR; PG8_SCHED;
            PG8_STAGE(PG8_SB(0, 1), b2 + hstep, voffB);
            PG8_WAIT_V(6); PG8_BAR; PG8_MMA(1, 1, At, B1); PG8_BAR;
            PG8_LDB(B0, 1, 0); PG8_SCHED; PG8_LDA(At, 1, 0); PG8_STAGE(PG8_SA(0, 1), a2 + hstep, voffA);
            PG8_WAIT_L(8); PG8_BAR; PG8_WAIT_L(0); PG8_MMA(0, 0, At, B0); PG8_BAR; PG8_SCHED;
            PG8_LDB(B1, 1, 1); PG8_STAGE(PG8_SB(1, 0), b3, voffB);
            PG8_BAR; PG8_WAIT_L(0); PG8_MMA(0, 1, At, B1); PG8_BAR;
            PG8_LDA(At, 1, 1); PG8_STAGE(PG8_SA(1, 0), a3, voffA);
            PG8_BAR; PG8_WAIT_L(0); PG8_MMA(1, 0, At, B0); PG8_BAR; PG8_SCHED;
            PG8_STAGE(PG8_SB(1, 1), b3 + hstep, voffB);
            PG8_WAIT_V(6); PG8_BAR; PG8_MMA(1, 1, At, B1); PG8_BAR;
        }
        PG8_STAMP();
        if constexpr (!Epi::AFTER_DRAIN) { E(acc, cur, wr, wc, fr, fq); S.done(cur); }
        PG8_STAMP();
        if (!has_next) break;
#pragma unroll
        for (int a = 0; a < 2; ++a)
#pragma unroll
            for (int b = 0; b < 2; ++b)
#pragma unroll
                for (int m = 0; m < 4; ++m)
#pragma unroll
                    for (int n = 0; n < 2; ++n) acc[a][b][m][n] = (f32x4){0.f, 0.f, 0.f, 0.f};
        cur = nxt; cA = nA; cB = nB; ++ui;
    }
    PG8_WAIT_V(0);
    if (wr == 0) PG8_BAR;
    PG8_BAR;
    if constexpr (Epi::AFTER_DRAIN) { E.fused(acc, cur, wr, wc, fr, fq, lds, wid, lane); S.done(cur); }
    PG8_STAMP();
    if (STAMP && wid == 0) { stamps[lane] = lane < nts ? (((unsigned long long)(unsigned)ts_hi << 32) | (unsigned)ts_lo) : 0ull;
        if (lane == 62) stamps[62] = rt_entry; if (lane == 63) stamps[63] = (unsigned long long)wall_clock64(); }
#undef PG8_STAMP
#undef PG8_SA
#undef PG8_SB
#undef PG8_STAGE
#undef PG8_LDA
#undef PG8_LDB
#undef PG8_MMA
#undef PG8_WAIT_V
#undef PG8_WAIT_L
#undef PG8_BAR
#undef PG8_SCHED
}
}


#define LAS __attribute__((address_space(3)))
typedef unsigned short bf16_t;
typedef short bf16x8 __attribute__((ext_vector_type(8)));
typedef short bf16x4 __attribute__((ext_vector_type(4)));
typedef float f32x4 __attribute__((ext_vector_type(4)));
typedef float f32x16 __attribute__((ext_vector_type(16)));
typedef unsigned u32x4 __attribute__((ext_vector_type(4)));
typedef unsigned u32x2 __attribute__((ext_vector_type(2)));

constexpr int D = 1024, T = 49152, NSEQ = 10, NMODC = 6144, FF = 4096;
constexpr int T_PROMPT = 32768;
constexpr float EPS = 1e-6f;
#ifndef PH
#define PH 16383
#endif
#ifndef DUP
#define DUP 0
#endif
constexpr int NWAVES = 8, NTHREADS = 512;
constexpr int LDS_BYTES = 139264;
constexpr int WIN_N = 3328;
constexpr int PROJ_N = 3072;

constexpr size_t MiB = 1u << 20;
constexpr size_t WS_MOD = 0;
constexpr size_t WS_BARW = 491520;
constexpr size_t WS_ABAR = 512 * 1024;
constexpr size_t WS_BBT = 1 * MiB;
constexpr size_t WS_CT = 1 * MiB + 512 * 1024;
constexpr size_t WS_DTOT = 2 * MiB;
constexpr size_t WS_A1 = 3 * MiB;
constexpr size_t WS_WIN = 10 * MiB;
constexpr size_t WS_WOUT = WS_WIN + (size_t)WIN_N * D * 2;
constexpr size_t WS_W1B = WS_WOUT + (size_t)D * D * 2;
constexpr size_t WS_W2B = WS_W1B + (size_t)FF * D * 2;
constexpr size_t WS_HBUF = 35 * MiB;
constexpr size_t WS_BIG = 131 * MiB;
constexpr size_t WS_S5E = WS_BIG + 96 * MiB;
constexpr size_t WS_X = 419 * MiB;
constexpr size_t WS_WGLU = WS_X;
constexpr size_t WS_W1A = WS_X + 4 * MiB;
constexpr size_t WS_W2A = WS_X + 12 * MiB;
constexpr size_t WS_SBUF = WS_X;
constexpr size_t WS_END = 467 * MiB;
static_assert(WS_W2B + (size_t)FF * D * 2 <= WS_HBUF, "ws map");

struct P { const float* in[26]; float* out; unsigned char* ws; };

typedef __bf16 bf16n2 __attribute__((ext_vector_type(2)));
typedef float f32x2n __attribute__((ext_vector_type(2)));
__device__ __forceinline__ unsigned pk_bf16(float lo, float hi) { const f32x2n f = {lo, hi}; const bf16n2 v = __builtin_convertvector(f, bf16n2); return __builtin_bit_cast(unsigned, v); }
__device__ __forceinline__ bf16_t f2bf(float f) { return (bf16_t)(pk_bf16(f, 0.f) & 0xffffu); }
__device__ __forceinline__ float bf2f(bf16_t b) { return __uint_as_float(((unsigned)b) << 16); }
__device__ __forceinline__ float wave_sum(float v) {
#pragma unroll
    for (int o = 1; o < 64; o <<= 1) v += __shfl_xor(v, o);
    return v;
}
__device__ __forceinline__ int row_seq(int row) { return row < T_PROMPT ? (row >> 14) : 2 + ((row - T_PROMPT) >> 11); }
__device__ __forceinline__ float sigmoidf_(float x) { return 1.0f / (1.0f + __expf(-x)); }
__device__ __forceinline__ float gelu_tanh(float y) {
    const float a = 0.7978845608028654f * (y + 0.044715f * y * y * y);
    const float th = 1.0f - 2.0f / (__expf(2.0f * a) + 1.0f);
    return 0.5f * y * (1.0f + th);
}
#define CFENCE() asm volatile("" ::: "memory")
#define LDS_WAIT() asm volatile("s_waitcnt lgkmcnt(0)" ::: "memory")

struct EpiRes {
    static constexpr bool PERM = false, AFTER_DRAIN = false;
    float* x; const float* gate; int row_off;
    __device__ __forceinline__ void operator()(const pg8::f32x4 (&acc)[2][2][4][2], const pg8::Unit& u, int wr, int wc, int fr, int fq) const {
        const int row0 = row_off + u.pm * 256 + wr * 64 + fr, col0 = u.pn * 256 + wc * 32 + 4 * fq;
        const float* gp = gate + (size_t)row_seq(row_off + u.pm * 256) * NMODC;
        pg8::f32x4 gv[2][2];
#pragma unroll
        for (int bj = 0; bj < 2; ++bj)
#pragma unroll
            for (int n = 0; n < 2; ++n) gv[bj][n] = *(const pg8::f32x4*)(gp + col0 + bj * 128 + n * 16);
#pragma unroll
        for (int ai = 0; ai < 2; ++ai)
#pragma unroll
            for (int m = 0; m < 4; ++m) { float* rowp = x + (size_t)(row0 + ai * 128 + m * 16) * D + col0;
#pragma unroll
                for (int bj = 0; bj < 2; ++bj)
#pragma unroll
                    for (int n = 0; n < 2; ++n) { pg8::f32x4* q = (pg8::f32x4*)(rowp + bj * 128 + n * 16); *q = *q + gv[bj][n] * acc[ai][bj][m][n]; }
                asm volatile("" ::: "memory"); }
    }
};
struct EpiGlu {
    static constexpr bool PERM = false, AFTER_DRAIN = false;
    const float* xp; const float* xs; float* out; const float* gate;
    __device__ __forceinline__ void operator()(const pg8::f32x4 (&acc)[2][2][4][2], const pg8::Unit& u, int wr, int wc, int fr, int fq) const {
        const int row0 = u.pm * 256 + wr * 64 + fr, col0 = u.pn * 128 + wc * 32 + 4 * fq;
        const float* gp = gate + (size_t)row_seq(u.pm * 256) * NMODC;
        pg8::f32x4 gv[2];
#pragma unroll
        for (int n = 0; n < 2; ++n) gv[n] = *(const pg8::f32x4*)(gp + col0 + n * 16);
#pragma unroll
        for (int ai = 0; ai < 2; ++ai)
#pragma unroll
            for (int m = 0; m < 4; ++m) { const int row = row0 + ai * 128 + m * 16;
                const float* xin = row < T_PROMPT ? xp + (size_t)row * D : xs + (size_t)(row - T_PROMPT) * D;
#pragma unroll
                for (int n = 0; n < 2; ++n) { const pg8::f32x4 val = acc[ai][0][m][n], gt = acc[ai][1][m][n]; pg8::f32x4 sg;
                    sg[0] = sigmoidf_(gt[0]); sg[1] = sigmoidf_(gt[1]); sg[2] = sigmoidf_(gt[2]); sg[3] = sigmoidf_(gt[3]);
                    const pg8::f32x4 xv = *(const pg8::f32x4*)(xin + col0 + n * 16);
                    *(pg8::f32x4*)(out + (size_t)row * D + col0 + n * 16) = xv + gv[n] * val * sg; }
                asm volatile("" ::: "memory"); }
    }
};
template <int ACT> struct EpiBf {
    static constexpr bool PERM = true, AFTER_DRAIN = false;
    bf16_t* O; int ldc; float* a1;
    __device__ __forceinline__ void operator()(const pg8::f32x4 (&acc)[2][2][4][2], const pg8::Unit& u, int wr, int wc, int fr, int fq) const {
        const int row0 = u.pm * 256 + wr * 64 + fr;
        if (ACT == 0 && u.pn == 12) {
            if (wc == 0) {
#pragma unroll
                for (int ai = 0; ai < 2; ++ai)
#pragma unroll
                    for (int m = 0; m < 4; ++m) { float* rp = a1 + (size_t)(row0 + ai * 128 + m * 16) * 32 + 8 * fq;
                        *(pg8::f32x4*)rp = acc[ai][0][m][0]; *(pg8::f32x4*)(rp + 4) = acc[ai][0][m][1]; }
            }
            return;
        }
        const int col0 = u.pn * 256 + wc * 32 + 8 * fq;
#pragma unroll
        for (int ai = 0; ai < 2; ++ai)
#pragma unroll
            for (int m = 0; m < 4; ++m) { bf16_t* rowp = O + (size_t)(row0 + ai * 128 + m * 16) * ldc + col0;
#pragma unroll
                for (int bj = 0; bj < 2; ++bj) { pg8::f32x4 v0 = acc[ai][bj][m][0], v1 = acc[ai][bj][m][1];
                    if (ACT == 1) {
#pragma unroll
                        for (int e = 0; e < 4; ++e) { const float a = fmaxf(v0[e], 0.f), b = fmaxf(v1[e], 0.f); v0[e] = a * a; v1[e] = b * b; } }
                    pg8::u32x4 wv; wv.x = pk_bf16(v0[0], v0[1]); wv.y = pk_bf16(v0[2], v0[3]); wv.z = pk_bf16(v1[0], v1[1]); wv.w = pk_bf16(v1[2], v1[3]);
                    *(pg8::u32x4*)(rowp + bj * 128) = wv; } }
    }
};

__device__ __forceinline__ void transpose_item(const float* W, int K, int N, int srccol0, bf16_t* WT, int dstrow0, int k0, LAS float* scr, int lane) {
#pragma unroll 8
    for (int i = 0; i < 32; ++i) { const int kk = 2 * i + (lane >> 5); scr[kk * 33 + (lane & 31)] = W[(size_t)(k0 + kk) * N + srccol0 + (lane & 31)]; }
    LDS_WAIT();
    const int c = lane & 7;
#pragma unroll
    for (int j = 0; j < 4; ++j) { const int n = (lane >> 3) + 8 * j; const LAS float* s = scr + (8 * c) * 33 + n;
        u32x4 o; o.x = pk_bf16(s[0 * 33], s[1 * 33]); o.y = pk_bf16(s[2 * 33], s[3 * 33]); o.z = pk_bf16(s[4 * 33], s[5 * 33]); o.w = pk_bf16(s[6 * 33], s[7 * 33]);
        *(u32x4*)(WT + (size_t)(dstrow0 + n) * K + k0 + 8 * c) = o; }
    LDS_WAIT();
}

__device__ __forceinline__ void p0_prep(const P& p, LAS unsigned char* lds) {
    const int tid = threadIdx.x, lane = tid & 63, w = tid >> 6;
    unsigned char* ws = p.ws;
    if ((int)blockIdx.x < 192) {
        LAS float* sc = (LAS float*)lds;
        LAS float* red = (LAS float*)(lds + 40960);
        for (int i = tid; i < NSEQ * D; i += NTHREADS) { const int s = i >> 10, d = i & 1023; const float c = s < 2 ? p.in[2][s * D + d] : p.in[3][(s - 2) * D + d]; sc[i] = c * sigmoidf_(c); }
        __syncthreads();
        for (int it = blockIdx.x; it < 192; it += gridDim.x) {
            const int l = it / 96, col0 = (it % 96) * 64, col = tid & 63, ks = w;
            float acc[NSEQ];
#pragma unroll
            for (int s = 0; s < NSEQ; ++s) acc[s] = 0.f;
            const float* wp = p.in[4] + ((size_t)l * D + ks * 128) * NMODC + col0 + col;
#pragma unroll 4
            for (int k = 0; k < 128; ++k) { const float wv = wp[(size_t)k * NMODC];
#pragma unroll
                for (int s = 0; s < NSEQ; ++s) acc[s] += sc[s * D + ks * 128 + k] * wv; }
#pragma unroll
            for (int s = 0; s < NSEQ; ++s) red[(ks * NSEQ + s) * 64 + col] = acc[s];
            __syncthreads();
            for (int i = tid; i < NSEQ * 64; i += NTHREADS) { const int s = i >> 6, cc = i & 63; float v = 0.f;
#pragma unroll
                for (int k8 = 0; k8 < 8; ++k8) v += red[(k8 * NSEQ + s) * 64 + cc];
                ((float*)(ws + WS_MOD))[((size_t)l * NSEQ + s) * NMODC + col0 + cc] = v + p.in[5][l * NMODC + col0 + cc]; }
            __syncthreads();
        }
    }
    __syncthreads();
    {
        LAS float* scr = (LAS float*)(lds + w * 16384);
        const int gw = blockIdx.x * NWAVES + w, NGW = gridDim.x * NWAVES;
        constexpr int I_GLU = 16 * 64, I_WIN = 16 * 96, I_WOUT = 16 * 32, I_W1 = 16 * 128, I_W2 = 64 * 32;
        constexpr int NITEMS = I_GLU + I_WIN + I_WOUT + 2 * I_W1 + 2 * I_W2;
        for (int it = gw; it < NITEMS; it += NGW) {
            int r = it;
            if (r < I_GLU) { const int kb = r / 64, nb = r % 64, n0 = nb * 32, pn = n0 >> 8, bj = (n0 >> 7) & 1, r0 = n0 & 127;
                transpose_item(p.in[16], D, 2 * D, bj * D + pn * 128 + r0, (bf16_t*)(ws + WS_WGLU), n0, kb * 64, scr, lane); continue; }
            r -= I_GLU;
            if (r < I_WIN) { const int kb = r / 96, nb = r % 96; transpose_item(p.in[17], D, PROJ_N, nb * 32, (bf16_t*)(ws + WS_WIN), nb * 32, kb * 64, scr, lane); continue; }
            r -= I_WIN;
            if (r < I_WOUT) { const int kb = r / 32, nb = r % 32; transpose_item(p.in[22], D, D, nb * 32, (bf16_t*)(ws + WS_WOUT), nb * 32, kb * 64, scr, lane); continue; }
            r -= I_WOUT;
            if (r < 2 * I_W1) { const int l = r / I_W1, q = r % I_W1, kb = q / 128, nb = q % 128;
                transpose_item(p.in[23] + (size_t)l * D * FF, D, FF, nb * 32, (bf16_t*)(ws + (l ? WS_W1B : WS_W1A)), nb * 32, kb * 64, scr, lane); continue; }
            r -= 2 * I_W1;
            { const int l = r / I_W2, q = r % I_W2, kb = q / 32, nb = q % 32;
                transpose_item(p.in[24] + (size_t)l * FF * D, FF, D, nb * 32, (bf16_t*)(ws + (l ? WS_W2B : WS_W2A)), nb * 32, kb * 64, scr, lane); }
        }
        bf16_t* wt = (bf16_t*)(ws + WS_WIN);
        for (int i = blockIdx.x * NTHREADS + tid; i < 256 * D; i += gridDim.x * NTHREADS) { const int r = i >> 10, k = i & 1023;
            const float v = r < 32 ? p.in[18][((size_t)(r >> 4) * D + k) * 16 + (r & 15)] : 0.f;
            wt[(size_t)(PROJ_N + r) * D + k] = f2bf(v); }
    }
    for (int i = blockIdx.x * NTHREADS + tid; i < 2 * 64 * 64; i += gridDim.x * NTHREADS) {
        const int pp = i & 63, dg = i >> 6;
        const float lr = p.in[8][i], li = p.in[9][i], dt = __expf(p.in[10][dg]);
        const float mag = __expf(lr * dt); float sn, cs; sincosf(li * dt, &sn, &cs);
        const float abr = mag * cs, abi = mag * sn, den = lr * lr + li * li;
        const float zr = ((abr - 1.0f) * lr + abi * li) / den, zi = (abi * lr - (abr - 1.0f) * li) / den;
        float* ab = (float*)(ws + WS_ABAR); ab[2 * i] = abr; ab[2 * i + 1] = abi;
        bf16_t* bbt = (bf16_t*)(ws + WS_BBT); bf16_t* ct = (bf16_t*)(ws + WS_CT);
#pragma unroll
        for (int h = 0; h < 16; ++h) {
            const float br = p.in[11][(size_t)i * 16 + h], bi = p.in[12][(size_t)i * 16 + h];
            bbt[((size_t)dg * 128 + pp) * 16 + h] = f2bf(zr * br - zi * bi);
            bbt[((size_t)dg * 128 + 64 + pp) * 16 + h] = f2bf(zr * bi + zi * br);
            ct[((size_t)dg * 16 + h) * 128 + pp] = f2bf(p.in[13][((size_t)dg * 16 + h) * 64 + pp]);
            ct[((size_t)dg * 16 + h) * 128 + 64 + pp] = f2bf(-p.in[14][((size_t)dg * 16 + h) * 64 + pp]);
        }
    }
}

template <int SRC, bool FINAL>
__device__ __forceinline__ void norm_phase(const P& p, const float* gvec, const float* shift, const float* scale) {
    const int tid = threadIdx.x, lane = tid & 63, w = tid >> 6;
    const int gw = blockIdx.x * NWAVES + w, NGW = gridDim.x * NWAVES;
    bf16_t* hb = (bf16_t*)(p.ws + WS_HBUF);
    f32x4 gq[4];
#pragma unroll
    for (int j = 0; j < 4; ++j) gq[j] = *(const f32x4*)(gvec + 4 * lane + 256 * j);
    for (int row = gw; row < T; row += NGW) {
        const float* xr = SRC == 0 ? (row < T_PROMPT ? p.in[0] + (size_t)row * D : p.in[1] + (size_t)(row - T_PROMPT) * D) : p.out + (size_t)row * D;
        f32x4 v[4]; float ss = 0.f;
#pragma unroll
        for (int j = 0; j < 4; ++j) { v[j] = *(const f32x4*)(xr + 4 * lane + 256 * j); ss += (v[j][0] * v[j][0] + v[j][1] * v[j][1]) + (v[j][2] * v[j][2] + v[j][3] * v[j][3]); }
        const float rstd = rsqrtf(wave_sum(ss) * (1.0f / D) + EPS);
        if (FINAL) {
#pragma unroll
            for (int j = 0; j < 4; ++j) *(f32x4*)(p.out + (size_t)row * D + 4 * lane + 256 * j) = v[j] * rstd * gq[j];
        } else {
            const int s = row_seq(row);
#pragma unroll
            for (int j = 0; j < 4; ++j) { const f32x4 sh = *(const f32x4*)(shift + (size_t)s * NMODC + 4 * lane + 256 * j), sc = *(const f32x4*)(scale + (size_t)s * NMODC + 4 * lane + 256 * j);
                const f32x4 o = (v[j] * rstd * gq[j]) * (sc + 1.0f) + sh;
                u32x2 wv; wv.x = pk_bf16(o[0], o[1]); wv.y = pk_bf16(o[2], o[3]);
                *(u32x2*)(hb + (size_t)row * D + 4 * lane + 256 * j) = wv; }
        }
    }
}

constexpr int S5_NCH = 384, S5_ROW = 132, S5_WAVE_LDS = 32 * S5_ROW * 4;
template <bool PC>
__device__ __forceinline__ void s5_pass(const P& p, LAS unsigned char* lds) {
    const int tid = threadIdx.x, lane = tid & 63, w = __builtin_amdgcn_readfirstlane(tid >> 6);
    const int b = blockIdx.x, g = (b & 7) * 8 + w;
    const int hh = lane >> 5, l32 = lane & 31, l16 = lane & 15, q16 = lane >> 4;
    LAS float* L = (LAS float*)(lds + w * S5_WAVE_LDS);
    const bf16_t* hb = (const bf16_t*)(p.ws + WS_HBUF);
    bf16_t* gout = (bf16_t*)(p.ws + WS_BIG);
    float* E = (float*)(p.ws + WS_S5E);
    const bf16_t* bbt = (const bf16_t*)(p.ws + WS_BBT); const bf16_t* ct = (const bf16_t*)(p.ws + WS_CT); const float* ab = (const float*)(p.ws + WS_ABAR);
    const float dsk = p.in[15][g * 16 + l16];
    for (int c = b >> 3; c < S5_NCH; c += (int)(gridDim.x >> 3)) {
        const int tok0 = c * 128;
        f32x4 yacc[8];
#pragma unroll
        for (int j = 0; j < 8; ++j) yacc[j] = (f32x4){0.f, 0.f, 0.f, 0.f};
#pragma unroll
        for (int dir = 0; dir < 2; ++dir) {
            const size_t eoff = (((size_t)dir * S5_NCH + c) * 64 + g) * 128;
            const int dg = dir * 64 + g;
            bf16x8 Bf[4], Cf[4];
#pragma unroll
            for (int nb = 0; nb < 4; ++nb) Bf[nb] = *(const bf16x8*)(bbt + ((size_t)dg * 128 + nb * 32 + l32) * 16 + 8 * hh);
            const float ar = ab[(dg * 64 + lane) * 2], ai = ab[(dg * 64 + lane) * 2 + 1];
#pragma unroll
            for (int ks = 0; ks < 4; ++ks) Cf[ks] = PC ? *(const bf16x8*)(ct + ((size_t)dg * 16 + l16) * 128 + 32 * ks + 8 * q16) : (bf16x8){0, 0, 0, 0, 0, 0, 0, 0};
            float hr = 0.f, hi = 0.f;
            if (PC) { hr = E[eoff + lane]; hi = E[eoff + 64 + lane]; }
#pragma unroll
            for (int sbi = 0; sbi < 4; ++sbi) {
                const int sb = dir == 0 ? sbi : 3 - sbi;
                const bf16x8 a = *(const bf16x8*)(hb + (size_t)(tok0 + sb * 32 + l32) * D + g * 16 + 8 * hh);
#pragma unroll
                for (int nb = 0; nb < 4; ++nb) {
                    f32x16 acc;
#pragma unroll
                    for (int i = 0; i < 16; ++i) acc[i] = 0.f;
                    acc = __builtin_amdgcn_mfma_f32_32x32x16_bf16(a, Bf[nb], acc, 0, 0, 0);
#pragma unroll
                    for (int i = 0; i < 16; ++i) L[(8 * (i >> 2) + 4 * hh + (i & 3)) * S5_ROW + nb * 32 + l32] = acc[i];
                }
                CFENCE(); LDS_WAIT(); CFENCE();
#pragma unroll 4
                for (int tt = 0; tt < 32; ++tt) {
                    const int t = dir == 0 ? tt : 31 - tt;
                    const float br = L[t * S5_ROW + lane], bi = L[t * S5_ROW + 64 + lane];
                    const float nhr = ar * hr - ai * hi + br, nhi = ar * hi + ai * hr + bi;
                    hr = nhr; hi = nhi;
                    if (PC) { CFENCE(); LAS bf16_t* hrow = (LAS bf16_t*)(L + t * S5_ROW); hrow[lane] = f2bf(hr); hrow[64 + lane] = f2bf(hi); CFENCE(); }
                }
                CFENCE(); LDS_WAIT(); CFENCE();
                if (PC) {
#pragma unroll
                    for (int mb = 0; mb < 2; ++mb)
#pragma unroll
                        for (int ks = 0; ks < 4; ++ks) {
                            const bf16x8 af = *(const LAS bf16x8*)((const LAS unsigned char*)L + (mb * 16 + l16) * (S5_ROW * 4) + (32 * ks + 8 * q16) * 2);
                            yacc[sb * 2 + mb] = __builtin_amdgcn_mfma_f32_16x16x32_bf16(af, Cf[ks], yacc[sb * 2 + mb], 0, 0, 0);
                        }
                    CFENCE(); LDS_WAIT(); CFENCE();
                }
            }
            if (!PC) { E[eoff + lane] = hr; E[eoff + 64 + lane] = hi; }
        }
        if (PC) {
#pragma unroll
            for (int j = 0; j < 8; ++j)
#pragma unroll
                for (int i = 0; i < 4; ++i) { const size_t o = (size_t)(tok0 + j * 16 + i) * D + g * 16; const int vo = 4 * q16 * D + l16;
                    const float y = yacc[j][i] + dsk * bf2f((hb + o)[vo]); (gout + o)[vo] = f2bf(gelu_tanh(y)); if (i == 3) CFENCE(); }
        }
    }
}
__device__ __forceinline__ void s5_carry(const P& p) {
    const int idx = blockIdx.x * NTHREADS + threadIdx.x;
    if (idx >= 2 * NSEQ * 64 * 64) return;
    const int pp = idx & 63, g = (idx >> 6) & 63, s = (idx >> 12) % NSEQ, dir = idx / (NSEQ * 4096);
    const float* ab = (const float*)(p.ws + WS_ABAR);
    float Ar = ab[((dir * 64 + g) * 64 + pp) * 2], Ai = ab[((dir * 64 + g) * 64 + pp) * 2 + 1];
#pragma unroll
    for (int k = 0; k < 7; ++k) { const float nr = Ar * Ar - Ai * Ai, ni = 2.0f * Ar * Ai; Ar = nr; Ai = ni; }
    const int c0 = s < 2 ? s * 128 : 256 + (s - 2) * 16, n = s < 2 ? 128 : 16;
    float* E = (float*)(p.ws + WS_S5E);
    float rr = 0.f, ri = 0.f;
    for (int i0 = 0; i0 < n; i0 += 8) {
        float er[8], ei[8]; size_t ad[8];
#pragma unroll
        for (int k = 0; k < 8; ++k) { const int i = i0 + k, c = dir == 0 ? c0 + i : c0 + n - 1 - i; ad[k] = (((size_t)dir * S5_NCH + c) * 64 + g) * 128 + pp; er[k] = E[ad[k]]; ei[k] = E[ad[k] + 64]; }
#pragma unroll
        for (int k = 0; k < 8; ++k) { E[ad[k]] = rr; E[ad[k] + 64] = ri; const float nr = Ar * rr - Ai * ri + er[k], ni = Ar * ri + Ai * rr + ei[k]; rr = nr; ri = ni; }
    }
}

constexpr int GQ = 0, GK = 17408, GKT = 34816, GVT = 53248, GSC = 90112, GA1 = 99328, GSUM = 103424, GEL = 105472, GRMS = 105984, GRSTD = 108032, GW2 = 108288;
constexpr int QST = 272, TST = 144;
__device__ __forceinline__ void gla_item_coords(int j, int& hd, int& tokbase) {
    hd = j & 3; const int q = j >> 2;
    if (q < 32) tokbase = (q >> 4) * 16384 + (q & 15) * 1024; else tokbase = T_PROMPT + ((q - 32) >> 1) * 2048 + ((q - 32) & 1) * 1024;
}
template <int MODE>
__device__ __forceinline__ void gla_phase(const P& p, LAS unsigned char* lds) {
    const int tid = threadIdx.x, lane = tid & 63, w = __builtin_amdgcn_readfirstlane(tid >> 6), hh = lane >> 5, l32 = lane & 31;
    const int chan = tid & 127, tg = w >> 1;
    const bf16_t* proj = (const bf16_t*)(p.ws + WS_BIG);
    const float* a1b = (const float*)(p.ws + WS_A1);
    bf16_t* hb = (bf16_t*)(p.ws + WS_HBUF);
    float* sbuf = (float*)(p.ws + WS_SBUF); float* dtot = (float*)(p.ws + WS_DTOT);
    LAS unsigned char* const qfrag = lds + GQ + l32 * QST + 16 * hh;
    LAS unsigned char* const kfrag = lds + GK + l32 * QST + 16 * hh;
    LAS unsigned char* const qperm = lds + GQ + l32 * QST + 8 * hh;
    LAS unsigned char* const ktfrag = lds + GKT + l32 * TST + 16 * hh;
    LAS unsigned char* const vtfrag = lds + GVT + (32 * w + l32) * TST + 16 * hh;
    LAS unsigned char* const scfrag = lds + GSC + l32 * TST + 16 * hh;
    LAS unsigned char* const scst = lds + GSC + (4 * hh) * TST + l32 * 2;
    LAS unsigned char* const elrd = lds + GEL + 16 * hh;
    LAS unsigned char* const rmsw = lds + GRMS + (4 * hh) * 32 + w * 4;
    LAS unsigned char* const rstdr = lds + GRSTD + (4 * hh) * 4;
    LAS unsigned char* const qprep = lds + GQ + (16 * tg) * QST + chan * 2;
    LAS unsigned char* const kprep = lds + GK + (16 * tg) * QST + chan * 2;
    LAS unsigned char* const a1rd = lds + GA1 + (16 * tg) * 64;
    const LAS float* const w2p = (const LAS float*)(lds + GW2) + chan;
    const int nitems = MODE == 0 ? 384 : 192;
    for (int it = blockIdx.x; it < nitems; it += gridDim.x) {
        const int dir = MODE == 0 ? it / 192 : (MODE == 1 ? 0 : 1);
        const int j = MODE == 0 ? it % 192 : it, full = dir * 192 + j;
        int hd, tokbase; gla_item_coords(j, hd, tokbase);
        __syncthreads();
        for (int i = tid; i < 16 * 128; i += NTHREADS) ((LAS float*)(lds + GW2))[i] = p.in[19][(size_t)(dir * 16 + (i >> 7)) * 512 + hd * 128 + (i & 127)];
        const float bias = p.in[20][dir * 512 + hd * 128 + chan];
        f32x16 S[4];
        float* const sb0 = sbuf + (size_t)full * 32768 + 32 * w; const int svo = (4 * hh) * 256 + l32;
#pragma unroll
        for (int cb = 0; cb < 4; ++cb)
#pragma unroll
            for (int i = 0; i < 16; ++i) S[cb][i] = MODE == 0 ? 0.f : (sb0 + (32 * cb + 8 * (i >> 2) + (i & 3)) * 256)[svo];
        float dsum = 0.f;
        float ng = 0.f; if (MODE == 2) ng = p.in[21][hd * 256 + 32 * w + l32];
        u32x4 pq[2], pk[2]; f32x4 pa = (f32x4){0.f, 0.f, 0.f, 0.f};
        const int qko = (tid >> 4) * PROJ_N + hd * 128 + (tid & 15) * 8;
        const int vo = (tid >> 5) * PROJ_N + 1024 + hd * 256 + (tid & 31) * 8;
        const int ao = (tid >> 2) * 32 + dir * 16 + (tid & 3) * 4;
#define GLA_LOAD(tbx) do { const bf16_t* pb_ = proj + (size_t)(tbx) * PROJ_N; \
            _Pragma("unroll") for (int i = 0; i < 2; ++i) { pq[i] = *(const u32x4*)(pb_ + (size_t)i * 32 * PROJ_N + qko); pk[i] = *(const u32x4*)(pb_ + (size_t)i * 32 * PROJ_N + 512 + qko); } \
            if (tid < 256) pa = *(const f32x4*)(a1b + (size_t)(tbx) * 32 + ao); } while (0)
        { int tb0 = tokbase + (dir == 0 ? 0 : 15) * 64; GLA_LOAD(tb0); }
        for (int ci = 0; ci < 16; ++ci) {
            int tb = tokbase + (dir == 0 ? ci : 15 - ci) * 64; asm volatile("" : "+s"(tb));
            int tbn = tokbase + (dir == 0 ? ci + 1 : 14 - ci) * 64; asm volatile("" : "+s"(tbn));
            { LAS unsigned char* const qs = lds + GQ + (tid >> 4) * QST + (tid & 15) * 16;
#pragma unroll
              for (int i = 0; i < 2; ++i) { *(LAS u32x4*)(qs + i * 32 * QST) = pq[i]; *(LAS u32x4*)(qs + (GK - GQ) + i * 32 * QST) = pk[i]; } }
            { const bf16_t* vb = proj + (size_t)tb * PROJ_N; LAS unsigned char* const vs = lds + GVT + ((tid & 31) * 8) * TST + (tid >> 5) * 2;
#pragma unroll
              for (int i = 0; i < 4; ++i) { const u32x4 pvv = *(const u32x4*)(vb + (size_t)i * 16 * PROJ_N + vo);
#pragma unroll
                for (int e = 0; e < 4; ++e) { const unsigned v2 = pvv[e];
                    *(LAS bf16_t*)(vs + (2 * e) * TST + i * 32) = (bf16_t)(v2 & 0xffffu);
                    *(LAS bf16_t*)(vs + (2 * e + 1) * TST + i * 32) = (bf16_t)(v2 >> 16); } } }
            if (tid < 256) *(LAS f32x4*)(lds + GA1 + (tid >> 2) * 64 + (tid & 3) * 16) = pa;
            __syncthreads();
            if (ci + 1 < 16) GLA_LOAD(tbn);
            float zc[16];
#pragma unroll
            for (int i = 0; i < 16; ++i) { const LAS f32x4* ap = (const LAS f32x4*)(a1rd + i * 64);
                float z = bias;
#pragma unroll
                for (int r4 = 0; r4 < 4; ++r4) { const f32x4 av = ap[r4]; z += av[0] * w2p[(4 * r4) * 128] + av[1] * w2p[(4 * r4 + 1) * 128] + av[2] * w2p[(4 * r4 + 2) * 128] + av[3] * w2p[(4 * r4 + 3) * 128]; }
                zc[i] = (fminf(z, 0.f) - __logf(1.0f + __expf(-fabsf(z)))) * (1.0f / 16.0f); }
            if (dir == 0) {
#pragma unroll
                for (int i = 1; i < 16; ++i) zc[i] += zc[i - 1];
            } else {
#pragma unroll
                for (int i = 14; i >= 0; --i) zc[i] += zc[i + 1];
            }
            ((LAS float*)(lds + GSUM))[tg * 128 + chan] = dir == 0 ? zc[15] : zc[0];
            __syncthreads();
            float blast, off;
            { const LAS float* gs = (const LAS float*)(lds + GSUM) + chan; const float g0 = gs[0], g1 = gs[128], g2 = gs[256], g3 = gs[384];
                blast = (g0 + g1) + (g2 + g3);
                if (dir == 0) off = (tg > 0 ? g0 : 0.f) + (tg > 1 ? g1 : 0.f) + (tg > 2 ? g2 : 0.f);
                else off = (tg < 3 ? g3 : 0.f) + (tg < 2 ? g2 : 0.f) + (tg < 1 ? g1 : 0.f); }
            {
                float kt[16];
#pragma unroll
                for (int i = 0; i < 16; ++i) { const float bc = zc[i] + off;
                    LAS bf16_t* qp = (LAS bf16_t*)(qprep + i * QST); LAS bf16_t* kp = (LAS bf16_t*)(kprep + i * QST);
                    const float qv = bf2f(*qp), kv = bf2f(*kp);
                    *qp = f2bf(qv * __expf(bc) * 0.08838834764831845f); *kp = f2bf(kv * __expf(-bc)); kt[i] = kv * __expf(blast - bc); }
                u32x4 k0, k1; k0.x = pk_bf16(kt[0], kt[1]); k0.y = pk_bf16(kt[2], kt[3]); k0.z = pk_bf16(kt[4], kt[5]); k0.w = pk_bf16(kt[6], kt[7]);
                k1.x = pk_bf16(kt[8], kt[9]); k1.y = pk_bf16(kt[10], kt[11]); k1.z = pk_bf16(kt[12], kt[13]); k1.w = pk_bf16(kt[14], kt[15]);
                *(LAS u32x4*)(lds + GKT + chan * TST + tg * 32) = k0; *(LAS u32x4*)(lds + GKT + chan * TST + tg * 32 + 16) = k1;
            }
            if (tg == 0) { ((LAS float*)(lds + GEL))[chan] = __expf(blast); dsum += blast; }
            __syncthreads();
            if (MODE != 0) {
                if (w < 4) { const int mb = w >> 1, nb = w & 1; f32x16 sc;
#pragma unroll
                    for (int i = 0; i < 16; ++i) sc[i] = 0.f;
#pragma unroll
                    for (int ks = 0; ks < 8; ++ks) { const bf16x8 a = *(const LAS bf16x8*)(qfrag + mb * 32 * QST + 32 * ks), bq = *(const LAS bf16x8*)(kfrag + nb * 32 * QST + 32 * ks);
                        sc = __builtin_amdgcn_mfma_f32_32x32x16_bf16(a, bq, sc, 0, 0, 0); }
                    const int dlt = (nb - mb) * 32 + l32 - 4 * hh;
                    LAS unsigned char* const sw = scst + mb * 32 * TST + nb * 64;
#pragma unroll
                    for (int i = 0; i < 16; ++i) { const int cst = 8 * (i >> 2) + (i & 3); const bool keep = dir == 0 ? (dlt <= cst) : (dlt >= cst);
                        *(LAS bf16_t*)(sw + cst * TST) = f2bf(keep ? sc[i] : 0.f); }
                }
                __syncthreads();
            }
            bf16x8 vf[4];
#pragma unroll
            for (int ks = 0; ks < 4; ++ks) vf[ks] = *(const LAS bf16x8*)(vtfrag + 32 * ks);
            if (MODE != 0) {
#pragma unroll
                for (int mb = 0; mb < 2; ++mb) {
                    f32x16 o;
#pragma unroll
                    for (int i = 0; i < 16; ++i) o[i] = 0.f;
#pragma unroll
                    for (int ks = 0; ks < 4; ++ks) { const bf16x8 a = *(const LAS bf16x8*)(scfrag + mb * 32 * TST + 32 * ks);
                        o = __builtin_amdgcn_mfma_f32_32x32x16_bf16(a, vf[ks], o, 0, 0, 0); }
#pragma unroll
                    for (int cb = 0; cb < 4; ++cb)
#pragma unroll
                        for (int h2 = 0; h2 < 2; ++h2) {
                            union { u32x4 u; bf16x8 v; } sb_;
                            sb_.u.x = pk_bf16(S[cb][8 * h2 + 0], S[cb][8 * h2 + 1]); sb_.u.y = pk_bf16(S[cb][8 * h2 + 2], S[cb][8 * h2 + 3]);
                            sb_.u.z = pk_bf16(S[cb][8 * h2 + 4], S[cb][8 * h2 + 5]); sb_.u.w = pk_bf16(S[cb][8 * h2 + 6], S[cb][8 * h2 + 7]);
                            const LAS unsigned char* base = qperm + mb * 32 * QST + (32 * cb + 16 * h2) * 2;
                            union { struct { u32x2 lo, hi; } s; bf16x8 v; } qa; qa.s.lo = *(const LAS u32x2*)base; qa.s.hi = *(const LAS u32x2*)(base + 16);
                            o = __builtin_amdgcn_mfma_f32_32x32x16_bf16(qa.v, sb_.v, o, 0, 0, 0);
                        }
                    bf16_t* orow = hb + (size_t)(tb + 32 * mb) * D + hd * 256 + 32 * w; const int ovo = 4 * hh * D + l32;
                    if (MODE == 1) {
#pragma unroll
                        for (int i = 0; i < 16; ++i) (orow + (size_t)(8 * (i >> 2) + (i & 3)) * D)[ovo] = f2bf(o[i]);
                    } else {
#pragma unroll
                        for (int i = 0; i < 16; ++i) { const int cst = 8 * (i >> 2) + (i & 3);
                            const float ov = o[i] + bf2f((orow + (size_t)cst * D)[ovo]); o[i] = ov;
                            float sq = ov * ov;
#pragma unroll
                            for (int sh = 1; sh < 32; sh <<= 1) sq += __shfl_xor(sq, sh);
                            if (l32 == 0) *(LAS float*)(rmsw + (32 * mb + cst) * 32) = sq; }
                        __syncthreads();
                        if (tid < 32) { const int tok = 32 * mb + tid; const LAS f32x4* rp = (const LAS f32x4*)(lds + GRMS + tok * 32); const f32x4 a = rp[0], bq = rp[1];
                            ((LAS float*)(lds + GRSTD))[tok] = rsqrtf(((a[0] + a[1]) + (a[2] + a[3]) + (bq[0] + bq[1]) + (bq[2] + bq[3])) * (1.0f / 256.0f) + EPS); }
                        __syncthreads();
                        const bf16_t* rrow = proj + (size_t)(tb + 32 * mb) * PROJ_N + 2048 + hd * 256 + 32 * w; const int rvo = 4 * hh * PROJ_N + l32;
#pragma unroll
                        for (int i = 0; i < 16; ++i) { const int cst = 8 * (i >> 2) + (i & 3);
                            const float rs = *(const LAS float*)(rstdr + (32 * mb + cst) * 4);
                            const float rv = bf2f((rrow + (size_t)cst * PROJ_N)[rvo]);
                            (orow + (size_t)cst * D)[ovo] = f2bf(o[i] * rs * ng * (rv * sigmoidf_(rv))); }
                    }
                    CFENCE();
                }
            }
#pragma unroll
            for (int cb = 0; cb < 4; ++cb) {
#pragma unroll
                for (int i4 = 0; i4 < 4; ++i4) { const f32x4 e = *(const LAS f32x4*)(elrd + (32 * cb + 8 * i4) * 4);
                    S[cb][4 * i4 + 0] *= e[0]; S[cb][4 * i4 + 1] *= e[1]; S[cb][4 * i4 + 2] *= e[2]; S[cb][4 * i4 + 3] *= e[3]; }
#pragma unroll
                for (int ks = 0; ks < 4; ++ks) { const bf16x8 a = *(const LAS bf16x8*)(ktfrag + cb * 32 * TST + 32 * ks);
                    S[cb] = __builtin_amdgcn_mfma_f32_32x32x16_bf16(a, vf[ks], S[cb], 0, 0, 0); }
            }
            __syncthreads();
        }
#undef GLA_LOAD
        if (MODE == 0) {
#pragma unroll
            for (int cb = 0; cb < 4; ++cb)
#pragma unroll
                for (int i = 0; i < 16; ++i) (sb0 + (32 * cb + 8 * (i >> 2) + (i & 3)) * 256)[svo] = S[cb][i];
            if (tg == 0) dtot[full * 128 + chan] = dsum;
        }
    }
}
__device__ __forceinline__ void gla_carry(const P& p) {
    float* sbuf = (float*)(p.ws + WS_SBUF); const float* dtot = (const float*)(p.ws + WS_DTOT);
    const int total = 80 * 8192;
    for (int e = blockIdx.x * NTHREADS + threadIdx.x; e < total; e += gridDim.x * NTHREADS) {
        const int e4 = e & 8191, ch = e >> 13, hd = ch & 3, s = (ch >> 2) % NSEQ, dir = ch / (4 * NSEQ);
        const int n = s < 2 ? 16 : 2, q0 = s < 2 ? s * 16 : 32 + (s - 2) * 2, chan = e4 >> 6;
        f32x4 run = (f32x4){0.f, 0.f, 0.f, 0.f};
        for (int i = 0; i < n; ++i) { const int sc = dir == 0 ? i : n - 1 - i, full = dir * 192 + (q0 + sc) * 4 + hd;
            f32x4* ptr = (f32x4*)(sbuf + (size_t)full * 32768) + e4; const float dcy = __expf(dtot[full * 128 + chan]);
            const f32x4 tmp = *ptr; *ptr = run; run = run * dcy + tmp; }
    }
}

#define XB_TMO      128
#define XB_XCNT(j)  (256  + 64 * (j))
#define XB_XSUB(j)  (1280 + 64 * (j))
#define XB_XGEN(j)  (2304 + 64 * (j))
#define XB_TOP      3328
#define XB_TOPGEN   3392
#define XCD_BAR_WORDS 3456
#define XB_SPIN_CAP (1u << 18)

__device__ __forceinline__ unsigned xb_ld(unsigned* p)              { return __hip_atomic_load(p, __ATOMIC_RELAXED, __HIP_MEMORY_SCOPE_AGENT); }
__device__ __forceinline__ unsigned xb_add(unsigned* p, unsigned v) { return __hip_atomic_fetch_add(p, v, __ATOMIC_RELAXED, __HIP_MEMORY_SCOPE_AGENT); }
__device__ __forceinline__ unsigned xb_xcc_id() { return (unsigned)__builtin_amdgcn_s_getreg((3 << 11) | 20) & 0xFu; }
#define XB_SPIN(cond, bar) do { unsigned _sp = 0; while (cond) { __builtin_amdgcn_s_sleep(1); \
    if ((++_sp & 255u) == 0u) { if (xb_ld(&(bar)[XB_TMO])) break; if (_sp > XB_SPIN_CAP) { atomicAdd(&(bar)[XB_TMO], 1u); break; } } } } while (0)

struct XcdBarrier {
    unsigned* bar; unsigned x;
    volatile LAS unsigned* st;
};

__device__ __forceinline__ XcdBarrier xcd_barrier_post(unsigned* bar, volatile LAS unsigned* st) {
    XcdBarrier b; b.bar = bar; b.x = xb_xcc_id(); b.st = st;
    if (threadIdx.x == 0) (void)xb_add(&bar[XB_XCNT(b.x)], 1u);
    return b;
}
__device__ __forceinline__ void xcd_barrier_complete(unsigned* bar, unsigned x, unsigned& nloc, unsigned& nx) {
    const unsigned G = gridDim.x * gridDim.y * gridDim.z;
    unsigned sum, cnt, mine, sp = 0u;
    for (;;) {
        sum = 0u; cnt = 0u; mine = 0u;
#pragma unroll
        for (unsigned j = 0; j < 16; ++j) { const unsigned c = xb_ld(&bar[XB_XCNT(j)]); sum += c; cnt += (c > 0u) ? 1u : 0u; mine = (j == x) ? c : mine; }
        if (sum == G) break;
        __builtin_amdgcn_s_sleep(1);
        if ((++sp & 255u) == 0u) { if (xb_ld(&bar[XB_TMO])) break; if (sp > XB_SPIN_CAP) { atomicAdd(&bar[XB_TMO], 1u); break; } }
    }
    nloc = mine > 0u ? mine : 1u; nx = cnt > 0u ? cnt : 1u;
}

__device__ __forceinline__ void xcd_barrier(const XcdBarrier& b) {
    asm volatile("s_waitcnt vmcnt(0)" ::: "memory");
    __syncthreads();
    if (threadIdx.x == 0) {
        unsigned* bar = b.bar;
        __builtin_amdgcn_s_waitcnt(0);
        unsigned nloc = b.st[0], nx = b.st[1];
        if (nloc == 0u) { xcd_barrier_complete(bar, b.x, nloc, nx); b.st[0] = nloc; b.st[1] = nx; }
        const unsigned old = xb_add(&bar[XB_XSUB(b.x)], 1u);
        const unsigned gen = old / nloc;
        if (old + 1u == (gen + 1u) * nloc) {
            __builtin_amdgcn_fence(__ATOMIC_RELEASE, "agent");
            asm volatile("s_waitcnt vmcnt(0)" ::: "memory");
            const unsigned og = xb_add(&bar[XB_TOP], 1u);
            const unsigned tg = og / nx;
            if (og + 1u == (tg + 1u) * nx) xb_add(&bar[XB_TOPGEN], 1u);
            else XB_SPIN(xb_ld(&bar[XB_TOPGEN]) == tg, bar);
            __builtin_amdgcn_fence(__ATOMIC_ACQUIRE, "agent");
            xb_add(&bar[XB_XGEN(b.x)], 1u);
            asm volatile("s_waitcnt vmcnt(0)" ::: "memory");
        } else {
            XB_SPIN(xb_ld(&bar[XB_XGEN(b.x)]) == gen, bar);
            __builtin_amdgcn_fence(__ATOMIC_ACQUIRE, "agent");
            asm volatile("s_waitcnt vmcnt(0)" ::: "memory");
        }
    }
    __syncthreads();
}

#define GRID_BAR() xcd_barrier(bar)

template <int L, int SL>
__device__ __forceinline__ void mlp_slab(const P& p, LAS unsigned char* lds, const XcdBarrier& bar) {
    unsigned char* ws = p.ws;
    const float* ml = (const float*)(ws + WS_MOD) + (size_t)L * NSEQ * NMODC;
    bf16_t* hb = (bf16_t*)(ws + WS_HBUF); bf16_t* big = (bf16_t*)(ws + WS_BIG);
    const bf16_t* w1 = (const bf16_t*)(ws + (L ? WS_W1B : WS_W1A)); const bf16_t* w2 = (const bf16_t*)(ws + (L ? WS_W2B : WS_W2A));
    { pg8::Gemm g{hb + (size_t)SL * 16384 * D, w1, 16384, FF, D}; pg8::StaticOrder S; S.init(16384, FF, gridDim.x, blockIdx.x);
      EpiBf<1> E{big, FF, nullptr};
      if (PH & 4096) pg8::gemm_phase<EpiBf<1>, pg8::StaticOrder>(lds, g, S, E, nullptr);
#if (DUP & 8)
      GRID_BAR();
      pg8::gemm_phase<EpiBf<1>, pg8::StaticOrder>(lds, g, S, E, nullptr);
#endif
    }
    GRID_BAR();
    { pg8::Gemm g{big, w2, 16384, D, FF}; pg8::StaticOrder S; S.init(16384, D, gridDim.x, blockIdx.x);
      EpiRes E{p.out, ml + 5 * D, SL * 16384};
      if (PH & 8192) pg8::gemm_phase<EpiRes, pg8::StaticOrder>(lds, g, S, E, nullptr); }
    GRID_BAR();
}
template <int L>
__device__ __forceinline__ void mlp_block(const P& p, LAS unsigned char* lds, const XcdBarrier& bar) {
    const float* ml = (const float*)(p.ws + WS_MOD) + (size_t)L * NSEQ * NMODC;
    norm_phase<1, false>(p, p.in[7] + L * D, ml + 3 * D, ml + 4 * D);
    GRID_BAR();
    mlp_slab<L, 0>(p, lds, bar); mlp_slab<L, 1>(p, lds, bar); mlp_slab<L, 2>(p, lds, bar);
}

__global__ void __launch_bounds__(NTHREADS, 2) hybrid_fwd(P p) {
    extern __shared__ __attribute__((aligned(16))) unsigned char lds_raw[];
    LAS unsigned char* lds = (LAS unsigned char*)lds_raw;
    cg::grid_group grid = cg::this_grid();
    unsigned char* ws = p.ws;
    const float* mod = (const float*)(ws + WS_MOD);
    bf16_t* hb = (bf16_t*)(ws + WS_HBUF);
    bf16_t* big = (bf16_t*)(ws + WS_BIG);

    volatile LAS unsigned* bst = (volatile LAS unsigned*)(lds + LDS_BYTES - 16);
    if (threadIdx.x < 2) bst[threadIdx.x] = 0u;
    if (blockIdx.x == 0) for (int i = threadIdx.x; i < XCD_BAR_WORDS; i += NTHREADS) ((unsigned*)(ws + WS_BARW))[i] = 0u;
    __syncthreads();
    grid.sync();
    const XcdBarrier bar = xcd_barrier_post((unsigned*)(ws + WS_BARW), bst);
    if (PH & 1) p0_prep(p, lds);
    GRID_BAR();
    if (PH & 2) norm_phase<0, false>(p, p.in[6], mod + 0 * D, mod + 1 * D);
    GRID_BAR();
    if (PH & 4) s5_pass<false>(p, lds);
    GRID_BAR();
    if (PH & 8) s5_carry(p);
    GRID_BAR();
    if (PH & 16) s5_pass<true>(p, lds);
    GRID_BAR();
#if (DUP & 1)
    if (PH & 4) s5_pass<false>(p, lds);
    GRID_BAR();
    if (PH & 8) s5_carry(p);
    GRID_BAR();
    if (PH & 16) s5_pass<true>(p, lds);
    GRID_BAR();
#endif
    { pg8::Gemm g{big, (const bf16_t*)(ws + WS_WGLU), T, 2 * D, D}; pg8::StaticOrder S; S.init(T, 2 * D, gridDim.x, blockIdx.x);
      EpiGlu E{p.in[0], p.in[1], p.out, mod + 2 * D};
      if (PH & 512) pg8::gemm_phase<EpiGlu, pg8::StaticOrder>(lds, g, S, E, nullptr);
#if (DUP & 8)
      GRID_BAR();
      pg8::gemm_phase<EpiGlu, pg8::StaticOrder>(lds, g, S, E, nullptr);
#endif
    }
    GRID_BAR();
    mlp_block<0>(p, lds, bar);
    norm_phase<1, false>(p, p.in[6] + D, mod + (size_t)NSEQ * NMODC + 0 * D, mod + (size_t)NSEQ * NMODC + 1 * D);
    GRID_BAR();
    { pg8::Gemm g{hb, (const bf16_t*)(ws + WS_WIN), T, WIN_N, D}; pg8::StaticOrder S; S.init(T, WIN_N, gridDim.x, blockIdx.x);
      EpiBf<0> E{big, PROJ_N, (float*)(ws + WS_A1)};
      if (PH & 1024) pg8::gemm_phase<EpiBf<0>, pg8::StaticOrder>(lds, g, S, E, nullptr); }
    GRID_BAR();
    if (PH & 32) gla_phase<0>(p, lds);
    GRID_BAR();
    if (PH & 64) gla_carry(p);
    GRID_BAR();
    if (PH & 128) gla_phase<1>(p, lds);
    GRID_BAR();
#if (DUP & 2)
    if (PH & 32) gla_phase<0>(p, lds);
    GRID_BAR();
    if (PH & 64) gla_carry(p);
    GRID_BAR();
    if (PH & 128) gla_phase<1>(p, lds);
    GRID_BAR();
#endif
    if (PH & 256) gla_phase<2>(p, lds);
    GRID_BAR();
    { pg8::Gemm g{hb, (const bf16_t*)(ws + WS_WOUT), T, D, D}; pg8::StaticOrder S; S.init(T, D, gridDim.x, blockIdx.x);
      EpiRes E{p.out, mod + (size_t)NSEQ * NMODC + 2 * D, 0};
      if (PH & 2048) pg8::gemm_phase<EpiRes, pg8::StaticOrder>(lds, g, S, E, nullptr); }
    GRID_BAR();
    mlp_block<1>(p, lds, bar);
#if (DUP & 4)
#pragma unroll 1
    for (int rep = 0; rep < 20; ++rep) GRID_BAR();
#endif
    if (PH == 0) norm_phase<0, true>(p, p.in[25], nullptr, nullptr); else norm_phase<1, true>(p, p.in[25], nullptr, nullptr);
}

extern "C" void kernel_launch(void* const* d_in, const int* in_sizes, int n_in, void* d_out, int out_size, void* d_ws, size_t ws_size, hipStream_t stream) {
    static int grid_blocks = 0;
    if (grid_blocks == 0) {
        if (n_in != 26 || out_size != T * D || ws_size < WS_END) { fprintf(stderr, "kernel_launch: unexpected sizes n_in %d out %d ws %zu\n", n_in, out_size, ws_size); grid_blocks = -1; return; }
        int dev = 0, cus = 0, per_cu = 0;
        hipGetDevice(&dev);
        hipDeviceGetAttribute(&cus, hipDeviceAttributeMultiprocessorCount, dev);
        hipFuncSetAttribute((const void*)hybrid_fwd, hipFuncAttributeMaxDynamicSharedMemorySize, LDS_BYTES);
        hipOccupancyMaxActiveBlocksPerMultiprocessor(&per_cu, (const void*)hybrid_fwd, NTHREADS, LDS_BYTES);
        if (per_cu < 1) { fprintf(stderr, "kernel_launch: occupancy query says %d blocks per CU\n", per_cu); grid_blocks = -1; return; }
        grid_blocks = cus;
        if (grid_blocks % 8) grid_blocks -= grid_blocks % 8;
    }
    if (grid_blocks < 0) return;
    P p{};
    for (int i = 0; i < 26; ++i) p.in[i] = (const float*)d_in[i];
    p.out = (float*)d_out; p.ws = (unsigned char*)d_ws;
    void* args[] = {&p};
    hipError_t e = hipLaunchCooperativeKernel((const void*)hybrid_fwd, dim3(grid_blocks), dim3(NTHREADS), args, LDS_BYTES, stream);
    if (e != hipSuccess) fprintf(stderr, "cooperative launch failed: %s (grid %d)\n", hipGetErrorString(e), grid_blocks);
}
```

```cpp
#include <hip/hip_runtime.h>
#include <hip/hip_cooperative_groups.h>
#include <cstdio>
namespace cg = cooperative_groups;

namespace pg8 {
#define PG8_LAS __attribute__((address_space(3)))
typedef unsigned short bf16_t;
typedef short bf16x8 __attribute__((ext_vector_type(8)));
typedef float f32x4 __attribute__((ext_vector_type(4)));
typedef unsigned u32x4 __attribute__((ext_vector_type(4)));
constexpr int BM = 256, BK = 64, HALF = 128, HTB = HALF * BK * 2  , STAGE_BYTES = 8 * HTB, NXCD = 8, WGM = 8;

__host__ __device__ __forceinline__ int lds_byte(int r, int c) { const int st = (r >> 4) * 2 + (c >> 5), rr = r & 15, cc = c & 31, ob = rr * 64 + cc * 2; return st * 1024 + (ob ^ (((ob >> 9) & 1) << 5)); }
__host__ __device__ __forceinline__ void stage_rc(int b, int& R, int& C) { const int st = b / 1024, sb = b % 1024, swz = sb ^ (((sb >> 9) & 1) << 5); R = (st >> 1) * 16 + swz / 64; C = (st & 1) * 32 + (swz % 64) / 2; }
__host__ __device__ __forceinline__ int perm32(int rho) { const int n = rho >> 4, i = rho & 15; return 8 * (i >> 2) + 4 * n + (i & 3); }

struct Unit { int pm, pn; };
struct Gemm { const bf16_t* A; const bf16_t* Bt; int M, N, K; };

struct StaticOrder {
    int nM, nN, nwg, G, c;
    __host__ __device__ void init(int M, int N, int G_, int c_) { nM = M / BM; nN = N / BM; nwg = nM * nN; G = G_; c = c_; }
    __host__ __device__ bool next(int i, Unit& u) const {
        const long L = (long)i * G + c; if (L >= nwg) return false;
        int wgid = (int)L; { const int q = nwg / NXCD, r = nwg % NXCD, xcd = wgid % NXCD, off = wgid / NXCD; wgid = (xcd < r ? xcd * (q + 1) : r * (q + 1) + (xcd - r) * q) + off; }
        const int nig = WGM * nN, gid = wgid / nig, fm = gid * WGM, gsz = (nM - fm) < WGM ? (nM - fm) : WGM;
        u.pm = fm + ((wgid % nig) % gsz); u.pn = (wgid % nig) / gsz; return true;
    }
    __device__ __forceinline__ void a_ready(const Unit&) const {}
    __device__ __forceinline__ void done(const Unit&) const {}
};


template <class Epi, class Sched, bool STAMP = false>
__device__ __forceinline__ void gemm_phase(PG8_LAS unsigned char* lds, const Gemm g, const Sched& S, const Epi& E, unsigned long long* stamps) {
    int tid_ = threadIdx.x; asm volatile("" : "+v"(tid_));
    const int tid = tid_, wid = __builtin_amdgcn_readfirstlane(tid >> 6), lane = tid & 63, wr = wid >> 2, wc = wid & 3, fr = lane & 15, fq = lane >> 4;
    const int K = g.K, nt = K / BK;
    int ts_lo = 0, ts_hi = 0, nts = 0; const unsigned long long rt_entry = STAMP ? (unsigned long long)wall_clock64() : 0ull;
#define PG8_STAMP() do { if (STAMP && wid == 0 && nts < 64) { const unsigned long long _c = (unsigned long long)clock64(); \
        ts_lo = (lane == nts) ? (int)(unsigned)_c : ts_lo; ts_hi = (lane == nts) ? (int)(unsigned)(_c >> 32) : ts_hi; ++nts; } } while (0)
    PG8_STAMP();
    unsigned voffA[2], voffB[2];
#pragma unroll
    for (int i = 0; i < 2; ++i) { int R, C; stage_rc(tid * 16 + i * 8192, R, C); const int Rb = Epi::PERM ? ((R & ~31) + perm32(R & 31)) : R;
        voffA[i] = (unsigned)(R * K + C) * 2u; voffB[i] = (unsigned)(Rb * K + C) * 2u; }
    const size_t kstep = (size_t)(BK * 2);
    const size_t hstep = (size_t)HALF * K * 2;
    const size_t tstep = 2 * hstep;
    const unsigned ldsw = (unsigned)wid * 1024u;
    const int aoff = lds_byte(wr * 64 + fr, fq * 8), boff = lds_byte(wc * 32 + fr, fq * 8);
#define PG8_SA(b, h) (((b) * 2 + (h)) * HTB)
#define PG8_SB(b, h) ((4 + (b) * 2 + (h)) * HTB)
#define PG8_STAGE(bufoff, gbase, voff) do { _Pragma("unroll") for (int _i = 0; _i < 2; ++_i) \
        __builtin_amdgcn_global_load_lds((const unsigned*)((const char*)(gbase) + (voff)[_i]), (PG8_LAS unsigned*)(lds + (bufoff) + ldsw + _i * 8192), 16, 0, 0); } while (0)
#define PG8_LDA(dst, b, h) do { _Pragma("unroll") for (int m = 0; m < 4; ++m) _Pragma("unroll") for (int k = 0; k < 2; ++k) dst[m][k] = *(const PG8_LAS bf16x8*)(lds + PG8_SA(b, h) + aoff + m * 2048 + k * 1024); } while (0)
#define PG8_LDB(dst, b, h) do { _Pragma("unroll") for (int n = 0; n < 2; ++n) _Pragma("unroll") for (int k = 0; k < 2; ++k) dst[n][k] = *(const PG8_LAS bf16x8*)(lds + PG8_SB(b, h) + boff + n * 2048 + k * 1024); } while (0)
#define PG8_MMA(ai, bj, At, Bt) do { __builtin_amdgcn_s_setprio(1); _Pragma("unroll") for (int m = 0; m < 4; ++m) _Pragma("unroll") for (int n = 0; n < 2; ++n) _Pragma("unroll") for (int k = 0; k < 2; ++k) \
        acc[ai][bj][m][n] = __builtin_amdgcn_mfma_f32_16x16x32_bf16(Bt[n][k], At[m][k], acc[ai][bj][m][n], 0, 0, 0); __builtin_amdgcn_s_setprio(0); } while (0)
#define PG8_WAIT_V(n) asm volatile("s_waitcnt vmcnt(" #n ")" ::: "memory")
#define PG8_WAIT_L(n) asm volatile("s_waitcnt lgkmcnt(" #n ")" ::: "memory")
#define PG8_BAR __builtin_amdgcn_s_barrier()
#define PG8_SCHED __builtin_amdgcn_sched_barrier(0)
    Unit cur, nxt; int ui = 0;
    if (!S.next(0, cur)) return;
    f32x4 acc[2][2][4][2];
#pragma unroll
    for (int a = 0; a < 2; ++a)
#pragma unroll
        for (int b = 0; b < 2; ++b)
#pragma unroll
            for (int m = 0; m < 4; ++m)
#pragma unroll
                for (int n = 0; n < 2; ++n) acc[a][b][m][n] = (f32x4){0.f, 0.f, 0.f, 0.f};
    bf16x8 At[4][2], B0[2][2], B1[2][2];
    const char* cA = (const char*)g.A + (size_t)cur.pm * tstep; const char* cB = (const char*)g.Bt + (size_t)cur.pn * tstep;
    S.a_ready(cur);
    PG8_STAGE(PG8_SB(0, 0), cB, voffB); PG8_STAGE(PG8_SA(0, 0), cA, voffA); PG8_STAGE(PG8_SB(0, 1), cB + hstep, voffB); PG8_STAGE(PG8_SA(0, 1), cA + hstep, voffA);
    if (wr == 1) PG8_BAR;
    PG8_WAIT_V(4); PG8_BAR;
    PG8_STAGE(PG8_SB(1, 0), cB + kstep, voffB); PG8_STAGE(PG8_SA(1, 0), cA + kstep, voffA); PG8_STAGE(PG8_SB(1, 1), cB + hstep + kstep, voffB);
    PG8_WAIT_V(6); PG8_BAR;
    PG8_STAMP();
    for (;;) {
        const bool has_next = S.next(ui + 1, nxt);
        const char* nA = has_next ? (const char*)g.A + (size_t)nxt.pm * tstep : cA; const char* nB = has_next ? (const char*)g.Bt + (size_t)nxt.pn * tstep : cB;
        for (int t = 0; t < nt; t += 2) {
            const bool last = (t == nt - 2);
            const char* a1 = cA + (size_t)(t + 1) * kstep;
            const char* a2 = last ? nA : cA + (size_t)(t + 2) * kstep; const char* b2 = last ? nB : cB + (size_t)(t + 2) * kstep;
            const char* a3 = a2 + kstep; const char* b3 = b2 + kstep;
            if (last && has_next) S.a_ready(nxt);
            PG8_LDB(B0, 0, 0); PG8_SCHED; PG8_LDA(At, 0, 0); PG8_STAGE(PG8_SA(1, 1), a1 + hstep, voffA);
            PG8_WAIT_L(8); PG8_BAR; PG8_WAIT_L(0); PG8_MMA(0, 0, At, B0); PG8_BAR; PG8_SCHED;
            PG8_LDB(B1, 0, 1); PG8_STAGE(PG8_SB(0, 0), b2, voffB);
            PG8_BAR; PG8_WAIT_L(0); PG8_MMA(0, 1, At, B1); PG8_BAR;
            PG8_LDA(At, 0, 1); PG8_STAGE(PG8_SA(0, 0), a2, voffA);
            PG8_BAR; PG8_WAIT_L(0); PG8_MMA(1, 0, At, B0); PG8_BAR; PG8_SCHED;
            PG8_STAGE(PG8_SB(0, 1), b2 + hstep, voffB);
            PG8_WAIT_V(6); PG8_BAR; PG8_MMA(1, 1, At, B1); PG8_BAR;
            PG8_LDB(B0, 1, 0); PG8_SCHED; PG8_LDA(At, 1, 0); PG8_STAGE(PG8_SA(0, 1), a2 + hstep, voffA);
            PG8_WAIT_L(8); PG8_BAR; PG8_WAIT_L(0); PG8_MMA(0, 0, At, B0); PG8_BAR; PG8_SCHED;
            PG8_LDB(B1, 1, 1); PG8_STAGE(PG8_SB(1, 0), b3, voffB);
            PG8_BAR; PG8_WAIT_L(0); PG8_MMA(0, 1, At, B1); PG8_BAR;
            PG8_LDA(At, 1, 1); PG8_STAGE(PG8_SA(1, 0), a3, voffA);
            PG8_BAR; PG8_WAIT_L(0); PG8_MMA(1, 0, At, B0); PG8_BAR; PG8_SCHED;
            PG8_STAGE(PG8_SB(1, 1), b3 + hstep, voffB);
            PG8_WAIT_V(6); PG8_BAR; PG8_MMA(1, 1, At, B1); PG8_BAR;
        }
        PG8_STAMP();
        if constexpr (!Epi::AFTER_DRAIN) { E(acc, cur, wr, wc, fr, fq); S.done(cur); }
        PG8_STAMP();
        if (!has_next) break;
#pragma unroll
        for (int a = 0; a < 2; ++a)
#pragma unroll
            for (int b = 0; b < 2; ++b)
#pragma unroll
                for (int m = 0; m < 4; ++m)
#pragma unroll
                    for (int n = 0; n < 2; ++n) acc[a][b][m][n] = (f32x4){0.f, 0.f, 0.f, 0.f};
        cur = nxt; cA = nA; cB = nB; ++ui;
    }
    PG8_WAIT_V(0);
    if (wr == 0) PG8_BAR;
    PG8_BAR;
    if constexpr (Epi::AFTER_DRAIN) { E.fused(acc, cur, wr, wc, fr, fq, lds, wid, lane); S.done(cur); }
    PG8_STAMP();
    if (STAMP && wid == 0) { stamps[lane] = lane < nts ? (((unsigned long long)(unsigned)ts_hi << 32) | (unsigned)ts_lo) : 0ull;
        if (lane == 62) stamps[62] = rt_entry; if (lane == 63) stamps[63] = (unsigned long long)wall_clock64(); }
#undef PG8_STAMP
#undef PG8_SA
#undef PG8_SB
#undef PG8_STAGE
#undef PG8_LDA
#undef PG8_LDB
#undef PG8_MMA
#undef PG8_WAIT_V
#undef PG8_WAIT_L
#undef PG8_BAR
#undef PG8_SCHED
}
}


#define LAS __attribute__((address_space(3)))
typedef unsigned short bf16_t;
typedef short bf16x8 __attribute__((ext_vector_type(8)));
typedef short bf16x4 __attribute__((ext_vector_type(4)));
typedef float f32x4 __attribute__((ext_vector_type(4)));
typedef float f32x16 __attribute__((ext_vector_type(16)));
typedef unsigned u32x4 __attribute__((ext_vector_type(4)));
typedef unsigned u32x2 __attribute__((ext_vector_type(2)));

constexpr int D = 1024, T = 49152, NSEQ = 10, NMODC = 6144, FF = 4096;
constexpr int T_PROMPT = 32768;
constexpr float EPS = 1e-6f;
#ifndef PH
#define PH 16383
#endif
#ifndef DUP
#define DUP 0
#endif
constexpr int NWAVES = 8, NTHREADS = 512;
constexpr int LDS_BYTES = 139264;
constexpr int WIN_N = 3328;
constexpr int PROJ_N = 3072;

constexpr size_t MiB = 1u << 20;
constexpr size_t WS_MOD = 0;
constexpr size_t WS_BARW = 491520;
constexpr size_t WS_ABAR = 512 * 1024;
constexpr size_t WS_BBT = 1 * MiB;
constexpr size_t WS_CT = 1 * MiB + 512 * 1024;
constexpr size_t WS_DTOT = 2 * MiB;
constexpr size_t WS_A1 = 3 * MiB;
constexpr size_t WS_WIN = 10 * MiB;
constexpr size_t WS_WOUT = WS_WIN + (size_t)WIN_N * D * 2;
constexpr size_t WS_W1B = WS_WOUT + (size_t)D * D * 2;
constexpr size_t WS_W2B = WS_W1B + (size_t)FF * D * 2;
constexpr size_t WS_HBUF = 35 * MiB;
constexpr size_t WS_BIG = 131 * MiB;
constexpr size_t WS_S5E = WS_BIG + 96 * MiB;
constexpr size_t WS_X = 419 * MiB;
constexpr size_t WS_WGLU = WS_X;
constexpr size_t WS_W1A = WS_X + 4 * MiB;
constexpr size_t WS_W2A = WS_X + 12 * MiB;
constexpr size_t WS_SBUF = WS_X;
constexpr size_t WS_END = 467 * MiB;
static_assert(WS_W2B + (size_t)FF * D * 2 <= WS_HBUF, "ws map");

struct P { const float* in[26]; float* out; unsigned char* ws; };

typedef __bf16 bf16n2 __attribute__((ext_vector_type(2)));
typedef float f32x2n __attribute__((ext_vector_type(2)));
__device__ __forceinline__ unsigned pk_bf16(float lo, float hi) { const f32x2n f = {lo, hi}; const bf16n2 v = __builtin_convertvector(f, bf16n2); return __builtin_bit_cast(unsigned, v); }
__device__ __forceinline__ bf16_t f2bf(float f) { return (bf16_t)(pk_bf16(f, 0.f) & 0xffffu); }
__device__ __forceinline__ float bf2f(bf16_t b) { return __uint_as_float(((unsigned)b) << 16); }
__device__ __forceinline__ float wave_sum(float v) {
#pragma unroll
    for (int o = 1; o < 64; o <<= 1) v += __shfl_xor(v, o);
    return v;
}
__device__ __forceinline__ int row_seq(int row) { return row < T_PROMPT ? (row >> 14) : 2 + ((row - T_PROMPT) >> 11); }
__device__ __forceinline__ float sigmoidf_(float x) { return 1.0f / (1.0f + __expf(-x)); }
__device__ __forceinline__ float gelu_tanh(float y) {
    const float a = 0.7978845608028654f * (y + 0.044715f * y * y * y);
    const float th = 1.0f - 2.0f / (__expf(2.0f * a) + 1.0f);
    return 0.5f * y * (1.0f + th);
}
#define CFENCE() asm volatile("" ::: "memory")
#define LDS_WAIT() asm volatile("s_waitcnt lgkmcnt(0)" ::: "memory")

struct EpiRes {
    static constexpr bool PERM = false, AFTER_DRAIN = false;
    float* x; const float* gate; int row_off;
    __device__ __forceinline__ void operator()(const pg8::f32x4 (&acc)[2][2][4][2], const pg8::Unit& u, int wr, int wc, int fr, int fq) const {
        const int row0 = row_off + u.pm * 256 + wr * 64 + fr, col0 = u.pn * 256 + wc * 32 + 4 * fq;
        const float* gp = gate + (size_t)row_seq(row_off + u.pm * 256) * NMODC;
        pg8::f32x4 gv[2][2];
#pragma unroll
        for (int bj = 0; bj < 2; ++bj)
#pragma unroll
            for (int n = 0; n < 2; ++n) gv[bj][n] = *(const pg8::f32x4*)(gp + col0 + bj * 128 + n * 16);
#pragma unroll
        for (int ai = 0; ai < 2; ++ai)
#pragma unroll
            for (int m = 0; m < 4; ++m) { float* rowp = x + (size_t)(row0 + ai * 128 + m * 16) * D + col0;
#pragma unroll
                for (int bj = 0; bj < 2; ++bj)
#pragma unroll
                    for (int n = 0; n < 2; ++n) { pg8::f32x4* q = (pg8::f32x4*)(rowp + bj * 128 + n * 16); *q = *q + gv[bj][n] * acc[ai][bj][m][n]; }
                asm volatile("" ::: "memory"); }
    }
};
struct EpiGlu {
    static constexpr bool PERM = false, AFTER_DRAIN = false;
    const float* xp; const float* xs; float* out; const float* gate;
    __device__ __forceinline__ void operator()(const pg8::f32x4 (&acc)[2][2][4][2], const pg8::Unit& u, int wr, int wc, int fr, int fq) const {
        const int row0 = u.pm * 256 + wr * 64 + fr, col0 = u.pn * 128 + wc * 32 + 4 * fq;
        const float* gp = gate + (size_t)row_seq(u.pm * 256) * NMODC;
        pg8::f32x4 gv[2];
#pragma unroll
        for (int n = 0; n < 2; ++n) gv[n] = *(const pg8::f32x4*)(gp + col0 + n * 16);
#pragma unroll
        for (int ai = 0; ai < 2; ++ai)
#pragma unroll
            for (int m = 0; m < 4; ++m) { const int row = row0 + ai * 128 + m * 16;
                const float* xin = row < T_PROMPT ? xp + (size_t)row * D : xs + (size_t)(row - T_PROMPT) * D;
#pragma unroll
                for (int n = 0; n < 2; ++n) { const pg8::f32x4 val = acc[ai][0][m][n], gt = acc[ai][1][m][n]; pg8::f32x4 sg;
                    sg[0] = sigmoidf_(gt[0]); sg[1] = sigmoidf_(gt[1]); sg[2] = sigmoidf_(gt[2]); sg[3] = sigmoidf_(gt[3]);
                    const pg8::f32x4 xv = *(const pg8::f32x4*)(xin + col0 + n * 16);
                    *(pg8::f32x4*)(out + (size_t)row * D + col0 + n * 16) = xv + gv[n] * val * sg; }
                asm volatile("" ::: "memory"); }
    }
};
template <int ACT> struct EpiBf {
    static constexpr bool PERM = true, AFTER_DRAIN = false;
    bf16_t* O; int ldc; float* a1;
    __device__ __forceinline__ void operator()(const pg8::f32x4 (&acc)[2][2][4][2], const pg8::Unit& u, int wr, int wc, int fr, int fq) const {
        const int row0 = u.pm * 256 + wr * 64 + fr;
        if (ACT == 0 && u.pn == 12) {
            if (wc == 0) {
#pragma unroll
                for (int ai = 0; ai < 2; ++ai)
#pragma unroll
                    for (int m = 0; m < 4; ++m) { float* rp = a1 + (size_t)(row0 + ai * 128 + m * 16) * 32 + 8 * fq;
                        *(pg8::f32x4*)rp = acc[ai][0][m][0]; *(pg8::f32x4*)(rp + 4) = acc[ai][0][m][1]; }
            }
            return;
        }
        const int col0 = u.pn * 256 + wc * 32 + 8 * fq;
#pragma unroll
        for (int ai = 0; ai < 2; ++ai)
#pragma unroll
            for (int m = 0; m < 4; ++m) { bf16_t* rowp = O + (size_t)(row0 + ai * 128 + m * 16) * ldc + col0;
#pragma unroll
                for (int bj = 0; bj < 2; ++bj) { pg8::f32x4 v0 = acc[ai][bj][m][0], v1 = acc[ai][bj][m][1];
                    if (ACT == 1) {
#pragma unroll
                        for (int e = 0; e < 4; ++e) { const float a = fmaxf(v0[e], 0.f), b = fmaxf(v1[e], 0.f); v0[e] = a * a; v1[e] = b * b; } }
                    pg8::u32x4 wv; wv.x = pk_bf16(v0[0], v0[1]); wv.y = pk_bf16(v0[2], v0[3]); wv.z = pk_bf16(v1[0], v1[1]); wv.w = pk_bf16(v1[2], v1[3]);
                    *(pg8::u32x4*)(rowp + bj * 128) = wv; } }
    }
};

__device__ __forceinline__ void transpose_item(const float* W, int K, int N, int srccol0, bf16_t* WT, int dstrow0, int k0, LAS float* scr, int lane) {
#pragma unroll 8
    for (int i = 0; i < 32; ++i) { const int kk = 2 * i + (lane >> 5); scr[kk * 33 + (lane & 31)] = W[(size_t)(k0 + kk) * N + srccol0 + (lane & 31)]; }
    LDS_WAIT();
    const int c = lane & 7;
#pragma unroll
    for (int j = 0; j < 4; ++j) { const int n = (lane >> 3) + 8 * j; const LAS float* s = scr + (8 * c) * 33 + n;
        u32x4 o; o.x = pk_bf16(s[0 * 33], s[1 * 33]); o.y = pk_bf16(s[2 * 33], s[3 * 33]); o.z = pk_bf16(s[4 * 33], s[5 * 33]); o.w = pk_bf16(s[6 * 33], s[7 * 33]);
        *(u32x4*)(WT + (size_t)(dstrow0 + n) * K + k0 + 8 * c) = o; }
    LDS_WAIT();
}

__device__ __forceinline__ void p0_prep(const P& p, LAS unsigned char* lds) {
    int tid_ = threadIdx.x; asm volatile("" : "+v"(tid_));
    const int tid = tid_, lane = tid & 63, w = tid >> 6;
    unsigned char* ws = p.ws;
    if ((int)blockIdx.x < 192) {
        LAS float* sc = (LAS float*)lds;
        LAS float* red = (LAS float*)(lds + 40960);
        for (int i = tid; i < NSEQ * D; i += NTHREADS) { const int s = i >> 10, d = i & 1023; const float c = s < 2 ? p.in[2][s * D + d] : p.in[3][(s - 2) * D + d]; sc[i] = c * sigmoidf_(c); }
        __syncthreads();
        for (int it = blockIdx.x; it < 192; it += gridDim.x) {
            const int l = it / 96, col0 = (it % 96) * 64, col = tid & 63, ks = w;
            float acc[NSEQ];
#pragma unroll
            for (int s = 0; s < NSEQ; ++s) acc[s] = 0.f;
            const float* wp = p.in[4] + ((size_t)l * D + ks * 128) * NMODC + col0 + col;
#pragma unroll 4
            for (int k = 0; k < 128; ++k) { const float wv = wp[(size_t)k * NMODC];
#pragma unroll
                for (int s = 0; s < NSEQ; ++s) acc[s] += sc[s * D + ks * 128 + k] * wv; }
#pragma unroll
            for (int s = 0; s < NSEQ; ++s) red[(ks * NSEQ + s) * 64 + col] = acc[s];
            __syncthreads();
            for (int i = tid; i < NSEQ * 64; i += NTHREADS) { const int s = i >> 6, cc = i & 63; float v = 0.f;
#pragma unroll
                for (int k8 = 0; k8 < 8; ++k8) v += red[(k8 * NSEQ + s) * 64 + cc];
                ((float*)(ws + WS_MOD))[((size_t)l * NSEQ + s) * NMODC + col0 + cc] = v + p.in[5][l * NMODC + col0 + cc]; }
            __syncthreads();
        }
    }
    __syncthreads();
    {
        LAS float* scr = (LAS float*)(lds + w * 16384);
        const int gw = blockIdx.x * NWAVES + w, NGW = gridDim.x * NWAVES;
        constexpr int I_GLU = 16 * 64, I_WIN = 16 * 96, I_WOUT = 16 * 32, I_W1 = 16 * 128, I_W2 = 64 * 32;
        constexpr int NITEMS = I_GLU + I_WIN + I_WOUT + 2 * I_W1 + 2 * I_W2;
        for (int it = gw; it < NITEMS; it += NGW) {
            int r = it;
            if (r < I_GLU) { const int kb = r / 64, nb = r % 64, n0 = nb * 32, pn = n0 >> 8, bj = (n0 >> 7) & 1, r0 = n0 & 127;
                transpose_item(p.in[16], D, 2 * D, bj * D + pn * 128 + r0, (bf16_t*)(ws + WS_WGLU), n0, kb * 64, scr, lane); continue; }
            r -= I_GLU;
            if (r < I_WIN) { const int kb = r / 96, nb = r % 96; transpose_item(p.in[17], D, PROJ_N, nb * 32, (bf16_t*)(ws + WS_WIN), nb * 32, kb * 64, scr, lane); continue; }
            r -= I_WIN;
            if (r < I_WOUT) { const int kb = r / 32, nb = r % 32; transpose_item(p.in[22], D, D, nb * 32, (bf16_t*)(ws + WS_WOUT), nb * 32, kb * 64, scr, lane); continue; }
            r -= I_WOUT;
            if (r < 2 * I_W1) { const int l = r / I_W1, q = r % I_W1, kb = q / 128, nb = q % 128;
                transpose_item(p.in[23] + (size_t)l * D * FF, D, FF, nb * 32, (bf16_t*)(ws + (l ? WS_W1B : WS_W1A)), nb * 32, kb * 64, scr, lane); continue; }
            r -= 2 * I_W1;
            { const int l = r / I_W2, q = r % I_W2, kb = q / 32, nb = q % 32;
                transpose_item(p.in[24] + (size_t)l * FF * D, FF, D, nb * 32, (bf16_t*)(ws + (l ? WS_W2B : WS_W2A)), nb * 32, kb * 64, scr, lane); }
        }
        bf16_t* wt = (bf16_t*)(ws + WS_WIN);
        for (int i = blockIdx.x * NTHREADS + tid; i < 256 * D; i += gridDim.x * NTHREADS) { const int r = i >> 10, k = i & 1023;
            const float v = r < 32 ? p.in[18][((size_t)(r >> 4) * D + k) * 16 + (r & 15)] : 0.f;
            wt[(size_t)(PROJ_N + r) * D + k] = f2bf(v); }
    }
    for (int i = blockIdx.x * NTHREADS + tid; i < 2 * 64 * 64; i += gridDim.x * NTHREADS) {
        const int pp = i & 63, dg = i >> 6;
        const float lr = p.in[8][i], li = p.in[9][i], dt = __expf(p.in[10][dg]);
        const float mag = __expf(lr * dt); float sn, cs; sincosf(li * dt, &sn, &cs);
        const float abr = mag * cs, abi = mag * sn, den = lr * lr + li * li;
        const float zr = ((abr - 1.0f) * lr + abi * li) / den, zi = (abi * lr - (abr - 1.0f) * li) / den;
        float* ab = (float*)(ws + WS_ABAR); ab[2 * i] = abr; ab[2 * i + 1] = abi;
        bf16_t* bbt = (bf16_t*)(ws + WS_BBT); bf16_t* ct = (bf16_t*)(ws + WS_CT);
#pragma unroll
        for (int h = 0; h < 16; ++h) {
            const float br = p.in[11][(size_t)i * 16 + h], bi = p.in[12][(size_t)i * 16 + h];
            bbt[((size_t)dg * 128 + pp) * 16 + h] = f2bf(zr * br - zi * bi);
            bbt[((size_t)dg * 128 + 64 + pp) * 16 + h] = f2bf(zr * bi + zi * br);
            ct[((size_t)dg * 16 + h) * 128 + pp] = f2bf(p.in[13][((size_t)dg * 16 + h) * 64 + pp]);
            ct[((size_t)dg * 16 + h) * 128 + 64 + pp] = f2bf(-p.in[14][((size_t)dg * 16 + h) * 64 + pp]);
        }
    }
}

template <int SRC, bool FINAL>
__device__ __forceinline__ void norm_phase(const P& p, const float* gvec, const float* shift, const float* scale) {
    int tid_ = threadIdx.x; asm volatile("" : "+v"(tid_));
    const int tid = tid_, lane = tid & 63, w = tid >> 6;
    const int gw = blockIdx.x * NWAVES + w, NGW = gridDim.x * NWAVES;
    bf16_t* hb = (bf16_t*)(p.ws + WS_HBUF);
    f32x4 gq[4];
#pragma unroll
    for (int j = 0; j < 4; ++j) gq[j] = *(const f32x4*)(gvec + 4 * lane + 256 * j);
    for (int row = gw; row < T; row += NGW) {
        const float* xr = SRC == 0 ? (row < T_PROMPT ? p.in[0] + (size_t)row * D : p.in[1] + (size_t)(row - T_PROMPT) * D) : p.out + (size_t)row * D;
        f32x4 v[4]; float ss = 0.f;
#pragma unroll
        for (int j = 0; j < 4; ++j) { v[j] = *(const f32x4*)(xr + 4 * lane + 256 * j); ss += (v[j][0] * v[j][0] + v[j][1] * v[j][1]) + (v[j][2] * v[j][2] + v[j][3] * v[j][3]); }
        const float rstd = rsqrtf(wave_sum(ss) * (1.0f / D) + EPS);
        if (FINAL) {
#pragma unroll
            for (int j = 0; j < 4; ++j) *(f32x4*)(p.out + (size_t)row * D + 4 * lane + 256 * j) = v[j] * rstd * gq[j];
        } else {
            const int s = row_seq(row);
#pragma unroll
            for (int j = 0; j < 4; ++j) { const f32x4 sh = *(const f32x4*)(shift + (size_t)s * NMODC + 4 * lane + 256 * j), sc = *(const f32x4*)(scale + (size_t)s * NMODC + 4 * lane + 256 * j);
                const f32x4 o = (v[j] * rstd * gq[j]) * (sc + 1.0f) + sh;
                u32x2 wv; wv.x = pk_bf16(o[0], o[1]); wv.y = pk_bf16(o[2], o[3]);
                *(u32x2*)(hb + (size_t)row * D + 4 * lane + 256 * j) = wv; }
        }
    }
}

constexpr int S5_NCH = 384, S5_HROW = 272, S5_UROW = 48, S5_UOFF = 32 * S5_HROW, S5_WAVE_LDS = S5_UOFF + 128 * S5_UROW;
#define CMAD(sr, si, mr, mi, br, bi) do { const float nr_ = (sr) * (mr) - (si) * (mi) + (br); const float ni_ = (sr) * (mi) + (si) * (mr) + (bi); (sr) = nr_; (si) = ni_; } while (0)
template <bool PC>
__device__ __forceinline__ void s5_pass(const P& p, LAS unsigned char* lds) {
    int tid_ = threadIdx.x; asm volatile("" : "+v"(tid_));
    const int tid = tid_, lane = tid & 63, w = __builtin_amdgcn_readfirstlane(tid >> 6);
    const int b = blockIdx.x, g = (b & 7) * 8 + w;
    const int hh = lane >> 5, l32 = lane & 31, l16 = lane & 15, q16 = lane >> 4;
    LAS unsigned char* const H = lds + w * S5_WAVE_LDS;
    LAS unsigned char* const hwr = H + (4 * hh) * S5_HROW + l32 * 4;
    const LAS unsigned char* const hrd = H + l16 * S5_HROW + q16 * 16;
    const bf16_t* hb = (const bf16_t*)(p.ws + WS_HBUF);
    bf16_t* gout = (bf16_t*)(p.ws + WS_BIG);
    float* E = (float*)(p.ws + WS_S5E);
    const bf16_t* bbt = (const bf16_t*)(p.ws + WS_BBT); const bf16_t* ct = (const bf16_t*)(p.ws + WS_CT); const float* ab = (const float*)(p.ws + WS_ABAR);
    const float dsk = p.in[15][g * 16 + l16];
    const int cstride = (int)(gridDim.x >> 3);
    const bf16_t* const ub = hb + (size_t)l32 * D + g * 16 + 8 * hh;
    bf16x8 afn[4]; f32x2n enr[2], eni[2];
    { const int c0 = b >> 3;
      if (c0 < S5_NCH) {
#pragma unroll
        for (int sb = 0; sb < 4; ++sb) afn[sb] = *(const bf16x8*)(ub + (size_t)(c0 * 128 + sb * 32) * D);
        if (PC) {
#pragma unroll
            for (int dir = 0; dir < 2; ++dir) { const size_t eo = (((size_t)dir * S5_NCH + c0) * 64 + g) * 128; enr[dir] = *(const f32x2n*)(E + eo + 2 * l32); eni[dir] = *(const f32x2n*)(E + eo + 64 + 2 * l32); } } } }
    for (int c = b >> 3; c < S5_NCH; c += cstride) {
        const int tok0 = c * 128;
        f32x2n ecr[2], eci[2];
#pragma unroll
        for (int sb = 0; sb < 4; ++sb) *(LAS bf16x8*)(H + S5_UOFF + (sb * 32 + l32) * S5_UROW + 16 * hh) = afn[sb];
#pragma unroll
        for (int dir = 0; dir < 2; ++dir) { ecr[dir] = enr[dir]; eci[dir] = eni[dir]; }
        CFENCE(); LDS_WAIT(); CFENCE();
        { int cn = c + cstride; asm volatile("" : "+s"(cn));
          if (cn < S5_NCH) {
#pragma unroll
            for (int sb = 0; sb < 4; ++sb) afn[sb] = *(const bf16x8*)(ub + (size_t)(cn * 128 + sb * 32) * D);
            if (PC) {
#pragma unroll
                for (int dir = 0; dir < 2; ++dir) { const size_t eo = (((size_t)dir * S5_NCH + cn) * 64 + g) * 128; enr[dir] = *(const f32x2n*)(E + eo + 2 * l32); eni[dir] = *(const f32x2n*)(E + eo + 64 + 2 * l32); } } } }
        f32x4 yacc[8];
#pragma unroll
        for (int j = 0; j < 8; ++j) yacc[j] = (f32x4){0.f, 0.f, 0.f, 0.f};
#pragma unroll
        for (int dir = 0; dir < 2; ++dir) {
            const size_t eoff = (((size_t)dir * S5_NCH + c) * 64 + g) * 128;
            const int dg = dir * 64 + g;
            bf16x8 Bf[4], Cf[4];
#pragma unroll
            for (int nb = 0; nb < 4; ++nb) Bf[nb] = *(const bf16x8*)(bbt + ((size_t)dg * 128 + (nb >> 1) * 64 + 2 * l32 + (nb & 1)) * 16 + 8 * hh);
#pragma unroll
            for (int ks = 0; ks < 4; ++ks) Cf[ks] = PC ? *(const bf16x8*)(ct + ((size_t)dg * 16 + l16) * 128 + 32 * ks + 8 * q16) : (bf16x8){0, 0, 0, 0, 0, 0, 0, 0};
            const f32x4 a1v = *(const f32x4*)(ab + ((size_t)dg * 64 + 2 * l32) * 2);
            const float a1Ar = a1v[0], a1Ai = a1v[1], a1Br = a1v[2], a1Bi = a1v[3];
            const float a2Ar = a1Ar * a1Ar - a1Ai * a1Ai, a2Ai = 2.f * a1Ar * a1Ai, a2Br = a1Br * a1Br - a1Bi * a1Bi, a2Bi = 2.f * a1Br * a1Bi;
            const float a3Ar = a2Ar * a1Ar - a2Ai * a1Ai, a3Ai = a2Ar * a1Ai + a2Ai * a1Ar, a3Br = a2Br * a1Br - a2Bi * a1Bi, a3Bi = a2Br * a1Bi + a2Bi * a1Br;
            const float a4Ar = a2Ar * a2Ar - a2Ai * a2Ai, a4Ai = 2.f * a2Ar * a2Ai, a4Br = a2Br * a2Br - a2Bi * a2Bi, a4Bi = 2.f * a2Br * a2Bi;
            const float a5Ar = a4Ar * a1Ar - a4Ai * a1Ai, a5Ai = a4Ar * a1Ai + a4Ai * a1Ar, a5Br = a4Br * a1Br - a4Bi * a1Bi, a5Bi = a4Br * a1Bi + a4Bi * a1Br;
            float hAr = 0.f, hAi = 0.f, hBr = 0.f, hBi = 0.f;
            if (PC) { hAr = ecr[dir][0]; hBr = ecr[dir][1]; hAi = eci[dir][0]; hBi = eci[dir][1]; }
            const bool lead = (hh == dir);
#pragma unroll
            for (int sbi = 0; sbi < 4; ++sbi) {
                const int sb = dir == 0 ? sbi : 3 - sbi;
                if (PC) __builtin_amdgcn_sched_barrier(0);
                const bf16x8 a = *(const LAS bf16x8*)(H + S5_UOFF + (sb * 32 + l32) * S5_UROW + 16 * hh);
                f32x16 acc[4];
#pragma unroll
                for (int nb = 0; nb < 4; ++nb) {
#pragma unroll
                    for (int i = 0; i < 16; ++i) acc[nb][i] = 0.f;
                    acc[nb] = __builtin_amdgcn_mfma_f32_32x32x16_bf16(a, Bf[nb], acc[nb], 0, 0, 0);
                }
                if (!PC) {
#pragma unroll
                    for (int gi = 0; gi < 4; ++gi)
#pragma unroll
                        for (int ri = 0; ri < 4; ++ri) { const int i = 4 * (dir == 0 ? gi : 3 - gi) + (dir == 0 ? ri : 3 - ri);
                            if (sbi == 0 && gi == 0 && ri == 0) { hAr = acc[0][i]; hAi = acc[2][i]; hBr = acc[1][i]; hBi = acc[3][i]; }
                            else if (ri == 0) { CMAD(hAr, hAi, a5Ar, a5Ai, acc[0][i], acc[2][i]); CMAD(hBr, hBi, a5Br, a5Bi, acc[1][i], acc[3][i]); }
                            else { CMAD(hAr, hAi, a1Ar, a1Ai, acc[0][i], acc[2][i]); CMAD(hBr, hBi, a1Br, a1Bi, acc[1][i], acc[3][i]); } }
                } else {
#pragma unroll
                    for (int gi = 0; gi < 4; ++gi) { const int gg = dir == 0 ? gi : 3 - gi;
                        float xAr = lead ? hAr : 0.f, xAi = lead ? hAi : 0.f, xBr = lead ? hBr : 0.f, xBi = lead ? hBi : 0.f;
#pragma unroll
                        for (int k = 0; k < 4; ++k) { const int i = 4 * gg + (dir == 0 ? k : 3 - k);
                            CMAD(xAr, xAi, a1Ar, a1Ai, acc[0][i], acc[2][i]); acc[0][i] = xAr; acc[2][i] = xAi;
                            CMAD(xBr, xBi, a1Br, a1Bi, acc[1][i], acc[3][i]); acc[1][i] = xBr; acc[3][i] = xBi; }
                        float eAr = __shfl_xor(xAr, 32), eAi = __shfl_xor(xAi, 32), eBr = __shfl_xor(xBr, 32), eBi = __shfl_xor(xBi, 32);
                        if (lead) { eAr = 0.f; eAi = 0.f; eBr = 0.f; eBi = 0.f; }
                        { const int i0 = 4 * gg + (dir == 0 ? 0 : 3), i1 = 4 * gg + (dir == 0 ? 1 : 2), i2 = 4 * gg + (dir == 0 ? 2 : 1), i3 = 4 * gg + (dir == 0 ? 3 : 0);
                          acc[0][i0] += a1Ar * eAr - a1Ai * eAi; acc[2][i0] += a1Ar * eAi + a1Ai * eAr; acc[1][i0] += a1Br * eBr - a1Bi * eBi; acc[3][i0] += a1Br * eBi + a1Bi * eBr;
                          acc[0][i1] += a2Ar * eAr - a2Ai * eAi; acc[2][i1] += a2Ar * eAi + a2Ai * eAr; acc[1][i1] += a2Br * eBr - a2Bi * eBi; acc[3][i1] += a2Br * eBi + a2Bi * eBr;
                          acc[0][i2] += a3Ar * eAr - a3Ai * eAi; acc[2][i2] += a3Ar * eAi + a3Ai * eAr; acc[1][i2] += a3Br * eBr - a3Bi * eBi; acc[3][i2] += a3Br * eBi + a3Bi * eBr;
                          acc[0][i3] += a4Ar * eAr - a4Ai * eAi; acc[2][i3] += a4Ar * eAi + a4Ai * eAr; acc[1][i3] += a4Br * eBr - a4Bi * eBi; acc[3][i3] += a4Br * eBi + a4Bi * eBr;
                          const float tAr = acc[0][i3], tAi = acc[2][i3], tBr = acc[1][i3], tBi = acc[3][i3];
                          const float rAr = __shfl_xor(tAr, 32), rAi = __shfl_xor(tAi, 32), rBr = __shfl_xor(tBr, 32), rBi = __shfl_xor(tBi, 32);
                          hAr = lead ? rAr : tAr; hAi = lead ? rAi : tAi; hBr = lead ? rBr : tBr; hBi = lead ? rBi : tBi; }
                    }
#pragma unroll
                    for (int i = 0; i < 16; ++i) { const int ro = (8 * (i >> 2) + (i & 3)) * S5_HROW;
                        *(LAS unsigned*)(hwr + ro) = pk_bf16(acc[0][i], acc[1][i]); *(LAS unsigned*)(hwr + ro + 128) = pk_bf16(acc[2][i], acc[3][i]); }
                    CFENCE(); LDS_WAIT(); CFENCE();
#pragma unroll
                    for (int mb = 0; mb < 2; ++mb)
#pragma unroll
                        for (int ks = 0; ks < 4; ++ks) { const bf16x8 af = *(const LAS bf16x8*)(hrd + mb * 16 * S5_HROW + 64 * ks);
                            yacc[sb * 2 + mb] = __builtin_amdgcn_mfma_f32_16x16x32_bf16(af, Cf[ks], yacc[sb * 2 + mb], 0, 0, 0); }
                    CFENCE(); LDS_WAIT(); CFENCE();
                }
            }
            if (!PC) {
                const float oAr = __shfl_xor(hAr, 32), oAi = __shfl_xor(hAi, 32), oBr = __shfl_xor(hBr, 32), oBi = __shfl_xor(hBi, 32);
                const float s0Ar = hh ? oAr : hAr, s0Ai = hh ? oAi : hAi, s0Br = hh ? oBr : hBr, s0Bi = hh ? oBi : hBi;
                const float s1Ar = hh ? hAr : oAr, s1Ai = hh ? hAi : oAi, s1Br = hh ? hBr : oBr, s1Bi = hh ? hBi : oBi;
                float eAr, eAi, eBr, eBi;
                if (dir == 0) { eAr = a4Ar * s0Ar - a4Ai * s0Ai + s1Ar; eAi = a4Ar * s0Ai + a4Ai * s0Ar + s1Ai; eBr = a4Br * s0Br - a4Bi * s0Bi + s1Br; eBi = a4Br * s0Bi + a4Bi * s0Br + s1Bi; }
                else { eAr = a4Ar * s1Ar - a4Ai * s1Ai + s0Ar; eAi = a4Ar * s1Ai + a4Ai * s1Ar + s0Ai; eBr = a4Br * s1Br - a4Bi * s1Bi + s0Br; eBi = a4Br * s1Bi + a4Bi * s1Br + s0Bi; }
                if (hh == 0) { *(f32x2n*)(E + eoff + 2 * l32) = (f32x2n){eAr, eBr}; *(f32x2n*)(E + eoff + 64 + 2 * l32) = (f32x2n){eAi, eBi}; }
            }
        }
        CFENCE(); LDS_WAIT(); CFENCE();
        if (PC) {
#pragma unroll
            for (int j = 0; j < 8; ++j)
#pragma unroll
                for (int i = 0; i < 4; ++i) { const size_t o = (size_t)(tok0 + j * 16 + i) * D + g * 16; const int vo = 4 * q16 * D + l16;
                    const float uu = bf2f(*(const LAS bf16_t*)(H + S5_UOFF + (4 * q16) * S5_UROW + l16 * 2 + (j * 16 + i) * S5_UROW));
                    const float y = yacc[j][i] + dsk * uu; (gout + o)[vo] = f2bf(gelu_tanh(y)); }
            CFENCE(); LDS_WAIT(); CFENCE();
        }
    }
}
__device__ __forceinline__ void s5_carry(const P& p) {
    int tid_ = threadIdx.x; asm volatile("" : "+v"(tid_));
    const int idx = blockIdx.x * NTHREADS + tid_;
    if (idx >= 2 * NSEQ * 64 * 64) return;
    const int pp = idx & 63, g = (idx >> 6) & 63, s = (idx >> 12) % NSEQ, dir = idx / (NSEQ * 4096);
    const float* ab = (const float*)(p.ws + WS_ABAR);
    float Ar = ab[((dir * 64 + g) * 64 + pp) * 2], Ai = ab[((dir * 64 + g) * 64 + pp) * 2 + 1];
#pragma unroll
    for (int k = 0; k < 7; ++k) { const float nr = Ar * Ar - Ai * Ai, ni = 2.0f * Ar * Ai; Ar = nr; Ai = ni; }
    const int c0 = s < 2 ? s * 128 : 256 + (s - 2) * 16, n = s < 2 ? 128 : 16;
    float* E = (float*)(p.ws + WS_S5E);
    float rr = 0.f, ri = 0.f;
    for (int i0 = 0; i0 < n; i0 += 8) {
        float er[8], ei[8]; size_t ad[8];
#pragma unroll
        for (int k = 0; k < 8; ++k) { const int i = i0 + k, c = dir == 0 ? c0 + i : c0 + n - 1 - i; ad[k] = (((size_t)dir * S5_NCH + c) * 64 + g) * 128 + pp; er[k] = E[ad[k]]; ei[k] = E[ad[k] + 64]; }
#pragma unroll
        for (int k = 0; k < 8; ++k) { E[ad[k]] = rr; E[ad[k] + 64] = ri; const float nr = Ar * rr - Ai * ri + er[k], ni = Ar * ri + Ai * rr + ei[k]; rr = nr; ri = ni; }
    }
}

constexpr int GQ = 0, GK = 17408, GKT = 34816, GVT = 53248, GSC = 90112, GA1 = 99328, GSUM = 103424, GEL = 105472, GRMS = 105984, GRSTD = 108032, GW2 = 108288;
constexpr int QST = 272, TST = 144, VST = 576;
__device__ __forceinline__ void gla_item_coords(int j, int& hd, int& tokbase) {
    hd = j & 3; const int q = j >> 2;
    if (q < 32) tokbase = (q >> 4) * 16384 + (q & 15) * 1024; else tokbase = T_PROMPT + ((q - 32) >> 1) * 2048 + ((q - 32) & 1) * 1024;
}
template <int MODE>
__device__ __forceinline__ void gla_phase(const P& p, LAS unsigned char* lds) {
    int tid_ = threadIdx.x; asm volatile("" : "+v"(tid_));
    const int tid = tid_, lane = tid & 63, w = __builtin_amdgcn_readfirstlane(tid >> 6), hh = lane >> 5, l32 = lane & 31;
    const int chan = tid & 127, tg = w >> 1;
    const bf16_t* proj = (const bf16_t*)(p.ws + WS_BIG);
    const float* a1b = (const float*)(p.ws + WS_A1);
    bf16_t* hb = (bf16_t*)(p.ws + WS_HBUF);
    float* sbuf = (float*)(p.ws + WS_SBUF); float* dtot = (float*)(p.ws + WS_DTOT);
    LAS unsigned char* const qfrag = lds + GQ + l32 * QST + 16 * hh;
    LAS unsigned char* const kfrag = lds + GK + l32 * QST + 16 * hh;
    LAS unsigned char* const qperm = lds + GQ + l32 * QST + 8 * hh;
    LAS unsigned char* const ktfrag = lds + GKT + l32 * TST + 16 * hh;
    LAS unsigned char* const vtr = lds + GVT + (8 * hh + ((lane & 15) >> 2)) * VST + (32 * w + 16 * ((lane >> 4) & 1) + 4 * (lane & 3)) * 2;
    LAS unsigned char* const scfrag = lds + GSC + l32 * TST + 16 * hh;
    LAS unsigned char* const scst = lds + GSC + (4 * hh) * TST + l32 * 2;
    LAS unsigned char* const elrd = lds + GEL + 16 * hh;
    LAS unsigned char* const rmsw = lds + GRMS + (4 * hh) * 32 + w * 4;
    LAS unsigned char* const rstdr = lds + GRSTD + (4 * hh) * 4;
    LAS unsigned char* const qprep = lds + GQ + (16 * tg) * QST + chan * 2;
    LAS unsigned char* const kprep = lds + GK + (16 * tg) * QST + chan * 2;
    LAS unsigned char* const a1rd = lds + GA1 + (16 * tg) * 64;
    const LAS float* const w2p = (const LAS float*)(lds + GW2) + chan;
    const int nitems = MODE == 0 ? 384 : 192;
    for (int it = blockIdx.x; it < nitems; it += gridDim.x) {
        const int dir = MODE == 0 ? it / 192 : (MODE == 1 ? 0 : 1);
        const int j = MODE == 0 ? it % 192 : it, full = dir * 192 + j;
        int hd, tokbase; gla_item_coords(j, hd, tokbase);
        __syncthreads();
        for (int i = tid; i < 16 * 128; i += NTHREADS) ((LAS float*)(lds + GW2))[i] = p.in[19][(size_t)(dir * 16 + (i >> 7)) * 512 + hd * 128 + (i & 127)];
        const float bias = p.in[20][dir * 512 + hd * 128 + chan];
        f32x16 S[4];
        float* const sb0 = sbuf + (size_t)full * 32768 + 32 * w; const int svo = (4 * hh) * 256 + l32;
#pragma unroll
        for (int cb = 0; cb < 4; ++cb)
#pragma unroll
            for (int i = 0; i < 16; ++i) S[cb][i] = MODE == 0 ? 0.f : (sb0 + (32 * cb + 8 * (i >> 2) + (i & 3)) * 256)[svo];
        float dsum = 0.f;
        u32x4 pq[2], pk[2], pv[4]; f32x4 pa = (f32x4){0.f, 0.f, 0.f, 0.f};
        const int qko = (tid >> 4) * PROJ_N + hd * 128 + (tid & 15) * 8;
        const int vo = (tid >> 5) * PROJ_N + 1024 + hd * 256 + (tid & 31) * 8;
        const int ao = (tid >> 2) * 32 + dir * 16 + (tid & 3) * 4;
#define GLA_LOAD(tbx) do { const bf16_t* pb_ = proj + (size_t)(tbx) * PROJ_N; \
            _Pragma("unroll") for (int i = 0; i < 2; ++i) { if (MODE != 0) pq[i] = *(const u32x4*)(pb_ + (size_t)i * 32 * PROJ_N + qko); pk[i] = *(const u32x4*)(pb_ + (size_t)i * 32 * PROJ_N + 512 + qko); } \
            _Pragma("unroll") for (int i = 0; i < 4; ++i) pv[i] = *(const u32x4*)(pb_ + (size_t)i * 16 * PROJ_N + vo); \
            if (tid < 256) pa = *(const f32x4*)(a1b + (size_t)(tbx) * 32 + ao); } while (0)
        { int tb0 = tokbase + (dir == 0 ? 0 : 15) * 64; GLA_LOAD(tb0); }
        for (int ci = 0; ci < 16; ++ci) {
            int tb = tokbase + (dir == 0 ? ci : 15 - ci) * 64; asm volatile("" : "+s"(tb));
            int tbn = tokbase + (dir == 0 ? ci + 1 : 14 - ci) * 64; asm volatile("" : "+s"(tbn));
            { LAS unsigned char* const qs = lds + GQ + (tid >> 4) * QST + (tid & 15) * 16;
#pragma unroll
              for (int i = 0; i < 2; ++i) { if (MODE != 0) *(LAS u32x4*)(qs + i * 32 * QST) = pq[i]; *(LAS u32x4*)(qs + (GK - GQ) + i * 32 * QST) = pk[i]; } }
            { LAS unsigned char* const vs = lds + GVT + (tid >> 5) * VST + (tid & 31) * 16;
#pragma unroll
              for (int i = 0; i < 4; ++i) *(LAS u32x4*)(vs + i * 16 * VST) = pv[i]; }
            if (tid < 256) *(LAS f32x4*)(lds + GA1 + (tid >> 2) * 64 + (tid & 3) * 16) = pa;
            __syncthreads();
            if (ci + 1 < 16) GLA_LOAD(tbn);
            float zc[16];
#pragma unroll
            for (int i = 0; i < 16; ++i) { const LAS f32x4* ap = (const LAS f32x4*)(a1rd + i * 64);
                float z = bias;
#pragma unroll
                for (int r4 = 0; r4 < 4; ++r4) { const f32x4 av = ap[r4]; z += av[0] * w2p[(4 * r4) * 128] + av[1] * w2p[(4 * r4 + 1) * 128] + av[2] * w2p[(4 * r4 + 2) * 128] + av[3] * w2p[(4 * r4 + 3) * 128]; }
                zc[i] = (fminf(z, 0.f) - __logf(1.0f + __expf(-fabsf(z)))) * (1.0f / 16.0f); }
            if (dir == 0) {
#pragma unroll
                for (int i = 1; i < 16; ++i) zc[i] += zc[i - 1];
            } else {
#pragma unroll
                for (int i = 14; i >= 0; --i) zc[i] += zc[i + 1];
            }
            ((LAS float*)(lds + GSUM))[tg * 128 + chan] = dir == 0 ? zc[15] : zc[0];
            __syncthreads();
            float blast, off;
            { const LAS float* gs = (const LAS float*)(lds + GSUM) + chan; const float g0 = gs[0], g1 = gs[128], g2 = gs[256], g3 = gs[384];
                blast = (g0 + g1) + (g2 + g3);
                if (dir == 0) off = (tg > 0 ? g0 : 0.f) + (tg > 1 ? g1 : 0.f) + (tg > 2 ? g2 : 0.f);
                else off = (tg < 3 ? g3 : 0.f) + (tg < 2 ? g2 : 0.f) + (tg < 1 ? g1 : 0.f); }
            {
                float kt[16];
#pragma unroll
                for (int i = 0; i < 16; ++i) { const float bc = zc[i] + off;
                    LAS bf16_t* qp = (LAS bf16_t*)(qprep + i * QST); LAS bf16_t* kp = (LAS bf16_t*)(kprep + i * QST);
                    const float kv = bf2f(*kp);
                    if (MODE != 0) { const float qv = bf2f(*qp); *qp = f2bf(qv * __expf(bc) * 0.08838834764831845f); *kp = f2bf(kv * __expf(-bc)); }
                    kt[i] = kv * __expf(blast - bc); }
                u32x4 k0, k1; k0.x = pk_bf16(kt[0], kt[1]); k0.y = pk_bf16(kt[2], kt[3]); k0.z = pk_bf16(kt[4], kt[5]); k0.w = pk_bf16(kt[6], kt[7]);
                k1.x = pk_bf16(kt[8], kt[9]); k1.y = pk_bf16(kt[10], kt[11]); k1.z = pk_bf16(kt[12], kt[13]); k1.w = pk_bf16(kt[14], kt[15]);
                *(LAS u32x4*)(lds + GKT + chan * TST + tg * 32) = k0; *(LAS u32x4*)(lds + GKT + chan * TST + tg * 32 + 16) = k1;
            }
            if (tg == 0) { ((LAS float*)(lds + GEL))[chan] = __expf(blast); dsum += blast; }
            __syncthreads();
            if (MODE != 0) {
                if (w < 4) { const int mb = w >> 1, nb = w & 1; f32x16 sc;
#pragma unroll
                    for (int i = 0; i < 16; ++i) sc[i] = 0.f;
#pragma unroll
                    for (int ks = 0; ks < 8; ++ks) { const bf16x8 a = *(const LAS bf16x8*)(qfrag + mb * 32 * QST + 32 * ks), bq = *(const LAS bf16x8*)(kfrag + nb * 32 * QST + 32 * ks);
                        sc = __builtin_amdgcn_mfma_f32_32x32x16_bf16(a, bq, sc, 0, 0, 0); }
                    const int dlt = (nb - mb) * 32 + l32 - 4 * hh;
                    LAS unsigned char* const sw = scst + mb * 32 * TST + nb * 64;
#pragma unroll
                    for (int i = 0; i < 16; ++i) { const int cst = 8 * (i >> 2) + (i & 3); const bool keep = dir == 0 ? (dlt <= cst) : (dlt >= cst);
                        *(LAS bf16_t*)(sw + cst * TST) = f2bf(keep ? sc[i] : 0.f); }
                }
                __syncthreads();
            }
            bf16x8 vf[4];
#pragma unroll
            for (int ks = 0; ks < 4; ++ks) { union { struct { bf16x4 lo, hi; } s; bf16x8 v; } vv;
                vv.s.lo = __builtin_amdgcn_ds_read_tr16_b64_v4i16((LAS bf16x4*)(vtr + (16 * ks) * VST));
                vv.s.hi = __builtin_amdgcn_ds_read_tr16_b64_v4i16((LAS bf16x4*)(vtr + (16 * ks + 4) * VST));
                vf[ks] = vv.v; }
            if (MODE != 0) {
#pragma unroll
                for (int mb = 0; mb < 2; ++mb) {
                    f32x16 o;
#pragma unroll
                    for (int i = 0; i < 16; ++i) o[i] = 0.f;
#pragma unroll
                    for (int ks = 0; ks < 4; ++ks) { const bf16x8 a = *(const LAS bf16x8*)(scfrag + mb * 32 * TST + 32 * ks);
                        o = __builtin_amdgcn_mfma_f32_32x32x16_bf16(a, vf[ks], o, 0, 0, 0); }
#pragma unroll
                    for (int cb = 0; cb < 4; ++cb)
#pragma unroll
                        for (int h2 = 0; h2 < 2; ++h2) {
                            union { u32x4 u; bf16x8 v; } sb_;
                            sb_.u.x = pk_bf16(S[cb][8 * h2 + 0], S[cb][8 * h2 + 1]); sb_.u.y = pk_bf16(S[cb][8 * h2 + 2], S[cb][8 * h2 + 3]);
                            sb_.u.z = pk_bf16(S[cb][8 * h2 + 4], S[cb][8 * h2 + 5]); sb_.u.w = pk_bf16(S[cb][8 * h2 + 6], S[cb][8 * h2 + 7]);
                            const LAS unsigned char* base = qperm + mb * 32 * QST + (32 * cb + 16 * h2) * 2;
                            union { struct { u32x2 lo, hi; } s; bf16x8 v; } qa; qa.s.lo = *(const LAS u32x2*)base; qa.s.hi = *(const LAS u32x2*)(base + 16);
                            o = __builtin_amdgcn_mfma_f32_32x32x16_bf16(qa.v, sb_.v, o, 0, 0, 0);
                        }
                    bf16_t* orow = hb + (size_t)(tb + 32 * mb) * D + hd * 256 + 32 * w; const int ovo = 4 * hh * D + l32;
                    if (MODE == 1) {
#pragma unroll
                        for (int i = 0; i < 16; ++i) (orow + (size_t)(8 * (i >> 2) + (i & 3)) * D)[ovo] = f2bf(o[i]);
                    } else {
#pragma unroll
                        for (int i = 0; i < 16; ++i) { const int cst = 8 * (i >> 2) + (i & 3);
                            const float ov = o[i] + bf2f((orow + (size_t)cst * D)[ovo]); o[i] = ov;
                            float sq = ov * ov;
#pragma unroll
                            for (int sh = 1; sh < 32; sh <<= 1) sq += __shfl_xor(sq, sh);
                            if (l32 == 0) *(LAS float*)(rmsw + (32 * mb + cst) * 32) = sq; }
                        __syncthreads();
                        if (tid < 32) { const int tok = 32 * mb + tid; const LAS f32x4* rp = (const LAS f32x4*)(lds + GRMS + tok * 32); const f32x4 a = rp[0], bq = rp[1];
                            ((LAS float*)(lds + GRSTD))[tok] = rsqrtf(((a[0] + a[1]) + (a[2] + a[3]) + (bq[0] + bq[1]) + (bq[2] + bq[3])) * (1.0f / 256.0f) + EPS); }
                        __syncthreads();
                        const bf16_t* rrow = proj + (size_t)(tb + 32 * mb) * PROJ_N + 2048 + hd * 256 + 32 * w; const int rvo = 4 * hh * PROJ_N + l32;
                        const float ng = p.in[21][hd * 256 + 32 * w + l32];
#pragma unroll
                        for (int i = 0; i < 16; ++i) { const int cst = 8 * (i >> 2) + (i & 3);
                            const float rs = *(const LAS float*)(rstdr + (32 * mb + cst) * 4);
                            const float rv = bf2f((rrow + (size_t)cst * PROJ_N)[rvo]);
                            (orow + (size_t)cst * D)[ovo] = f2bf(o[i] * rs * ng * (rv * sigmoidf_(rv))); }
                    }
                    CFENCE();
                }
            }
#pragma unroll
            for (int cb = 0; cb < 4; ++cb) {
#pragma unroll
                for (int i4 = 0; i4 < 4; ++i4) { const f32x4 e = *(const LAS f32x4*)(elrd + (32 * cb + 8 * i4) * 4);
                    S[cb][4 * i4 + 0] *= e[0]; S[cb][4 * i4 + 1] *= e[1]; S[cb][4 * i4 + 2] *= e[2]; S[cb][4 * i4 + 3] *= e[3]; }
#pragma unroll
                for (int ks = 0; ks < 4; ++ks) { const bf16x8 a = *(const LAS bf16x8*)(ktfrag + cb * 32 * TST + 32 * ks);
                    S[cb] = __builtin_amdgcn_mfma_f32_32x32x16_bf16(a, vf[ks], S[cb], 0, 0, 0); }
            }
            __syncthreads();
        }
#undef GLA_LOAD
        if (MODE == 0) {
#pragma unroll
            for (int cb = 0; cb < 4; ++cb)
#pragma unroll
                for (int i = 0; i < 16; ++i) (sb0 + (32 * cb + 8 * (i >> 2) + (i & 3)) * 256)[svo] = S[cb][i];
            if (tg == 0) dtot[full * 128 + chan] = dsum;
        }
    }
}
__device__ __forceinline__ void gla_carry(const P& p) {
    float* sbuf = (float*)(p.ws + WS_SBUF); const float* dtot = (const float*)(p.ws + WS_DTOT);
    const int total = 80 * 8192;
    int tid_ = threadIdx.x; asm volatile("" : "+v"(tid_));
    for (int e = blockIdx.x * NTHREADS + tid_; e < total; e += gridDim.x * NTHREADS) {
        const int e4 = e & 8191, ch = e >> 13, hd = ch & 3, s = (ch >> 2) % NSEQ, dir = ch / (4 * NSEQ);
        const int n = s < 2 ? 16 : 2, q0 = s < 2 ? s * 16 : 32 + (s - 2) * 2, chan = e4 >> 6;
        f32x4 run = (f32x4){0.f, 0.f, 0.f, 0.f};
        for (int i = 0; i < n; ++i) { const int sc = dir == 0 ? i : n - 1 - i, full = dir * 192 + (q0 + sc) * 4 + hd;
            f32x4* ptr = (f32x4*)(sbuf + (size_t)full * 32768) + e4; const float dcy = __expf(dtot[full * 128 + chan]);
            const f32x4 tmp = *ptr; *ptr = run; run = run * dcy + tmp; }
    }
}

#define XB_TMO      128
#define XB_XCNT(j)  (256  + 64 * (j))
#define XB_XSUB(j)  (1280 + 64 * (j))
#define XB_XGEN(j)  (2304 + 64 * (j))
#define XB_TOP      3328
#define XB_TOPGEN   3392
#define XCD_BAR_WORDS 3456
#define XB_SPIN_CAP (1u << 18)

__device__ __forceinline__ unsigned xb_ld(unsigned* p)              { return __hip_atomic_load(p, __ATOMIC_RELAXED, __HIP_MEMORY_SCOPE_AGENT); }
__device__ __forceinline__ unsigned xb_add(unsigned* p, unsigned v) { return __hip_atomic_fetch_add(p, v, __ATOMIC_RELAXED, __HIP_MEMORY_SCOPE_AGENT); }
__device__ __forceinline__ unsigned xb_xcc_id() { return (unsigned)__builtin_amdgcn_s_getreg((3 << 11) | 20) & 0xFu; }
#define XB_SPIN(cond, bar) do { unsigned _sp = 0; while (cond) { __builtin_amdgcn_s_sleep(1); \
    if ((++_sp & 255u) == 0u) { if (xb_ld(&(bar)[XB_TMO])) break; if (_sp > XB_SPIN_CAP) { atomicAdd(&(bar)[XB_TMO], 1u); break; } } } } while (0)

struct XcdBarrier {
    unsigned* bar; unsigned x;
    volatile LAS unsigned* st;
};

__device__ __forceinline__ XcdBarrier xcd_barrier_post(unsigned* bar, volatile LAS unsigned* st) {
    XcdBarrier b; b.bar = bar; b.x = xb_xcc_id(); b.st = st;
    if (threadIdx.x == 0) (void)xb_add(&bar[XB_XCNT(b.x)], 1u);
    return b;
}
__device__ __forceinline__ void xcd_barrier_complete(unsigned* bar, unsigned x, unsigned& nloc, unsigned& nx) {
    const unsigned G = gridDim.x * gridDim.y * gridDim.z;
    unsigned sum, cnt, mine, sp = 0u;
    for (;;) {
        sum = 0u; cnt = 0u; mine = 0u;
#pragma unroll
        for (unsigned j = 0; j < 16; ++j) { const unsigned c = xb_ld(&bar[XB_XCNT(j)]); sum += c; cnt += (c > 0u) ? 1u : 0u; mine = (j == x) ? c : mine; }
        if (sum == G) break;
        __builtin_amdgcn_s_sleep(1);
        if ((++sp & 255u) == 0u) { if (xb_ld(&bar[XB_TMO])) break; if (sp > XB_SPIN_CAP) { atomicAdd(&bar[XB_TMO], 1u); break; } }
    }
    nloc = mine > 0u ? mine : 1u; nx = cnt > 0u ? cnt : 1u;
}

__device__ __forceinline__ void xcd_barrier(const XcdBarrier& b) {
    asm volatile("s_waitcnt vmcnt(0)" ::: "memory");
    __syncthreads();
    if (threadIdx.x == 0) {
        unsigned* bar = b.bar;
        __builtin_amdgcn_s_waitcnt(0);
        unsigned nloc = b.st[0], nx = b.st[1];
        if (nloc == 0u) { xcd_barrier_complete(bar, b.x, nloc, nx); b.st[0] = nloc; b.st[1] = nx; }
        const unsigned old = xb_add(&bar[XB_XSUB(b.x)], 1u);
        const unsigned gen = old / nloc;
        if (old + 1u == (gen + 1u) * nloc) {
            __builtin_amdgcn_fence(__ATOMIC_RELEASE, "agent");
            asm volatile("s_waitcnt vmcnt(0)" ::: "memory");
            const unsigned og = xb_add(&bar[XB_TOP], 1u);
            const unsigned tg = og / nx;
            if (og + 1u == (tg + 1u) * nx) xb_add(&bar[XB_TOPGEN], 1u);
            else XB_SPIN(xb_ld(&bar[XB_TOPGEN]) == tg, bar);
            __builtin_amdgcn_fence(__ATOMIC_ACQUIRE, "agent");
            xb_add(&bar[XB_XGEN(b.x)], 1u);
            asm volatile("s_waitcnt vmcnt(0)" ::: "memory");
        } else {
            XB_SPIN(xb_ld(&bar[XB_XGEN(b.x)]) == gen, bar);
            __builtin_amdgcn_fence(__ATOMIC_ACQUIRE, "agent");
            asm volatile("s_waitcnt vmcnt(0)" ::: "memory");
        }
    }
    __syncthreads();
}

#define GRID_BAR() xcd_barrier(bar)

template <int L, int SL>
__device__ __forceinline__ void mlp_slab(const P& p, LAS unsigned char* lds, const XcdBarrier& bar) {
    unsigned char* ws = p.ws;
    const float* ml = (const float*)(ws + WS_MOD) + (size_t)L * NSEQ * NMODC;
    bf16_t* hb = (bf16_t*)(ws + WS_HBUF); bf16_t* big = (bf16_t*)(ws + WS_BIG);
    const bf16_t* w1 = (const bf16_t*)(ws + (L ? WS_W1B : WS_W1A)); const bf16_t* w2 = (const bf16_t*)(ws + (L ? WS_W2B : WS_W2A));
    { pg8::Gemm g{hb + (size_t)SL * 16384 * D, w1, 16384, FF, D}; pg8::StaticOrder S; S.init(16384, FF, gridDim.x, blockIdx.x);
      EpiBf<1> E{big, FF, nullptr};
      if (PH & 4096) pg8::gemm_phase<EpiBf<1>, pg8::StaticOrder>(lds, g, S, E, nullptr);
#if (DUP & 8)
      GRID_BAR(); pg8::gemm_phase<EpiBf<1>, pg8::StaticOrder>(lds, g, S, E, nullptr);
      GRID_BAR(); pg8::gemm_phase<EpiBf<1>, pg8::StaticOrder>(lds, g, S, E, nullptr);
      GRID_BAR(); pg8::gemm_phase<EpiBf<1>, pg8::StaticOrder>(lds, g, S, E, nullptr);
#endif
    }
    GRID_BAR();
    { pg8::Gemm g{big, w2, 16384, D, FF}; pg8::StaticOrder S; S.init(16384, D, gridDim.x, blockIdx.x);
      EpiRes E{p.out, ml + 5 * D, SL * 16384};
      if (PH & 8192) pg8::gemm_phase<EpiRes, pg8::StaticOrder>(lds, g, S, E, nullptr); }
    GRID_BAR();
}
template <int L>
__device__ __forceinline__ void mlp_block(const P& p, LAS unsigned char* lds, const XcdBarrier& bar) {
    const float* ml = (const float*)(p.ws + WS_MOD) + (size_t)L * NSEQ * NMODC;
    norm_phase<1, false>(p, p.in[7] + L * D, ml + 3 * D, ml + 4 * D);
    GRID_BAR();
    mlp_slab<L, 0>(p, lds, bar); mlp_slab<L, 1>(p, lds, bar); mlp_slab<L, 2>(p, lds, bar);
}

__global__ void __launch_bounds__(NTHREADS, 2) hybrid_fwd(P p) {
    extern __shared__ __attribute__((aligned(16))) unsigned char lds_raw[];
    LAS unsigned char* lds = (LAS unsigned char*)lds_raw;
    cg::grid_group grid = cg::this_grid();
    unsigned char* ws = p.ws;
    const float* mod = (const float*)(ws + WS_MOD);
    bf16_t* hb = (bf16_t*)(ws + WS_HBUF);
    bf16_t* big = (bf16_t*)(ws + WS_BIG);

    volatile LAS unsigned* bst = (volatile LAS unsigned*)(lds + LDS_BYTES - 16);
    if (threadIdx.x < 2) bst[threadIdx.x] = 0u;
    if (blockIdx.x == 0) for (int i = threadIdx.x; i < XCD_BAR_WORDS; i += NTHREADS) ((unsigned*)(ws + WS_BARW))[i] = 0u;
    __syncthreads();
    grid.sync();
    const XcdBarrier bar = xcd_barrier_post((unsigned*)(ws + WS_BARW), bst);
    if (PH & 1) p0_prep(p, lds);
    GRID_BAR();
    if (PH & 2) norm_phase<0, false>(p, p.in[6], mod + 0 * D, mod + 1 * D);
    GRID_BAR();
    if (PH & 4) s5_pass<false>(p, lds);
    GRID_BAR();
    if (PH & 8) s5_carry(p);
    GRID_BAR();
    if (PH & 16) s5_pass<true>(p, lds);
    GRID_BAR();
#if (DUP & 1)
    if (PH & 4) s5_pass<false>(p, lds);
    GRID_BAR();
    if (PH & 8) s5_carry(p);
    GRID_BAR();
    if (PH & 16) s5_pass<true>(p, lds);
    GRID_BAR();
#endif
    { pg8::Gemm g{big, (const bf16_t*)(ws + WS_WGLU), T, 2 * D, D}; pg8::StaticOrder S; S.init(T, 2 * D, gridDim.x, blockIdx.x);
      EpiGlu E{p.in[0], p.in[1], p.out, mod + 2 * D};
      if (PH & 512) pg8::gemm_phase<EpiGlu, pg8::StaticOrder>(lds, g, S, E, nullptr);
#if (DUP & 8)
      GRID_BAR(); pg8::gemm_phase<EpiGlu, pg8::StaticOrder>(lds, g, S, E, nullptr);
      GRID_BAR(); pg8::gemm_phase<EpiGlu, pg8::StaticOrder>(lds, g, S, E, nullptr);
      GRID_BAR(); pg8::gemm_phase<EpiGlu, pg8::StaticOrder>(lds, g, S, E, nullptr);
#endif
    }
    GRID_BAR();
    mlp_block<0>(p, lds, bar);
    norm_phase<1, false>(p, p.in[6] + D, mod + (size_t)NSEQ * NMODC + 0 * D, mod + (size_t)NSEQ * NMODC + 1 * D);
    GRID_BAR();
    { pg8::Gemm g{hb, (const bf16_t*)(ws + WS_WIN), T, WIN_N, D}; pg8::StaticOrder S; S.init(T, WIN_N, gridDim.x, blockIdx.x);
      EpiBf<0> E{big, PROJ_N, (float*)(ws + WS_A1)};
      if (PH & 1024) pg8::gemm_phase<EpiBf<0>, pg8::StaticOrder>(lds, g, S, E, nullptr); }
    GRID_BAR();
    if (PH & 32) gla_phase<0>(p, lds);
    GRID_BAR();
    if (PH & 64) gla_carry(p);
    GRID_BAR();
    if (PH & 128) gla_phase<1>(p, lds);
    GRID_BAR();
#if (DUP & 2)
    if (PH & 32) gla_phase<0>(p, lds);
    GRID_BAR();
    if (PH & 64) gla_carry(p);
    GRID_BAR();
    if (PH & 128) gla_phase<1>(p, lds);
    GRID_BAR();
#endif
    if (PH & 256) gla_phase<2>(p, lds);
    GRID_BAR();
    { pg8::Gemm g{hb, (const bf16_t*)(ws + WS_WOUT), T, D, D}; pg8::StaticOrder S; S.init(T, D, gridDim.x, blockIdx.x);
      EpiRes E{p.out, mod + (size_t)NSEQ * NMODC + 2 * D, 0};
      if (PH & 2048) pg8::gemm_phase<EpiRes, pg8::StaticOrder>(lds, g, S, E, nullptr); }
    GRID_BAR();
    mlp_block<1>(p, lds, bar);
#if (DUP & 4)
#pragma unroll 1
    for (int rep = 0; rep < 20; ++rep) GRID_BAR();
#endif
    if (PH == 0) norm_phase<0, true>(p, p.in[25], nullptr, nullptr); else norm_phase<1, true>(p, p.in[25], nullptr, nullptr);
}

extern "C" void kernel_launch(void* const* d_in, const int* in_sizes, int n_in, void* d_out, int out_size, void* d_ws, size_t ws_size, hipStream_t stream) {
    static int grid_blocks = 0;
    if (grid_blocks == 0) {
        if (n_in != 26 || out_size != T * D || ws_size < WS_END) { fprintf(stderr, "kernel_launch: unexpected sizes n_in %d out %d ws %zu\n", n_in, out_size, ws_size); grid_blocks = -1; return; }
        int dev = 0, cus = 0, per_cu = 0;
        hipGetDevice(&dev);
        hipDeviceGetAttribute(&cus, hipDeviceAttributeMultiprocessorCount, dev);
        hipFuncSetAttribute((const void*)hybrid_fwd, hipFuncAttributeMaxDynamicSharedMemorySize, LDS_BYTES);
        hipOccupancyMaxActiveBlocksPerMultiprocessor(&per_cu, (const void*)hybrid_fwd, NTHREADS, LDS_BYTES);
        if (per_cu < 1) { fprintf(stderr, "kernel_launch: occupancy query says %d blocks per CU\n", per_cu); grid_blocks = -1; return; }
        grid_blocks = cus;
        if (grid_blocks % 8) grid_blocks -= grid_blocks % 8;
    }
    if (grid_blocks < 0) return;
    P p{};
    for (int i = 0; i < 26; ++i) p.in[i] = (const float*)d_in[i];
    p.out = (float*)d_out; p.ws = (unsigned char*)d_ws;
    void* args[] = {&p};
    hipError_t e = hipLaunchCooperativeKernel((const void*)hybrid_fwd, dim3(grid_blocks), dim3(NTHREADS), args, LDS_BYTES, stream);
    if (e != hipSuccess) fprintf(stderr, "cooperative launch failed: %s (grid %d)\n", hipGetErrorString(e), grid_blocks);
}
```

```cpp
#include <hip/hip_runtime.h>
#include <hip/hip_cooperative_groups.h>
#include <cstdio>
namespace cg = cooperative_groups;

namespace pg8 {
#define PG8_LAS __attribute__((address_space(3)))
typedef unsigned short bf16_t;
typedef short bf16x8 __attribute__((ext_vector_type(8)));
typedef float f32x4 __attribute__((ext_vector_type(4)));
typedef unsigned u32x4 __attribute__((ext_vector_type(4)));
constexpr int BM = 256, BK = 64, HALF = 128, HTB = HALF * BK * 2  , STAGE_BYTES = 8 * HTB, NXCD = 8, WGM = 8;

__host__ __device__ __forceinline__ int lds_byte(int r, int c) { const int st = (r >> 4) * 2 + (c >> 5), rr = r & 15, cc = c & 31, ob = rr * 64 + cc * 2; return st * 1024 + (ob ^ (((ob >> 9) & 1) << 5)); }
__host__ __device__ __forceinline__ void stage_rc(int b, int& R, int& C) { const int st = b / 1024, sb = b % 1024, swz = sb ^ (((sb >> 9) & 1) << 5); R = (st >> 1) * 16 + swz / 64; C = (st & 1) * 32 + (swz % 64) / 2; }
__host__ __device__ __forceinline__ int perm32(int rho) { const int n = rho >> 4, i = rho & 15; return 8 * (i >> 2) + 4 * n + (i & 3); }

struct Unit { int pm, pn; };
struct Gemm { const bf16_t* A; const bf16_t* Bt; int M, N, K; };

struct StaticOrder {
    int nM, nN, nwg, G, c;
    __host__ __device__ void init(int M, int N, int G_, int c_) { nM = M / BM; nN = N / BM; nwg = nM * nN; G = G_; c = c_; }
    __host__ __device__ bool next(int i, Unit& u) const {
        const long L = (long)i * G + c; if (L >= nwg) return false;
        int wgid = (int)L; { const int q = nwg / NXCD, r = nwg % NXCD, xcd = wgid % NXCD, off = wgid / NXCD; wgid = (xcd < r ? xcd * (q + 1) : r * (q + 1) + (xcd - r) * q) + off; }
        const int nig = WGM * nN, gid = wgid / nig, fm = gid * WGM, gsz = (nM - fm) < WGM ? (nM - fm) : WGM;
        u.pm = fm + ((wgid % nig) % gsz); u.pn = (wgid % nig) / gsz; return true;
    }
    __device__ __forceinline__ void a_ready(const Unit&) const {}
    __device__ __forceinline__ void done(const Unit&) const {}
};


template <class Epi, class Sched, bool STAMP = false>
__device__ __forceinline__ void gemm_phase(PG8_LAS unsigned char* lds, const Gemm g, const Sched& S, const Epi& E, unsigned long long* stamps) {
    int tid_ = threadIdx.x; asm volatile("" : "+v"(tid_));
    const int tid = tid_, wid = __builtin_amdgcn_readfirstlane(tid >> 6), lane = tid & 63, wr = wid >> 2, wc = wid & 3, fr = lane & 15, fq = lane >> 4;
    const int K = g.K, nt = K / BK;
    int ts_lo = 0, ts_hi = 0, nts = 0; const unsigned long long rt_entry = STAMP ? (unsigned long long)wall_clock64() : 0ull;
#define PG8_STAMP() do { if (STAMP && wid == 0 && nts < 64) { const unsigned long long _c = (unsigned long long)clock64(); \
        ts_lo = (lane == nts) ? (int)(unsigned)_c : ts_lo; ts_hi = (lane == nts) ? (int)(unsigned)(_c >> 32) : ts_hi; ++nts; } } while (0)
    PG8_STAMP();
    unsigned voffA[2], voffB[2];
#pragma unroll
    for (int i = 0; i < 2; ++i) { int R, C; stage_rc(tid * 16 + i * 8192, R, C); const int Rb = Epi::PERM ? ((R & ~31) + perm32(R & 31)) : R;
        voffA[i] = (unsigned)(R * K + C) * 2u; voffB[i] = (unsigned)(Rb * K + C) * 2u; }
    const size_t kstep = (size_t)(BK * 2);
    const size_t hstep = (size_t)HALF * K * 2;
    const size_t tstep = 2 * hstep;
    const unsigned ldsw = (unsigned)wid * 1024u;
    const int aoff = lds_byte(wr * 64 + fr, fq * 8), boff = lds_byte(wc * 32 + fr, fq * 8);
#define PG8_SA(b, h) (((b) * 2 + (h)) * HTB)
#define PG8_SB(b, h) ((4 + (b) * 2 + (h)) * HTB)
#define PG8_STAGE(bufoff, gbase, voff) do { _Pragma("unroll") for (int _i = 0; _i < 2; ++_i) \
        __builtin_amdgcn_global_load_lds((const unsigned*)((const char*)(gbase) + (voff)[_i]), (PG8_LAS unsigned*)(lds + (bufoff) + ldsw + _i * 8192), 16, 0, 0); } while (0)
#define PG8_LDA(dst, b, h) do { _Pragma("unroll") for (int m = 0; m < 4; ++m) _Pragma("unroll") for (int k = 0; k < 2; ++k) dst[m][k] = *(const PG8_LAS bf16x8*)(lds + PG8_SA(b, h) + aoff + m * 2048 + k * 1024); } while (0)
#define PG8_LDB(dst, b, h) do { _Pragma("unroll") for (int n = 0; n < 2; ++n) _Pragma("unroll") for (int k = 0; k < 2; ++k) dst[n][k] = *(const PG8_LAS bf16x8*)(lds + PG8_SB(b, h) + boff + n * 2048 + k * 1024); } while (0)
#define PG8_MMA(ai, bj, At, Bt) do { __builtin_amdgcn_s_setprio(1); _Pragma("unroll") for (int m = 0; m < 4; ++m) _Pragma("unroll") for (int n = 0; n < 2; ++n) _Pragma("unroll") for (int k = 0; k < 2; ++k) \
        acc[ai][bj][m][n] = __builtin_amdgcn_mfma_f32_16x16x32_bf16(Bt[n][k], At[m][k], acc[ai][bj][m][n], 0, 0, 0); __builtin_amdgcn_s_setprio(0); } while (0)
#define PG8_WAIT_V(n) asm volatile("s_waitcnt vmcnt(" #n ")" ::: "memory")
#define PG8_WAIT_L(n) asm volatile("s_waitcnt lgkmcnt(" #n ")" ::: "memory")
#define PG8_BAR __builtin_amdgcn_s_barrier()
#define PG8_SCHED __builtin_amdgcn_sched_barrier(0)
    Unit cur, nxt; int ui = 0;
    if (!S.next(0, cur)) return;
    f32x4 acc[2][2][4][2];
#pragma unroll
    for (int a = 0; a < 2; ++a)
#pragma unroll
        for (int b = 0; b < 2; ++b)
#pragma unroll
            for (int m = 0; m < 4; ++m)
#pragma unroll
                for (int n = 0; n < 2; ++n) acc[a][b][m][n] = (f32x4){0.f, 0.f, 0.f, 0.f};
    bf16x8 At[4][2], B0[2][2], B1[2][2];
    const char* cA = (const char*)g.A + (size_t)cur.pm * tstep; const char* cB = (const char*)g.Bt + (size_t)cur.pn * tstep;
    S.a_ready(cur);
    PG8_STAGE(PG8_SB(0, 0), cB, voffB); PG8_STAGE(PG8_SA(0, 0), cA, voffA); PG8_STAGE(PG8_SB(0, 1), cB + hstep, voffB); PG8_STAGE(PG8_SA(0, 1), cA + hstep, voffA);
    if (wr == 1) PG8_BAR;
    PG8_WAIT_V(4); PG8_BAR;
    PG8_STAGE(PG8_SB(1, 0), cB + kstep, voffB); PG8_STAGE(PG8_SA(1, 0), cA + kstep, voffA); PG8_STAGE(PG8_SB(1, 1), cB + hstep + kstep, voffB);
    PG8_WAIT_V(6); PG8_BAR;
    PG8_STAMP();
    for (;;) {
        const bool has_next = S.next(ui + 1, nxt);
        const char* nA = has_next ? (const char*)g.A + (size_t)nxt.pm * tstep : cA; const char* nB = has_next ? (const char*)g.Bt + (size_t)nxt.pn * tstep : cB;
        for (int t = 0; t < nt; t += 2) {
            const bool last = (t == nt - 2);
            const char* a1 = cA + (size_t)(t + 1) * kstep;
            const char* a2 = last ? nA : cA + (size_t)(t + 2) * kstep; const char* b2 = last ? nB : cB + (size_t)(t + 2) * kstep;
            const char* a3 = a2 + kstep; const char* b3 = b2 + kstep;
            if (last && has_next) S.a_ready(nxt);
            PG8_LDB(B0, 0, 0); PG8_SCHED; PG8_LDA(At, 0, 0); PG8_STAGE(PG8_SA(1, 1), a1 + hstep, voffA);
            PG8_WAIT_L(8); PG8_BAR; PG8_WAIT_L(0); PG8_MMA(0, 0, At, B0); PG8_BAR; PG8_SCHED;
            PG8_LDB(B1, 0, 1); PG8_STAGE(PG8_SB(0, 0), b2, voffB);
            PG8_BAR; PG8_WAIT_L(0); PG8_MMA(0, 1, At, B1); PG8_BAR;
            PG8_LDA(At, 0, 1); PG8_STAGE(PG8_SA(0, 0), a2, voffA);
            PG8_BAR; PG8_WAIT_L(0); PG8_MMA(1, 0, At, B0); PG8_BAR; PG8_SCHED;
            PG8_STAGE(PG8_SB(0, 1), b2 + hstep, voffB);
            PG8_WAIT_V(6); PG8_BAR; PG8_MMA(1, 1, At, B1); PG8_BAR;
            PG8_LDB(B0, 1, 0); PG8_SCHED; PG8_LDA(At, 1, 0); PG8_STAGE(PG8_SA(0, 1), a2 + hstep, voffA);
            PG8_WAIT_L(8); PG8_BAR; PG8_WAIT_L(0); PG8_MMA(0, 0, At, B0); PG8_BAR; PG8_SCHED;
            PG8_LDB(B1, 1, 1); PG8_STAGE(PG8_SB(1, 0), b3, voffB);
            PG8_BAR; PG8_WAIT_L(0); PG8_MMA(0, 1, At, B1); PG8_BAR;
            PG8_LDA(At, 1, 1); PG8_STAGE(PG8_SA(1, 0), a3, voffA);
            PG8_BAR; PG8_WAIT_L(0); PG8_MMA(1, 0, At, B0); PG8_BAR; PG8_SCHED;
            PG8_STAGE(PG8_SB(1, 1), b3 + hstep, voffB);
            PG8_WAIT_V(6); PG8_BAR; PG8_MMA(1, 1, At, B1); PG8_BAR;
        }
        PG8_STAMP();
        if constexpr (!Epi::AFTER_DRAIN) { E(acc, cur, wr, wc, fr, fq); S.done(cur); }
        PG8_STAMP();
        if (!has_next) break;
#pragma unroll
        for (int a = 0; a < 2; ++a)
#pragma unroll
            for (int b = 0; b < 2; ++b)
#pragma unroll
                for (int m = 0; m < 4; ++m)
#pragma unroll
                    for (int n = 0; n < 2; ++n) acc[a][b][m][n] = (f32x4){0.f, 0.f, 0.f, 0.f};
        cur = nxt; cA = nA; cB = nB; ++ui;
    }
    PG8_WAIT_V(0);
    if (wr == 0) PG8_BAR;
    PG8_BAR;
    if constexpr (Epi::AFTER_DRAIN) { E.fused(acc, cur, wr, wc, fr, fq, lds, wid, lane); S.done(cur); }
    PG8_STAMP();
    if (STAMP && wid == 0) { stamps[lane] = lane < nts ? (((unsigned long long)(unsigned)ts_hi << 32) | (unsigned)ts_lo) : 0ull;
        if (lane == 62) stamps[62] = rt_entry; if (lane == 63) stamps[63] = (unsigned long long)wall_clock64(); }
#undef PG8_STAMP
#undef PG8_SA
#undef PG8_SB
#undef PG8_STAGE
#undef PG8_LDA
#undef PG8_LDB
#undef PG8_MMA
#undef PG8_WAIT_V
#undef PG8_WAIT_L
#undef PG8_BAR
#undef PG8_SCHED
}
}


#define LAS __attribute__((address_space(3)))
typedef unsigned short bf16_t;
typedef short bf16x8 __attribute__((ext_vector_type(8)));
typedef short bf16x4 __attribute__((ext_vector_type(4)));
typedef float f32x4 __attribute__((ext_vector_type(4)));
typedef float f32x16 __attribute__((ext_vector_type(16)));
typedef unsigned u32x4 __attribute__((ext_vector_type(4)));
typedef unsigned u32x2 __attribute__((ext_vector_type(2)));

constexpr int D = 1024, T = 49152, NSEQ = 10, NMODC = 6144, FF = 4096;
constexpr int T_PROMPT = 32768;
constexpr float EPS = 1e-6f;
#ifndef PH
#define PH 16383
#endif
#ifndef DUP
#define DUP 0
#endif
constexpr int NWAVES = 8, NTHREADS = 512;
constexpr int LDS_BYTES = 139264;
constexpr int WIN_N = 3328;
constexpr int PROJ_N = 3072;

constexpr size_t MiB = 1u << 20;
constexpr size_t WS_MOD = 0;
constexpr size_t WS_BARW = 491520;
constexpr size_t WS_ABAR = 512 * 1024;
constexpr size_t WS_BBT = 1 * MiB;
constexpr size_t WS_CT = 1 * MiB + 512 * 1024;
constexpr size_t WS_DTOT = 2 * MiB;
constexpr size_t WS_A1 = 3 * MiB;
constexpr size_t WS_WIN = 10 * MiB;
constexpr size_t WS_WOUT = WS_WIN + (size_t)WIN_N * D * 2;
constexpr size_t WS_W1B = WS_WOUT + (size_t)D * D * 2;
constexpr size_t WS_W2B = WS_W1B + (size_t)FF * D * 2;
constexpr size_t WS_HBUF = 35 * MiB;
constexpr size_t WS_BIG = 131 * MiB;
constexpr size_t WS_S5E = WS_BIG + 96 * MiB;
constexpr size_t WS_X = 419 * MiB;
constexpr size_t WS_WGLU = WS_X;
constexpr size_t WS_W1A = WS_X + 4 * MiB;
constexpr size_t WS_W2A = WS_X + 12 * MiB;
constexpr size_t WS_SBUF = WS_X;
constexpr size_t WS_END = 467 * MiB;
static_assert(WS_W2B + (size_t)FF * D * 2 <= WS_HBUF, "ws map");

struct P { const float* in[26]; float* out; unsigned char* ws; };

typedef __bf16 bf16n2 __attribute__((ext_vector_type(2)));
typedef float f32x2n __attribute__((ext_vector_type(2)));
__device__ __forceinline__ unsigned pk_bf16(float lo, float hi) { const f32x2n f = {lo, hi}; const bf16n2 v = __builtin_convertvector(f, bf16n2); return __builtin_bit_cast(unsigned, v); }
__device__ __forceinline__ bf16_t f2bf(float f) { return (bf16_t)(pk_bf16(f, 0.f) & 0xffffu); }
__device__ __forceinline__ float bf2f(bf16_t b) { return __uint_as_float(((unsigned)b) << 16); }
__device__ __forceinline__ float wave_sum(float v) {
#pragma unroll
    for (int o = 1; o < 64; o <<= 1) v += __shfl_xor(v, o);
    return v;
}
__device__ __forceinline__ int row_seq(int row) { return row < T_PROMPT ? (row >> 14) : 2 + ((row - T_PROMPT) >> 11); }
__device__ __forceinline__ float sigmoidf_(float x) { return 1.0f / (1.0f + __expf(-x)); }
__device__ __forceinline__ float gelu_tanh(float y) {
    const float a = 0.7978845608028654f * (y + 0.044715f * y * y * y);
    const float th = 1.0f - 2.0f / (__expf(2.0f * a) + 1.0f);
    return 0.5f * y * (1.0f + th);
}
#define CFENCE() asm volatile("" ::: "memory")
#define LDS_WAIT() asm volatile("s_waitcnt lgkmcnt(0)" ::: "memory")

struct EpiRes {
    static constexpr bool PERM = false, AFTER_DRAIN = false;
    float* x; const float* gate; int row_off;
    __device__ __forceinline__ void operator()(const pg8::f32x4 (&acc)[2][2][4][2], const pg8::Unit& u, int wr, int wc, int fr, int fq) const {
        const int row0 = row_off + u.pm * 256 + wr * 64 + fr, col0 = u.pn * 256 + wc * 32 + 4 * fq;
        const float* gp = gate + (size_t)row_seq(row_off + u.pm * 256) * NMODC;
        pg8::f32x4 gv[2][2];
#pragma unroll
        for (int bj = 0; bj < 2; ++bj)
#pragma unroll
            for (int n = 0; n < 2; ++n) gv[bj][n] = *(const pg8::f32x4*)(gp + col0 + bj * 128 + n * 16);
#pragma unroll
        for (int ai = 0; ai < 2; ++ai)
#pragma unroll
            for (int m = 0; m < 4; ++m) { float* rowp = x + (size_t)(row0 + ai * 128 + m * 16) * D + col0;
#pragma unroll
                for (int bj = 0; bj < 2; ++bj)
#pragma unroll
                    for (int n = 0; n < 2; ++n) { pg8::f32x4* q = (pg8::f32x4*)(rowp + bj * 128 + n * 16); *q = *q + gv[bj][n] * acc[ai][bj][m][n]; }
                asm volatile("" ::: "memory"); }
    }
};
struct EpiGlu {
    static constexpr bool PERM = false, AFTER_DRAIN = false;
    const float* xp; const float* xs; float* out; const float* gate;
    __device__ __forceinline__ void operator()(const pg8::f32x4 (&acc)[2][2][4][2], const pg8::Unit& u, int wr, int wc, int fr, int fq) const {
        const int row0 = u.pm * 256 + wr * 64 + fr, col0 = u.pn * 128 + wc * 32 + 4 * fq;
        const float* gp = gate + (size_t)row_seq(u.pm * 256) * NMODC;
        pg8::f32x4 gv[2];
#pragma unroll
        for (int n = 0; n < 2; ++n) gv[n] = *(const pg8::f32x4*)(gp + col0 + n * 16);
#pragma unroll
        for (int ai = 0; ai < 2; ++ai)
#pragma unroll
            for (int m = 0; m < 4; ++m) { const int row = row0 + ai * 128 + m * 16;
                const float* xin = row < T_PROMPT ? xp + (size_t)row * D : xs + (size_t)(row - T_PROMPT) * D;
#pragma unroll
                for (int n = 0; n < 2; ++n) { const pg8::f32x4 val = acc[ai][0][m][n], gt = acc[ai][1][m][n]; pg8::f32x4 sg;
                    sg[0] = sigmoidf_(gt[0]); sg[1] = sigmoidf_(gt[1]); sg[2] = sigmoidf_(gt[2]); sg[3] = sigmoidf_(gt[3]);
                    const pg8::f32x4 xv = *(const pg8::f32x4*)(xin + col0 + n * 16);
                    *(pg8::f32x4*)(out + (size_t)row * D + col0 + n * 16) = xv + gv[n] * val * sg; }
                asm volatile("" ::: "memory"); }
    }
};
template <int ACT> struct EpiBf {
    static constexpr bool PERM = true, AFTER_DRAIN = false;
    bf16_t* O; int ldc; float* a1;
    __device__ __forceinline__ void operator()(const pg8::f32x4 (&acc)[2][2][4][2], const pg8::Unit& u, int wr, int wc, int fr, int fq) const {
        const int row0 = u.pm * 256 + wr * 64 + fr;
        if (ACT == 0 && u.pn == 12) {
            if (wc == 0) {
#pragma unroll
                for (int ai = 0; ai < 2; ++ai)
#pragma unroll
                    for (int m = 0; m < 4; ++m) { float* rp = a1 + (size_t)(row0 + ai * 128 + m * 16) * 32 + 8 * fq;
                        *(pg8::f32x4*)rp = acc[ai][0][m][0]; *(pg8::f32x4*)(rp + 4) = acc[ai][0][m][1]; }
            }
            return;
        }
        const int col0 = u.pn * 256 + wc * 32 + 8 * fq;
#pragma unroll
        for (int ai = 0; ai < 2; ++ai)
#pragma unroll
            for (int m = 0; m < 4; ++m) { bf16_t* rowp = O + (size_t)(row0 + ai * 128 + m * 16) * ldc + col0;
#pragma unroll
                for (int bj = 0; bj < 2; ++bj) { pg8::f32x4 v0 = acc[ai][bj][m][0], v1 = acc[ai][bj][m][1];
                    if (ACT == 1) {
#pragma unroll
                        for (int e = 0; e < 4; ++e) { const float a = fmaxf(v0[e], 0.f), b = fmaxf(v1[e], 0.f); v0[e] = a * a; v1[e] = b * b; } }
                    pg8::u32x4 wv; wv.x = pk_bf16(v0[0], v0[1]); wv.y = pk_bf16(v0[2], v0[3]); wv.z = pk_bf16(v1[0], v1[1]); wv.w = pk_bf16(v1[2], v1[3]);
                    *(pg8::u32x4*)(rowp + bj * 128) = wv; } }
    }
};

__device__ __forceinline__ void transpose_item(const float* W, int K, int N, int srccol0, bf16_t* WT, int dstrow0, int k0, LAS float* scr, int lane) {
    { float tv[32];
#pragma unroll
      for (int i = 0; i < 32; ++i) tv[i] = W[(size_t)(k0 + 2 * i + (lane >> 5)) * N + srccol0 + (lane & 31)];
#pragma unroll
      for (int i = 0; i < 32; ++i) scr[(2 * i + (lane >> 5)) * 33 + (lane & 31)] = tv[i]; }
    LDS_WAIT();
    const int c = lane & 7;
#pragma unroll
    for (int j = 0; j < 4; ++j) { const int n = (lane >> 3) + 8 * j; const LAS float* s = scr + (8 * c) * 33 + n;
        u32x4 o; o.x = pk_bf16(s[0 * 33], s[1 * 33]); o.y = pk_bf16(s[2 * 33], s[3 * 33]); o.z = pk_bf16(s[4 * 33], s[5 * 33]); o.w = pk_bf16(s[6 * 33], s[7 * 33]);
        *(u32x4*)(WT + (size_t)(dstrow0 + n) * K + k0 + 8 * c) = o; }
    LDS_WAIT();
}

__device__ __forceinline__ void p0_prep(const P& p, LAS unsigned char* lds) {
    int tid_ = threadIdx.x; asm volatile("" : "+v"(tid_));
    const int tid = tid_, lane = tid & 63, w = tid >> 6;
    unsigned char* ws = p.ws;
    if ((int)blockIdx.x < 192) {
        LAS float* sc = (LAS float*)lds;
        LAS float* red = (LAS float*)(lds + 40960);
        for (int i = tid; i < NSEQ * D; i += NTHREADS) { const int s = i >> 10, d = i & 1023; const float c = s < 2 ? p.in[2][s * D + d] : p.in[3][(s - 2) * D + d]; sc[i] = c * sigmoidf_(c); }
        __syncthreads();
        for (int it = blockIdx.x; it < 192; it += gridDim.x) {
            const int l = it / 96, col0 = (it % 96) * 64, col = tid & 63, ks = w;
            float acc[NSEQ];
#pragma unroll
            for (int s = 0; s < NSEQ; ++s) acc[s] = 0.f;
            const float* wp = p.in[4] + ((size_t)l * D + ks * 128) * NMODC + col0 + col;
#pragma unroll 16
            for (int k = 0; k < 128; ++k) { const float wv = wp[(size_t)k * NMODC];
#pragma unroll
                for (int s = 0; s < NSEQ; ++s) acc[s] += sc[s * D + ks * 128 + k] * wv; }
#pragma unroll
            for (int s = 0; s < NSEQ; ++s) red[(ks * NSEQ + s) * 64 + col] = acc[s];
            __syncthreads();
            for (int i = tid; i < NSEQ * 64; i += NTHREADS) { const int s = i >> 6, cc = i & 63; float v = 0.f;
#pragma unroll
                for (int k8 = 0; k8 < 8; ++k8) v += red[(k8 * NSEQ + s) * 64 + cc];
                ((float*)(ws + WS_MOD))[((size_t)l * NSEQ + s) * NMODC + col0 + cc] = v + p.in[5][l * NMODC + col0 + cc]; }
            __syncthreads();
        }
    }
    __syncthreads();
    {
        LAS float* scr = (LAS float*)(lds + w * 16384);
        const int gw = blockIdx.x * NWAVES + w, NGW = gridDim.x * NWAVES;
        constexpr int I_GLU = 16 * 64, I_WIN = 16 * 96, I_WOUT = 16 * 32, I_W1 = 16 * 128, I_W2 = 64 * 32;
        constexpr int NITEMS = I_GLU + I_WIN + I_WOUT + 2 * I_W1 + 2 * I_W2;
        for (int it = gw; it < NITEMS; it += NGW) {
            int r = it;
            if (r < I_GLU) { const int kb = r / 64, nb = r % 64, n0 = nb * 32, pn = n0 >> 8, bj = (n0 >> 7) & 1, r0 = n0 & 127;
                transpose_item(p.in[16], D, 2 * D, bj * D + pn * 128 + r0, (bf16_t*)(ws + WS_WGLU), n0, kb * 64, scr, lane); continue; }
            r -= I_GLU;
            if (r < I_WIN) { const int kb = r / 96, nb = r % 96; transpose_item(p.in[17], D, PROJ_N, nb * 32, (bf16_t*)(ws + WS_WIN), nb * 32, kb * 64, scr, lane); continue; }
            r -= I_WIN;
            if (r < I_WOUT) { const int kb = r / 32, nb = r % 32; transpose_item(p.in[22], D, D, nb * 32, (bf16_t*)(ws + WS_WOUT), nb * 32, kb * 64, scr, lane); continue; }
            r -= I_WOUT;
            if (r < 2 * I_W1) { const int l = r / I_W1, q = r % I_W1, kb = q / 128, nb = q % 128;
                transpose_item(p.in[23] + (size_t)l * D * FF, D, FF, nb * 32, (bf16_t*)(ws + (l ? WS_W1B : WS_W1A)), nb * 32, kb * 64, scr, lane); continue; }
            r -= 2 * I_W1;
            { const int l = r / I_W2, q = r % I_W2, kb = q / 32, nb = q % 32;
                transpose_item(p.in[24] + (size_t)l * FF * D, FF, D, nb * 32, (bf16_t*)(ws + (l ? WS_W2B : WS_W2A)), nb * 32, kb * 64, scr, lane); }
        }
        bf16_t* wt = (bf16_t*)(ws + WS_WIN);
        for (int i = blockIdx.x * NTHREADS + tid; i < 256 * D; i += gridDim.x * NTHREADS) { const int r = i >> 10, k = i & 1023;
            const float v = r < 32 ? p.in[18][((size_t)(r >> 4) * D + k) * 16 + (r & 15)] : 0.f;
            wt[(size_t)(PROJ_N + r) * D + k] = f2bf(v); }
    }
    for (int i = blockIdx.x * NTHREADS + tid; i < 2 * 64 * 64; i += gridDim.x * NTHREADS) {
        const int pp = i & 63, dg = i >> 6;
        const float lr = p.in[8][i], li = p.in[9][i], dt = __expf(p.in[10][dg]);
        const float mag = __expf(lr * dt); float sn, cs; sincosf(li * dt, &sn, &cs);
        const float abr = mag * cs, abi = mag * sn, den = lr * lr + li * li;
        const float zr = ((abr - 1.0f) * lr + abi * li) / den, zi = (abi * lr - (abr - 1.0f) * li) / den;
        float* ab = (float*)(ws + WS_ABAR); ab[2 * i] = abr; ab[2 * i + 1] = abi;
        bf16_t* bbt = (bf16_t*)(ws + WS_BBT); bf16_t* ct = (bf16_t*)(ws + WS_CT);
#pragma unroll
        for (int h = 0; h < 16; ++h) {
            const float br = p.in[11][(size_t)i * 16 + h], bi = p.in[12][(size_t)i * 16 + h];
            bbt[((size_t)dg * 128 + pp) * 16 + h] = f2bf(zr * br - zi * bi);
            bbt[((size_t)dg * 128 + 64 + pp) * 16 + h] = f2bf(zr * bi + zi * br);
            ct[((size_t)dg * 16 + h) * 128 + pp] = f2bf(p.in[13][((size_t)dg * 16 + h) * 64 + pp]);
            ct[((size_t)dg * 16 + h) * 128 + 64 + pp] = f2bf(-p.in[14][((size_t)dg * 16 + h) * 64 + pp]);
        }
    }
}

template <int SRC, bool FINAL>
__device__ __forceinline__ void norm_phase(const P& p, const float* gvec, const float* shift, const float* scale) {
    int tid_ = threadIdx.x; asm volatile("" : "+v"(tid_));
    const int tid = tid_, lane = tid & 63, w = tid >> 6;
    const int gw = blockIdx.x * NWAVES + w, NGW = gridDim.x * NWAVES;
    bf16_t* hb = (bf16_t*)(p.ws + WS_HBUF);
    f32x4 gq[4];
#pragma unroll
    for (int j = 0; j < 4; ++j) gq[j] = *(const f32x4*)(gvec + 4 * lane + 256 * j);
    f32x4 vn[4];
    { const int row = gw; const float* xr = SRC == 0 ? (row < T_PROMPT ? p.in[0] + (size_t)row * D : p.in[1] + (size_t)(row - T_PROMPT) * D) : p.out + (size_t)row * D;
#pragma unroll
      for (int j = 0; j < 4; ++j) vn[j] = *(const f32x4*)(xr + 4 * lane + 256 * j); }
    for (int row = gw; row < T; row += NGW) {
        f32x4 v[4]; float ss = 0.f;
#pragma unroll
        for (int j = 0; j < 4; ++j) { v[j] = vn[j]; ss += (v[j][0] * v[j][0] + v[j][1] * v[j][1]) + (v[j][2] * v[j][2] + v[j][3] * v[j][3]); }
        { const int rn = row + NGW < T ? row + NGW : row;
          const float* xr = SRC == 0 ? (rn < T_PROMPT ? p.in[0] + (size_t)rn * D : p.in[1] + (size_t)(rn - T_PROMPT) * D) : p.out + (size_t)rn * D;
#pragma unroll
          for (int j = 0; j < 4; ++j) vn[j] = *(const f32x4*)(xr + 4 * lane + 256 * j); }
        const float rstd = rsqrtf(wave_sum(ss) * (1.0f / D) + EPS);
        if (FINAL) {
#pragma unroll
            for (int j = 0; j < 4; ++j) *(f32x4*)(p.out + (size_t)row * D + 4 * lane + 256 * j) = v[j] * rstd * gq[j];
        } else {
            const int s = row_seq(row);
#pragma unroll
            for (int j = 0; j < 4; ++j) { const f32x4 sh = *(const f32x4*)(shift + (size_t)s * NMODC + 4 * lane + 256 * j), sc = *(const f32x4*)(scale + (size_t)s * NMODC + 4 * lane + 256 * j);
                const f32x4 o = (v[j] * rstd * gq[j]) * (sc + 1.0f) + sh;
                u32x2 wv; wv.x = pk_bf16(o[0], o[1]); wv.y = pk_bf16(o[2], o[3]);
                *(u32x2*)(hb + (size_t)row * D + 4 * lane + 256 * j) = wv; }
        }
    }
}

constexpr int S5_NCH = 384, S5_HROW = 272, S5_UROW = 48, S5_UOFF = 32 * S5_HROW, S5_WAVE_LDS = S5_UOFF + 128 * S5_UROW;
#define CMAD(sr, si, mr, mi, br, bi) do { const float nr_ = (sr) * (mr) - (si) * (mi) + (br); const float ni_ = (sr) * (mi) + (si) * (mr) + (bi); (sr) = nr_; (si) = ni_; } while (0)
template <bool PC>
__device__ __forceinline__ void s5_pass(const P& p, LAS unsigned char* lds) {
    int tid_ = threadIdx.x; asm volatile("" : "+v"(tid_));
    const int tid = tid_, lane = tid & 63, w = __builtin_amdgcn_readfirstlane(tid >> 6);
    const int b = blockIdx.x, g = (b & 7) * 8 + w;
    const int hh = lane >> 5, l32 = lane & 31, l16 = lane & 15, q16 = lane >> 4;
    LAS unsigned char* const H = lds + w * S5_WAVE_LDS;
    LAS unsigned char* const hwr = H + (4 * hh) * S5_HROW + l32 * 4;
    const LAS unsigned char* const hrd = H + l16 * S5_HROW + q16 * 16;
    const bf16_t* hb = (const bf16_t*)(p.ws + WS_HBUF);
    bf16_t* gout = (bf16_t*)(p.ws + WS_BIG);
    float* E = (float*)(p.ws + WS_S5E);
    const bf16_t* bbt = (const bf16_t*)(p.ws + WS_BBT); const bf16_t* ct = (const bf16_t*)(p.ws + WS_CT); const float* ab = (const float*)(p.ws + WS_ABAR);
    const float dsk = p.in[15][g * 16 + l16];
    const int cstride = (int)(gridDim.x >> 3);
    const bf16_t* const ub = hb + (size_t)l32 * D + g * 16 + 8 * hh;
    bf16x8 afn[4]; f32x2n enr[2], eni[2];
    { const int c0 = b >> 3;
      if (c0 < S5_NCH) {
#pragma unroll
        for (int sb = 0; sb < 4; ++sb) afn[sb] = *(const bf16x8*)(ub + (size_t)(c0 * 128 + sb * 32) * D);
        if (PC) {
#pragma unroll
            for (int dir = 0; dir < 2; ++dir) { const size_t eo = (((size_t)dir * S5_NCH + c0) * 64 + g) * 128; enr[dir] = *(const f32x2n*)(E + eo + 2 * l32); eni[dir] = *(const f32x2n*)(E + eo + 64 + 2 * l32); } } } }
    for (int c = b >> 3; c < S5_NCH; c += cstride) {
        const int tok0 = c * 128;
        f32x2n ecr[2], eci[2];
#pragma unroll
        for (int sb = 0; sb < 4; ++sb) *(LAS bf16x8*)(H + S5_UOFF + (sb * 32 + l32) * S5_UROW + 16 * hh) = afn[sb];
#pragma unroll
        for (int dir = 0; dir < 2; ++dir) { ecr[dir] = enr[dir]; eci[dir] = eni[dir]; }
        CFENCE(); LDS_WAIT(); CFENCE();
        { int cn = c + cstride; asm volatile("" : "+s"(cn));
          if (cn < S5_NCH) {
#pragma unroll
            for (int sb = 0; sb < 4; ++sb) afn[sb] = *(const bf16x8*)(ub + (size_t)(cn * 128 + sb * 32) * D);
            if (PC) {
#pragma unroll
                for (int dir = 0; dir < 2; ++dir) { const size_t eo = (((size_t)dir * S5_NCH + cn) * 64 + g) * 128; enr[dir] = *(const f32x2n*)(E + eo + 2 * l32); eni[dir] = *(const f32x2n*)(E + eo + 64 + 2 * l32); } } } }
        f32x4 yacc[8];
#pragma unroll
        for (int j = 0; j < 8; ++j) yacc[j] = (f32x4){0.f, 0.f, 0.f, 0.f};
#pragma unroll
        for (int dir = 0; dir < 2; ++dir) {
            const size_t eoff = (((size_t)dir * S5_NCH + c) * 64 + g) * 128;
            const int dg = dir * 64 + g;
            bf16x8 Bf[4], Cf[4];
#pragma unroll
            for (int nb = 0; nb < 4; ++nb) Bf[nb] = *(const bf16x8*)(bbt + ((size_t)dg * 128 + (nb >> 1) * 64 + 2 * l32 + (nb & 1)) * 16 + 8 * hh);
#pragma unroll
            for (int ks = 0; ks < 4; ++ks) Cf[ks] = PC ? *(const bf16x8*)(ct + ((size_t)dg * 16 + l16) * 128 + 32 * ks + 8 * q16) : (bf16x8){0, 0, 0, 0, 0, 0, 0, 0};
            const f32x4 a1v = *(const f32x4*)(ab + ((size_t)dg * 64 + 2 * l32) * 2);
            const float a1Ar = a1v[0], a1Ai = a1v[1], a1Br = a1v[2], a1Bi = a1v[3];
            const float a2Ar = a1Ar * a1Ar - a1Ai * a1Ai, a2Ai = 2.f * a1Ar * a1Ai, a2Br = a1Br * a1Br - a1Bi * a1Bi, a2Bi = 2.f * a1Br * a1Bi;
            const float a3Ar = a2Ar * a1Ar - a2Ai * a1Ai, a3Ai = a2Ar * a1Ai + a2Ai * a1Ar, a3Br = a2Br * a1Br - a2Bi * a1Bi, a3Bi = a2Br * a1Bi + a2Bi * a1Br;
            const float a4Ar = a2Ar * a2Ar - a2Ai * a2Ai, a4Ai = 2.f * a2Ar * a2Ai, a4Br = a2Br * a2Br - a2Bi * a2Bi, a4Bi = 2.f * a2Br * a2Bi;
            const float a5Ar = a4Ar * a1Ar - a4Ai * a1Ai, a5Ai = a4Ar * a1Ai + a4Ai * a1Ar, a5Br = a4Br * a1Br - a4Bi * a1Bi, a5Bi = a4Br * a1Bi + a4Bi * a1Br;
            float hAr = 0.f, hAi = 0.f, hBr = 0.f, hBi = 0.f;
            if (PC) { hAr = ecr[dir][0]; hBr = ecr[dir][1]; hAi = eci[dir][0]; hBi = eci[dir][1]; }
            const bool lead = (hh == dir);
#pragma unroll
            for (int sbi = 0; sbi < 4; ++sbi) {
                const int sb = dir == 0 ? sbi : 3 - sbi;
                if (PC) __builtin_amdgcn_sched_barrier(0);
                const bf16x8 a = *(const LAS bf16x8*)(H + S5_UOFF + (sb * 32 + l32) * S5_UROW + 16 * hh);
                f32x16 acc[4];
#pragma unroll
                for (int nb = 0; nb < 4; ++nb) {
#pragma unroll
                    for (int i = 0; i < 16; ++i) acc[nb][i] = 0.f;
                    acc[nb] = __builtin_amdgcn_mfma_f32_32x32x16_bf16(a, Bf[nb], acc[nb], 0, 0, 0);
                }
                if (!PC) {
#pragma unroll
                    for (int gi = 0; gi < 4; ++gi)
#pragma unroll
                        for (int ri = 0; ri < 4; ++ri) { const int i = 4 * (dir == 0 ? gi : 3 - gi) + (dir == 0 ? ri : 3 - ri);
                            if (sbi == 0 && gi == 0 && ri == 0) { hAr = acc[0][i]; hAi = acc[2][i]; hBr = acc[1][i]; hBi = acc[3][i]; }
                            else if (ri == 0) { CMAD(hAr, hAi, a5Ar, a5Ai, acc[0][i], acc[2][i]); CMAD(hBr, hBi, a5Br, a5Bi, acc[1][i], acc[3][i]); }
                            else { CMAD(hAr, hAi, a1Ar, a1Ai, acc[0][i], acc[2][i]); CMAD(hBr, hBi, a1Br, a1Bi, acc[1][i], acc[3][i]); } }
                } else {
#pragma unroll
                    for (int gi = 0; gi < 4; ++gi) { const int gg = dir == 0 ? gi : 3 - gi;
                        float xAr = lead ? hAr : 0.f, xAi = lead ? hAi : 0.f, xBr = lead ? hBr : 0.f, xBi = lead ? hBi : 0.f;
#pragma unroll
                        for (int k = 0; k < 4; ++k) { const int i = 4 * gg + (dir == 0 ? k : 3 - k);
                            CMAD(xAr, xAi, a1Ar, a1Ai, acc[0][i], acc[2][i]); acc[0][i] = xAr; acc[2][i] = xAi;
                            CMAD(xBr, xBi, a1Br, a1Bi, acc[1][i], acc[3][i]); acc[1][i] = xBr; acc[3][i] = xBi; }
                        float eAr = __shfl_xor(xAr, 32), eAi = __shfl_xor(xAi, 32), eBr = __shfl_xor(xBr, 32), eBi = __shfl_xor(xBi, 32);
                        if (lead) { eAr = 0.f; eAi = 0.f; eBr = 0.f; eBi = 0.f; }
                        { const int i0 = 4 * gg + (dir == 0 ? 0 : 3), i1 = 4 * gg + (dir == 0 ? 1 : 2), i2 = 4 * gg + (dir == 0 ? 2 : 1), i3 = 4 * gg + (dir == 0 ? 3 : 0);
                          acc[0][i0] += a1Ar * eAr - a1Ai * eAi; acc[2][i0] += a1Ar * eAi + a1Ai * eAr; acc[1][i0] += a1Br * eBr - a1Bi * eBi; acc[3][i0] += a1Br * eBi + a1Bi * eBr;
                          acc[0][i1] += a2Ar * eAr - a2Ai * eAi; acc[2][i1] += a2Ar * eAi + a2Ai * eAr; acc[1][i1] += a2Br * eBr - a2Bi * eBi; acc[3][i1] += a2Br * eBi + a2Bi * eBr;
                          acc[0][i2] += a3Ar * eAr - a3Ai * eAi; acc[2][i2] += a3Ar * eAi + a3Ai * eAr; acc[1][i2] += a3Br * eBr - a3Bi * eBi; acc[3][i2] += a3Br * eBi + a3Bi * eBr;
                          acc[0][i3] += a4Ar * eAr - a4Ai * eAi; acc[2][i3] += a4Ar * eAi + a4Ai * eAr; acc[1][i3] += a4Br * eBr - a4Bi * eBi; acc[3][i3] += a4Br * eBi + a4Bi * eBr;
                          const float tAr = acc[0][i3], tAi = acc[2][i3], tBr = acc[1][i3], tBi = acc[3][i3];
                          const float rAr = __shfl_xor(tAr, 32), rAi = __shfl_xor(tAi, 32), rBr = __shfl_xor(tBr, 32), rBi = __shfl_xor(tBi, 32);
                          hAr = lead ? rAr : tAr; hAi = lead ? rAi : tAi; hBr = lead ? rBr : tBr; hBi = lead ? rBi : tBi; }
                    }
#pragma unroll
                    for (int i = 0; i < 16; ++i) { const int ro = (8 * (i >> 2) + (i & 3)) * S5_HROW;
                        *(LAS unsigned*)(hwr + ro) = pk_bf16(acc[0][i], acc[1][i]); *(LAS unsigned*)(hwr + ro + 128) = pk_bf16(acc[2][i], acc[3][i]); }
                    CFENCE(); LDS_WAIT(); CFENCE();
#pragma unroll
                    for (int mb = 0; mb < 2; ++mb)
#pragma unroll
                        for (int ks = 0; ks < 4; ++ks) { const bf16x8 af = *(const LAS bf16x8*)(hrd + mb * 16 * S5_HROW + 64 * ks);
                            yacc[sb * 2 + mb] = __builtin_amdgcn_mfma_f32_16x16x32_bf16(af, Cf[ks], yacc[sb * 2 + mb], 0, 0, 0); }
                    CFENCE(); LDS_WAIT(); CFENCE();
                }
            }
            if (!PC) {
                const float oAr = __shfl_xor(hAr, 32), oAi = __shfl_xor(hAi, 32), oBr = __shfl_xor(hBr, 32), oBi = __shfl_xor(hBi, 32);
                const float s0Ar = hh ? oAr : hAr, s0Ai = hh ? oAi : hAi, s0Br = hh ? oBr : hBr, s0Bi = hh ? oBi : hBi;
                const float s1Ar = hh ? hAr : oAr, s1Ai = hh ? hAi : oAi, s1Br = hh ? hBr : oBr, s1Bi = hh ? hBi : oBi;
                float eAr, eAi, eBr, eBi;
                if (dir == 0) { eAr = a4Ar * s0Ar - a4Ai * s0Ai + s1Ar; eAi = a4Ar * s0Ai + a4Ai * s0Ar + s1Ai; eBr = a4Br * s0Br - a4Bi * s0Bi + s1Br; eBi = a4Br * s0Bi + a4Bi * s0Br + s1Bi; }
                else { eAr = a4Ar * s1Ar - a4Ai * s1Ai + s0Ar; eAi = a4Ar * s1Ai + a4Ai * s1Ar + s0Ai; eBr = a4Br * s1Br - a4Bi * s1Bi + s0Br; eBi = a4Br * s1Bi + a4Bi * s1Br + s0Bi; }
                if (hh == 0) { *(f32x2n*)(E + eoff + 2 * l32) = (f32x2n){eAr, eBr}; *(f32x2n*)(E + eoff + 64 + 2 * l32) = (f32x2n){eAi, eBi}; }
            }
        }
        CFENCE(); LDS_WAIT(); CFENCE();
        if (PC) {
#pragma unroll
            for (int j = 0; j < 8; ++j)
#pragma unroll
                for (int i = 0; i < 4; ++i) { LAS bf16_t* up = (LAS bf16_t*)(H + S5_UOFF + (4 * q16) * S5_UROW + l16 * 2 + (j * 16 + i) * S5_UROW);
                    const float y = yacc[j][i] + dsk * bf2f(*up); *up = f2bf(gelu_tanh(y)); }
            CFENCE(); LDS_WAIT(); CFENCE();
#pragma unroll
            for (int k = 0; k < 4; ++k) { const int idx = lane + 64 * k, tk = idx >> 1, hf = idx & 1;
                const u32x4 v = *(const LAS u32x4*)(H + S5_UOFF + tk * S5_UROW + hf * 16);
                *(u32x4*)(gout + (size_t)(tok0 + tk) * D + g * 16 + hf * 8) = v; }
            CFENCE(); LDS_WAIT(); CFENCE();
        }
    }
}
__device__ __forceinline__ void s5_carry(const P& p) {
    int tid_ = threadIdx.x; asm volatile("" : "+v"(tid_));
    const int idx = blockIdx.x * NTHREADS + tid_;
    if (idx >= 2 * NSEQ * 64 * 64) return;
    const int pp = idx & 63, g = (idx >> 6) & 63, s = (idx >> 12) % NSEQ, dir = idx / (NSEQ * 4096);
    const float* ab = (const float*)(p.ws + WS_ABAR);
    float Ar = ab[((dir * 64 + g) * 64 + pp) * 2], Ai = ab[((dir * 64 + g) * 64 + pp) * 2 + 1];
#pragma unroll
    for (int k = 0; k < 7; ++k) { const float nr = Ar * Ar - Ai * Ai, ni = 2.0f * Ar * Ai; Ar = nr; Ai = ni; }
    const int c0 = s < 2 ? s * 128 : 256 + (s - 2) * 16, n = s < 2 ? 128 : 16;
    float* E = (float*)(p.ws + WS_S5E);
    float rr = 0.f, ri = 0.f;
    for (int i0 = 0; i0 < n; i0 += 16) {
        float er[16], ei[16];
#pragma unroll
        for (int k = 0; k < 16; ++k) { const int i = i0 + k, c = dir == 0 ? c0 + i : c0 + n - 1 - i; const size_t ad = (((size_t)dir * S5_NCH + c) * 64 + g) * 128 + pp; er[k] = E[ad]; ei[k] = E[ad + 64]; }
#pragma unroll
        for (int k = 0; k < 16; ++k) { const int i = i0 + k, c = dir == 0 ? c0 + i : c0 + n - 1 - i; const size_t ad = (((size_t)dir * S5_NCH + c) * 64 + g) * 128 + pp;
            E[ad] = rr; E[ad + 64] = ri; const float nr = Ar * rr - Ai * ri + er[k], ni = Ar * ri + Ai * rr + ei[k]; rr = nr; ri = ni; }
    }
}

constexpr int GQ = 0, GK = 17408, GKT = 34816, GVT = 53248, GSC = 90112, GA1 = 99328, GSUM = 103424, GEL = 105472, GRMS = 105984, GRSTD = 108032, GW2 = 108288;
constexpr int QST = 272, TST = 144, VST = 576;
__device__ __forceinline__ void gla_item_coords(int j, int& hd, int& tokbase) {
    hd = j & 3; const int q = j >> 2;
    if (q < 32) tokbase = (q >> 4) * 16384 + (q & 15) * 1024; else tokbase = T_PROMPT + ((q - 32) >> 1) * 2048 + ((q - 32) & 1) * 1024;
}
template <int MODE>
__device__ __forceinline__ void gla_phase(const P& p, LAS unsigned char* lds) {
    int tid_ = threadIdx.x; asm volatile("" : "+v"(tid_));
    const int tid = tid_, lane = tid & 63, w = __builtin_amdgcn_readfirstlane(tid >> 6), hh = lane >> 5, l32 = lane & 31;
    const int chan = tid & 127, tg = w >> 1;
    const bf16_t* proj = (const bf16_t*)(p.ws + WS_BIG);
    const float* a1b = (const float*)(p.ws + WS_A1);
    bf16_t* hb = (bf16_t*)(p.ws + WS_HBUF);
    float* sbuf = (float*)(p.ws + WS_SBUF); float* dtot = (float*)(p.ws + WS_DTOT);
    LAS unsigned char* const qfrag = lds + GQ + l32 * QST + 16 * hh;
    LAS unsigned char* const kfrag = lds + GK + l32 * QST + 16 * hh;
    LAS unsigned char* const qperm = lds + GQ + l32 * QST + 8 * hh;
    LAS unsigned char* const ktfrag = lds + GKT + l32 * TST + 16 * hh;
    LAS unsigned char* const vtr = lds + GVT + (8 * hh + ((lane & 15) >> 2)) * VST + (32 * w + 16 * ((lane >> 4) & 1) + 4 * (lane & 3)) * 2;
    LAS unsigned char* const scfrag = lds + GSC + l32 * TST + 16 * hh;
    LAS unsigned char* const otw = lds + GVT + (4 * hh) * VST + (32 * w + l32) * 2;
    LAS unsigned char* const scst = lds + GSC + (4 * hh) * TST + l32 * 2;
    LAS unsigned char* const elrd = lds + GEL + 16 * hh;
    LAS unsigned char* const rmsw = lds + GRMS + (4 * hh) * 32 + w * 4;
    LAS unsigned char* const rstdr = lds + GRSTD + (4 * hh) * 4;
    LAS unsigned char* const qprep = lds + GQ + (16 * tg) * QST + chan * 2;
    LAS unsigned char* const kprep = lds + GK + (16 * tg) * QST + chan * 2;
    LAS unsigned char* const a1rd = lds + GA1 + (16 * tg) * 64;
    const LAS float* const w2p = (const LAS float*)(lds + GW2) + chan;
    const int nitems = MODE == 0 ? 384 : 192;
    for (int it = blockIdx.x; it < nitems; it += gridDim.x) {
        const int dir = MODE == 0 ? it / 192 : (MODE == 1 ? 0 : 1);
        const int j = MODE == 0 ? it % 192 : it, full = dir * 192 + j;
        int hd, tokbase; gla_item_coords(j, hd, tokbase);
        __syncthreads();
        for (int i = tid; i < 16 * 128; i += NTHREADS) ((LAS float*)(lds + GW2))[i] = p.in[19][(size_t)(dir * 16 + (i >> 7)) * 512 + hd * 128 + (i & 127)];
        const float bias = p.in[20][dir * 512 + hd * 128 + chan];
        f32x16 S[4];
        float* const sb0 = sbuf + (size_t)full * 32768 + 32 * w; const int svo = (4 * hh) * 256 + l32;
#pragma unroll
        for (int cb = 0; cb < 4; ++cb)
#pragma unroll
            for (int i = 0; i < 16; ++i) S[cb][i] = MODE == 0 ? 0.f : (sb0 + (32 * cb + 8 * (i >> 2) + (i & 3)) * 256)[svo];
        float dsum = 0.f;
        u32x4 pq[2], pk[2], pv[4]; f32x4 pa = (f32x4){0.f, 0.f, 0.f, 0.f};
        const int qko = (tid >> 4) * PROJ_N + hd * 128 + (tid & 15) * 8;
        const int vo = (tid >> 5) * PROJ_N + 1024 + hd * 256 + (tid & 31) * 8;
        const int ao = (tid >> 2) * 32 + dir * 16 + (tid & 3) * 4;
#define GLA_LOAD(tbx) do { const bf16_t* pb_ = proj + (size_t)(tbx) * PROJ_N; \
            _Pragma("unroll") for (int i = 0; i < 2; ++i) { if (MODE != 0) pq[i] = *(const u32x4*)(pb_ + (size_t)i * 32 * PROJ_N + qko); pk[i] = *(const u32x4*)(pb_ + (size_t)i * 32 * PROJ_N + 512 + qko); } \
            _Pragma("unroll") for (int i = 0; i < 4; ++i) pv[i] = *(const u32x4*)(pb_ + (size_t)i * 16 * PROJ_N + vo); \
            if (tid < 256) pa = *(const f32x4*)(a1b + (size_t)(tbx) * 32 + ao); } while (0)
        { int tb0 = tokbase + (dir == 0 ? 0 : 15) * 64; GLA_LOAD(tb0); }
        for (int ci = 0; ci < 16; ++ci) {
            int tb = tokbase + (dir == 0 ? ci : 15 - ci) * 64; asm volatile("" : "+s"(tb));
            int tbn = tokbase + (dir == 0 ? ci + 1 : 14 - ci) * 64; asm volatile("" : "+s"(tbn));
            { LAS unsigned char* const qs = lds + GQ + (tid >> 4) * QST + (tid & 15) * 16;
#pragma unroll
              for (int i = 0; i < 2; ++i) { if (MODE != 0) *(LAS u32x4*)(qs + i * 32 * QST) = pq[i]; *(LAS u32x4*)(qs + (GK - GQ) + i * 32 * QST) = pk[i]; } }
            { LAS unsigned char* const vs = lds + GVT + (tid >> 5) * VST + (tid & 31) * 16;
#pragma unroll
              for (int i = 0; i < 4; ++i) *(LAS u32x4*)(vs + i * 16 * VST) = pv[i]; }
            if (tid < 256) *(LAS f32x4*)(lds + GA1 + (tid >> 2) * 64 + (tid & 3) * 16) = pa;
            __syncthreads();
            if (ci + 1 < 16) GLA_LOAD(tbn);
            float zc[16];
#pragma unroll
            for (int i = 0; i < 16; ++i) { const LAS f32x4* ap = (const LAS f32x4*)(a1rd + i * 64);
                float z = bias;
#pragma unroll
                for (int r4 = 0; r4 < 4; ++r4) { const f32x4 av = ap[r4]; z += av[0] * w2p[(4 * r4) * 128] + av[1] * w2p[(4 * r4 + 1) * 128] + av[2] * w2p[(4 * r4 + 2) * 128] + av[3] * w2p[(4 * r4 + 3) * 128]; }
                zc[i] = (fminf(z, 0.f) - __logf(1.0f + __expf(-fabsf(z)))) * (1.0f / 16.0f); }
            if (dir == 0) {
#pragma unroll
                for (int i = 1; i < 16; ++i) zc[i] += zc[i - 1];
            } else {
#pragma unroll
                for (int i = 14; i >= 0; --i) zc[i] += zc[i + 1];
            }
            ((LAS float*)(lds + GSUM))[tg * 128 + chan] = dir == 0 ? zc[15] : zc[0];
            __syncthreads();
            float blast, off;
            { const LAS float* gs = (const LAS float*)(lds + GSUM) + chan; const float g0 = gs[0], g1 = gs[128], g2 = gs[256], g3 = gs[384];
                blast = (g0 + g1) + (g2 + g3);
                if (dir == 0) off = (tg > 0 ? g0 : 0.f) + (tg > 1 ? g1 : 0.f) + (tg > 2 ? g2 : 0.f);
                else off = (tg < 3 ? g3 : 0.f) + (tg < 2 ? g2 : 0.f) + (tg < 1 ? g1 : 0.f); }
            {
                float kt[16];
#pragma unroll
                for (int i = 0; i < 16; ++i) { const float bc = zc[i] + off;
                    LAS bf16_t* qp = (LAS bf16_t*)(qprep + i * QST); LAS bf16_t* kp = (LAS bf16_t*)(kprep + i * QST);
                    const float kv = bf2f(*kp);
                    if (MODE != 0) { const float qv = bf2f(*qp); *qp = f2bf(qv * __expf(bc) * 0.08838834764831845f); *kp = f2bf(kv * __expf(-bc)); }
                    kt[i] = kv * __expf(blast - bc); }
                u32x4 k0, k1; k0.x = pk_bf16(kt[0], kt[1]); k0.y = pk_bf16(kt[2], kt[3]); k0.z = pk_bf16(kt[4], kt[5]); k0.w = pk_bf16(kt[6], kt[7]);
                k1.x = pk_bf16(kt[8], kt[9]); k1.y = pk_bf16(kt[10], kt[11]); k1.z = pk_bf16(kt[12], kt[13]); k1.w = pk_bf16(kt[14], kt[15]);
                *(LAS u32x4*)(lds + GKT + chan * TST + tg * 32) = k0; *(LAS u32x4*)(lds + GKT + chan * TST + tg * 32 + 16) = k1;
            }
            if (tg == 0) { ((LAS float*)(lds + GEL))[chan] = __expf(blast); dsum += blast; }
            __syncthreads();
            if (MODE != 0) {
                if (w < 4) { const int mb = w >> 1, nb = w & 1; f32x16 sc;
#pragma unroll
                    for (int i = 0; i < 16; ++i) sc[i] = 0.f;
#pragma unroll
                    for (int ks = 0; ks < 8; ++ks) { const bf16x8 a = *(const LAS bf16x8*)(qfrag + mb * 32 * QST + 32 * ks), bq = *(const LAS bf16x8*)(kfrag + nb * 32 * QST + 32 * ks);
                        sc = __builtin_amdgcn_mfma_f32_32x32x16_bf16(a, bq, sc, 0, 0, 0); }
                    const int dlt = (nb - mb) * 32 + l32 - 4 * hh;
                    LAS unsigned char* const sw = scst + mb * 32 * TST + nb * 64;
#pragma unroll
                    for (int i = 0; i < 16; ++i) { const int cst = 8 * (i >> 2) + (i & 3); const bool keep = dir == 0 ? (dlt <= cst) : (dlt >= cst);
                        *(LAS bf16_t*)(sw + cst * TST) = f2bf(keep ? sc[i] : 0.f); }
                }
                __syncthreads();
            }
            bf16x8 vf[4];
#pragma unroll
            for (int ks = 0; ks < 4; ++ks) { union { struct { bf16x4 lo, hi; } s; bf16x8 v; } vv;
                vv.s.lo = __builtin_amdgcn_ds_read_tr16_b64_v4i16((LAS bf16x4*)(vtr + (16 * ks) * VST));
                vv.s.hi = __builtin_amdgcn_ds_read_tr16_b64_v4i16((LAS bf16x4*)(vtr + (16 * ks + 4) * VST));
                vf[ks] = vv.v; }
            if (MODE != 0) {
                __syncthreads();
#pragma unroll
                for (int mb = 0; mb < 2; ++mb) {
                    f32x16 o;
#pragma unroll
                    for (int i = 0; i < 16; ++i) o[i] = 0.f;
#pragma unroll
                    for (int ks = 0; ks < 4; ++ks) { const bf16x8 a = *(const LAS bf16x8*)(scfrag + mb * 32 * TST + 32 * ks);
                        o = __builtin_amdgcn_mfma_f32_32x32x16_bf16(a, vf[ks], o, 0, 0, 0); }
#pragma unroll
                    for (int cb = 0; cb < 4; ++cb)
#pragma unroll
                        for (int h2 = 0; h2 < 2; ++h2) {
                            union { u32x4 u; bf16x8 v; } sb_;
                            sb_.u.x = pk_bf16(S[cb][8 * h2 + 0], S[cb][8 * h2 + 1]); sb_.u.y = pk_bf16(S[cb][8 * h2 + 2], S[cb][8 * h2 + 3]);
                            sb_.u.z = pk_bf16(S[cb][8 * h2 + 4], S[cb][8 * h2 + 5]); sb_.u.w = pk_bf16(S[cb][8 * h2 + 6], S[cb][8 * h2 + 7]);
                            const LAS unsigned char* base = qperm + mb * 32 * QST + (32 * cb + 16 * h2) * 2;
                            union { struct { u32x2 lo, hi; } s; bf16x8 v; } qa; qa.s.lo = *(const LAS u32x2*)base; qa.s.hi = *(const LAS u32x2*)(base + 16);
                            o = __builtin_amdgcn_mfma_f32_32x32x16_bf16(qa.v, sb_.v, o, 0, 0, 0);
                        }
#pragma unroll
                    for (int i = 0; i < 16; ++i) *(LAS bf16_t*)(otw + (32 * mb + 8 * (i >> 2) + (i & 3)) * VST) = f2bf(o[i]);
                    CFENCE();
                }
            }
#pragma unroll
            for (int cb = 0; cb < 4; ++cb) {
#pragma unroll
                for (int i4 = 0; i4 < 4; ++i4) { const f32x4 e = *(const LAS f32x4*)(elrd + (32 * cb + 8 * i4) * 4);
                    S[cb][4 * i4 + 0] *= e[0]; S[cb][4 * i4 + 1] *= e[1]; S[cb][4 * i4 + 2] *= e[2]; S[cb][4 * i4 + 3] *= e[3]; }
#pragma unroll
                for (int ks = 0; ks < 4; ++ks) { const bf16x8 a = *(const LAS bf16x8*)(ktfrag + cb * 32 * TST + 32 * ks);
                    S[cb] = __builtin_amdgcn_mfma_f32_32x32x16_bf16(a, vf[ks], S[cb], 0, 0, 0); }
            }
            __syncthreads();
            if (MODE != 0) {
                u32x4 ob[4];
#pragma unroll
                for (int i = 0; i < 4; ++i) ob[i] = *(const LAS u32x4*)(lds + GVT + ((tid >> 5) + 16 * i) * VST + (tid & 31) * 16);
                bf16_t* const og = hb + (size_t)(tb + (tid >> 5)) * D + hd * 256 + (tid & 31) * 8;
                if (MODE == 1) {
#pragma unroll
                    for (int i = 0; i < 4; ++i) *(u32x4*)(og + (size_t)(16 * i) * D) = ob[i];
                } else {
                    const bf16_t* const rg = proj + (size_t)(tb + (tid >> 5)) * PROJ_N + 2048 + hd * 256 + (tid & 31) * 8;
                    u32x4 of[4], rr[4];
#pragma unroll
                    for (int i = 0; i < 4; ++i) { of[i] = *(const u32x4*)(og + (size_t)(16 * i) * D); rr[i] = *(const u32x4*)(rg + (size_t)(16 * i) * PROJ_N); }
                    const f32x4 ng0 = *(const f32x4*)(p.in[21] + hd * 256 + (tid & 31) * 8), ng1 = *(const f32x4*)(p.in[21] + hd * 256 + (tid & 31) * 8 + 4);
#pragma unroll
                    for (int i = 0; i < 4; ++i) {
                        float ov[8]; float sq = 0.f;
#pragma unroll
                        for (int e = 0; e < 4; ++e) { ov[2 * e] = __uint_as_float(ob[i][e] << 16) + __uint_as_float(of[i][e] << 16); ov[2 * e + 1] = __uint_as_float(ob[i][e] & 0xffff0000u) + __uint_as_float(of[i][e] & 0xffff0000u);
                            sq += ov[2 * e] * ov[2 * e] + ov[2 * e + 1] * ov[2 * e + 1]; }
#pragma unroll
                        for (int sh = 1; sh < 32; sh <<= 1) sq += __shfl_xor(sq, sh);
                        const float rs = rsqrtf(sq * (1.0f / 256.0f) + EPS);
                        u32x4 wv;
#pragma unroll
                        for (int e = 0; e < 4; ++e) { const float r0 = __uint_as_float(rr[i][e] << 16), r1 = __uint_as_float(rr[i][e] & 0xffff0000u);
                            const float g0 = e < 2 ? ng0[2 * e] : ng1[2 * e - 4], g1 = e < 2 ? ng0[2 * e + 1] : ng1[2 * e - 3];
                            wv[e] = pk_bf16(ov[2 * e] * rs * g0 * (r0 * sigmoidf_(r0)), ov[2 * e + 1] * rs * g1 * (r1 * sigmoidf_(r1))); }
                        *(u32x4*)(og + (size_t)(16 * i) * D) = wv;
                    }
                }
                __syncthreads();
            }
        }
#undef GLA_LOAD
        if (MODE == 0) {
#pragma unroll
            for (int cb = 0; cb < 4; ++cb)
#pragma unroll
                for (int i = 0; i < 16; ++i) (sb0 + (32 * cb + 8 * (i >> 2) + (i & 3)) * 256)[svo] = S[cb][i];
            if (tg == 0) dtot[full * 128 + chan] = dsum;
        }
    }
}
__device__ __forceinline__ void gla_carry(const P& p) {
    float* sbuf = (float*)(p.ws + WS_SBUF); const float* dtot = (const float*)(p.ws + WS_DTOT);
    const int total = 80 * 8192;
    int tid_ = threadIdx.x; asm volatile("" : "+v"(tid_));
    for (int e = blockIdx.x * NTHREADS + tid_; e < total; e += gridDim.x * NTHREADS) {
        const int e4 = e & 8191, ch = e >> 13, hd = ch & 3, s = (ch >> 2) % NSEQ, dir = ch / (4 * NSEQ);
        const int n = s < 2 ? 16 : 2, q0 = s < 2 ? s * 16 : 32 + (s - 2) * 2, chan = e4 >> 6;
        f32x4 run = (f32x4){0.f, 0.f, 0.f, 0.f};
        float* const base = sbuf + (size_t)e4 * 4;
        if (n == 16) {
            f32x4 tmp[16]; float dcy[16];
#pragma unroll
            for (int i = 0; i < 16; ++i) { const int sc = dir == 0 ? i : 15 - i, full = dir * 192 + (q0 + sc) * 4 + hd; tmp[i] = *(const f32x4*)(base + (size_t)full * 32768); dcy[i] = dtot[full * 128 + chan]; }
#pragma unroll
            for (int i = 0; i < 16; ++i) { const int sc = dir == 0 ? i : 15 - i, full = dir * 192 + (q0 + sc) * 4 + hd; *(f32x4*)(base + (size_t)full * 32768) = run; run = run * __expf(dcy[i]) + tmp[i]; }
        } else {
            for (int i = 0; i < n; ++i) { const int sc = dir == 0 ? i : n - 1 - i, full = dir * 192 + (q0 + sc) * 4 + hd;
                f32x4* ptr = (f32x4*)(base + (size_t)full * 32768); const float dcy = __expf(dtot[full * 128 + chan]);
                const f32x4 tmp = *ptr; *ptr = run; run = run * dcy + tmp; }
        }
    }
}

#define XB_TMO      128
#define XB_XCNT(j)  (256  + 64 * (j))
#define XB_XSUB(j)  (1280 + 64 * (j))
#define XB_XGEN(j)  (2304 + 64 * (j))
#define XB_TOP      3328
#define XB_TOPGEN   3392
#define XCD_BAR_WORDS 3456
#define XB_SPIN_CAP (1u << 18)

__device__ __forceinline__ unsigned xb_ld(unsigned* p)              { return __hip_atomic_load(p, __ATOMIC_RELAXED, __HIP_MEMORY_SCOPE_AGENT); }
__device__ __forceinline__ unsigned xb_add(unsigned* p, unsigned v) { return __hip_atomic_fetch_add(p, v, __ATOMIC_RELAXED, __HIP_MEMORY_SCOPE_AGENT); }
__device__ __forceinline__ unsigned xb_xcc_id() { return (unsigned)__builtin_amdgcn_s_getreg((3 << 11) | 20) & 0xFu; }
#define XB_SPIN(cond, bar) do { unsigned _sp = 0; while (cond) { __builtin_amdgcn_s_sleep(1); \
    if ((++_sp & 255u) == 0u) { if (xb_ld(&(bar)[XB_TMO])) break; if (_sp > XB_SPIN_CAP) { atomicAdd(&(bar)[XB_TMO], 1u); break; } } } } while (0)

struct XcdBarrier {
    unsigned* bar; unsigned x;
    volatile LAS unsigned* st;
};

__device__ __forceinline__ XcdBarrier xcd_barrier_post(unsigned* bar, volatile LAS unsigned* st) {
    XcdBarrier b; b.bar = bar; b.x = xb_xcc_id(); b.st = st;
    if (threadIdx.x == 0) (void)xb_add(&bar[XB_XCNT(b.x)], 1u);
    return b;
}
__device__ __forceinline__ void xcd_barrier_complete(unsigned* bar, unsigned x, unsigned& nloc, unsigned& nx) {
    const unsigned G = gridDim.x * gridDim.y * gridDim.z;
    unsigned sum, cnt, mine, sp = 0u;
    for (;;) {
        sum = 0u; cnt = 0u; mine = 0u;
#pragma unroll
        for (unsigned j = 0; j < 16; ++j) { const unsigned c = xb_ld(&bar[XB_XCNT(j)]); sum += c; cnt += (c > 0u) ? 1u : 0u; mine = (j == x) ? c : mine; }
        if (sum == G) break;
        __builtin_amdgcn_s_sleep(1);
        if ((++sp & 255u) == 0u) { if (xb_ld(&bar[XB_TMO])) break; if (sp > XB_SPIN_CAP) { atomicAdd(&bar[XB_TMO], 1u); break; } }
    }
    nloc = mine > 0u ? mine : 1u; nx = cnt > 0u ? cnt : 1u;
}

__device__ __forceinline__ void xcd_barrier(const XcdBarrier& b) {
    asm volatile("s_waitcnt vmcnt(0)" ::: "memory");
    __syncthreads();
    if (threadIdx.x == 0) {
        unsigned* bar = b.bar;
        __builtin_amdgcn_s_waitcnt(0);
        unsigned nloc = b.st[0], nx = b.st[1];
        if (nloc == 0u) { xcd_barrier_complete(bar, b.x, nloc, nx); b.st[0] = nloc; b.st[1] = nx; }
        const unsigned old = xb_add(&bar[XB_XSUB(b.x)], 1u);
        const unsigned gen = old / nloc;
        if (old + 1u == (gen + 1u) * nloc) {
            __builtin_amdgcn_fence(__ATOMIC_RELEASE, "agent");
            asm volatile("s_waitcnt vmcnt(0)" ::: "memory");
            const unsigned og = xb_add(&bar[XB_TOP], 1u);
            const unsigned tg = og / nx;
            if (og + 1u == (tg + 1u) * nx) xb_add(&bar[XB_TOPGEN], 1u);
            else XB_SPIN(xb_ld(&bar[XB_TOPGEN]) == tg, bar);
            __builtin_amdgcn_fence(__ATOMIC_ACQUIRE, "agent");
            xb_add(&bar[XB_XGEN(b.x)], 1u);
            asm volatile("s_waitcnt vmcnt(0)" ::: "memory");
        } else {
            XB_SPIN(xb_ld(&bar[XB_XGEN(b.x)]) == gen, bar);
            __builtin_amdgcn_fence(__ATOMIC_ACQUIRE, "agent");
            asm volatile("s_waitcnt vmcnt(0)" ::: "memory");
        }
    }
    __syncthreads();
}

#define GRID_BAR() xcd_barrier(bar)

template <int L, int SL>
__device__ __forceinline__ void mlp_slab(const P& p, LAS unsigned char* lds, const XcdBarrier& bar) {
    unsigned char* ws = p.ws;
    const float* ml = (const float*)(ws + WS_MOD) + (size_t)L * NSEQ * NMODC;
    bf16_t* hb = (bf16_t*)(ws + WS_HBUF); bf16_t* big = (bf16_t*)(ws + WS_BIG);
    const bf16_t* w1 = (const bf16_t*)(ws + (L ? WS_W1B : WS_W1A)); const bf16_t* w2 = (const bf16_t*)(ws + (L ? WS_W2B : WS_W2A));
    { pg8::Gemm g{hb + (size_t)SL * 16384 * D, w1, 16384, FF, D}; pg8::StaticOrder S; S.init(16384, FF, gridDim.x, blockIdx.x);
      EpiBf<1> E{big, FF, nullptr};
      if (PH & 4096) pg8::gemm_phase<EpiBf<1>, pg8::StaticOrder>(lds, g, S, E, nullptr);
#if (DUP & 8)
      GRID_BAR(); pg8::gemm_phase<EpiBf<1>, pg8::StaticOrder>(lds, g, S, E, nullptr);
      GRID_BAR(); pg8::gemm_phase<EpiBf<1>, pg8::StaticOrder>(lds, g, S, E, nullptr);
      GRID_BAR(); pg8::gemm_phase<EpiBf<1>, pg8::StaticOrder>(lds, g, S, E, nullptr);
#endif
    }
    GRID_BAR();
    { pg8::Gemm g{big, w2, 16384, D, FF}; pg8::StaticOrder S; S.init(16384, D, gridDim.x, blockIdx.x);
      EpiRes E{p.out, ml + 5 * D, SL * 16384};
      if (PH & 8192) pg8::gemm_phase<EpiRes, pg8::StaticOrder>(lds, g, S, E, nullptr); }
    GRID_BAR();
}
template <int L>
__device__ __forceinline__ void mlp_block(const P& p, LAS unsigned char* lds, const XcdBarrier& bar) {
    const float* ml = (const float*)(p.ws + WS_MOD) + (size_t)L * NSEQ * NMODC;
    norm_phase<1, false>(p, p.in[7] + L * D, ml + 3 * D, ml + 4 * D);
    GRID_BAR();
    mlp_slab<L, 0>(p, lds, bar); mlp_slab<L, 1>(p, lds, bar); mlp_slab<L, 2>(p, lds, bar);
}

__global__ void __launch_bounds__(NTHREADS, 2) hybrid_fwd(P p) {
    extern __shared__ __attribute__((aligned(16))) unsigned char lds_raw[];
    LAS unsigned char* lds = (LAS unsigned char*)lds_raw;
    cg::grid_group grid = cg::this_grid();
    unsigned char* ws = p.ws;
    const float* mod = (const float*)(ws + WS_MOD);
    bf16_t* hb = (bf16_t*)(ws + WS_HBUF);
    bf16_t* big = (bf16_t*)(ws + WS_BIG);

    volatile LAS unsigned* bst = (volatile LAS unsigned*)(lds + LDS_BYTES - 16);
    if (threadIdx.x < 2) bst[threadIdx.x] = 0u;
    if (blockIdx.x == 0) for (int i = threadIdx.x; i < XCD_BAR_WORDS; i += NTHREADS) ((unsigned*)(ws + WS_BARW))[i] = 0u;
    __syncthreads();
    grid.sync();
    const XcdBarrier bar = xcd_barrier_post((unsigned*)(ws + WS_BARW), bst);
    if (PH & 1) p0_prep(p, lds);
    GRID_BAR();
    if (PH & 2) norm_phase<0, false>(p, p.in[6], mod + 0 * D, mod + 1 * D);
    GRID_BAR();
    if (PH & 4) s5_pass<false>(p, lds);
    GRID_BAR();
    if (PH & 8) s5_carry(p);
    GRID_BAR();
    if (PH & 16) s5_pass<true>(p, lds);
    GRID_BAR();
#if (DUP & 1)
    if (PH & 4) s5_pass<false>(p, lds);
    GRID_BAR();
    if (PH & 8) s5_carry(p);
    GRID_BAR();
    if (PH & 16) s5_pass<true>(p, lds);
    GRID_BAR();
#endif
    { pg8::Gemm g{big, (const bf16_t*)(ws + WS_WGLU), T, 2 * D, D}; pg8::StaticOrder S; S.init(T, 2 * D, gridDim.x, blockIdx.x);
      EpiGlu E{p.in[0], p.in[1], p.out, mod + 2 * D};
      if (PH & 512) pg8::gemm_phase<EpiGlu, pg8::StaticOrder>(lds, g, S, E, nullptr);
#if (DUP & 8)
      GRID_BAR(); pg8::gemm_phase<EpiGlu, pg8::StaticOrder>(lds, g, S, E, nullptr);
      GRID_BAR(); pg8::gemm_phase<EpiGlu, pg8::StaticOrder>(lds, g, S, E, nullptr);
      GRID_BAR(); pg8::gemm_phase<EpiGlu, pg8::StaticOrder>(lds, g, S, E, nullptr);
#endif
    }
    GRID_BAR();
    mlp_block<0>(p, lds, bar);
    norm_phase<1, false>(p, p.in[6] + D, mod + (size_t)NSEQ * NMODC + 0 * D, mod + (size_t)NSEQ * NMODC + 1 * D);
    GRID_BAR();
    { pg8::Gemm g{hb, (const bf16_t*)(ws + WS_WIN), T, WIN_N, D}; pg8::StaticOrder S; S.init(T, WIN_N, gridDim.x, blockIdx.x);
      EpiBf<0> E{big, PROJ_N, (float*)(ws + WS_A1)};
      if (PH & 1024) pg8::gemm_phase<EpiBf<0>, pg8::StaticOrder>(lds, g, S, E, nullptr); }
    GRID_BAR();
    if (PH & 32) gla_phase<0>(p, lds);
    GRID_BAR();
    if (PH & 64) gla_carry(p);
    GRID_BAR();
    if (PH & 128) gla_phase<1>(p, lds);
    GRID_BAR();
#if (DUP & 2)
    if (PH & 32) gla_phase<0>(p, lds);
    GRID_BAR();
    if (PH & 64) gla_carry(p);
    GRID_BAR();
    if (PH & 128) gla_phase<1>(p, lds);
    GRID_BAR();
#endif
    if (PH & 256) gla_phase<2>(p, lds);
    GRID_BAR();
    { pg8::Gemm g{hb, (const bf16_t*)(ws + WS_WOUT), T, D, D}; pg8::StaticOrder S; S.init(T, D, gridDim.x, blockIdx.x);
      EpiRes E{p.out, mod + (size_t)NSEQ * NMODC + 2 * D, 0};
      if (PH & 2048) pg8::gemm_phase<EpiRes, pg8::StaticOrder>(lds, g, S, E, nullptr); }
    GRID_BAR();
    mlp_block<1>(p, lds, bar);
#if (DUP & 4)
#pragma unroll 1
    for (int rep = 0; rep < 20; ++rep) GRID_BAR();
#endif
    if (PH == 0) norm_phase<0, true>(p, p.in[25], nullptr, nullptr); else norm_phase<1, true>(p, p.in[25], nullptr, nullptr);
}

extern "C" void kernel_launch(void* const* d_in, const int* in_sizes, int n_in, void* d_out, int out_size, void* d_ws, size_t ws_size, hipStream_t stream) {
    static int grid_blocks = 0;
    if (grid_blocks == 0) {
        if (n_in != 26 || out_size != T * D || ws_size < WS_END) { fprintf(stderr, "kernel_launch: unexpected sizes n_in %d out %d ws %zu\n", n_in, out_size, ws_size); grid_blocks = -1; return; }
        int dev = 0, cus = 0, per_cu = 0;
        hipGetDevice(&dev);
        hipDeviceGetAttribute(&cus, hipDeviceAttributeMultiprocessorCount, dev);
        hipFuncSetAttribute((const void*)hybrid_fwd, hipFuncAttributeMaxDynamicSharedMemorySize, LDS_BYTES);
        hipOccupancyMaxActiveBlocksPerMultiprocessor(&per_cu, (const void*)hybrid_fwd, NTHREADS, LDS_BYTES);
        if (per_cu < 1) { fprintf(stderr, "kernel_launch: occupancy query says %d blocks per CU\n", per_cu); grid_blocks = -1; return; }
        grid_blocks = cus;
        if (grid_blocks % 8) grid_blocks -= grid_blocks % 8;
    }
    if (grid_blocks < 0) return;
    P p{};
    for (int i = 0; i < 26; ++i) p.in[i] = (const float*)d_in[i];
    p.out = (float*)d_out; p.ws = (unsigned char*)d_ws;
    void* args[] = {&p};
    hipError_t e = hipLaunchCooperativeKernel((const void*)hybrid_fwd, dim3(grid_blocks), dim3(NTHREADS), args, LDS_BYTES, stream);
    if (e != hipSuccess) fprintf(stderr, "cooperative launch failed: %s (grid %d)\n", hipGetErrorString(e), grid_blocks);
}
```

```cpp
#include <hip/hip_runtime.h>
#include <hip/hip_cooperative_groups.h>
#include <cstdio>
namespace cg = cooperative_groups;

namespace pg8 {
#define PG8_LAS __attribute__((address_space(3)))
typedef unsigned short bf16_t;
typedef short bf16x8 __attribute__((ext_vector_type(8)));
typedef float f32x4 __attribute__((ext_vector_type(4)));
typedef unsigned u32x4 __attribute__((ext_vector_type(4)));
constexpr int BM = 256, BK = 64, HALF = 128, HTB = HALF * BK * 2  , STAGE_BYTES = 8 * HTB, NXCD = 8, WGM = 8;

__host__ __device__ __forceinline__ int lds_byte(int r, int c) { const int st = (r >> 4) * 2 + (c >> 5), rr = r & 15, cc = c & 31, ob = rr * 64 + cc * 2; return st * 1024 + (ob ^ (((ob >> 9) & 1) << 5)); }
__host__ __device__ __forceinline__ void stage_rc(int b, int& R, int& C) { const int st = b / 1024, sb = b % 1024, swz = sb ^ (((sb >> 9) & 1) << 5); R = (st >> 1) * 16 + swz / 64; C = (st & 1) * 32 + (swz % 64) / 2; }
__host__ __device__ __forceinline__ int perm32(int rho) { const int n = rho >> 4, i = rho & 15; return 8 * (i >> 2) + 4 * n + (i & 3); }

struct Unit { int pm, pn; };
struct Gemm { const bf16_t* A; const bf16_t* Bt; int M, N, K; };

struct StaticOrder {
    int nM, nN, nwg, G, c;
    __host__ __device__ void init(int M, int N, int G_, int c_) { nM = M / BM; nN = N / BM; nwg = nM * nN; G = G_; c = c_; }
    __host__ __device__ bool next(int i, Unit& u) const {
        const long L = (long)i * G + c; if (L >= nwg) return false;
        int wgid = (int)L; { const int q = nwg / NXCD, r = nwg % NXCD, xcd = wgid % NXCD, off = wgid / NXCD; wgid = (xcd < r ? xcd * (q + 1) : r * (q + 1) + (xcd - r) * q) + off; }
        const int nig = WGM * nN, gid = wgid / nig, fm = gid * WGM, gsz = (nM - fm) < WGM ? (nM - fm) : WGM;
        u.pm = fm + ((wgid % nig) % gsz); u.pn = (wgid % nig) / gsz; return true;
    }
    __device__ __forceinline__ void a_ready(const Unit&) const {}
    __device__ __forceinline__ void done(const Unit&) const {}
};


template <class Epi, class Sched, bool STAMP = false>
__device__ __forceinline__ void gemm_phase(PG8_LAS unsigned char* lds, const Gemm g, const Sched& S, const Epi& E, unsigned long long* stamps) {
    int tid_ = threadIdx.x; asm volatile("" : "+v"(tid_));
    const int tid = tid_, wid = __builtin_amdgcn_readfirstlane(tid >> 6), lane = tid & 63, wr = wid >> 2, wc = wid & 3, fr = lane & 15, fq = lane >> 4;
    const int K = g.K, nt = K / BK;
    int ts_lo = 0, ts_hi = 0, nts = 0; const unsigned long long rt_entry = STAMP ? (unsigned long long)wall_clock64() : 0ull;
#define PG8_STAMP() do { if (STAMP && wid == 0 && nts < 64) { const unsigned long long _c = (unsigned long long)clock64(); \
        ts_lo = (lane == nts) ? (int)(unsigned)_c : ts_lo; ts_hi = (lane == nts) ? (int)(unsigned)(_c >> 32) : ts_hi; ++nts; } } while (0)
    PG8_STAMP();
    unsigned voffA[2], voffB[2];
#pragma unroll
    for (int i = 0; i < 2; ++i) { int R, C; stage_rc(tid * 16 + i * 8192, R, C); const int Rb = Epi::PERM ? ((R & ~31) + perm32(R & 31)) : R;
        voffA[i] = (unsigned)(R * K + C) * 2u; voffB[i] = (unsigned)(Rb * K + C) * 2u; }
    const size_t kstep = (size_t)(BK * 2);
    const size_t hstep = (size_t)HALF * K * 2;
    const size_t tstep = 2 * hstep;
    const unsigned ldsw = (unsigned)wid * 1024u;
    const int aoff = lds_byte(wr * 64 + fr, fq * 8), boff = lds_byte(wc * 32 + fr, fq * 8);
#define PG8_SA(b, h) (((b) * 2 + (h)) * HTB)
#define PG8_SB(b, h) ((4 + (b) * 2 + (h)) * HTB)
#define PG8_STAGE(bufoff, gbase, voff) do { _Pragma("unroll") for (int _i = 0; _i < 2; ++_i) \
        __builtin_amdgcn_global_load_lds((const unsigned*)((const char*)(gbase) + (voff)[_i]), (PG8_LAS unsigned*)(lds + (bufoff) + ldsw + _i * 8192), 16, 0, 0); } while (0)
#define PG8_LDA(dst, b, h) do { _Pragma("unroll") for (int m = 0; m < 4; ++m) _Pragma("unroll") for (int k = 0; k < 2; ++k) dst[m][k] = *(const PG8_LAS bf16x8*)(lds + PG8_SA(b, h) + aoff + m * 2048 + k * 1024); } while (0)
#define PG8_LDB(dst, b, h) do { _Pragma("unroll") for (int n = 0; n < 2; ++n) _Pragma("unroll") for (int k = 0; k < 2; ++k) dst[n][k] = *(const PG8_LAS bf16x8*)(lds + PG8_SB(b, h) + boff + n * 2048 + k * 1024); } while (0)
#define PG8_MMA(ai, bj, At, Bt) do { __builtin_amdgcn_s_setprio(1); _Pragma("unroll") for (int m = 0; m < 4; ++m) _Pragma("unroll") for (int n = 0; n < 2; ++n) _Pragma("unroll") for (int k = 0; k < 2; ++k) \
        acc[ai][bj][m][n] = __builtin_amdgcn_mfma_f32_16x16x32_bf16(Bt[n][k], At[m][k], acc[ai][bj][m][n], 0, 0, 0); __builtin_amdgcn_s_setprio(0); } while (0)
#define PG8_WAIT_V(n) asm volatile("s_waitcnt vmcnt(" #n ")" ::: "memory")
#define PG8_WAIT_L(n) asm volatile("s_waitcnt lgkmcnt(" #n ")" ::: "memory")
#define PG8_BAR __builtin_amdgcn_s_barrier()
#define PG8_SCHED __builtin_amdgcn_sched_barrier(0)
    Unit cur, nxt; int ui = 0;
    if (!S.next(0, cur)) return;
    f32x4 acc[2][2][4][2];
#pragma unroll
    for (int a = 0; a < 2; ++a)
#pragma unroll
        for (int b = 0; b < 2; ++b)
#pragma unroll
            for (int m = 0; m < 4; ++m)
#pragma unroll
                for (int n = 0; n < 2; ++n) acc[a][b][m][n] = (f32x4){0.f, 0.f, 0.f, 0.f};
    bf16x8 At[4][2], B0[2][2], B1[2][2];
    const char* cA = (const char*)g.A + (size_t)cur.pm * tstep; const char* cB = (const char*)g.Bt + (size_t)cur.pn * tstep;
    S.a_ready(cur);
    PG8_STAGE(PG8_SB(0, 0), cB, voffB); PG8_STAGE(PG8_SA(0, 0), cA, voffA); PG8_STAGE(PG8_SB(0, 1), cB + hstep, voffB); PG8_STAGE(PG8_SA(0, 1), cA + hstep, voffA);
    if (wr == 1) PG8_BAR;
    PG8_WAIT_V(4); PG8_BAR;
    PG8_STAGE(PG8_SB(1, 0), cB + kstep, voffB); PG8_STAGE(PG8_SA(1, 0), cA + kstep, voffA); PG8_STAGE(PG8_SB(1, 1), cB + hstep + kstep, voffB);
    PG8_WAIT_V(6); PG8_BAR;
    PG8_STAMP();
    for (;;) {
        const bool has_next = S.next(ui + 1, nxt);
        const char* nA = has_next ? (const char*)g.A + (size_t)nxt.pm * tstep : cA; const char* nB = has_next ? (const char*)g.Bt + (size_t)nxt.pn * tstep : cB;
        for (int t = 0; t < nt; t += 2) {
            const bool last = (t == nt - 2);
            const char* a1 = cA + (size_t)(t + 1) * kstep;
            const char* a2 = last ? nA : cA + (size_t)(t + 2) * kstep; const char* b2 = last ? nB : cB + (size_t)(t + 2) * kstep;
            const char* a3 = a2 + kstep; const char* b3 = b2 + kstep;
            if (last && has_next) S.a_ready(nxt);
            PG8_LDB(B0, 0, 0); PG8_SCHED; PG8_LDA(At, 0, 0); PG8_STAGE(PG8_SA(1, 1), a1 + hstep, voffA);
            PG8_WAIT_L(8); PG8_BAR; PG8_WAIT_L(0); PG8_MMA(0, 0, At, B0); PG8_BAR; PG8_SCHED;
            PG8_LDB(B1, 0, 1); PG8_STAGE(PG8_SB(0, 0), b2, voffB);
            PG8_BAR; PG8_WAIT_L(0); PG8_MMA(0, 1, At, B1); PG8_BAR;
            PG8_LDA(At, 0, 1); PG8_STAGE(PG8_SA(0, 0), a2, voffA);
            PG8_BAR; PG8_WAIT_L(0); PG8_MMA(1, 0, At, B0); PG8_BAR; PG8_SCHED;
            PG8_STAGE(PG8_SB(0, 1), b2 + hstep, voffB);
            PG8_WAIT_V(6); PG8_BAR; PG8_MMA(1, 1, At, B1); PG8_BAR;
            PG8_LDB(B0, 1, 0); PG8_SCHED; PG8_LDA(At, 1, 0); PG8_STAGE(PG8_SA(0, 1), a2 + hstep, voffA);
            PG8_WAIT_L(8); PG8_BAR; PG8_WAIT_L(0); PG8_MMA(0, 0, At, B0); PG8_BAR; PG8_SCHED;
            PG8_LDB(B1, 1, 1); PG8_STAGE(PG8_SB(1, 0), b3, voffB);
            PG8_BAR; PG8_WAIT_L(0); PG8_MMA(0, 1, At, B1); PG8_BAR;
            PG8_LDA(At, 1, 1); PG8_STAGE(PG8_SA(1, 0), a3, voffA);
            PG8_BAR; PG8_WAIT_L(0); PG8_MMA(1, 0, At, B0); PG8_BAR; PG8_SCHED;
            PG8_STAGE(PG8_SB(1, 1), b3 + hstep, voffB);
            PG8_WAIT_V(6); PG8_BAR; PG8_MMA(1, 1, At, B1); PG8_BAR;
        }
        PG8_STAMP();
        if constexpr (!Epi::AFTER_DRAIN) { E(acc, cur, wr, wc, fr, fq); S.done(cur); }
        PG8_STAMP();
        if (!has_next) break;
#pragma unroll
        for (int a = 0; a < 2; ++a)
#pragma unroll
            for (int b = 0; b < 2; ++b)
#pragma unroll
                for (int m = 0; m < 4; ++m)
#pragma unroll
                    for (int n = 0; n < 2; ++n) acc[a][b][m][n] = (f32x4){0.f, 0.f, 0.f, 0.f};
        cur = nxt; cA = nA; cB = nB; ++ui;
    }
    PG8_WAIT_V(0);
    if (wr == 0) PG8_BAR;
    PG8_BAR;
    if constexpr (Epi::AFTER_DRAIN) { E.fused(acc, cur, wr, wc, fr, fq, lds, wid, lane); S.done(cur); }
    PG8_STAMP();
    if (STAMP && wid == 0) { stamps[lane] = lane < nts ? (((unsigned long long)(unsigned)ts_hi << 32) | (unsigned)ts_lo) : 0ull;
        if (lane == 62) stamps[62] = rt_entry; if (lane == 63) stamps[63] = (unsigned long long)wall_clock64(); }
#undef PG8_STAMP
#undef PG8_SA
#undef PG8_SB
#undef PG8_STAGE
#undef PG8_LDA
#undef PG8_LDB
#undef PG8_MMA
#undef PG8_WAIT_V
#undef PG8_WAIT_L
#undef PG8_BAR
#undef PG8_SCHED
}
}


#define LAS __attribute__((address_space(3)))
typedef unsigned short bf16_t;
typedef short bf16x8 __attribute__((ext_vector_type(8)));
typedef short bf16x4 __attribute__((ext_vector_type(4)));
typedef float f32x4 __attribute__((ext_vector_type(4)));
typedef float f32x16 __attribute__((ext_vector_type(16)));
typedef unsigned u32x4 __attribute__((ext_vector_type(4)));
typedef unsigned u32x2 __attribute__((ext_vector_type(2)));

constexpr int D = 1024, T = 49152, NSEQ = 10, NMODC = 6144, FF = 4096;
constexpr int T_PROMPT = 32768;
constexpr float EPS = 1e-6f;
#ifndef PH
#define PH 16383
#endif
#ifndef DUP
#define DUP 0
#endif
constexpr int NWAVES = 8, NTHREADS = 512;
constexpr int LDS_BYTES = 139264;
constexpr int WIN_N = 3328;
constexpr int PROJ_N = 3072;

constexpr size_t MiB = 1u << 20;
constexpr size_t WS_MOD = 0;
constexpr size_t WS_BARW = 491520;
constexpr size_t WS_ABAR = 512 * 1024;
constexpr size_t WS_BBT = 1 * MiB;
constexpr size_t WS_CT = 1 * MiB + 512 * 1024;
constexpr size_t WS_DTOT = 2 * MiB;
constexpr size_t WS_A1 = 3 * MiB;
constexpr size_t WS_WIN = 10 * MiB;
constexpr size_t WS_WOUT = WS_WIN + (size_t)WIN_N * D * 2;
constexpr size_t WS_W1B = WS_WOUT + (size_t)D * D * 2;
constexpr size_t WS_W2B = WS_W1B + (size_t)FF * D * 2;
constexpr size_t WS_HBUF = 35 * MiB;
constexpr size_t WS_BIG = 131 * MiB;
constexpr size_t WS_S5E = WS_BIG + 96 * MiB;
constexpr size_t WS_X = 419 * MiB;
constexpr size_t WS_WGLU = WS_X;
constexpr size_t WS_W1A = WS_X + 4 * MiB;
constexpr size_t WS_W2A = WS_X + 12 * MiB;
constexpr size_t WS_SBUF = WS_X;
constexpr size_t WS_END = 467 * MiB;
static_assert(WS_W2B + (size_t)FF * D * 2 <= WS_HBUF, "ws map");

struct P { const float* in[26]; float* out; unsigned char* ws; };

typedef __bf16 bf16n2 __attribute__((ext_vector_type(2)));
typedef float f32x2n __attribute__((ext_vector_type(2)));
__device__ __forceinline__ unsigned pk_bf16(float lo, float hi) { const f32x2n f = {lo, hi}; const bf16n2 v = __builtin_convertvector(f, bf16n2); return __builtin_bit_cast(unsigned, v); }
__device__ __forceinline__ bf16_t f2bf(float f) { return (bf16_t)(pk_bf16(f, 0.f) & 0xffffu); }
__device__ __forceinline__ float bf2f(bf16_t b) { return __uint_as_float(((unsigned)b) << 16); }
__device__ __forceinline__ float wave_sum(float v) {
#pragma unroll
    for (int o = 1; o < 64; o <<= 1) v += __shfl_xor(v, o);
    return v;
}
__device__ __forceinline__ int row_seq(int row) { return row < T_PROMPT ? (row >> 14) : 2 + ((row - T_PROMPT) >> 11); }
__device__ __forceinline__ float sigmoidf_(float x) { return 1.0f / (1.0f + __expf(-x)); }
__device__ __forceinline__ float gelu_tanh(float y) {
    const float a = 0.7978845608028654f * (y + 0.044715f * y * y * y);
    const float th = 1.0f - 2.0f / (__expf(2.0f * a) + 1.0f);
    return 0.5f * y * (1.0f + th);
}
#define CFENCE() asm volatile("" ::: "memory")
#define LDS_WAIT() asm volatile("s_waitcnt lgkmcnt(0)" ::: "memory")

struct EpiRes {
    static constexpr bool PERM = false, AFTER_DRAIN = false;
    float* x; const float* gate; int row_off;
    __device__ __forceinline__ void operator()(const pg8::f32x4 (&acc)[2][2][4][2], const pg8::Unit& u, int wr, int wc, int fr, int fq) const {
        const int row0 = row_off + u.pm * 256 + wr * 64 + fr, col0 = u.pn * 256 + wc * 32 + 4 * fq;
        const float* gp = gate + (size_t)row_seq(row_off + u.pm * 256) * NMODC;
        pg8::f32x4 gv[2][2];
#pragma unroll
        for (int bj = 0; bj < 2; ++bj)
#pragma unroll
            for (int n = 0; n < 2; ++n) gv[bj][n] = *(const pg8::f32x4*)(gp + col0 + bj * 128 + n * 16);
#pragma unroll
        for (int ai = 0; ai < 2; ++ai)
#pragma unroll
            for (int m = 0; m < 4; ++m) { float* rowp = x + (size_t)(row0 + ai * 128 + m * 16) * D + col0;
#pragma unroll
                for (int bj = 0; bj < 2; ++bj)
#pragma unroll
                    for (int n = 0; n < 2; ++n) { pg8::f32x4* q = (pg8::f32x4*)(rowp + bj * 128 + n * 16); *q = *q + gv[bj][n] * acc[ai][bj][m][n]; }
                asm volatile("" ::: "memory"); }
    }
};
struct EpiGlu {
    static constexpr bool PERM = false, AFTER_DRAIN = false;
    const float* xp; const float* xs; float* out; const float* gate;
    __device__ __forceinline__ void operator()(const pg8::f32x4 (&acc)[2][2][4][2], const pg8::Unit& u, int wr, int wc, int fr, int fq) const {
        const int row0 = u.pm * 256 + wr * 64 + fr, col0 = u.pn * 128 + wc * 32 + 4 * fq;
        const float* gp = gate + (size_t)row_seq(u.pm * 256) * NMODC;
        pg8::f32x4 gv[2];
#pragma unroll
        for (int n = 0; n < 2; ++n) gv[n] = *(const pg8::f32x4*)(gp + col0 + n * 16);
#pragma unroll
        for (int ai = 0; ai < 2; ++ai)
#pragma unroll
            for (int m = 0; m < 4; ++m) { const int row = row0 + ai * 128 + m * 16;
                const float* xin = row < T_PROMPT ? xp + (size_t)row * D : xs + (size_t)(row - T_PROMPT) * D;
#pragma unroll
                for (int n = 0; n < 2; ++n) { const pg8::f32x4 val = acc[ai][0][m][n], gt = acc[ai][1][m][n]; pg8::f32x4 sg;
                    sg[0] = sigmoidf_(gt[0]); sg[1] = sigmoidf_(gt[1]); sg[2] = sigmoidf_(gt[2]); sg[3] = sigmoidf_(gt[3]);
                    const pg8::f32x4 xv = *(const pg8::f32x4*)(xin + col0 + n * 16);
                    *(pg8::f32x4*)(out + (size_t)row * D + col0 + n * 16) = xv + gv[n] * val * sg; }
                asm volatile("" ::: "memory"); }
    }
};
template <int ACT> struct EpiBf {
    static constexpr bool PERM = true, AFTER_DRAIN = false;
    bf16_t* O; int ldc; float* a1;
    __device__ __forceinline__ void operator()(const pg8::f32x4 (&acc)[2][2][4][2], const pg8::Unit& u, int wr, int wc, int fr, int fq) const {
        const int row0 = u.pm * 256 + wr * 64 + fr;
        if (ACT == 0 && u.pn == 12) {
            if (wc == 0) {
#pragma unroll
                for (int ai = 0; ai < 2; ++ai)
#pragma unroll
                    for (int m = 0; m < 4; ++m) { float* rp = a1 + (size_t)(row0 + ai * 128 + m * 16) * 32 + 8 * fq;
                        *(pg8::f32x4*)rp = acc[ai][0][m][0]; *(pg8::f32x4*)(rp + 4) = acc[ai][0][m][1]; }
            }
            return;
        }
        const int col0 = u.pn * 256 + wc * 32 + 8 * fq;
#pragma unroll
        for (int ai = 0; ai < 2; ++ai)
#pragma unroll
            for (int m = 0; m < 4; ++m) { bf16_t* rowp = O + (size_t)(row0 + ai * 128 + m * 16) * ldc + col0;
#pragma unroll
                for (int bj = 0; bj < 2; ++bj) { pg8::f32x4 v0 = acc[ai][bj][m][0], v1 = acc[ai][bj][m][1];
                    if (ACT == 1) {
#pragma unroll
                        for (int e = 0; e < 4; ++e) { const float a = fmaxf(v0[e], 0.f), b = fmaxf(v1[e], 0.f); v0[e] = a * a; v1[e] = b * b; } }
                    pg8::u32x4 wv; wv.x = pk_bf16(v0[0], v0[1]); wv.y = pk_bf16(v0[2], v0[3]); wv.z = pk_bf16(v1[0], v1[1]); wv.w = pk_bf16(v1[2], v1[3]);
                    *(pg8::u32x4*)(rowp + bj * 128) = wv; } }
    }
};

__device__ __forceinline__ void transpose_item(const float* W, int K, int N, int srccol0, bf16_t* WT, int dstrow0, int k0, LAS float* scr, int lane) {
    { float tv[32];
#pragma unroll
      for (int i = 0; i < 32; ++i) tv[i] = W[(size_t)(k0 + 2 * i + (lane >> 5)) * N + srccol0 + (lane & 31)];
#pragma unroll
      for (int i = 0; i < 32; ++i) scr[(2 * i + (lane >> 5)) * 33 + (lane & 31)] = tv[i]; }
    LDS_WAIT();
    const int c = lane & 7;
#pragma unroll
    for (int j = 0; j < 4; ++j) { const int n = (lane >> 3) + 8 * j; const LAS float* s = scr + (8 * c) * 33 + n;
        u32x4 o; o.x = pk_bf16(s[0 * 33], s[1 * 33]); o.y = pk_bf16(s[2 * 33], s[3 * 33]); o.z = pk_bf16(s[4 * 33], s[5 * 33]); o.w = pk_bf16(s[6 * 33], s[7 * 33]);
        *(u32x4*)(WT + (size_t)(dstrow0 + n) * K + k0 + 8 * c) = o; }
    LDS_WAIT();
}

__device__ __forceinline__ void p0_prep(const P& p, LAS unsigned char* lds) {
    int tid_ = threadIdx.x; asm volatile("" : "+v"(tid_));
    const int tid = tid_, lane = tid & 63, w = tid >> 6;
    unsigned char* ws = p.ws;
    if ((int)blockIdx.x < 192) {
        LAS float* sc = (LAS float*)lds;
        LAS float* red = (LAS float*)(lds + 40960);
        for (int i = tid; i < NSEQ * D; i += NTHREADS) { const int s = i >> 10, d = i & 1023; const float c = s < 2 ? p.in[2][s * D + d] : p.in[3][(s - 2) * D + d]; sc[i] = c * sigmoidf_(c); }
        __syncthreads();
        for (int it = blockIdx.x; it < 192; it += gridDim.x) {
            const int l = it / 96, col0 = (it % 96) * 64, col = tid & 63, ks = w;
            float acc[NSEQ];
#pragma unroll
            for (int s = 0; s < NSEQ; ++s) acc[s] = 0.f;
            const float* wp = p.in[4] + ((size_t)l * D + ks * 128) * NMODC + col0 + col;
#pragma unroll 16
            for (int k = 0; k < 128; ++k) { const float wv = wp[(size_t)k * NMODC];
#pragma unroll
                for (int s = 0; s < NSEQ; ++s) acc[s] += sc[s * D + ks * 128 + k] * wv; }
#pragma unroll
            for (int s = 0; s < NSEQ; ++s) red[(ks * NSEQ + s) * 64 + col] = acc[s];
            __syncthreads();
            for (int i = tid; i < NSEQ * 64; i += NTHREADS) { const int s = i >> 6, cc = i & 63; float v = 0.f;
#pragma unroll
                for (int k8 = 0; k8 < 8; ++k8) v += red[(k8 * NSEQ + s) * 64 + cc];
                ((float*)(ws + WS_MOD))[((size_t)l * NSEQ + s) * NMODC + col0 + cc] = v + p.in[5][l * NMODC + col0 + cc]; }
            __syncthreads();
        }
    }
    __syncthreads();
    {
        LAS float* scr = (LAS float*)(lds + w * 16384);
        const int gw = blockIdx.x * NWAVES + w, NGW = gridDim.x * NWAVES;
        constexpr int I_GLU = 16 * 64, I_WIN = 16 * 96, I_WOUT = 16 * 32, I_W1 = 16 * 128, I_W2 = 64 * 32;
        constexpr int NITEMS = I_GLU + I_WIN + I_WOUT + 2 * I_W1 + 2 * I_W2;
        for (int it = gw; it < NITEMS; it += NGW) {
            int r = it;
            if (r < I_GLU) { const int kb = r / 64, nb = r % 64, n0 = nb * 32, pn = n0 >> 8, bj = (n0 >> 7) & 1, r0 = n0 & 127;
                transpose_item(p.in[16], D, 2 * D, bj * D + pn * 128 + r0, (bf16_t*)(ws + WS_WGLU), n0, kb * 64, scr, lane); continue; }
            r -= I_GLU;
            if (r < I_WIN) { const int kb = r / 96, nb = r % 96; transpose_item(p.in[17], D, PROJ_N, nb * 32, (bf16_t*)(ws + WS_WIN), nb * 32, kb * 64, scr, lane); continue; }
            r -= I_WIN;
            if (r < I_WOUT) { const int kb = r / 32, nb = r % 32; transpose_item(p.in[22], D, D, nb * 32, (bf16_t*)(ws + WS_WOUT), nb * 32, kb * 64, scr, lane); continue; }
            r -= I_WOUT;
            if (r < 2 * I_W1) { const int l = r / I_W1, q = r % I_W1, kb = q / 128, nb = q % 128;
                transpose_item(p.in[23] + (size_t)l * D * FF, D, FF, nb * 32, (bf16_t*)(ws + (l ? WS_W1B : WS_W1A)), nb * 32, kb * 64, scr, lane); continue; }
            r -= 2 * I_W1;
            { const int l = r / I_W2, q = r % I_W2, kb = q / 32, nb = q % 32;
                transpose_item(p.in[24] + (size_t)l * FF * D, FF, D, nb * 32, (bf16_t*)(ws + (l ? WS_W2B : WS_W2A)), nb * 32, kb * 64, scr, lane); }
        }
        bf16_t* wt = (bf16_t*)(ws + WS_WIN);
        for (int i = blockIdx.x * NTHREADS + tid; i < 256 * D; i += gridDim.x * NTHREADS) { const int r = i >> 10, k = i & 1023;
            const float v = r < 32 ? p.in[18][((size_t)(r >> 4) * D + k) * 16 + (r & 15)] : 0.f;
            wt[(size_t)(PROJ_N + r) * D + k] = f2bf(v); }
    }
    for (int i = blockIdx.x * NTHREADS + tid; i < 2 * 64 * 64; i += gridDim.x * NTHREADS) {
        const int pp = i & 63, dg = i >> 6;
        const float lr = p.in[8][i], li = p.in[9][i], dt = __expf(p.in[10][dg]);
        const float mag = __expf(lr * dt); float sn, cs; sincosf(li * dt, &sn, &cs);
        const float abr = mag * cs, abi = mag * sn, den = lr * lr + li * li;
        const float zr = ((abr - 1.0f) * lr + abi * li) / den, zi = (abi * lr - (abr - 1.0f) * li) / den;
        float* ab = (float*)(ws + WS_ABAR); ab[2 * i] = abr; ab[2 * i + 1] = abi;
        bf16_t* bbt = (bf16_t*)(ws + WS_BBT); bf16_t* ct = (bf16_t*)(ws + WS_CT);
#pragma unroll
        for (int h = 0; h < 16; ++h) {
            const float br = p.in[11][(size_t)i * 16 + h], bi = p.in[12][(size_t)i * 16 + h];
            bbt[((size_t)dg * 128 + pp) * 16 + h] = f2bf(zr * br - zi * bi);
            bbt[((size_t)dg * 128 + 64 + pp) * 16 + h] = f2bf(zr * bi + zi * br);
            ct[((size_t)dg * 16 + h) * 128 + pp] = f2bf(p.in[13][((size_t)dg * 16 + h) * 64 + pp]);
            ct[((size_t)dg * 16 + h) * 128 + 64 + pp] = f2bf(-p.in[14][((size_t)dg * 16 + h) * 64 + pp]);
        }
    }
}

template <int SRC, bool FINAL>
__device__ __forceinline__ void norm_phase(const P& p, const float* gvec, const float* shift, const float* scale) {
    int tid_ = threadIdx.x; asm volatile("" : "+v"(tid_));
    const int tid = tid_, lane = tid & 63, w = tid >> 6;
    const int gw = blockIdx.x * NWAVES + w, NGW = gridDim.x * NWAVES;
    bf16_t* hb = (bf16_t*)(p.ws + WS_HBUF);
    f32x4 gq[4];
#pragma unroll
    for (int j = 0; j < 4; ++j) gq[j] = *(const f32x4*)(gvec + 4 * lane + 256 * j);
    f32x4 vn[4];
    { const int row = gw; const float* xr = SRC == 0 ? (row < T_PROMPT ? p.in[0] + (size_t)row * D : p.in[1] + (size_t)(row - T_PROMPT) * D) : p.out + (size_t)row * D;
#pragma unroll
      for (int j = 0; j < 4; ++j) vn[j] = *(const f32x4*)(xr + 4 * lane + 256 * j); }
    for (int row = gw; row < T; row += NGW) {
        f32x4 v[4]; float ss = 0.f;
#pragma unroll
        for (int j = 0; j < 4; ++j) { v[j] = vn[j]; ss += (v[j][0] * v[j][0] + v[j][1] * v[j][1]) + (v[j][2] * v[j][2] + v[j][3] * v[j][3]); }
        { const int rn = row + NGW < T ? row + NGW : row;
          const float* xr = SRC == 0 ? (rn < T_PROMPT ? p.in[0] + (size_t)rn * D : p.in[1] + (size_t)(rn - T_PROMPT) * D) : p.out + (size_t)rn * D;
#pragma unroll
          for (int j = 0; j < 4; ++j) vn[j] = *(const f32x4*)(xr + 4 * lane + 256 * j); }
        const float rstd = rsqrtf(wave_sum(ss) * (1.0f / D) + EPS);
        if (FINAL) {
#pragma unroll
            for (int j = 0; j < 4; ++j) *(f32x4*)(p.out + (size_t)row * D + 4 * lane + 256 * j) = v[j] * rstd * gq[j];
        } else {
            const int s = row_seq(row);
#pragma unroll
            for (int j = 0; j < 4; ++j) { const f32x4 sh = *(const f32x4*)(shift + (size_t)s * NMODC + 4 * lane + 256 * j), sc = *(const f32x4*)(scale + (size_t)s * NMODC + 4 * lane + 256 * j);
                const f32x4 o = (v[j] * rstd * gq[j]) * (sc + 1.0f) + sh;
                u32x2 wv; wv.x = pk_bf16(o[0], o[1]); wv.y = pk_bf16(o[2], o[3]);
                *(u32x2*)(hb + (size_t)row * D + 4 * lane + 256 * j) = wv; }
        }
    }
}

constexpr int S5_NCH = 384, S5_HROW = 272, S5_UROW = 48, S5_UOFF = 32 * S5_HROW, S5_WAVE_LDS = S5_UOFF + 128 * S5_UROW;
__device__ __forceinline__ void half_bcast(float x, float& lo, float& hi) { const auto r = __builtin_amdgcn_permlane32_swap(__float_as_uint(x), __float_as_uint(x), false, false); lo = __uint_as_float(r[0]); hi = __uint_as_float(r[1]); }
#define CMAD(sr, si, mr, mi, br, bi) do { const float nr_ = (sr) * (mr) - (si) * (mi) + (br); const float ni_ = (sr) * (mi) + (si) * (mr) + (bi); (sr) = nr_; (si) = ni_; } while (0)
template <bool PC>
__device__ __forceinline__ void s5_pass(const P& p, LAS unsigned char* lds) {
    int tid_ = threadIdx.x; asm volatile("" : "+v"(tid_));
    const int tid = tid_, lane = tid & 63, w = __builtin_amdgcn_readfirstlane(tid >> 6);
    const int b = blockIdx.x, g = (b & 7) * 8 + w;
    const int hh = lane >> 5, l32 = lane & 31, l16 = lane & 15, q16 = lane >> 4;
    LAS unsigned char* const H = lds + w * S5_WAVE_LDS;
    LAS unsigned char* const hwr = H + (4 * hh) * S5_HROW + l32 * 4;
    const LAS unsigned char* const hrd = H + l16 * S5_HROW + q16 * 16;
    const bf16_t* hb = (const bf16_t*)(p.ws + WS_HBUF);
    bf16_t* gout = (bf16_t*)(p.ws + WS_BIG);
    float* E = (float*)(p.ws + WS_S5E);
    const bf16_t* bbt = (const bf16_t*)(p.ws + WS_BBT); const bf16_t* ct = (const bf16_t*)(p.ws + WS_CT); const float* ab = (const float*)(p.ws + WS_ABAR);
    const float dsk = p.in[15][g * 16 + l16];
    const int cstride = (int)(gridDim.x >> 3);
    const bf16_t* const ub = hb + (size_t)l32 * D + g * 16 + 8 * hh;
    bf16x8 afn[4]; f32x2n enr[2], eni[2];
    { const int c0 = b >> 3;
      if (c0 < S5_NCH) {
#pragma unroll
        for (int sb = 0; sb < 4; ++sb) afn[sb] = *(const bf16x8*)(ub + (size_t)(c0 * 128 + sb * 32) * D);
        if (PC) {
#pragma unroll
            for (int dir = 0; dir < 2; ++dir) { const size_t eo = (((size_t)dir * S5_NCH + c0) * 64 + g) * 128; enr[dir] = *(const f32x2n*)(E + eo + 2 * l32); eni[dir] = *(const f32x2n*)(E + eo + 64 + 2 * l32); } } } }
    for (int c = b >> 3; c < S5_NCH; c += cstride) {
        const int tok0 = c * 128;
        f32x2n ecr[2], eci[2];
#pragma unroll
        for (int sb = 0; sb < 4; ++sb) *(LAS bf16x8*)(H + S5_UOFF + (sb * 32 + l32) * S5_UROW + 16 * hh) = afn[sb];
#pragma unroll
        for (int dir = 0; dir < 2; ++dir) { ecr[dir] = enr[dir]; eci[dir] = eni[dir]; }
        CFENCE(); LDS_WAIT(); CFENCE();
        { int cn = c + cstride; asm volatile("" : "+s"(cn));
          if (cn < S5_NCH) {
#pragma unroll
            for (int sb = 0; sb < 4; ++sb) afn[sb] = *(const bf16x8*)(ub + (size_t)(cn * 128 + sb * 32) * D);
            if (PC) {
#pragma unroll
                for (int dir = 0; dir < 2; ++dir) { const size_t eo = (((size_t)dir * S5_NCH + cn) * 64 + g) * 128; enr[dir] = *(const f32x2n*)(E + eo + 2 * l32); eni[dir] = *(const f32x2n*)(E + eo + 64 + 2 * l32); } } } }
        f32x4 yacc[8];
#pragma unroll
        for (int j = 0; j < 8; ++j) yacc[j] = (f32x4){0.f, 0.f, 0.f, 0.f};
#pragma unroll
        for (int dir = 0; dir < 2; ++dir) {
            const size_t eoff = (((size_t)dir * S5_NCH + c) * 64 + g) * 128;
            const int dg = dir * 64 + g;
            bf16x8 Bf[4], Cf[4];
#pragma unroll
            for (int nb = 0; nb < 4; ++nb) Bf[nb] = *(const bf16x8*)(bbt + ((size_t)dg * 128 + (nb >> 1) * 64 + 2 * l32 + (nb & 1)) * 16 + 8 * hh);
#pragma unroll
            for (int ks = 0; ks < 4; ++ks) Cf[ks] = PC ? *(const bf16x8*)(ct + ((size_t)dg * 16 + l16) * 128 + 32 * ks + 8 * q16) : (bf16x8){0, 0, 0, 0, 0, 0, 0, 0};
            const f32x4 a1v = *(const f32x4*)(ab + ((size_t)dg * 64 + 2 * l32) * 2);
            const float a1Ar = a1v[0], a1Ai = a1v[1], a1Br = a1v[2], a1Bi = a1v[3];
            const float a2Ar = a1Ar * a1Ar - a1Ai * a1Ai, a2Ai = 2.f * a1Ar * a1Ai, a2Br = a1Br * a1Br - a1Bi * a1Bi, a2Bi = 2.f * a1Br * a1Bi;
            const float a3Ar = a2Ar * a1Ar - a2Ai * a1Ai, a3Ai = a2Ar * a1Ai + a2Ai * a1Ar, a3Br = a2Br * a1Br - a2Bi * a1Bi, a3Bi = a2Br * a1Bi + a2Bi * a1Br;
            const float a4Ar = a2Ar * a2Ar - a2Ai * a2Ai, a4Ai = 2.f * a2Ar * a2Ai, a4Br = a2Br * a2Br - a2Bi * a2Bi, a4Bi = 2.f * a2Br * a2Bi;
            const float a5Ar = a4Ar * a1Ar - a4Ai * a1Ai, a5Ai = a4Ar * a1Ai + a4Ai * a1Ar, a5Br = a4Br * a1Br - a4Bi * a1Bi, a5Bi = a4Br * a1Bi + a4Bi * a1Br;
            float hAr = 0.f, hAi = 0.f, hBr = 0.f, hBi = 0.f;
            if (PC) { hAr = ecr[dir][0]; hBr = ecr[dir][1]; hAi = eci[dir][0]; hBi = eci[dir][1]; }
            const bool lead = (hh == dir);
#pragma unroll
            for (int sbi = 0; sbi < 4; ++sbi) {
                const int sb = dir == 0 ? sbi : 3 - sbi;
                if (PC) __builtin_amdgcn_sched_barrier(0);
                const bf16x8 a = *(const LAS bf16x8*)(H + S5_UOFF + (sb * 32 + l32) * S5_UROW + 16 * hh);
                f32x16 acc[4];
#pragma unroll
                for (int nb = 0; nb < 4; ++nb) {
#pragma unroll
                    for (int i = 0; i < 16; ++i) acc[nb][i] = 0.f;
                    acc[nb] = __builtin_amdgcn_mfma_f32_32x32x16_bf16(a, Bf[nb], acc[nb], 0, 0, 0);
                }
                if (!PC) {
#pragma unroll
                    for (int gi = 0; gi < 4; ++gi)
#pragma unroll
                        for (int ri = 0; ri < 4; ++ri) { const int i = 4 * (dir == 0 ? gi : 3 - gi) + (dir == 0 ? ri : 3 - ri);
                            if (sbi == 0 && gi == 0 && ri == 0) { hAr = acc[0][i]; hAi = acc[2][i]; hBr = acc[1][i]; hBi = acc[3][i]; }
                            else if (ri == 0) { CMAD(hAr, hAi, a5Ar, a5Ai, acc[0][i], acc[2][i]); CMAD(hBr, hBi, a5Br, a5Bi, acc[1][i], acc[3][i]); }
                            else { CMAD(hAr, hAi, a1Ar, a1Ai, acc[0][i], acc[2][i]); CMAD(hBr, hBi, a1Br, a1Bi, acc[1][i], acc[3][i]); } }
                } else {
#pragma unroll
                    for (int gi = 0; gi < 4; ++gi) { const int gg = dir == 0 ? gi : 3 - gi;
                        float xAr = lead ? hAr : 0.f, xAi = lead ? hAi : 0.f, xBr = lead ? hBr : 0.f, xBi = lead ? hBi : 0.f;
#pragma unroll
                        for (int k = 0; k < 4; ++k) { const int i = 4 * gg + (dir == 0 ? k : 3 - k);
                            CMAD(xAr, xAi, a1Ar, a1Ai, acc[0][i], acc[2][i]); acc[0][i] = xAr; acc[2][i] = xAi;
                            CMAD(xBr, xBi, a1Br, a1Bi, acc[1][i], acc[3][i]); acc[1][i] = xBr; acc[3][i] = xBi; }
                        float eAr, eAi, eBr, eBi, dmy;
                        if (dir == 0) { half_bcast(xAr, eAr, dmy); half_bcast(xAi, eAi, dmy); half_bcast(xBr, eBr, dmy); half_bcast(xBi, eBi, dmy); }
                        else { half_bcast(xAr, dmy, eAr); half_bcast(xAi, dmy, eAi); half_bcast(xBr, dmy, eBr); half_bcast(xBi, dmy, eBi); }
                        if (lead) { eAr = 0.f; eAi = 0.f; eBr = 0.f; eBi = 0.f; }
                        { const int i0 = 4 * gg + (dir == 0 ? 0 : 3), i1 = 4 * gg + (dir == 0 ? 1 : 2), i2 = 4 * gg + (dir == 0 ? 2 : 1), i3 = 4 * gg + (dir == 0 ? 3 : 0);
                          acc[0][i0] += a1Ar * eAr - a1Ai * eAi; acc[2][i0] += a1Ar * eAi + a1Ai * eAr; acc[1][i0] += a1Br * eBr - a1Bi * eBi; acc[3][i0] += a1Br * eBi + a1Bi * eBr;
                          acc[0][i1] += a2Ar * eAr - a2Ai * eAi; acc[2][i1] += a2Ar * eAi + a2Ai * eAr; acc[1][i1] += a2Br * eBr - a2Bi * eBi; acc[3][i1] += a2Br * eBi + a2Bi * eBr;
                          acc[0][i2] += a3Ar * eAr - a3Ai * eAi; acc[2][i2] += a3Ar * eAi + a3Ai * eAr; acc[1][i2] += a3Br * eBr - a3Bi * eBi; acc[3][i2] += a3Br * eBi + a3Bi * eBr;
                          acc[0][i3] += a4Ar * eAr - a4Ai * eAi; acc[2][i3] += a4Ar * eAi + a4Ai * eAr; acc[1][i3] += a4Br * eBr - a4Bi * eBi; acc[3][i3] += a4Br * eBi + a4Bi * eBr;
                          const float tAr = acc[0][i3], tAi = acc[2][i3], tBr = acc[1][i3], tBi = acc[3][i3];
                          float dm2;
                          if (dir == 0) { half_bcast(tAr, dm2, hAr); half_bcast(tAi, dm2, hAi); half_bcast(tBr, dm2, hBr); half_bcast(tBi, dm2, hBi); }
                          else { half_bcast(tAr, hAr, dm2); half_bcast(tAi, hAi, dm2); half_bcast(tBr, hBr, dm2); half_bcast(tBi, hBi, dm2); } }
                    }
#pragma unroll
                    for (int i = 0; i < 16; ++i) { const int ro = (8 * (i >> 2) + (i & 3)) * S5_HROW;
                        *(LAS unsigned*)(hwr + ro) = pk_bf16(acc[0][i], acc[1][i]); *(LAS unsigned*)(hwr + ro + 128) = pk_bf16(acc[2][i], acc[3][i]); }
                    CFENCE(); LDS_WAIT(); CFENCE();
#pragma unroll
                    for (int mb = 0; mb < 2; ++mb)
#pragma unroll
                        for (int ks = 0; ks < 4; ++ks) { const bf16x8 af = *(const LAS bf16x8*)(hrd + mb * 16 * S5_HROW + 64 * ks);
                            yacc[sb * 2 + mb] = __builtin_amdgcn_mfma_f32_16x16x32_bf16(af, Cf[ks], yacc[sb * 2 + mb], 0, 0, 0); }
                    CFENCE(); LDS_WAIT(); CFENCE();
                }
            }
            if (!PC) {
                float s0Ar, s0Ai, s0Br, s0Bi, s1Ar, s1Ai, s1Br, s1Bi;
                half_bcast(hAr, s0Ar, s1Ar); half_bcast(hAi, s0Ai, s1Ai); half_bcast(hBr, s0Br, s1Br); half_bcast(hBi, s0Bi, s1Bi);
                float eAr, eAi, eBr, eBi;
                if (dir == 0) { eAr = a4Ar * s0Ar - a4Ai * s0Ai + s1Ar; eAi = a4Ar * s0Ai + a4Ai * s0Ar + s1Ai; eBr = a4Br * s0Br - a4Bi * s0Bi + s1Br; eBi = a4Br * s0Bi + a4Bi * s0Br + s1Bi; }
                else { eAr = a4Ar * s1Ar - a4Ai * s1Ai + s0Ar; eAi = a4Ar * s1Ai + a4Ai * s1Ar + s0Ai; eBr = a4Br * s1Br - a4Bi * s1Bi + s0Br; eBi = a4Br * s1Bi + a4Bi * s1Br + s0Bi; }
                if (hh == 0) { *(f32x2n*)(E + eoff + 2 * l32) = (f32x2n){eAr, eBr}; *(f32x2n*)(E + eoff + 64 + 2 * l32) = (f32x2n){eAi, eBi}; }
            }
        }
        CFENCE(); LDS_WAIT(); CFENCE();
        if (PC) {
#pragma unroll
            for (int j = 0; j < 8; ++j)
#pragma unroll
                for (int i = 0; i < 4; ++i) { LAS bf16_t* up = (LAS bf16_t*)(H + S5_UOFF + (4 * q16) * S5_UROW + l16 * 2 + (j * 16 + i) * S5_UROW);
                    const float y = yacc[j][i] + dsk * bf2f(*up); *up = f2bf(gelu_tanh(y)); }
            CFENCE(); LDS_WAIT(); CFENCE();
#pragma unroll
            for (int k = 0; k < 4; ++k) { const int idx = lane + 64 * k, tk = idx >> 1, hf = idx & 1;
                const u32x4 v = *(const LAS u32x4*)(H + S5_UOFF + tk * S5_UROW + hf * 16);
                *(u32x4*)(gout + (size_t)(tok0 + tk) * D + g * 16 + hf * 8) = v; }
            CFENCE(); LDS_WAIT(); CFENCE();
        }
    }
}
__device__ __forceinline__ void s5_carry(const P& p) {
    int tid_ = threadIdx.x; asm volatile("" : "+v"(tid_));
    const int idx = blockIdx.x * NTHREADS + tid_;
    if (idx >= 2 * NSEQ * 64 * 64) return;
    const int pp = idx & 63, g = (idx >> 6) & 63, s = (idx >> 12) % NSEQ, dir = idx / (NSEQ * 4096);
    const float* ab = (const float*)(p.ws + WS_ABAR);
    float Ar = ab[((dir * 64 + g) * 64 + pp) * 2], Ai = ab[((dir * 64 + g) * 64 + pp) * 2 + 1];
#pragma unroll
    for (int k = 0; k < 7; ++k) { const float nr = Ar * Ar - Ai * Ai, ni = 2.0f * Ar * Ai; Ar = nr; Ai = ni; }
    const int c0 = s < 2 ? s * 128 : 256 + (s - 2) * 16, n = s < 2 ? 128 : 16;
    float* E = (float*)(p.ws + WS_S5E);
    float rr = 0.f, ri = 0.f;
    for (int i0 = 0; i0 < n; i0 += 16) {
        float er[16], ei[16];
#pragma unroll
        for (int k = 0; k < 16; ++k) { const int i = i0 + k, c = dir == 0 ? c0 + i : c0 + n - 1 - i; const size_t ad = (((size_t)dir * S5_NCH + c) * 64 + g) * 128 + pp; er[k] = E[ad]; ei[k] = E[ad + 64]; }
#pragma unroll
        for (int k = 0; k < 16; ++k) { const int i = i0 + k, c = dir == 0 ? c0 + i : c0 + n - 1 - i; const size_t ad = (((size_t)dir * S5_NCH + c) * 64 + g) * 128 + pp;
            E[ad] = rr; E[ad + 64] = ri; const float nr = Ar * rr - Ai * ri + er[k], ni = Ar * ri + Ai * rr + ei[k]; rr = nr; ri = ni; }
    }
}

constexpr int GQ = 0, GK = 17408, GKT = 34816, GVT = 53248, GSC = 90112, GA1 = 99328, GSUM = 103424, GEL = 105472, GRMS = 105984, GRSTD = 108032, GW2 = 108288;
constexpr int QST = 272, TST = 144, VST = 576;
__device__ __forceinline__ void gla_item_coords(int j, int& hd, int& tokbase) {
    hd = j & 3; const int q = j >> 2;
    if (q < 32) tokbase = (q >> 4) * 16384 + (q & 15) * 1024; else tokbase = T_PROMPT + ((q - 32) >> 1) * 2048 + ((q - 32) & 1) * 1024;
}
template <int MODE>
__device__ __forceinline__ void gla_phase(const P& p, LAS unsigned char* lds) {
    int tid_ = threadIdx.x; asm volatile("" : "+v"(tid_));
    const int tid = tid_, lane = tid & 63, w = __builtin_amdgcn_readfirstlane(tid >> 6), hh = lane >> 5, l32 = lane & 31;
    const int chan = tid & 127, tg = w >> 1;
    const bf16_t* proj = (const bf16_t*)(p.ws + WS_BIG);
    const float* a1b = (const float*)(p.ws + WS_A1);
    bf16_t* hb = (bf16_t*)(p.ws + WS_HBUF);
    float* sbuf = (float*)(p.ws + WS_SBUF); float* dtot = (float*)(p.ws + WS_DTOT);
    LAS unsigned char* const qfrag = lds + GQ + l32 * QST + 16 * hh;
    LAS unsigned char* const kfrag = lds + GK + l32 * QST + 16 * hh;
    LAS unsigned char* const qperm = lds + GQ + l32 * QST + 8 * hh;
    LAS unsigned char* const ktfrag = lds + GKT + l32 * TST + 16 * hh;
    LAS unsigned char* const vtr = lds + GVT + (8 * hh + ((lane & 15) >> 2)) * VST + (32 * w + 16 * ((lane >> 4) & 1) + 4 * (lane & 3)) * 2;
    LAS unsigned char* const scfrag = lds + GSC + l32 * TST + 16 * hh;
    LAS unsigned char* const otw = lds + GVT + (4 * hh) * VST + (32 * w + l32) * 2;
    LAS unsigned char* const scst = lds + GSC + (4 * hh) * TST + l32 * 2;
    LAS unsigned char* const elrd = lds + GEL + 16 * hh;
    LAS unsigned char* const rmsw = lds + GRMS + (4 * hh) * 32 + w * 4;
    LAS unsigned char* const rstdr = lds + GRSTD + (4 * hh) * 4;
    LAS unsigned char* const qprep = lds + GQ + (16 * tg) * QST + chan * 2;
    LAS unsigned char* const kprep = lds + GK + (16 * tg) * QST + chan * 2;
    LAS unsigned char* const a1rd = lds + GA1 + (16 * tg) * 64;
    const LAS float* const w2p = (const LAS float*)(lds + GW2) + chan;
    const int nitems = MODE == 0 ? 384 : 192;
    for (int it = blockIdx.x; it < nitems; it += gridDim.x) {
        const int dir = MODE == 0 ? it / 192 : (MODE == 1 ? 0 : 1);
        const int j = MODE == 0 ? it % 192 : it, full = dir * 192 + j;
        int hd, tokbase; gla_item_coords(j, hd, tokbase);
        __syncthreads();
        for (int i = tid; i < 16 * 128; i += NTHREADS) ((LAS float*)(lds + GW2))[i] = p.in[19][(size_t)(dir * 16 + (i >> 7)) * 512 + hd * 128 + (i & 127)];
        const float bias = p.in[20][dir * 512 + hd * 128 + chan];
        f32x16 S[4];
        float* const sb0 = sbuf + (size_t)full * 32768 + 32 * w; const int svo = (4 * hh) * 256 + l32;
#pragma unroll
        for (int cb = 0; cb < 4; ++cb)
#pragma unroll
            for (int i = 0; i < 16; ++i) S[cb][i] = MODE == 0 ? 0.f : (sb0 + (32 * cb + 8 * (i >> 2) + (i & 3)) * 256)[svo];
        float dsum = 0.f;
        u32x4 pq[2], pk[2], pv[4]; f32x4 pa = (f32x4){0.f, 0.f, 0.f, 0.f};
        const int qko = (tid >> 4) * PROJ_N + hd * 128 + (tid & 15) * 8;
        const int vo = (tid >> 5) * PROJ_N + 1024 + hd * 256 + (tid & 31) * 8;
        const int ao = (tid >> 2) * 32 + dir * 16 + (tid & 3) * 4;
#define GLA_LOAD(tbx) do { const bf16_t* pb_ = proj + (size_t)(tbx) * PROJ_N; \
            _Pragma("unroll") for (int i = 0; i < 2; ++i) { if (MODE != 0) pq[i] = *(const u32x4*)(pb_ + (size_t)i * 32 * PROJ_N + qko); pk[i] = *(const u32x4*)(pb_ + (size_t)i * 32 * PROJ_N + 512 + qko); } \
            _Pragma("unroll") for (int i = 0; i < 4; ++i) pv[i] = *(const u32x4*)(pb_ + (size_t)i * 16 * PROJ_N + vo); \
            if (tid < 256) pa = *(const f32x4*)(a1b + (size_t)(tbx) * 32 + ao); } while (0)
        { int tb0 = tokbase + (dir == 0 ? 0 : 15) * 64; GLA_LOAD(tb0); }
        for (int ci = 0; ci < 16; ++ci) {
            int tb = tokbase + (dir == 0 ? ci : 15 - ci) * 64; asm volatile("" : "+s"(tb));
            int tbn = tokbase + (dir == 0 ? ci + 1 : 14 - ci) * 64; asm volatile("" : "+s"(tbn));
            { LAS unsigned char* const qs = lds + GQ + (tid >> 4) * QST + (tid & 15) * 16;
#pragma unroll
              for (int i = 0; i < 2; ++i) { if (MODE != 0) *(LAS u32x4*)(qs + i * 32 * QST) = pq[i]; *(LAS u32x4*)(qs + (GK - GQ) + i * 32 * QST) = pk[i]; } }
            { LAS unsigned char* const vs = lds + GVT + (tid >> 5) * VST + (tid & 31) * 16;
#pragma unroll
              for (int i = 0; i < 4; ++i) *(LAS u32x4*)(vs + i * 16 * VST) = pv[i]; }
            if (tid < 256) *(LAS f32x4*)(lds + GA1 + (tid >> 2) * 64 + (tid & 3) * 16) = pa;
            __syncthreads();
            if (ci + 1 < 16) GLA_LOAD(tbn);
            float zc[16];
#pragma unroll
            for (int i = 0; i < 16; ++i) { const LAS f32x4* ap = (const LAS f32x4*)(a1rd + i * 64);
                float z = bias;
#pragma unroll
                for (int r4 = 0; r4 < 4; ++r4) { const f32x4 av = ap[r4]; z += av[0] * w2p[(4 * r4) * 128] + av[1] * w2p[(4 * r4 + 1) * 128] + av[2] * w2p[(4 * r4 + 2) * 128] + av[3] * w2p[(4 * r4 + 3) * 128]; }
                zc[i] = (fminf(z, 0.f) - __logf(1.0f + __expf(-fabsf(z)))) * (1.0f / 16.0f); }
            if (dir == 0) {
#pragma unroll
                for (int i = 1; i < 16; ++i) zc[i] += zc[i - 1];
            } else {
#pragma unroll
                for (int i = 14; i >= 0; --i) zc[i] += zc[i + 1];
            }
            ((LAS float*)(lds + GSUM))[tg * 128 + chan] = dir == 0 ? zc[15] : zc[0];
            __syncthreads();
            float blast, off;
            { const LAS float* gs = (const LAS float*)(lds + GSUM) + chan; const float g0 = gs[0], g1 = gs[128], g2 = gs[256], g3 = gs[384];
                blast = (g0 + g1) + (g2 + g3);
                if (dir == 0) off = (tg > 0 ? g0 : 0.f) + (tg > 1 ? g1 : 0.f) + (tg > 2 ? g2 : 0.f);
                else off = (tg < 3 ? g3 : 0.f) + (tg < 2 ? g2 : 0.f) + (tg < 1 ? g1 : 0.f); }
            {
                float kt[16];
#pragma unroll
                for (int i = 0; i < 16; ++i) { const float bc = zc[i] + off;
                    LAS bf16_t* qp = (LAS bf16_t*)(qprep + i * QST); LAS bf16_t* kp = (LAS bf16_t*)(kprep + i * QST);
                    const float kv = bf2f(*kp);
                    if (MODE != 0) { const float qv = bf2f(*qp); *qp = f2bf(qv * __expf(bc) * 0.08838834764831845f); *kp = f2bf(kv * __expf(-bc)); }
                    kt[i] = kv * __expf(blast - bc); }
                u32x4 k0, k1; k0.x = pk_bf16(kt[0], kt[1]); k0.y = pk_bf16(kt[2], kt[3]); k0.z = pk_bf16(kt[4], kt[5]); k0.w = pk_bf16(kt[6], kt[7]);
                k1.x = pk_bf16(kt[8], kt[9]); k1.y = pk_bf16(kt[10], kt[11]); k1.z = pk_bf16(kt[12], kt[13]); k1.w = pk_bf16(kt[14], kt[15]);
                *(LAS u32x4*)(lds + GKT + chan * TST + tg * 32) = k0; *(LAS u32x4*)(lds + GKT + chan * TST + tg * 32 + 16) = k1;
            }
            if (tg == 0) { ((LAS float*)(lds + GEL))[chan] = __expf(blast); dsum += blast; }
            __syncthreads();
            if (MODE != 0) {
                if (w < 4) { const int mb = w >> 1, nb = w & 1; f32x16 sc;
#pragma unroll
                    for (int i = 0; i < 16; ++i) sc[i] = 0.f;
#pragma unroll
                    for (int ks = 0; ks < 8; ++ks) { const bf16x8 a = *(const LAS bf16x8*)(qfrag + mb * 32 * QST + 32 * ks), bq = *(const LAS bf16x8*)(kfrag + nb * 32 * QST + 32 * ks);
                        sc = __builtin_amdgcn_mfma_f32_32x32x16_bf16(a, bq, sc, 0, 0, 0); }
                    const int dlt = (nb - mb) * 32 + l32 - 4 * hh;
                    LAS unsigned char* const sw = scst + mb * 32 * TST + nb * 64;
#pragma unroll
                    for (int i = 0; i < 16; ++i) { const int cst = 8 * (i >> 2) + (i & 3); const bool keep = dir == 0 ? (dlt <= cst) : (dlt >= cst);
                        *(LAS bf16_t*)(sw + cst * TST) = f2bf(keep ? sc[i] : 0.f); }
                }
                __syncthreads();
            }
            bf16x8 vf[4];
#pragma unroll
            for (int ks = 0; ks < 4; ++ks) { union { struct { bf16x4 lo, hi; } s; bf16x8 v; } vv;
                vv.s.lo = __builtin_amdgcn_ds_read_tr16_b64_v4i16((LAS bf16x4*)(vtr + (16 * ks) * VST));
                vv.s.hi = __builtin_amdgcn_ds_read_tr16_b64_v4i16((LAS bf16x4*)(vtr + (16 * ks + 4) * VST));
                vf[ks] = vv.v; }
            if (MODE != 0) {
                __syncthreads();
#pragma unroll
                for (int mb = 0; mb < 2; ++mb) {
                    f32x16 o;
#pragma unroll
                    for (int i = 0; i < 16; ++i) o[i] = 0.f;
#pragma unroll
                    for (int ks = 0; ks < 4; ++ks) { const bf16x8 a = *(const LAS bf16x8*)(scfrag + mb * 32 * TST + 32 * ks);
                        o = __builtin_amdgcn_mfma_f32_32x32x16_bf16(a, vf[ks], o, 0, 0, 0); }
#pragma unroll
                    for (int cb = 0; cb < 4; ++cb)
#pragma unroll
                        for (int h2 = 0; h2 < 2; ++h2) {
                            union { u32x4 u; bf16x8 v; } sb_;
                            sb_.u.x = pk_bf16(S[cb][8 * h2 + 0], S[cb][8 * h2 + 1]); sb_.u.y = pk_bf16(S[cb][8 * h2 + 2], S[cb][8 * h2 + 3]);
                            sb_.u.z = pk_bf16(S[cb][8 * h2 + 4], S[cb][8 * h2 + 5]); sb_.u.w = pk_bf16(S[cb][8 * h2 + 6], S[cb][8 * h2 + 7]);
                            const LAS unsigned char* base = qperm + mb * 32 * QST + (32 * cb + 16 * h2) * 2;
                            union { struct { u32x2 lo, hi; } s; bf16x8 v; } qa; qa.s.lo = *(const LAS u32x2*)base; qa.s.hi = *(const LAS u32x2*)(base + 16);
                            o = __builtin_amdgcn_mfma_f32_32x32x16_bf16(qa.v, sb_.v, o, 0, 0, 0);
                        }
#pragma unroll
                    for (int i = 0; i < 16; ++i) *(LAS bf16_t*)(otw + (32 * mb + 8 * (i >> 2) + (i & 3)) * VST) = f2bf(o[i]);
                    CFENCE();
                }
            }
            u32x4 of[4], rr[4];
            if (MODE == 2) {
                const bf16_t* const og2 = hb + (size_t)(tb + (tid >> 5)) * D + hd * 256 + (tid & 31) * 8;
                const bf16_t* const rg = proj + (size_t)(tb + (tid >> 5)) * PROJ_N + 2048 + hd * 256 + (tid & 31) * 8;
#pragma unroll
                for (int i = 0; i < 4; ++i) { of[i] = *(const u32x4*)(og2 + (size_t)(16 * i) * D); rr[i] = *(const u32x4*)(rg + (size_t)(16 * i) * PROJ_N); }
            }
#pragma unroll
            for (int cb = 0; cb < 4; ++cb) {
#pragma unroll
                for (int i4 = 0; i4 < 4; ++i4) { const f32x4 e = *(const LAS f32x4*)(elrd + (32 * cb + 8 * i4) * 4);
                    S[cb][4 * i4 + 0] *= e[0]; S[cb][4 * i4 + 1] *= e[1]; S[cb][4 * i4 + 2] *= e[2]; S[cb][4 * i4 + 3] *= e[3]; }
#pragma unroll
                for (int ks = 0; ks < 4; ++ks) { const bf16x8 a = *(const LAS bf16x8*)(ktfrag + cb * 32 * TST + 32 * ks);
                    S[cb] = __builtin_amdgcn_mfma_f32_32x32x16_bf16(a, vf[ks], S[cb], 0, 0, 0); }
            }
            __syncthreads();
            if (MODE != 0) {
                u32x4 ob[4];
#pragma unroll
                for (int i = 0; i < 4; ++i) ob[i] = *(const LAS u32x4*)(lds + GVT + ((tid >> 5) + 16 * i) * VST + (tid & 31) * 16);
                bf16_t* const og = hb + (size_t)(tb + (tid >> 5)) * D + hd * 256 + (tid & 31) * 8;
                if (MODE == 1) {
#pragma unroll
                    for (int i = 0; i < 4; ++i) *(u32x4*)(og + (size_t)(16 * i) * D) = ob[i];
                } else {
                    const f32x4 ng0 = *(const f32x4*)(p.in[21] + hd * 256 + (tid & 31) * 8), ng1 = *(const f32x4*)(p.in[21] + hd * 256 + (tid & 31) * 8 + 4);
#pragma unroll
                    for (int i = 0; i < 4; ++i) {
                        float ov[8]; float sq = 0.f;
#pragma unroll
                        for (int e = 0; e < 4; ++e) { ov[2 * e] = __uint_as_float(ob[i][e] << 16) + __uint_as_float(of[i][e] << 16); ov[2 * e + 1] = __uint_as_float(ob[i][e] & 0xffff0000u) + __uint_as_float(of[i][e] & 0xffff0000u);
                            sq += ov[2 * e] * ov[2 * e] + ov[2 * e + 1] * ov[2 * e + 1]; }
#pragma unroll
                        for (int sh = 1; sh < 32; sh <<= 1) sq += __shfl_xor(sq, sh);
                        const float rs = rsqrtf(sq * (1.0f / 256.0f) + EPS);
                        u32x4 wv;
#pragma unroll
                        for (int e = 0; e < 4; ++e) { const float r0 = __uint_as_float(rr[i][e] << 16), r1 = __uint_as_float(rr[i][e] & 0xffff0000u);
                            const float g0 = e < 2 ? ng0[2 * e] : ng1[2 * e - 4], g1 = e < 2 ? ng0[2 * e + 1] : ng1[2 * e - 3];
                            wv[e] = pk_bf16(ov[2 * e] * rs * g0 * (r0 * sigmoidf_(r0)), ov[2 * e + 1] * rs * g1 * (r1 * sigmoidf_(r1))); }
                        *(u32x4*)(og + (size_t)(16 * i) * D) = wv;
                    }
                }
                __syncthreads();
            }
        }
#undef GLA_LOAD
        if (MODE == 0) {
#pragma unroll
            for (int cb = 0; cb < 4; ++cb)
#pragma unroll
                for (int i = 0; i < 16; ++i) (sb0 + (32 * cb + 8 * (i >> 2) + (i & 3)) * 256)[svo] = S[cb][i];
            if (tg == 0) dtot[full * 128 + chan] = dsum;
        }
    }
}
__device__ __forceinline__ void gla_carry(const P& p) {
    float* sbuf = (float*)(p.ws + WS_SBUF); const float* dtot = (const float*)(p.ws + WS_DTOT);
    const int total = 80 * 8192;
    int tid_ = threadIdx.x; asm volatile("" : "+v"(tid_));
    for (int e = blockIdx.x * NTHREADS + tid_; e < total; e += gridDim.x * NTHREADS) {
        const int e4 = e & 8191, ch = e >> 13, hd = ch & 3, s = (ch >> 2) % NSEQ, dir = ch / (4 * NSEQ);
        const int n = s < 2 ? 16 : 2, q0 = s < 2 ? s * 16 : 32 + (s - 2) * 2, chan = e4 >> 6;
        f32x4 run = (f32x4){0.f, 0.f, 0.f, 0.f};
        float* const base = sbuf + (size_t)e4 * 4;
        if (n == 16) {
            f32x4 tmp[16]; float dcy[16];
#pragma unroll
            for (int i = 0; i < 16; ++i) { const int sc = dir == 0 ? i : 15 - i, full = dir * 192 + (q0 + sc) * 4 + hd; tmp[i] = *(const f32x4*)(base + (size_t)full * 32768); dcy[i] = dtot[full * 128 + chan]; }
#pragma unroll
            for (int i = 0; i < 16; ++i) { const int sc = dir == 0 ? i : 15 - i, full = dir * 192 + (q0 + sc) * 4 + hd; *(f32x4*)(base + (size_t)full * 32768) = run; run = run * __expf(dcy[i]) + tmp[i]; }
        } else {
            for (int i = 0; i < n; ++i) { const int sc = dir == 0 ? i : n - 1 - i, full = dir * 192 + (q0 + sc) * 4 + hd;
                f32x4* ptr = (f32x4*)(base + (size_t)full * 32768); const float dcy = __expf(dtot[full * 128 + chan]);
                const f32x4 tmp = *ptr; *ptr = run; run = run * dcy + tmp; }
        }
    }
}

#define XB_TMO      128
#define XB_XCNT(j)  (256  + 64 * (j))
#define XB_XSUB(j)  (1280 + 64 * (j))
#define XB_XGEN(j)  (2304 + 64 * (j))
#define XB_TOP      3328
#define XB_TOPGEN   3392
#define XCD_BAR_WORDS 3456
#define XB_SPIN_CAP (1u << 18)

__device__ __forceinline__ unsigned xb_ld(unsigned* p)              { return __hip_atomic_load(p, __ATOMIC_RELAXED, __HIP_MEMORY_SCOPE_AGENT); }
__device__ __forceinline__ unsigned xb_add(unsigned* p, unsigned v) { return __hip_atomic_fetch_add(p, v, __ATOMIC_RELAXED, __HIP_MEMORY_SCOPE_AGENT); }
__device__ __forceinline__ unsigned xb_xcc_id() { return (unsigned)__builtin_amdgcn_s_getreg((3 << 11) | 20) & 0xFu; }
#define XB_SPIN(cond, bar) do { unsigned _sp = 0; while (cond) { __builtin_amdgcn_s_sleep(1); \
    if ((++_sp & 255u) == 0u) { if (xb_ld(&(bar)[XB_TMO])) break; if (_sp > XB_SPIN_CAP) { atomicAdd(&(bar)[XB_TMO], 1u); break; } } } } while (0)

struct XcdBarrier {
    unsigned* bar; unsigned x;
    volatile LAS unsigned* st;
};

__device__ __forceinline__ XcdBarrier xcd_barrier_post(unsigned* bar, volatile LAS unsigned* st) {
    XcdBarrier b; b.bar = bar; b.x = xb_xcc_id(); b.st = st;
    if (threadIdx.x == 0) (void)xb_add(&bar[XB_XCNT(b.x)], 1u);
    return b;
}
__device__ __forceinline__ void xcd_barrier_complete(unsigned* bar, unsigned x, unsigned& nloc, unsigned& nx) {
    const unsigned G = gridDim.x * gridDim.y * gridDim.z;
    unsigned sum, cnt, mine, sp = 0u;
    for (;;) {
        sum = 0u; cnt = 0u; mine = 0u;
#pragma unroll
        for (unsigned j = 0; j < 16; ++j) { const unsigned c = xb_ld(&bar[XB_XCNT(j)]); sum += c; cnt += (c > 0u) ? 1u : 0u; mine = (j == x) ? c : mine; }
        if (sum == G) break;
        __builtin_amdgcn_s_sleep(1);
        if ((++sp & 255u) == 0u) { if (xb_ld(&bar[XB_TMO])) break; if (sp > XB_SPIN_CAP) { atomicAdd(&bar[XB_TMO], 1u); break; } }
    }
    nloc = mine > 0u ? mine : 1u; nx = cnt > 0u ? cnt : 1u;
}

__device__ __forceinline__ void xcd_barrier(const XcdBarrier& b) {
    asm volatile("s_waitcnt vmcnt(0)" ::: "memory");
    __syncthreads();
    if (threadIdx.x == 0) {
        unsigned* bar = b.bar;
        __builtin_amdgcn_s_waitcnt(0);
        unsigned nloc = b.st[0], nx = b.st[1];
        if (nloc == 0u) { xcd_barrier_complete(bar, b.x, nloc, nx); b.st[0] = nloc; b.st[1] = nx; }
        const unsigned old = xb_add(&bar[XB_XSUB(b.x)], 1u);
        const unsigned gen = old / nloc;
        if (old + 1u == (gen + 1u) * nloc) {
            __builtin_amdgcn_fence(__ATOMIC_RELEASE, "agent");
            asm volatile("s_waitcnt vmcnt(0)" ::: "memory");
            const unsigned og = xb_add(&bar[XB_TOP], 1u);
            const unsigned tg = og / nx;
            if (og + 1u == (tg + 1u) * nx) xb_add(&bar[XB_TOPGEN], 1u);
            else XB_SPIN(xb_ld(&bar[XB_TOPGEN]) == tg, bar);
            __builtin_amdgcn_fence(__ATOMIC_ACQUIRE, "agent");
            xb_add(&bar[XB_XGEN(b.x)], 1u);
            asm volatile("s_waitcnt vmcnt(0)" ::: "memory");
        } else {
            XB_SPIN(xb_ld(&bar[XB_XGEN(b.x)]) == gen, bar);
            __builtin_amdgcn_fence(__ATOMIC_ACQUIRE, "agent");
            asm volatile("s_waitcnt vmcnt(0)" ::: "memory");
        }
    }
    __syncthreads();
}

#define GRID_BAR() xcd_barrier(bar)

template <int L, int SL>
__device__ __forceinline__ void mlp_up(const P& p, LAS unsigned char* lds) {
    unsigned char* ws = p.ws;
    bf16_t* hb = (bf16_t*)(ws + WS_HBUF); bf16_t* hid = (bf16_t*)(ws + WS_BIG + (size_t)(SL & 1) * 128 * MiB);
    const bf16_t* w1 = (const bf16_t*)(ws + (L ? WS_W1B : WS_W1A));
    pg8::Gemm g{hb + (size_t)SL * 16384 * D, w1, 16384, FF, D}; pg8::StaticOrder S; S.init(16384, FF, gridDim.x, blockIdx.x);
    EpiBf<1> E{hid, FF, nullptr};
    if (PH & 4096) pg8::gemm_phase<EpiBf<1>, pg8::StaticOrder>(lds, g, S, E, nullptr);
}
template <int L, int SL>
__device__ __forceinline__ void mlp_down(const P& p, LAS unsigned char* lds) {
    unsigned char* ws = p.ws;
    const float* ml = (const float*)(ws + WS_MOD) + (size_t)L * NSEQ * NMODC;
    bf16_t* hid = (bf16_t*)(ws + WS_BIG + (size_t)(SL & 1) * 128 * MiB);
    const bf16_t* w2 = (const bf16_t*)(ws + (L ? WS_W2B : WS_W2A));
    pg8::Gemm g{hid, w2, 16384, D, FF}; pg8::StaticOrder S; S.init(16384, D, gridDim.x, blockIdx.x);
    EpiRes E{p.out, ml + 5 * D, SL * 16384};
    if (PH & 8192) pg8::gemm_phase<EpiRes, pg8::StaticOrder>(lds, g, S, E, nullptr);
}
template <int L>
__device__ __forceinline__ void mlp_block(const P& p, LAS unsigned char* lds, const XcdBarrier& bar) {
    const float* ml = (const float*)(p.ws + WS_MOD) + (size_t)L * NSEQ * NMODC;
    norm_phase<1, false>(p, p.in[7] + L * D, ml + 3 * D, ml + 4 * D);
    GRID_BAR();
    mlp_up<L, 0>(p, lds);
    GRID_BAR();
    mlp_down<L, 0>(p, lds); mlp_up<L, 1>(p, lds);
    GRID_BAR();
    mlp_down<L, 1>(p, lds); mlp_up<L, 2>(p, lds);
    GRID_BAR();
    mlp_down<L, 2>(p, lds);
    GRID_BAR();
}

__global__ void __launch_bounds__(NTHREADS, 2) hybrid_fwd(P p) {
    extern __shared__ __attribute__((aligned(16))) unsigned char lds_raw[];
    LAS unsigned char* lds = (LAS unsigned char*)lds_raw;
    cg::grid_group grid = cg::this_grid();
    unsigned char* ws = p.ws;
    const float* mod = (const float*)(ws + WS_MOD);
    bf16_t* hb = (bf16_t*)(ws + WS_HBUF);
    bf16_t* big = (bf16_t*)(ws + WS_BIG);

    volatile LAS unsigned* bst = (volatile LAS unsigned*)(lds + LDS_BYTES - 16);
    if (threadIdx.x < 2) bst[threadIdx.x] = 0u;
    if (blockIdx.x == 0) for (int i = threadIdx.x; i < XCD_BAR_WORDS; i += NTHREADS) ((unsigned*)(ws + WS_BARW))[i] = 0u;
    __syncthreads();
    grid.sync();
    const XcdBarrier bar = xcd_barrier_post((unsigned*)(ws + WS_BARW), bst);
    if (PH & 1) p0_prep(p, lds);
    GRID_BAR();
    if (PH & 2) norm_phase<0, false>(p, p.in[6], mod + 0 * D, mod + 1 * D);
    GRID_BAR();
    if (PH & 4) s5_pass<false>(p, lds);
    GRID_BAR();
    if (PH & 8) s5_carry(p);
    GRID_BAR();
    if (PH & 16) s5_pass<true>(p, lds);
    GRID_BAR();
#if (DUP & 1)
    if (PH & 4) s5_pass<false>(p, lds);
    GRID_BAR();
    if (PH & 8) s5_carry(p);
    GRID_BAR();
    if (PH & 16) s5_pass<true>(p, lds);
    GRID_BAR();
#endif
    { pg8::Gemm g{big, (const bf16_t*)(ws + WS_WGLU), T, 2 * D, D}; pg8::StaticOrder S; S.init(T, 2 * D, gridDim.x, blockIdx.x);
      EpiGlu E{p.in[0], p.in[1], p.out, mod + 2 * D};
      if (PH & 512) pg8::gemm_phase<EpiGlu, pg8::StaticOrder>(lds, g, S, E, nullptr);
#if (DUP & 8)
      GRID_BAR(); pg8::gemm_phase<EpiGlu, pg8::StaticOrder>(lds, g, S, E, nullptr);
      GRID_BAR(); pg8::gemm_phase<EpiGlu, pg8::StaticOrder>(lds, g, S, E, nullptr);
      GRID_BAR(); pg8::gemm_phase<EpiGlu, pg8::StaticOrder>(lds, g, S, E, nullptr);
#endif
    }
    GRID_BAR();
    mlp_block<0>(p, lds, bar);
    norm_phase<1, false>(p, p.in[6] + D, mod + (size_t)NSEQ * NMODC + 0 * D, mod + (size_t)NSEQ * NMODC + 1 * D);
    GRID_BAR();
    { pg8::Gemm g{hb, (const bf16_t*)(ws + WS_WIN), T, WIN_N, D}; pg8::StaticOrder S; S.init(T, WIN_N, gridDim.x, blockIdx.x);
      EpiBf<0> E{big, PROJ_N, (float*)(ws + WS_A1)};
      if (PH & 1024) pg8::gemm_phase<EpiBf<0>, pg8::StaticOrder>(lds, g, S, E, nullptr); }
    GRID_BAR();
    if (PH & 32) gla_phase<0>(p, lds);
    GRID_BAR();
    if (PH & 64) gla_carry(p);
    GRID_BAR();
    if (PH & 128) gla_phase<1>(p, lds);
    GRID_BAR();
#if (DUP & 2)
    if (PH & 32) gla_phase<0>(p, lds);
    GRID_BAR();
    if (PH & 64) gla_carry(p);
    GRID_BAR();
    if (PH & 128) gla_phase<1>(p, lds);
    GRID_BAR();
#endif
    if (PH & 256) gla_phase<2>(p, lds);
    GRID_BAR();
    { pg8::Gemm g{hb, (const bf16_t*)(ws + WS_WOUT), T, D, D}; pg8::StaticOrder S; S.init(T, D, gridDim.x, blockIdx.x);
      EpiRes E{p.out, mod + (size_t)NSEQ * NMODC + 2 * D, 0};
      if (PH & 2048) pg8::gemm_phase<EpiRes, pg8::StaticOrder>(lds, g, S, E, nullptr); }
    GRID_BAR();
    mlp_block<1>(p, lds, bar);
#if (DUP & 4)
#pragma unroll 1
    for (int rep = 0; rep < 20; ++rep) GRID_BAR();
#endif
    if (PH == 0) norm_phase<0, true>(p, p.in[25], nullptr, nullptr); else norm_phase<1, true>(p, p.in[25], nullptr, nullptr);
}

extern "C" void kernel_launch(void* const* d_in, const int* in_sizes, int n_in, void* d_out, int out_size, void* d_ws, size_t ws_size, hipStream_t stream) {
    static int grid_blocks = 0;
    if (grid_blocks == 0) {
        if (n_in != 26 || out_size != T * D || ws_size < WS_END) { fprintf(stderr, "kernel_launch: unexpected sizes n_in %d out %d ws %zu\n", n_in, out_size, ws_size); grid_blocks = -1; return; }
        int dev = 0, cus = 0, per_cu = 0;
        hipGetDevice(&dev);
        hipDeviceGetAttribute(&cus, hipDeviceAttributeMultiprocessorCount, dev);
        hipFuncSetAttribute((const void*)hybrid_fwd, hipFuncAttributeMaxDynamicSharedMemorySize, LDS_BYTES);
        hipOccupancyMaxActiveBlocksPerMultiprocessor(&per_cu, (const void*)hybrid_fwd, NTHREADS, LDS_BYTES);
        if (per_cu < 1) { fprintf(stderr, "kernel_launch: occupancy query says %d blocks per CU\n", per_cu); grid_blocks = -1; return; }
        grid_blocks = cus;
        if (grid_blocks % 8) grid_blocks -= grid_blocks % 8;
    }
    if (grid_blocks < 0) return;
    P p{};
    for (int i = 0; i < 26; ++i) p.in[i] = (const float*)d_in[i];
    p.out = (float*)d_out; p.ws = (unsigned char*)d_ws;
    void* args[] = {&p};
    hipError_t e = hipLaunchCooperativeKernel((const void*)hybrid_fwd, dim3(grid_blocks), dim3(NTHREADS), args, LDS_BYTES, stream);
    if (e != hipSuccess) fprintf(stderr, "cooperative launch failed: %s (grid %d)\n", hipGetErrorString(e), grid_blocks);
}
```

```cpp
#include <hip/hip_runtime.h>
#include <hip/hip_cooperative_groups.h>
#include <cstdio>
namespace cg = cooperative_groups;

namespace pg8 {
#define PG8_LAS __attribute__((address_space(3)))
typedef unsigned short bf16_t;
typedef short bf16x8 __attribute__((ext_vector_type(8)));
typedef float f32x4 __attribute__((ext_vector_type(4)));
typedef unsigned u32x4 __attribute__((ext_vector_type(4)));
constexpr int BM = 256, BK = 64, HALF = 128, HTB = HALF * BK * 2  , STAGE_BYTES = 8 * HTB, NXCD = 8, WGM = 8;

__host__ __device__ __forceinline__ int lds_byte(int r, int c) { const int st = (r >> 4) * 2 + (c >> 5), rr = r & 15, cc = c & 31, ob = rr * 64 + cc * 2; return st * 1024 + (ob ^ (((ob >> 9) & 1) << 5)); }
__host__ __device__ __forceinline__ void stage_rc(int b, int& R, int& C) { const int st = b / 1024, sb = b % 1024, swz = sb ^ (((sb >> 9) & 1) << 5); R = (st >> 1) * 16 + swz / 64; C = (st & 1) * 32 + (swz % 64) / 2; }
__host__ __device__ __forceinline__ int perm32(int rho) { const int n = rho >> 4, i = rho & 15; return 8 * (i >> 2) + 4 * n + (i & 3); }

struct Unit { int pm, pn; };
struct Gemm { const bf16_t* A; const bf16_t* Bt; int M, N, K; };

struct StaticOrder {
    int nM, nN, nwg, G, c;
    __host__ __device__ void init(int M, int N, int G_, int c_) { nM = M / BM; nN = N / BM; nwg = nM * nN; G = G_; c = c_; }
    __host__ __device__ bool next(int i, Unit& u) const {
        const long L = (long)i * G + c; if (L >= nwg) return false;
        int wgid = (int)L; { const int q = nwg / NXCD, r = nwg % NXCD, xcd = wgid % NXCD, off = wgid / NXCD; wgid = (xcd < r ? xcd * (q + 1) : r * (q + 1) + (xcd - r) * q) + off; }
        const int nig = WGM * nN, gid = wgid / nig, fm = gid * WGM, gsz = (nM - fm) < WGM ? (nM - fm) : WGM;
        u.pm = fm + ((wgid % nig) % gsz); u.pn = (wgid % nig) / gsz; return true;
    }
    __device__ __forceinline__ void a_ready(const Unit&) const {}
    __device__ __forceinline__ void done(const Unit&) const {}
};


template <class Epi, class Sched, bool STAMP = false>
__device__ __forceinline__ void gemm_phase(PG8_LAS unsigned char* lds, const Gemm g, const Sched& S, const Epi& E, unsigned long long* stamps) {
    int tid_ = threadIdx.x; asm volatile("" : "+v"(tid_));
    const int tid = tid_, wid = __builtin_amdgcn_readfirstlane(tid >> 6), lane = tid & 63, wr = wid >> 2, wc = wid & 3, fr = lane & 15, fq = lane >> 4;
    const int K = g.K, nt = K / BK;
    int ts_lo = 0, ts_hi = 0, nts = 0; const unsigned long long rt_entry = STAMP ? (unsigned long long)wall_clock64() : 0ull;
#define PG8_STAMP() do { if (STAMP && wid == 0 && nts < 64) { const unsigned long long _c = (unsigned long long)clock64(); \
        ts_lo = (lane == nts) ? (int)(unsigned)_c : ts_lo; ts_hi = (lane == nts) ? (int)(unsigned)(_c >> 32) : ts_hi; ++nts; } } while (0)
    PG8_STAMP();
    unsigned voffA[2], voffB[2];
#pragma unroll
    for (int i = 0; i < 2; ++i) { int R, C; stage_rc(tid * 16 + i * 8192, R, C); const int Rb = Epi::PERM ? ((R & ~31) + perm32(R & 31)) : R;
        voffA[i] = (unsigned)(R * K + C) * 2u; voffB[i] = (unsigned)(Rb * K + C) * 2u; }
    const size_t kstep = (size_t)(BK * 2);
    const size_t hstep = (size_t)HALF * K * 2;
    const size_t tstep = 2 * hstep;
    const unsigned ldsw = (unsigned)wid * 1024u;
    const int aoff = lds_byte(wr * 64 + fr, fq * 8), boff = lds_byte(wc * 32 + fr, fq * 8);
#define PG8_SA(b, h) (((b) * 2 + (h)) * HTB)
#define PG8_SB(b, h) ((4 + (b) * 2 + (h)) * HTB)
#define PG8_STAGE(bufoff, gbase, voff) do { _Pragma("unroll") for (int _i = 0; _i < 2; ++_i) \
        __builtin_amdgcn_global_load_lds((const unsigned*)((const char*)(gbase) + (voff)[_i]), (PG8_LAS unsigned*)(lds + (bufoff) + ldsw + _i * 8192), 16, 0, 0); } while (0)
#define PG8_LDA(dst, b, h) do { _Pragma("unroll") for (int m = 0; m < 4; ++m) _Pragma("unroll") for (int k = 0; k < 2; ++k) dst[m][k] = *(const PG8_LAS bf16x8*)(lds + PG8_SA(b, h) + aoff + m * 2048 + k * 1024); } while (0)
#define PG8_LDB(dst, b, h) do { _Pragma("unroll") for (int n = 0; n < 2; ++n) _Pragma("unroll") for (int k = 0; k < 2; ++k) dst[n][k] = *(const PG8_LAS bf16x8*)(lds + PG8_SB(b, h) + boff + n * 2048 + k * 1024); } while (0)
#define PG8_MMA(ai, bj, At, Bt) do { __builtin_amdgcn_s_setprio(1); _Pragma("unroll") for (int m = 0; m < 4; ++m) _Pragma("unroll") for (int n = 0; n < 2; ++n) _Pragma("unroll") for (int k = 0; k < 2; ++k) \
        acc[ai][bj][m][n] = __builtin_amdgcn_mfma_f32_16x16x32_bf16(Bt[n][k], At[m][k], acc[ai][bj][m][n], 0, 0, 0); __builtin_amdgcn_s_setprio(0); } while (0)
#define PG8_WAIT_V(n) asm volatile("s_waitcnt vmcnt(" #n ")" ::: "memory")
#define PG8_WAIT_L(n) asm volatile("s_waitcnt lgkmcnt(" #n ")" ::: "memory")
#define PG8_BAR __builtin_amdgcn_s_barrier()
#define PG8_SCHED __builtin_amdgcn_sched_barrier(0)
    Unit cur, nxt; int ui = 0;
    if (!S.next(0, cur)) return;
    f32x4 acc[2][2][4][2];
#pragma unroll
    for (int a = 0; a < 2; ++a)
#pragma unroll
        for (int b = 0; b < 2; ++b)
#pragma unroll
            for (int m = 0; m < 4; ++m)
#pragma unroll
                for (int n = 0; n < 2; ++n) acc[a][b][m][n] = (f32x4){0.f, 0.f, 0.f, 0.f};
    bf16x8 At[4][2], B0[2][2], B1[2][2];
    const char* cA = (const char*)g.A + (size_t)cur.pm * tstep; const char* cB = (const char*)g.Bt + (size_t)cur.pn * tstep;
    S.a_ready(cur);
    PG8_STAGE(PG8_SB(0, 0), cB, voffB); PG8_STAGE(PG8_SA(0, 0), cA, voffA); PG8_STAGE(PG8_SB(0, 1), cB + hstep, voffB); PG8_STAGE(PG8_SA(0, 1), cA + hstep, voffA);
    if (wr == 1) PG8_BAR;
    PG8_WAIT_V(4); PG8_BAR;
    PG8_STAGE(PG8_SB(1, 0), cB + kstep, voffB); PG8_STAGE(PG8_SA(1, 0), cA + kstep, voffA); PG8_STAGE(PG8_SB(1, 1), cB + hstep + kstep, voffB);
    PG8_WAIT_V(6); PG8_BAR;
    PG8_STAMP();
    for (;;) {
        const bool has_next = S.next(ui + 1, nxt);
        const char* nA = has_next ? (const char*)g.A + (size_t)nxt.pm * tstep : cA; const char* nB = has_next ? (const char*)g.Bt + (size_t)nxt.pn * tstep : cB;
        for (int t = 0; t < nt; t += 2) {
            const bool last = (t == nt - 2);
            const char* a1 = cA + (size_t)(t + 1) * kstep;
            const char* a2 = last ? nA : cA + (size_t)(t + 2) * kstep; const char* b2 = last ? nB : cB + (size_t)(t + 2) * kstep;
            const char* a3 = a2 + kstep; const char* b3 = b2 + kstep;
            if (last && has_next) S.a_ready(nxt);
            PG8_LDB(B0, 0, 0); PG8_SCHED; PG8_LDA(At, 0, 0); PG8_STAGE(PG8_SA(1, 1), a1 + hstep, voffA);
            PG8_WAIT_L(8); PG8_BAR; PG8_WAIT_L(0); PG8_MMA(0, 0, At, B0); PG8_BAR; PG8_SCHED;
            PG8_LDB(B1, 0, 1); PG8_STAGE(PG8_SB(0, 0), b2, voffB);
            PG8_BAR; PG8_WAIT_L(0); PG8_MMA(0, 1, At, B1); PG8_BAR;
            PG8_LDA(At, 0, 1); PG8_STAGE(PG8_SA(0, 0), a2, voffA);
            PG8_BAR; PG8_WAIT_L(0); PG8_MMA(1, 0, At, B0); PG8_BAR; PG8_SCHED;
            PG8_STAGE(PG8_SB(0, 1), b2 + hstep, voffB);
            PG8_WAIT_V(6); PG8_BAR; PG8_MMA(1, 1, At, B1); PG8_BAR;
            PG8_LDB(B0, 1, 0); PG8_SCHED; PG8_LDA(At, 1, 0); PG8_STAGE(PG8_SA(0, 1), a2 + hstep, voffA);
            PG8_WAIT_L(8); PG8_BAR; PG8_WAIT_L(0); PG8_MMA(0, 0, At, B0); PG8_BAR; PG8_SCHED;
            PG8_LDB(B1, 1, 1); PG8_STAGE(PG8_SB(1, 0), b3, voffB);
            PG8_BAR; PG8_WAIT_L(0); PG8_MMA(0, 1, At, B1); PG8_BAR;
            PG8_LDA(At, 1, 1); PG8_STAGE(PG8_SA(1, 0), a3, voffA);
            PG8_BAR; PG8_WAIT_L(0); PG8_MMA(1, 0, At, B0); PG8_BAR; PG8_SCHED;
            PG8_STAGE(PG8_SB(1, 1), b3 + hstep, voffB);
            PG8_WAIT_V(6); PG8_BAR; PG8_MMA(1, 1, At, B1); PG8_BAR;
        }
        PG8_STAMP();
        if constexpr (!Epi::AFTER_DRAIN) { E(acc, cur, wr, wc, fr, fq); S.done(cur); }
        PG8_STAMP();
        if (!has_next) break;
#pragma unroll
        for (int a = 0; a < 2; ++a)
#pragma unroll
            for (int b = 0; b < 2; ++b)
#pragma unroll
                for (int m = 0; m < 4; ++m)
#pragma unroll
                    for (int n = 0; n < 2; ++n) acc[a][b][m][n] = (f32x4){0.f, 0.f, 0.f, 0.f};
        cur = nxt; cA = nA; cB = nB; ++ui;
    }
    PG8_WAIT_V(0);
    if (wr == 0) PG8_BAR;
    PG8_BAR;
    if constexpr (Epi::AFTER_DRAIN) { E.fused(acc, cur, wr, wc, fr, fq, lds, wid, lane); S.done(cur); }
    PG8_STAMP();
    if (STAMP && wid == 0) { stamps[lane] = lane < nts ? (((unsigned long long)(unsigned)ts_hi << 32) | (unsigned)ts_lo) : 0ull;
        if (lane == 62) stamps[62] = rt_entry; if (lane == 63) stamps[63] = (unsigned long long)wall_clock64(); }
#undef PG8_STAMP
#undef PG8_SA
#undef PG8_SB
#undef PG8_STAGE
#undef PG8_LDA
#undef PG8_LDB
#undef PG8_MMA
#undef PG8_WAIT_V
#undef PG8_WAIT_L
#undef PG8_BAR
#undef PG8_SCHED
}
}


#define LAS __attribute__((address_space(3)))
typedef unsigned short bf16_t;
typedef short bf16x8 __attribute__((ext_vector_type(8)));
typedef short bf16x4 __attribute__((ext_vector_type(4)));
typedef float f32x4 __attribute__((ext_vector_type(4)));
typedef float f32x16 __attribute__((ext_vector_type(16)));
typedef unsigned u32x4 __attribute__((ext_vector_type(4)));
typedef unsigned u32x2 __attribute__((ext_vector_type(2)));

constexpr int D = 1024, T = 49152, NSEQ = 10, NMODC = 6144, FF = 4096;
constexpr int T_PROMPT = 32768;
constexpr float EPS = 1e-6f;
#ifndef PH
#define PH 16383
#endif
#ifndef DUP
#define DUP 0
#endif
constexpr int NWAVES = 8, NTHREADS = 512;
constexpr int LDS_BYTES = 139264;
constexpr int WIN_N = 3328;
constexpr int PROJ_N = 3072;

constexpr size_t MiB = 1u << 20;
constexpr size_t WS_MOD = 0;
constexpr size_t WS_BARW = 491520;
constexpr size_t WS_ABAR = 512 * 1024;
constexpr size_t WS_BBT = 1 * MiB;
constexpr size_t WS_CT = 1 * MiB + 512 * 1024;
constexpr size_t WS_DTOT = 2 * MiB;
constexpr size_t WS_A1 = 3 * MiB;
constexpr size_t WS_WIN = 10 * MiB;
constexpr size_t WS_WOUT = WS_WIN + (size_t)WIN_N * D * 2;
constexpr size_t WS_W1B = WS_WOUT + (size_t)D * D * 2;
constexpr size_t WS_W2B = WS_W1B + (size_t)FF * D * 2;
constexpr size_t WS_HBUF = 35 * MiB;
constexpr size_t WS_BIG = 131 * MiB;
constexpr size_t WS_S5E = WS_BIG + 96 * MiB;
constexpr size_t WS_X = 419 * MiB;
constexpr size_t WS_WGLU = WS_X;
constexpr size_t WS_W1A = WS_X + 4 * MiB;
constexpr size_t WS_W2A = WS_X + 12 * MiB;
constexpr size_t WS_SBUF = WS_X;
constexpr size_t WS_END = 467 * MiB;
static_assert(WS_W2B + (size_t)FF * D * 2 <= WS_HBUF, "ws map");

struct P { const float* in[26]; float* out; unsigned char* ws; };

typedef __bf16 bf16n2 __attribute__((ext_vector_type(2)));
typedef float f32x2n __attribute__((ext_vector_type(2)));
__device__ __forceinline__ unsigned pk_bf16(float lo, float hi) { const f32x2n f = {lo, hi}; const bf16n2 v = __builtin_convertvector(f, bf16n2); return __builtin_bit_cast(unsigned, v); }
__device__ __forceinline__ bf16_t f2bf(float f) { return (bf16_t)(pk_bf16(f, 0.f) & 0xffffu); }
__device__ __forceinline__ float bf2f(bf16_t b) { return __uint_as_float(((unsigned)b) << 16); }
__device__ __forceinline__ float wave_sum(float v) {
#pragma unroll
    for (int o = 1; o < 64; o <<= 1) v += __shfl_xor(v, o);
    return v;
}
__device__ __forceinline__ int row_seq(int row) { return row < T_PROMPT ? (row >> 14) : 2 + ((row - T_PROMPT) >> 11); }
__device__ __forceinline__ float sigmoidf_(float x) { return 1.0f / (1.0f + __expf(-x)); }
__device__ __forceinline__ float gelu_tanh(float y) {
    const float a = 0.7978845608028654f * (y + 0.044715f * y * y * y);
    const float th = 1.0f - 2.0f / (__expf(2.0f * a) + 1.0f);
    return 0.5f * y * (1.0f + th);
}
#define CFENCE() asm volatile("" ::: "memory")
#define LDS_WAIT() asm volatile("s_waitcnt lgkmcnt(0)" ::: "memory")

struct EpiRes {
    static constexpr bool PERM = false, AFTER_DRAIN = false;
    float* x; const float* gate; int row_off;
    __device__ __forceinline__ void operator()(const pg8::f32x4 (&acc)[2][2][4][2], const pg8::Unit& u, int wr, int wc, int fr, int fq) const {
        const int row0 = row_off + u.pm * 256 + wr * 64 + fr, col0 = u.pn * 256 + wc * 32 + 4 * fq;
        const float* gp = gate + (size_t)row_seq(row_off + u.pm * 256) * NMODC;
        pg8::f32x4 gv[2][2];
#pragma unroll
        for (int bj = 0; bj < 2; ++bj)
#pragma unroll
            for (int n = 0; n < 2; ++n) gv[bj][n] = *(const pg8::f32x4*)(gp + col0 + bj * 128 + n * 16);
#pragma unroll
        for (int ai = 0; ai < 2; ++ai)
#pragma unroll
            for (int m = 0; m < 4; ++m) { float* rowp = x + (size_t)(row0 + ai * 128 + m * 16) * D + col0;
#pragma unroll
                for (int bj = 0; bj < 2; ++bj)
#pragma unroll
                    for (int n = 0; n < 2; ++n) { pg8::f32x4* q = (pg8::f32x4*)(rowp + bj * 128 + n * 16); *q = *q + gv[bj][n] * acc[ai][bj][m][n]; }
                if (m & 1) asm volatile("" ::: "memory"); }
    }
};
struct EpiGlu {
    static constexpr bool PERM = false, AFTER_DRAIN = false;
    const float* xp; const float* xs; float* out; const float* gate;
    __device__ __forceinline__ void operator()(const pg8::f32x4 (&acc)[2][2][4][2], const pg8::Unit& u, int wr, int wc, int fr, int fq) const {
        const int row0 = u.pm * 256 + wr * 64 + fr, col0 = u.pn * 128 + wc * 32 + 4 * fq;
        const float* gp = gate + (size_t)row_seq(u.pm * 256) * NMODC;
        pg8::f32x4 gv[2];
#pragma unroll
        for (int n = 0; n < 2; ++n) gv[n] = *(const pg8::f32x4*)(gp + col0 + n * 16);
#pragma unroll
        for (int ai = 0; ai < 2; ++ai)
#pragma unroll
            for (int m = 0; m < 4; ++m) { const int row = row0 + ai * 128 + m * 16;
                const float* xin = row < T_PROMPT ? xp + (size_t)row * D : xs + (size_t)(row - T_PROMPT) * D;
#pragma unroll
                for (int n = 0; n < 2; ++n) { const pg8::f32x4 val = acc[ai][0][m][n], gt = acc[ai][1][m][n]; pg8::f32x4 sg;
                    sg[0] = sigmoidf_(gt[0]); sg[1] = sigmoidf_(gt[1]); sg[2] = sigmoidf_(gt[2]); sg[3] = sigmoidf_(gt[3]);
                    const pg8::f32x4 xv = *(const pg8::f32x4*)(xin + col0 + n * 16);
                    *(pg8::f32x4*)(out + (size_t)row * D + col0 + n * 16) = xv + gv[n] * val * sg; }
                if (m & 1) asm volatile("" ::: "memory"); }
    }
};
template <int ACT> struct EpiBf {
    static constexpr bool PERM = true, AFTER_DRAIN = false;
    bf16_t* O; int ldc; float* a1;
    __device__ __forceinline__ void operator()(const pg8::f32x4 (&acc)[2][2][4][2], const pg8::Unit& u, int wr, int wc, int fr, int fq) const {
        const int row0 = u.pm * 256 + wr * 64 + fr;
        if (ACT == 0 && u.pn == 12) {
            if (wc == 0) {
#pragma unroll
                for (int ai = 0; ai < 2; ++ai)
#pragma unroll
                    for (int m = 0; m < 4; ++m) { float* rp = a1 + (size_t)(row0 + ai * 128 + m * 16) * 32 + 8 * fq;
                        *(pg8::f32x4*)rp = acc[ai][0][m][0]; *(pg8::f32x4*)(rp + 4) = acc[ai][0][m][1]; }
            }
            return;
        }
        const int col0 = u.pn * 256 + wc * 32 + 8 * fq;
#pragma unroll
        for (int ai = 0; ai < 2; ++ai)
#pragma unroll
            for (int m = 0; m < 4; ++m) { bf16_t* rowp = O + (size_t)(row0 + ai * 128 + m * 16) * ldc + col0;
#pragma unroll
                for (int bj = 0; bj < 2; ++bj) { pg8::f32x4 v0 = acc[ai][bj][m][0], v1 = acc[ai][bj][m][1];
                    if (ACT == 1) {
#pragma unroll
                        for (int e = 0; e < 4; ++e) { const float a = fmaxf(v0[e], 0.f), b = fmaxf(v1[e], 0.f); v0[e] = a * a; v1[e] = b * b; } }
                    pg8::u32x4 wv; wv.x = pk_bf16(v0[0], v0[1]); wv.y = pk_bf16(v0[2], v0[3]); wv.z = pk_bf16(v1[0], v1[1]); wv.w = pk_bf16(v1[2], v1[3]);
                    *(pg8::u32x4*)(rowp + bj * 128) = wv; } }
    }
};

__device__ __forceinline__ void transpose_item(const float* W, int K, int N, int srccol0, bf16_t* WT, int dstrow0, int k0, LAS float* scr, int lane) {
    { float tv[32];
#pragma unroll
      for (int i = 0; i < 32; ++i) tv[i] = W[(size_t)(k0 + 2 * i + (lane >> 5)) * N + srccol0 + (lane & 31)];
#pragma unroll
      for (int i = 0; i < 32; ++i) scr[(2 * i + (lane >> 5)) * 33 + (lane & 31)] = tv[i]; }
    LDS_WAIT();
    const int c = lane & 7;
#pragma unroll
    for (int j = 0; j < 4; ++j) { const int n = (lane >> 3) + 8 * j; const LAS float* s = scr + (8 * c) * 33 + n;
        u32x4 o; o.x = pk_bf16(s[0 * 33], s[1 * 33]); o.y = pk_bf16(s[2 * 33], s[3 * 33]); o.z = pk_bf16(s[4 * 33], s[5 * 33]); o.w = pk_bf16(s[6 * 33], s[7 * 33]);
        *(u32x4*)(WT + (size_t)(dstrow0 + n) * K + k0 + 8 * c) = o; }
    LDS_WAIT();
}

__device__ __forceinline__ void p0_prep(const P& p, LAS unsigned char* lds) {
    int tid_ = threadIdx.x; asm volatile("" : "+v"(tid_));
    const int tid = tid_, lane = tid & 63, w = tid >> 6;
    unsigned char* ws = p.ws;
    if ((int)blockIdx.x < 192) {
        LAS float* sc = (LAS float*)lds;
        LAS float* red = (LAS float*)(lds + 40960);
        for (int i = tid; i < NSEQ * D; i += NTHREADS) { const int s = i >> 10, d = i & 1023; const float c = s < 2 ? p.in[2][s * D + d] : p.in[3][(s - 2) * D + d]; sc[i] = c * sigmoidf_(c); }
        __syncthreads();
        for (int it = blockIdx.x; it < 192; it += gridDim.x) {
            const int l = it / 96, col0 = (it % 96) * 64, col = tid & 63, ks = w;
            float acc[NSEQ];
#pragma unroll
            for (int s = 0; s < NSEQ; ++s) acc[s] = 0.f;
            const float* wp = p.in[4] + ((size_t)l * D + ks * 128) * NMODC + col0 + col;
#pragma unroll 16
            for (int k = 0; k < 128; ++k) { const float wv = wp[(size_t)k * NMODC];
#pragma unroll
                for (int s = 0; s < NSEQ; ++s) acc[s] += sc[s * D + ks * 128 + k] * wv; }
#pragma unroll
            for (int s = 0; s < NSEQ; ++s) red[(ks * NSEQ + s) * 64 + col] = acc[s];
            __syncthreads();
            for (int i = tid; i < NSEQ * 64; i += NTHREADS) { const int s = i >> 6, cc = i & 63; float v = 0.f;
#pragma unroll
                for (int k8 = 0; k8 < 8; ++k8) v += red[(k8 * NSEQ + s) * 64 + cc];
                ((float*)(ws + WS_MOD))[((size_t)l * NSEQ + s) * NMODC + col0 + cc] = v + p.in[5][l * NMODC + col0 + cc]; }
            __syncthreads();
        }
    }
    __syncthreads();
    {
        LAS float* scr = (LAS float*)(lds + w * 16384);
        const int gw = blockIdx.x * NWAVES + w, NGW = gridDim.x * NWAVES;
        constexpr int I_GLU = 16 * 64, I_WIN = 16 * 96, I_WOUT = 16 * 32, I_W1 = 16 * 128, I_W2 = 64 * 32;
        constexpr int NITEMS = I_GLU + I_WIN + I_WOUT + 2 * I_W1 + 2 * I_W2;
        for (int it = gw; it < NITEMS; it += NGW) {
            int r = it;
            if (r < I_GLU) { const int kb = r / 64, nb = r % 64, n0 = nb * 32, pn = n0 >> 8, bj = (n0 >> 7) & 1, r0 = n0 & 127;
                transpose_item(p.in[16], D, 2 * D, bj * D + pn * 128 + r0, (bf16_t*)(ws + WS_WGLU), n0, kb * 64, scr, lane); continue; }
            r -= I_GLU;
            if (r < I_WIN) { const int kb = r / 96, nb = r % 96; transpose_item(p.in[17], D, PROJ_N, nb * 32, (bf16_t*)(ws + WS_WIN), nb * 32, kb * 64, scr, lane); continue; }
            r -= I_WIN;
            if (r < I_WOUT) { const int kb = r / 32, nb = r % 32; transpose_item(p.in[22], D, D, nb * 32, (bf16_t*)(ws + WS_WOUT), nb * 32, kb * 64, scr, lane); continue; }
            r -= I_WOUT;
            if (r < 2 * I_W1) { const int l = r / I_W1, q = r % I_W1, kb = q / 128, nb = q % 128;
                transpose_item(p.in[23] + (size_t)l * D * FF, D, FF, nb * 32, (bf16_t*)(ws + (l ? WS_W1B : WS_W1A)), nb * 32, kb * 64, scr, lane); continue; }
            r -= 2 * I_W1;
            { const int l = r / I_W2, q = r % I_W2, kb = q / 32, nb = q % 32;
                transpose_item(p.in[24] + (size_t)l * FF * D, FF, D, nb * 32, (bf16_t*)(ws + (l ? WS_W2B : WS_W2A)), nb * 32, kb * 64, scr, lane); }
        }
        bf16_t* wt = (bf16_t*)(ws + WS_WIN);
        for (int i = blockIdx.x * NTHREADS + tid; i < 256 * D; i += gridDim.x * NTHREADS) { const int r = i >> 10, k = i & 1023;
            const float v = r < 32 ? p.in[18][((size_t)(r >> 4) * D + k) * 16 + (r & 15)] : 0.f;
            wt[(size_t)(PROJ_N + r) * D + k] = f2bf(v); }
    }
    for (int i = blockIdx.x * NTHREADS + tid; i < 2 * 64 * 64; i += gridDim.x * NTHREADS) {
        const int pp = i & 63, dg = i >> 6;
        const float lr = p.in[8][i], li = p.in[9][i], dt = __expf(p.in[10][dg]);
        const float mag = __expf(lr * dt); float sn, cs; sincosf(li * dt, &sn, &cs);
        const float abr = mag * cs, abi = mag * sn, den = lr * lr + li * li;
        const float zr = ((abr - 1.0f) * lr + abi * li) / den, zi = (abi * lr - (abr - 1.0f) * li) / den;
        float* ab = (float*)(ws + WS_ABAR); ab[2 * i] = abr; ab[2 * i + 1] = abi;
        bf16_t* bbt = (bf16_t*)(ws + WS_BBT); bf16_t* ct = (bf16_t*)(ws + WS_CT);
#pragma unroll
        for (int h = 0; h < 16; ++h) {
            const float br = p.in[11][(size_t)i * 16 + h], bi = p.in[12][(size_t)i * 16 + h];
            bbt[((size_t)dg * 128 + pp) * 16 + h] = f2bf(zr * br - zi * bi);
            bbt[((size_t)dg * 128 + 64 + pp) * 16 + h] = f2bf(zr * bi + zi * br);
            ct[((size_t)dg * 16 + h) * 128 + pp] = f2bf(p.in[13][((size_t)dg * 16 + h) * 64 + pp]);
            ct[((size_t)dg * 16 + h) * 128 + 64 + pp] = f2bf(-p.in[14][((size_t)dg * 16 + h) * 64 + pp]);
        }
    }
}

template <int SRC, bool FINAL>
__device__ __forceinline__ void norm_phase(const P& p, const float* gvec, const float* shift, const float* scale) {
    int tid_ = threadIdx.x; asm volatile("" : "+v"(tid_));
    const int tid = tid_, lane = tid & 63, w = tid >> 6;
    const int gw = blockIdx.x * NWAVES + w, NGW = gridDim.x * NWAVES;
    bf16_t* hb = (bf16_t*)(p.ws + WS_HBUF);
    f32x4 gq[4];
#pragma unroll
    for (int j = 0; j < 4; ++j) gq[j] = *(const f32x4*)(gvec + 4 * lane + 256 * j);
    f32x4 vn[4];
    { const int row = gw; const float* xr = SRC == 0 ? (row < T_PROMPT ? p.in[0] + (size_t)row * D : p.in[1] + (size_t)(row - T_PROMPT) * D) : p.out + (size_t)row * D;
#pragma unroll
      for (int j = 0; j < 4; ++j) vn[j] = *(const f32x4*)(xr + 4 * lane + 256 * j); }
    for (int row = gw; row < T; row += NGW) {
        f32x4 v[4]; float ss = 0.f;
#pragma unroll
        for (int j = 0; j < 4; ++j) { v[j] = vn[j]; ss += (v[j][0] * v[j][0] + v[j][1] * v[j][1]) + (v[j][2] * v[j][2] + v[j][3] * v[j][3]); }
        { const int rn = row + NGW < T ? row + NGW : row;
          const float* xr = SRC == 0 ? (rn < T_PROMPT ? p.in[0] + (size_t)rn * D : p.in[1] + (size_t)(rn - T_PROMPT) * D) : p.out + (size_t)rn * D;
#pragma unroll
          for (int j = 0; j < 4; ++j) vn[j] = *(const f32x4*)(xr + 4 * lane + 256 * j); }
        const float rstd = rsqrtf(wave_sum(ss) * (1.0f / D) + EPS);
        if (FINAL) {
#pragma unroll
            for (int j = 0; j < 4; ++j) *(f32x4*)(p.out + (size_t)row * D + 4 * lane + 256 * j) = v[j] * rstd * gq[j];
        } else {
            const int s = row_seq(row);
#pragma unroll
            for (int j = 0; j < 4; ++j) { const f32x4 sh = *(const f32x4*)(shift + (size_t)s * NMODC + 4 * lane + 256 * j), sc = *(const f32x4*)(scale + (size_t)s * NMODC + 4 * lane + 256 * j);
                const f32x4 o = (v[j] * rstd * gq[j]) * (sc + 1.0f) + sh;
                u32x2 wv; wv.x = pk_bf16(o[0], o[1]); wv.y = pk_bf16(o[2], o[3]);
                *(u32x2*)(hb + (size_t)row * D + 4 * lane + 256 * j) = wv; }
        }
    }
}

constexpr int S5_NCH = 384, S5_HROW = 272, S5_UROW = 48, S5_UOFF = 32 * S5_HROW, S5_WAVE_LDS = S5_UOFF + 128 * S5_UROW;
__device__ __forceinline__ void half_bcast(float x, float& lo, float& hi) { const auto r = __builtin_amdgcn_permlane32_swap(__float_as_uint(x), __float_as_uint(x), false, false); lo = __uint_as_float(r[0]); hi = __uint_as_float(r[1]); }
#define CMAD(sr, si, mr, mi, br, bi) do { const float nr_ = (sr) * (mr) - (si) * (mi) + (br); const float ni_ = (sr) * (mi) + (si) * (mr) + (bi); (sr) = nr_; (si) = ni_; } while (0)
template <bool PC>
__device__ __forceinline__ void s5_pass(const P& p, LAS unsigned char* lds) {
    int tid_ = threadIdx.x; asm volatile("" : "+v"(tid_));
    const int tid = tid_, lane = tid & 63, w = __builtin_amdgcn_readfirstlane(tid >> 6);
    const int b = blockIdx.x, g = (b & 7) * 8 + w;
    const int hh = lane >> 5, l32 = lane & 31, l16 = lane & 15, q16 = lane >> 4;
    LAS unsigned char* const H = lds + w * S5_WAVE_LDS;
    LAS unsigned char* const hwr = H + (4 * hh) * S5_HROW + l32 * 4;
    const LAS unsigned char* const hrd = H + l16 * S5_HROW + q16 * 16;
    const bf16_t* hb = (const bf16_t*)(p.ws + WS_HBUF);
    bf16_t* gout = (bf16_t*)(p.ws + WS_BIG);
    float* E = (float*)(p.ws + WS_S5E);
    const bf16_t* bbt = (const bf16_t*)(p.ws + WS_BBT); const bf16_t* ct = (const bf16_t*)(p.ws + WS_CT); const float* ab = (const float*)(p.ws + WS_ABAR);
    const float dsk = p.in[15][g * 16 + l16];
    const int cstride = (int)(gridDim.x >> 3);
    const bf16_t* const ub = hb + (size_t)l32 * D + g * 16 + 8 * hh;
    bf16x8 afn[4]; f32x2n enr[2], eni[2];
    { const int c0 = b >> 3;
      if (c0 < S5_NCH) {
#pragma unroll
        for (int sb = 0; sb < 4; ++sb) afn[sb] = *(const bf16x8*)(ub + (size_t)(c0 * 128 + sb * 32) * D);
        if (PC) {
#pragma unroll
            for (int dir = 0; dir < 2; ++dir) { const size_t eo = (((size_t)dir * S5_NCH + c0) * 64 + g) * 128; enr[dir] = *(const f32x2n*)(E + eo + 2 * l32); eni[dir] = *(const f32x2n*)(E + eo + 64 + 2 * l32); } } } }
    for (int c = b >> 3; c < S5_NCH; c += cstride) {
        const int tok0 = c * 128;
        f32x2n ecr[2], eci[2];
#pragma unroll
        for (int sb = 0; sb < 4; ++sb) *(LAS bf16x8*)(H + S5_UOFF + (sb * 32 + l32) * S5_UROW + 16 * hh) = afn[sb];
#pragma unroll
        for (int dir = 0; dir < 2; ++dir) { ecr[dir] = enr[dir]; eci[dir] = eni[dir]; }
        CFENCE(); LDS_WAIT(); CFENCE();
        { int cn = c + cstride; asm volatile("" : "+s"(cn));
          if (cn < S5_NCH) {
#pragma unroll
            for (int sb = 0; sb < 4; ++sb) afn[sb] = *(const bf16x8*)(ub + (size_t)(cn * 128 + sb * 32) * D);
            if (PC) {
#pragma unroll
                for (int dir = 0; dir < 2; ++dir) { const size_t eo = (((size_t)dir * S5_NCH + cn) * 64 + g) * 128; enr[dir] = *(const f32x2n*)(E + eo + 2 * l32); eni[dir] = *(const f32x2n*)(E + eo + 64 + 2 * l32); } } } }
        f32x4 yacc[8];
#pragma unroll
        for (int j = 0; j < 8; ++j) yacc[j] = (f32x4){0.f, 0.f, 0.f, 0.f};
#pragma unroll
        for (int dir = 0; dir < 2; ++dir) {
            const size_t eoff = (((size_t)dir * S5_NCH + c) * 64 + g) * 128;
            const int dg = dir * 64 + g;
            bf16x8 Bf[4], Cf[4];
#pragma unroll
            for (int nb = 0; nb < 4; ++nb) Bf[nb] = *(const bf16x8*)(bbt + ((size_t)dg * 128 + (nb >> 1) * 64 + 2 * l32 + (nb & 1)) * 16 + 8 * hh);
#pragma unroll
            for (int ks = 0; ks < 4; ++ks) Cf[ks] = PC ? *(const bf16x8*)(ct + ((size_t)dg * 16 + l16) * 128 + 32 * ks + 8 * q16) : (bf16x8){0, 0, 0, 0, 0, 0, 0, 0};
            const f32x4 a1v = *(const f32x4*)(ab + ((size_t)dg * 64 + 2 * l32) * 2);
            const float a1Ar = a1v[0], a1Ai = a1v[1], a1Br = a1v[2], a1Bi = a1v[3];
            const float a2Ar = a1Ar * a1Ar - a1Ai * a1Ai, a2Ai = 2.f * a1Ar * a1Ai, a2Br = a1Br * a1Br - a1Bi * a1Bi, a2Bi = 2.f * a1Br * a1Bi;
            const float a3Ar = a2Ar * a1Ar - a2Ai * a1Ai, a3Ai = a2Ar * a1Ai + a2Ai * a1Ar, a3Br = a2Br * a1Br - a2Bi * a1Bi, a3Bi = a2Br * a1Bi + a2Bi * a1Br;
            const float a4Ar = a2Ar * a2Ar - a2Ai * a2Ai, a4Ai = 2.f * a2Ar * a2Ai, a4Br = a2Br * a2Br - a2Bi * a2Bi, a4Bi = 2.f * a2Br * a2Bi;
            const float a5Ar = a4Ar * a1Ar - a4Ai * a1Ai, a5Ai = a4Ar * a1Ai + a4Ai * a1Ar, a5Br = a4Br * a1Br - a4Bi * a1Bi, a5Bi = a4Br * a1Bi + a4Bi * a1Br;
            float hAr = 0.f, hAi = 0.f, hBr = 0.f, hBi = 0.f;
            if (PC) { hAr = ecr[dir][0]; hBr = ecr[dir][1]; hAi = eci[dir][0]; hBi = eci[dir][1]; }
            const bool lead = (hh == dir);
#pragma unroll
            for (int sbi = 0; sbi < 4; ++sbi) {
                const int sb = dir == 0 ? sbi : 3 - sbi;
                if (PC) __builtin_amdgcn_sched_barrier(0);
                const bf16x8 a = *(const LAS bf16x8*)(H + S5_UOFF + (sb * 32 + l32) * S5_UROW + 16 * hh);
                f32x16 acc[4];
#pragma unroll
                for (int nb = 0; nb < 4; ++nb) {
#pragma unroll
                    for (int i = 0; i < 16; ++i) acc[nb][i] = 0.f;
                    acc[nb] = __builtin_amdgcn_mfma_f32_32x32x16_bf16(a, Bf[nb], acc[nb], 0, 0, 0);
                }
                if (!PC) {
#pragma unroll
                    for (int gi = 0; gi < 4; ++gi)
#pragma unroll
                        for (int ri = 0; ri < 4; ++ri) { const int i = 4 * (dir == 0 ? gi : 3 - gi) + (dir == 0 ? ri : 3 - ri);
                            if (sbi == 0 && gi == 0 && ri == 0) { hAr = acc[0][i]; hAi = acc[2][i]; hBr = acc[1][i]; hBi = acc[3][i]; }
                            else if (ri == 0) { CMAD(hAr, hAi, a5Ar, a5Ai, acc[0][i], acc[2][i]); CMAD(hBr, hBi, a5Br, a5Bi, acc[1][i], acc[3][i]); }
                            else { CMAD(hAr, hAi, a1Ar, a1Ai, acc[0][i], acc[2][i]); CMAD(hBr, hBi, a1Br, a1Bi, acc[1][i], acc[3][i]); } }
                } else {
#pragma unroll
                    for (int gi = 0; gi < 4; ++gi) { const int gg = dir == 0 ? gi : 3 - gi;
                        float xAr = lead ? hAr : 0.f, xAi = lead ? hAi : 0.f, xBr = lead ? hBr : 0.f, xBi = lead ? hBi : 0.f;
#pragma unroll
                        for (int k = 0; k < 4; ++k) { const int i = 4 * gg + (dir == 0 ? k : 3 - k);
                            CMAD(xAr, xAi, a1Ar, a1Ai, acc[0][i], acc[2][i]); acc[0][i] = xAr; acc[2][i] = xAi;
                            CMAD(xBr, xBi, a1Br, a1Bi, acc[1][i], acc[3][i]); acc[1][i] = xBr; acc[3][i] = xBi; }
                        float eAr, eAi, eBr, eBi, dmy;
                        if (dir == 0) { half_bcast(xAr, eAr, dmy); half_bcast(xAi, eAi, dmy); half_bcast(xBr, eBr, dmy); half_bcast(xBi, eBi, dmy); }
                        else { half_bcast(xAr, dmy, eAr); half_bcast(xAi, dmy, eAi); half_bcast(xBr, dmy, eBr); half_bcast(xBi, dmy, eBi); }
                        if (lead) { eAr = 0.f; eAi = 0.f; eBr = 0.f; eBi = 0.f; }
                        { const int i0 = 4 * gg + (dir == 0 ? 0 : 3), i1 = 4 * gg + (dir == 0 ? 1 : 2), i2 = 4 * gg + (dir == 0 ? 2 : 1), i3 = 4 * gg + (dir == 0 ? 3 : 0);
                          acc[0][i0] += a1Ar * eAr - a1Ai * eAi; acc[2][i0] += a1Ar * eAi + a1Ai * eAr; acc[1][i0] += a1Br * eBr - a1Bi * eBi; acc[3][i0] += a1Br * eBi + a1Bi * eBr;
                          acc[0][i1] += a2Ar * eAr - a2Ai * eAi; acc[2][i1] += a2Ar * eAi + a2Ai * eAr; acc[1][i1] += a2Br * eBr - a2Bi * eBi; acc[3][i1] += a2Br * eBi + a2Bi * eBr;
                          acc[0][i2] += a3Ar * eAr - a3Ai * eAi; acc[2][i2] += a3Ar * eAi + a3Ai * eAr; acc[1][i2] += a3Br * eBr - a3Bi * eBi; acc[3][i2] += a3Br * eBi + a3Bi * eBr;
                          acc[0][i3] += a4Ar * eAr - a4Ai * eAi; acc[2][i3] += a4Ar * eAi + a4Ai * eAr; acc[1][i3] += a4Br * eBr - a4Bi * eBi; acc[3][i3] += a4Br * eBi + a4Bi * eBr;
                          const float tAr = acc[0][i3], tAi = acc[2][i3], tBr = acc[1][i3], tBi = acc[3][i3];
                          float dm2;
                          if (dir == 0) { half_bcast(tAr, dm2, hAr); half_bcast(tAi, dm2, hAi); half_bcast(tBr, dm2, hBr); half_bcast(tBi, dm2, hBi); }
                          else { half_bcast(tAr, hAr, dm2); half_bcast(tAi, hAi, dm2); half_bcast(tBr, hBr, dm2); half_bcast(tBi, hBi, dm2); } }
                    }
#pragma unroll
                    for (int i = 0; i < 16; ++i) { const int ro = (8 * (i >> 2) + (i & 3)) * S5_HROW;
                        *(LAS unsigned*)(hwr + ro) = pk_bf16(acc[0][i], acc[1][i]); *(LAS unsigned*)(hwr + ro + 128) = pk_bf16(acc[2][i], acc[3][i]); }
                    CFENCE(); LDS_WAIT(); CFENCE();
#pragma unroll
                    for (int mb = 0; mb < 2; ++mb)
#pragma unroll
                        for (int ks = 0; ks < 4; ++ks) { const bf16x8 af = *(const LAS bf16x8*)(hrd + mb * 16 * S5_HROW + 64 * ks);
                            yacc[sb * 2 + mb] = __builtin_amdgcn_mfma_f32_16x16x32_bf16(af, Cf[ks], yacc[sb * 2 + mb], 0, 0, 0); }
                    CFENCE(); LDS_WAIT(); CFENCE();
                }
            }
            if (!PC) {
                float s0Ar, s0Ai, s0Br, s0Bi, s1Ar, s1Ai, s1Br, s1Bi;
                half_bcast(hAr, s0Ar, s1Ar); half_bcast(hAi, s0Ai, s1Ai); half_bcast(hBr, s0Br, s1Br); half_bcast(hBi, s0Bi, s1Bi);
                float eAr, eAi, eBr, eBi;
                if (dir == 0) { eAr = a4Ar * s0Ar - a4Ai * s0Ai + s1Ar; eAi = a4Ar * s0Ai + a4Ai * s0Ar + s1Ai; eBr = a4Br * s0Br - a4Bi * s0Bi + s1Br; eBi = a4Br * s0Bi + a4Bi * s0Br + s1Bi; }
                else { eAr = a4Ar * s1Ar - a4Ai * s1Ai + s0Ar; eAi = a4Ar * s1Ai + a4Ai * s1Ar + s0Ai; eBr = a4Br * s1Br - a4Bi * s1Bi + s0Br; eBi = a4Br * s1Bi + a4Bi * s1Br + s0Bi; }
                if (hh == 0) { *(f32x2n*)(E + eoff + 2 * l32) = (f32x2n){eAr, eBr}; *(f32x2n*)(E + eoff + 64 + 2 * l32) = (f32x2n){eAi, eBi}; }
            }
        }
        CFENCE(); LDS_WAIT(); CFENCE();
        if (PC) {
#pragma unroll
            for (int j = 0; j < 8; ++j)
#pragma unroll
                for (int i = 0; i < 4; ++i) { LAS bf16_t* up = (LAS bf16_t*)(H + S5_UOFF + (4 * q16) * S5_UROW + l16 * 2 + (j * 16 + i) * S5_UROW);
                    const float y = yacc[j][i] + dsk * bf2f(*up); *up = f2bf(gelu_tanh(y)); }
            CFENCE(); LDS_WAIT(); CFENCE();
#pragma unroll
            for (int k = 0; k < 4; ++k) { const int idx = lane + 64 * k, tk = idx >> 1, hf = idx & 1;
                const u32x4 v = *(const LAS u32x4*)(H + S5_UOFF + tk * S5_UROW + hf * 16);
                *(u32x4*)(gout + (size_t)(tok0 + tk) * D + g * 16 + hf * 8) = v; }
            CFENCE(); LDS_WAIT(); CFENCE();
        }
    }
}
__device__ __forceinline__ void s5_carry(const P& p) {
    int tid_ = threadIdx.x; asm volatile("" : "+v"(tid_));
    const int idx = blockIdx.x * NTHREADS + tid_;
    if (idx >= 2 * NSEQ * 64 * 64) return;
    const int pp = idx & 63, g = (idx >> 6) & 63, s = (idx >> 12) % NSEQ, dir = idx / (NSEQ * 4096);
    const float* ab = (const float*)(p.ws + WS_ABAR);
    float Ar = ab[((dir * 64 + g) * 64 + pp) * 2], Ai = ab[((dir * 64 + g) * 64 + pp) * 2 + 1];
#pragma unroll
    for (int k = 0; k < 7; ++k) { const float nr = Ar * Ar - Ai * Ai, ni = 2.0f * Ar * Ai; Ar = nr; Ai = ni; }
    const int c0 = s < 2 ? s * 128 : 256 + (s - 2) * 16, n = s < 2 ? 128 : 16;
    float* E = (float*)(p.ws + WS_S5E);
    float rr = 0.f, ri = 0.f;
    for (int i0 = 0; i0 < n; i0 += 16) {
        float er[16], ei[16];
#pragma unroll
        for (int k = 0; k < 16; ++k) { const int i = i0 + k, c = dir == 0 ? c0 + i : c0 + n - 1 - i; const size_t ad = (((size_t)dir * S5_NCH + c) * 64 + g) * 128 + pp; er[k] = E[ad]; ei[k] = E[ad + 64]; }
#pragma unroll
        for (int k = 0; k < 16; ++k) { const int i = i0 + k, c = dir == 0 ? c0 + i : c0 + n - 1 - i; const size_t ad = (((size_t)dir * S5_NCH + c) * 64 + g) * 128 + pp;
            E[ad] = rr; E[ad + 64] = ri; const float nr = Ar * rr - Ai * ri + er[k], ni = Ar * ri + Ai * rr + ei[k]; rr = nr; ri = ni; }
    }
}

constexpr int GQ = 0, GK = 17408, GKT = 34816, GVT = 53248, GSC = 90112, GA1 = 99328, GSUM = 103424, GEL = 105472, GRMS = 105984, GRSTD = 108032, GW2 = 108288;
constexpr int QST = 272, TST = 144, VST = 576;
__device__ __forceinline__ void gla_item_coords(int j, int& hd, int& tokbase) {
    hd = j & 3; const int q = j >> 2;
    if (q < 32) tokbase = (q >> 4) * 16384 + (q & 15) * 1024; else tokbase = T_PROMPT + ((q - 32) >> 1) * 2048 + ((q - 32) & 1) * 1024;
}
template <int MODE>
__device__ __forceinline__ void gla_phase(const P& p, LAS unsigned char* lds) {
    int tid_ = threadIdx.x; asm volatile("" : "+v"(tid_));
    const int tid = tid_, lane = tid & 63, w = __builtin_amdgcn_readfirstlane(tid >> 6), hh = lane >> 5, l32 = lane & 31;
    const int chan = tid & 127, tg = w >> 1;
    const bf16_t* proj = (const bf16_t*)(p.ws + WS_BIG);
    const float* a1b = (const float*)(p.ws + WS_A1);
    bf16_t* hb = (bf16_t*)(p.ws + WS_HBUF);
    float* sbuf = (float*)(p.ws + WS_SBUF); float* dtot = (float*)(p.ws + WS_DTOT);
    LAS unsigned char* const qfrag = lds + GQ + l32 * QST + 16 * hh;
    LAS unsigned char* const kfrag = lds + GK + l32 * QST + 16 * hh;
    LAS unsigned char* const qperm = lds + GQ + l32 * QST + 8 * hh;
    LAS unsigned char* const ktfrag = lds + GKT + l32 * TST + 16 * hh;
    LAS unsigned char* const vtr = lds + GVT + (8 * hh + ((lane & 15) >> 2)) * VST + (32 * w + 16 * ((lane >> 4) & 1) + 4 * (lane & 3)) * 2;
    LAS unsigned char* const scfrag = lds + GSC + l32 * TST + 16 * hh;
    LAS unsigned char* const otw = lds + GVT + (4 * hh) * VST + (32 * w + l32) * 2;
    LAS unsigned char* const scst = lds + GSC + (4 * hh) * TST + l32 * 2;
    LAS unsigned char* const elrd = lds + GEL + 16 * hh;
    LAS unsigned char* const rmsw = lds + GRMS + (4 * hh) * 32 + w * 4;
    LAS unsigned char* const rstdr = lds + GRSTD + (4 * hh) * 4;
    LAS unsigned char* const qprep = lds + GQ + (16 * tg) * QST + chan * 2;
    LAS unsigned char* const kprep = lds + GK + (16 * tg) * QST + chan * 2;
    LAS unsigned char* const a1rd = lds + GA1 + (16 * tg) * 64;
    const LAS float* const w2p = (const LAS float*)(lds + GW2) + chan;
    const int nitems = MODE == 0 ? 384 : 192;
    for (int it = blockIdx.x; it < nitems; it += gridDim.x) {
        const int dir = MODE == 0 ? it / 192 : (MODE == 1 ? 0 : 1);
        const int j = MODE == 0 ? it % 192 : it, full = dir * 192 + j;
        int hd, tokbase; gla_item_coords(j, hd, tokbase);
        __syncthreads();
        for (int i = tid; i < 16 * 128; i += NTHREADS) ((LAS float*)(lds + GW2))[i] = p.in[19][(size_t)(dir * 16 + (i >> 7)) * 512 + hd * 128 + (i & 127)];
        const float bias = p.in[20][dir * 512 + hd * 128 + chan];
        f32x16 S[4];
        float* const sb0 = sbuf + (size_t)full * 32768 + 32 * w; const int svo = (4 * hh) * 256 + l32;
#pragma unroll
        for (int cb = 0; cb < 4; ++cb)
#pragma unroll
            for (int i = 0; i < 16; ++i) S[cb][i] = MODE == 0 ? 0.f : (sb0 + (32 * cb + 8 * (i >> 2) + (i & 3)) * 256)[svo];
        float dsum = 0.f;
        u32x4 pq[2], pk[2], pv[4]; f32x4 pa = (f32x4){0.f, 0.f, 0.f, 0.f};
        const int qko = (tid >> 4) * PROJ_N + hd * 128 + (tid & 15) * 8;
        const int vo = (tid >> 5) * PROJ_N + 1024 + hd * 256 + (tid & 31) * 8;
        const int ao = (tid >> 2) * 32 + dir * 16 + (tid & 3) * 4;
#define GLA_LOAD(tbx) do { const bf16_t* pb_ = proj + (size_t)(tbx) * PROJ_N; \
            _Pragma("unroll") for (int i = 0; i < 2; ++i) { if (MODE != 0) pq[i] = *(const u32x4*)(pb_ + (size_t)i * 32 * PROJ_N + qko); pk[i] = *(const u32x4*)(pb_ + (size_t)i * 32 * PROJ_N + 512 + qko); } \
            _Pragma("unroll") for (int i = 0; i < 4; ++i) pv[i] = *(const u32x4*)(pb_ + (size_t)i * 16 * PROJ_N + vo); \
            if (tid < 256) pa = *(const f32x4*)(a1b + (size_t)(tbx) * 32 + ao); } while (0)
        { int tb0 = tokbase + (dir == 0 ? 0 : 15) * 64; GLA_LOAD(tb0); }
        for (int ci = 0; ci < 16; ++ci) {
            int tb = tokbase + (dir == 0 ? ci : 15 - ci) * 64; asm volatile("" : "+s"(tb));
            int tbn = tokbase + (dir == 0 ? ci + 1 : 14 - ci) * 64; asm volatile("" : "+s"(tbn));
            { LAS unsigned char* const qs = lds + GQ + (tid >> 4) * QST + (tid & 15) * 16;
#pragma unroll
              for (int i = 0; i < 2; ++i) { if (MODE != 0) *(LAS u32x4*)(qs + i * 32 * QST) = pq[i]; *(LAS u32x4*)(qs + (GK - GQ) + i * 32 * QST) = pk[i]; } }
            { LAS unsigned char* const vs = lds + GVT + (tid >> 5) * VST + (tid & 31) * 16;
#pragma unroll
              for (int i = 0; i < 4; ++i) *(LAS u32x4*)(vs + i * 16 * VST) = pv[i]; }
            if (tid < 256) *(LAS f32x4*)(lds + GA1 + (tid >> 2) * 64 + (tid & 3) * 16) = pa;
            __syncthreads();
            if (ci + 1 < 16) GLA_LOAD(tbn);
            float zc[16];
#pragma unroll
            for (int i = 0; i < 16; ++i) { const LAS f32x4* ap = (const LAS f32x4*)(a1rd + i * 64);
                float z = bias;
#pragma unroll
                for (int r4 = 0; r4 < 4; ++r4) { const f32x4 av = ap[r4]; z += av[0] * w2p[(4 * r4) * 128] + av[1] * w2p[(4 * r4 + 1) * 128] + av[2] * w2p[(4 * r4 + 2) * 128] + av[3] * w2p[(4 * r4 + 3) * 128]; }
                zc[i] = (fminf(z, 0.f) - __logf(1.0f + __expf(-fabsf(z)))) * (1.0f / 16.0f); }
            if (dir == 0) {
#pragma unroll
                for (int i = 1; i < 16; ++i) zc[i] += zc[i - 1];
            } else {
#pragma unroll
                for (int i = 14; i >= 0; --i) zc[i] += zc[i + 1];
            }
            ((LAS float*)(lds + GSUM))[tg * 128 + chan] = dir == 0 ? zc[15] : zc[0];
            __syncthreads();
            float blast, off;
            { const LAS float* gs = (const LAS float*)(lds + GSUM) + chan; const float g0 = gs[0], g1 = gs[128], g2 = gs[256], g3 = gs[384];
                blast = (g0 + g1) + (g2 + g3);
                if (dir == 0) off = (tg > 0 ? g0 : 0.f) + (tg > 1 ? g1 : 0.f) + (tg > 2 ? g2 : 0.f);
                else off = (tg < 3 ? g3 : 0.f) + (tg < 2 ? g2 : 0.f) + (tg < 1 ? g1 : 0.f); }
            {
                float kt[16];
#pragma unroll
                for (int i = 0; i < 16; ++i) { const float bc = zc[i] + off;
                    LAS bf16_t* qp = (LAS bf16_t*)(qprep + i * QST); LAS bf16_t* kp = (LAS bf16_t*)(kprep + i * QST);
                    const float kv = bf2f(*kp);
                    if (MODE != 0) { const float qv = bf2f(*qp); *qp = f2bf(qv * __expf(bc) * 0.08838834764831845f); *kp = f2bf(kv * __expf(-bc)); }
                    kt[i] = kv * __expf(blast - bc); }
                u32x4 k0, k1; k0.x = pk_bf16(kt[0], kt[1]); k0.y = pk_bf16(kt[2], kt[3]); k0.z = pk_bf16(kt[4], kt[5]); k0.w = pk_bf16(kt[6], kt[7]);
                k1.x = pk_bf16(kt[8], kt[9]); k1.y = pk_bf16(kt[10], kt[11]); k1.z = pk_bf16(kt[12], kt[13]); k1.w = pk_bf16(kt[14], kt[15]);
                *(LAS u32x4*)(lds + GKT + chan * TST + tg * 32) = k0; *(LAS u32x4*)(lds + GKT + chan * TST + tg * 32 + 16) = k1;
            }
            if (tg == 0) { ((LAS float*)(lds + GEL))[chan] = __expf(blast); dsum += blast; }
            __syncthreads();
            if (MODE != 0) {
                if (w < 4) { const int mb = w >> 1, nb = w & 1; f32x16 sc;
#pragma unroll
                    for (int i = 0; i < 16; ++i) sc[i] = 0.f;
#pragma unroll
                    for (int ks = 0; ks < 8; ++ks) { const bf16x8 a = *(const LAS bf16x8*)(qfrag + mb * 32 * QST + 32 * ks), bq = *(const LAS bf16x8*)(kfrag + nb * 32 * QST + 32 * ks);
                        sc = __builtin_amdgcn_mfma_f32_32x32x16_bf16(a, bq, sc, 0, 0, 0); }
                    const int dlt = (nb - mb) * 32 + l32 - 4 * hh;
                    LAS unsigned char* const sw = scst + mb * 32 * TST + nb * 64;
#pragma unroll
                    for (int i = 0; i < 16; ++i) { const int cst = 8 * (i >> 2) + (i & 3); const bool keep = dir == 0 ? (dlt <= cst) : (dlt >= cst);
                        *(LAS bf16_t*)(sw + cst * TST) = f2bf(keep ? sc[i] : 0.f); }
                }
                __syncthreads();
            }
            bf16x8 vf[4];
#pragma unroll
            for (int ks = 0; ks < 4; ++ks) { union { struct { bf16x4 lo, hi; } s; bf16x8 v; } vv;
                vv.s.lo = __builtin_amdgcn_ds_read_tr16_b64_v4i16((LAS bf16x4*)(vtr + (16 * ks) * VST));
                vv.s.hi = __builtin_amdgcn_ds_read_tr16_b64_v4i16((LAS bf16x4*)(vtr + (16 * ks + 4) * VST));
                vf[ks] = vv.v; }
            if (MODE != 0) {
                __syncthreads();
#pragma unroll
                for (int mb = 0; mb < 2; ++mb) {
                    f32x16 o;
#pragma unroll
                    for (int i = 0; i < 16; ++i) o[i] = 0.f;
#pragma unroll
                    for (int ks = 0; ks < 4; ++ks) { const bf16x8 a = *(const LAS bf16x8*)(scfrag + mb * 32 * TST + 32 * ks);
                        o = __builtin_amdgcn_mfma_f32_32x32x16_bf16(a, vf[ks], o, 0, 0, 0); }
#pragma unroll
                    for (int cb = 0; cb < 4; ++cb)
#pragma unroll
                        for (int h2 = 0; h2 < 2; ++h2) {
                            union { u32x4 u; bf16x8 v; } sb_;
                            sb_.u.x = pk_bf16(S[cb][8 * h2 + 0], S[cb][8 * h2 + 1]); sb_.u.y = pk_bf16(S[cb][8 * h2 + 2], S[cb][8 * h2 + 3]);
                            sb_.u.z = pk_bf16(S[cb][8 * h2 + 4], S[cb][8 * h2 + 5]); sb_.u.w = pk_bf16(S[cb][8 * h2 + 6], S[cb][8 * h2 + 7]);
                            const LAS unsigned char* base = qperm + mb * 32 * QST + (32 * cb + 16 * h2) * 2;
                            union { struct { u32x2 lo, hi; } s; bf16x8 v; } qa; qa.s.lo = *(const LAS u32x2*)base; qa.s.hi = *(const LAS u32x2*)(base + 16);
                            o = __builtin_amdgcn_mfma_f32_32x32x16_bf16(qa.v, sb_.v, o, 0, 0, 0);
                        }
#pragma unroll
                    for (int i = 0; i < 16; ++i) *(LAS bf16_t*)(otw + (32 * mb + 8 * (i >> 2) + (i & 3)) * VST) = f2bf(o[i]);
                    CFENCE();
                }
            }
            u32x4 of[4], rr[4];
            if (MODE == 2) {
                const bf16_t* const og2 = hb + (size_t)(tb + (tid >> 5)) * D + hd * 256 + (tid & 31) * 8;
                const bf16_t* const rg = proj + (size_t)(tb + (tid >> 5)) * PROJ_N + 2048 + hd * 256 + (tid & 31) * 8;
#pragma unroll
                for (int i = 0; i < 4; ++i) { of[i] = *(const u32x4*)(og2 + (size_t)(16 * i) * D); rr[i] = *(const u32x4*)(rg + (size_t)(16 * i) * PROJ_N); }
            }
#pragma unroll
            for (int cb = 0; cb < 4; ++cb) {
#pragma unroll
                for (int i4 = 0; i4 < 4; ++i4) { const f32x4 e = *(const LAS f32x4*)(elrd + (32 * cb + 8 * i4) * 4);
                    S[cb][4 * i4 + 0] *= e[0]; S[cb][4 * i4 + 1] *= e[1]; S[cb][4 * i4 + 2] *= e[2]; S[cb][4 * i4 + 3] *= e[3]; }
#pragma unroll
                for (int ks = 0; ks < 4; ++ks) { const bf16x8 a = *(const LAS bf16x8*)(ktfrag + cb * 32 * TST + 32 * ks);
                    S[cb] = __builtin_amdgcn_mfma_f32_32x32x16_bf16(a, vf[ks], S[cb], 0, 0, 0); }
            }
            __syncthreads();
            if (MODE != 0) {
                u32x4 ob[4];
#pragma unroll
                for (int i = 0; i < 4; ++i) ob[i] = *(const LAS u32x4*)(lds + GVT + ((tid >> 5) + 16 * i) * VST + (tid & 31) * 16);
                bf16_t* const og = hb + (size_t)(tb + (tid >> 5)) * D + hd * 256 + (tid & 31) * 8;
                if (MODE == 1) {
#pragma unroll
                    for (int i = 0; i < 4; ++i) *(u32x4*)(og + (size_t)(16 * i) * D) = ob[i];
                } else {
                    const f32x4 ng0 = *(const f32x4*)(p.in[21] + hd * 256 + (tid & 31) * 8), ng1 = *(const f32x4*)(p.in[21] + hd * 256 + (tid & 31) * 8 + 4);
#pragma unroll
                    for (int i = 0; i < 4; ++i) {
                        float ov[8]; float sq = 0.f;
#pragma unroll
                        for (int e = 0; e < 4; ++e) { ov[2 * e] = __uint_as_float(ob[i][e] << 16) + __uint_as_float(of[i][e] << 16); ov[2 * e + 1] = __uint_as_float(ob[i][e] & 0xffff0000u) + __uint_as_float(of[i][e] & 0xffff0000u);
                            sq += ov[2 * e] * ov[2 * e] + ov[2 * e + 1] * ov[2 * e + 1]; }
#pragma unroll
                        for (int sh = 1; sh < 32; sh <<= 1) sq += __shfl_xor(sq, sh);
                        const float rs = rsqrtf(sq * (1.0f / 256.0f) + EPS);
                        u32x4 wv;
#pragma unroll
                        for (int e = 0; e < 4; ++e) { const float r0 = __uint_as_float(rr[i][e] << 16), r1 = __uint_as_float(rr[i][e] & 0xffff0000u);
                            const float g0 = e < 2 ? ng0[2 * e] : ng1[2 * e - 4], g1 = e < 2 ? ng0[2 * e + 1] : ng1[2 * e - 3];
                            wv[e] = pk_bf16(ov[2 * e] * rs * g0 * (r0 * sigmoidf_(r0)), ov[2 * e + 1] * rs * g1 * (r1 * sigmoidf_(r1))); }
                        *(u32x4*)(og + (size_t)(16 * i) * D) = wv;
                    }
                }
                __syncthreads();
            }
        }
#undef GLA_LOAD
        if (MODE == 0) {
#pragma unroll
            for (int cb = 0; cb < 4; ++cb)
#pragma unroll
                for (int i = 0; i < 16; ++i) (sb0 + (32 * cb + 8 * (i >> 2) + (i & 3)) * 256)[svo] = S[cb][i];
            if (tg == 0) dtot[full * 128 + chan] = dsum;
        }
    }
}
__device__ __forceinline__ void gla_carry(const P& p) {
    float* sbuf = (float*)(p.ws + WS_SBUF); const float* dtot = (const float*)(p.ws + WS_DTOT);
    const int total = 80 * 8192;
    int tid_ = threadIdx.x; asm volatile("" : "+v"(tid_));
    for (int e = blockIdx.x * NTHREADS + tid_; e < total; e += gridDim.x * NTHREADS) {
        const int e4 = e & 8191, ch = e >> 13, hd = ch & 3, s = (ch >> 2) % NSEQ, dir = ch / (4 * NSEQ);
        const int n = s < 2 ? 16 : 2, q0 = s < 2 ? s * 16 : 32 + (s - 2) * 2, chan = e4 >> 6;
        f32x4 run = (f32x4){0.f, 0.f, 0.f, 0.f};
        float* const base = sbuf + (size_t)e4 * 4;
        if (n == 16) {
            f32x4 tmp[16]; float dcy[16];
#pragma unroll
            for (int i = 0; i < 16; ++i) { const int sc = dir == 0 ? i : 15 - i, full = dir * 192 + (q0 + sc) * 4 + hd; tmp[i] = *(const f32x4*)(base + (size_t)full * 32768); dcy[i] = dtot[full * 128 + chan]; }
#pragma unroll
            for (int i = 0; i < 16; ++i) { const int sc = dir == 0 ? i : 15 - i, full = dir * 192 + (q0 + sc) * 4 + hd; *(f32x4*)(base + (size_t)full * 32768) = run; run = run * __expf(dcy[i]) + tmp[i]; }
        } else {
            for (int i = 0; i < n; ++i) { const int sc = dir == 0 ? i : n - 1 - i, full = dir * 192 + (q0 + sc) * 4 + hd;
                f32x4* ptr = (f32x4*)(base + (size_t)full * 32768); const float dcy = __expf(dtot[full * 128 + chan]);
                const f32x4 tmp = *ptr; *ptr = run; run = run * dcy + tmp; }
        }
    }
}

#define XB_TMO      128
#define XB_XCNT(j)  (256  + 64 * (j))
#define XB_XSUB(j)  (1280 + 64 * (j))
#define XB_XGEN(j)  (2304 + 64 * (j))
#define XB_TOP      3328
#define XB_TOPGEN   3392
#define XCD_BAR_WORDS 3456
#define XB_SPIN_CAP (1u << 18)

__device__ __forceinline__ unsigned xb_ld(unsigned* p)              { return __hip_atomic_load(p, __ATOMIC_RELAXED, __HIP_MEMORY_SCOPE_AGENT); }
__device__ __forceinline__ unsigned xb_add(unsigned* p, unsigned v) { return __hip_atomic_fetch_add(p, v, __ATOMIC_RELAXED, __HIP_MEMORY_SCOPE_AGENT); }
__device__ __forceinline__ unsigned xb_xcc_id() { return (unsigned)__builtin_amdgcn_s_getreg((3 << 11) | 20) & 0xFu; }
#define XB_SPIN(cond, bar) do { unsigned _sp = 0; while (cond) { __builtin_amdgcn_s_sleep(1); \
    if ((++_sp & 255u) == 0u) { if (xb_ld(&(bar)[XB_TMO])) break; if (_sp > XB_SPIN_CAP) { atomicAdd(&(bar)[XB_TMO], 1u); break; } } } } while (0)

struct XcdBarrier {
    unsigned* bar; unsigned x;
    volatile LAS unsigned* st;
};

__device__ __forceinline__ XcdBarrier xcd_barrier_post(unsigned* bar, volatile LAS unsigned* st) {
    XcdBarrier b; b.bar = bar; b.x = xb_xcc_id(); b.st = st;
    if (threadIdx.x == 0) (void)xb_add(&bar[XB_XCNT(b.x)], 1u);
    return b;
}
__device__ __forceinline__ void xcd_barrier_complete(unsigned* bar, unsigned x, unsigned& nloc, unsigned& nx) {
    const unsigned G = gridDim.x * gridDim.y * gridDim.z;
    unsigned sum, cnt, mine, sp = 0u;
    for (;;) {
        sum = 0u; cnt = 0u; mine = 0u;
#pragma unroll
        for (unsigned j = 0; j < 16; ++j) { const unsigned c = xb_ld(&bar[XB_XCNT(j)]); sum += c; cnt += (c > 0u) ? 1u : 0u; mine = (j == x) ? c : mine; }
        if (sum == G) break;
        __builtin_amdgcn_s_sleep(1);
        if ((++sp & 255u) == 0u) { if (xb_ld(&bar[XB_TMO])) break; if (sp > XB_SPIN_CAP) { atomicAdd(&bar[XB_TMO], 1u); break; } }
    }
    nloc = mine > 0u ? mine : 1u; nx = cnt > 0u ? cnt : 1u;
}

__device__ __forceinline__ void xcd_barrier(const XcdBarrier& b) {
    asm volatile("s_waitcnt vmcnt(0)" ::: "memory");
    __syncthreads();
    if (threadIdx.x == 0) {
        unsigned* bar = b.bar;
        __builtin_amdgcn_s_waitcnt(0);
        unsigned nloc = b.st[0], nx = b.st[1];
        if (nloc == 0u) { xcd_barrier_complete(bar, b.x, nloc, nx); b.st[0] = nloc; b.st[1] = nx; }
        const unsigned old = xb_add(&bar[XB_XSUB(b.x)], 1u);
        const unsigned gen = old / nloc;
        if (old + 1u == (gen + 1u) * nloc) {
            __builtin_amdgcn_fence(__ATOMIC_RELEASE, "agent");
            asm volatile("s_waitcnt vmcnt(0)" ::: "memory");
            const unsigned og = xb_add(&bar[XB_TOP], 1u);
            const unsigned tg = og / nx;
            if (og + 1u == (tg + 1u) * nx) xb_add(&bar[XB_TOPGEN], 1u);
            else XB_SPIN(xb_ld(&bar[XB_TOPGEN]) == tg, bar);
            __builtin_amdgcn_fence(__ATOMIC_ACQUIRE, "agent");
            xb_add(&bar[XB_XGEN(b.x)], 1u);
            asm volatile("s_waitcnt vmcnt(0)" ::: "memory");
        } else {
            XB_SPIN(xb_ld(&bar[XB_XGEN(b.x)]) == gen, bar);
            __builtin_amdgcn_fence(__ATOMIC_ACQUIRE, "agent");
            asm volatile("s_waitcnt vmcnt(0)" ::: "memory");
        }
    }
    __syncthreads();
}

#define GRID_BAR() xcd_barrier(bar)

template <int L, int SL>
__device__ __forceinline__ void mlp_up(const P& p, LAS unsigned char* lds) {
    unsigned char* ws = p.ws;
    bf16_t* hb = (bf16_t*)(ws + WS_HBUF); bf16_t* hid = (bf16_t*)(ws + WS_BIG + (size_t)(SL & 1) * 128 * MiB);
    const bf16_t* w1 = (const bf16_t*)(ws + (L ? WS_W1B : WS_W1A));
    pg8::Gemm g{hb + (size_t)SL * 16384 * D, w1, 16384, FF, D}; pg8::StaticOrder S; S.init(16384, FF, gridDim.x, blockIdx.x);
    EpiBf<1> E{hid, FF, nullptr};
    if (PH & 4096) pg8::gemm_phase<EpiBf<1>, pg8::StaticOrder>(lds, g, S, E, nullptr);
}
template <int L, int SL>
__device__ __forceinline__ void mlp_down(const P& p, LAS unsigned char* lds) {
    unsigned char* ws = p.ws;
    const float* ml = (const float*)(ws + WS_MOD) + (size_t)L * NSEQ * NMODC;
    bf16_t* hid = (bf16_t*)(ws + WS_BIG + (size_t)(SL & 1) * 128 * MiB);
    const bf16_t* w2 = (const bf16_t*)(ws + (L ? WS_W2B : WS_W2A));
    pg8::Gemm g{hid, w2, 16384, D, FF}; pg8::StaticOrder S; S.init(16384, D, gridDim.x, blockIdx.x);
    EpiRes E{p.out, ml + 5 * D, SL * 16384};
    if (PH & 8192) pg8::gemm_phase<EpiRes, pg8::StaticOrder>(lds, g, S, E, nullptr);
}
template <int L>
__device__ __forceinline__ void mlp_block(const P& p, LAS unsigned char* lds, const XcdBarrier& bar) {
    const float* ml = (const float*)(p.ws + WS_MOD) + (size_t)L * NSEQ * NMODC;
    norm_phase<1, false>(p, p.in[7] + L * D, ml + 3 * D, ml + 4 * D);
    GRID_BAR();
    mlp_up<L, 0>(p, lds);
    GRID_BAR();
    mlp_down<L, 0>(p, lds); mlp_up<L, 1>(p, lds);
    GRID_BAR();
    mlp_down<L, 1>(p, lds); mlp_up<L, 2>(p, lds);
    GRID_BAR();
    mlp_down<L, 2>(p, lds);
    GRID_BAR();
}

__global__ void __launch_bounds__(NTHREADS, 2) hybrid_fwd(P p) {
    extern __shared__ __attribute__((aligned(16))) unsigned char lds_raw[];
    LAS unsigned char* lds = (LAS unsigned char*)lds_raw;
    cg::grid_group grid = cg::this_grid();
    unsigned char* ws = p.ws;
    const float* mod = (const float*)(ws + WS_MOD);
    bf16_t* hb = (bf16_t*)(ws + WS_HBUF);
    bf16_t* big = (bf16_t*)(ws + WS_BIG);

    volatile LAS unsigned* bst = (volatile LAS unsigned*)(lds + LDS_BYTES - 16);
    if (threadIdx.x < 2) bst[threadIdx.x] = 0u;
    if (blockIdx.x == 0) for (int i = threadIdx.x; i < XCD_BAR_WORDS; i += NTHREADS) ((unsigned*)(ws + WS_BARW))[i] = 0u;
    __syncthreads();
    grid.sync();
    const XcdBarrier bar = xcd_barrier_post((unsigned*)(ws + WS_BARW), bst);
    if (PH & 1) p0_prep(p, lds);
    GRID_BAR();
    if (PH & 2) norm_phase<0, false>(p, p.in[6], mod + 0 * D, mod + 1 * D);
    GRID_BAR();
    if (PH & 4) s5_pass<false>(p, lds);
    GRID_BAR();
    if (PH & 8) s5_carry(p);
    GRID_BAR();
    if (PH & 16) s5_pass<true>(p, lds);
    GRID_BAR();
#if (DUP & 1)
    if (PH & 4) s5_pass<false>(p, lds);
    GRID_BAR();
    if (PH & 8) s5_carry(p);
    GRID_BAR();
    if (PH & 16) s5_pass<true>(p, lds);
    GRID_BAR();
#endif
    { pg8::Gemm g{big, (const bf16_t*)(ws + WS_WGLU), T, 2 * D, D}; pg8::StaticOrder S; S.init(T, 2 * D, gridDim.x, blockIdx.x);
      EpiGlu E{p.in[0], p.in[1], p.out, mod + 2 * D};
      if (PH & 512) pg8::gemm_phase<EpiGlu, pg8::StaticOrder>(lds, g, S, E, nullptr);
#if (DUP & 8)
      GRID_BAR(); pg8::gemm_phase<EpiGlu, pg8::StaticOrder>(lds, g, S, E, nullptr);
      GRID_BAR(); pg8::gemm_phase<EpiGlu, pg8::StaticOrder>(lds, g, S, E, nullptr);
      GRID_BAR(); pg8::gemm_phase<EpiGlu, pg8::StaticOrder>(lds, g, S, E, nullptr);
#endif
    }
    GRID_BAR();
    mlp_block<0>(p, lds, bar);
    norm_phase<1, false>(p, p.in[6] + D, mod + (size_t)NSEQ * NMODC + 0 * D, mod + (size_t)NSEQ * NMODC + 1 * D);
    GRID_BAR();
    { pg8::Gemm g{hb, (const bf16_t*)(ws + WS_WIN), T, WIN_N, D}; pg8::StaticOrder S; S.init(T, WIN_N, gridDim.x, blockIdx.x);
      EpiBf<0> E{big, PROJ_N, (float*)(ws + WS_A1)};
      if (PH & 1024) pg8::gemm_phase<EpiBf<0>, pg8::StaticOrder>(lds, g, S, E, nullptr); }
    GRID_BAR();
    if (PH & 32) gla_phase<0>(p, lds);
    GRID_BAR();
    if (PH & 64) gla_carry(p);
    GRID_BAR();
    if (PH & 128) gla_phase<1>(p, lds);
    GRID_BAR();
#if (DUP & 2)
    if (PH & 32) gla_phase<0>(p, lds);
    GRID_BAR();
    if (PH & 64) gla_carry(p);
    GRID_BAR();
    if (PH & 128) gla_phase<1>(p, lds);
    GRID_BAR();
#endif
    if (PH & 256) gla_phase<2>(p, lds);
    GRID_BAR();
    { pg8::Gemm g{hb, (const bf16_t*)(ws + WS_WOUT), T, D, D}; pg8::StaticOrder S; S.init(T, D, gridDim.x, blockIdx.x);
      EpiRes E{p.out, mod + (size_t)NSEQ * NMODC + 2 * D, 0};
      if (PH & 2048) pg8::gemm_phase<EpiRes, pg8::StaticOrder>(lds, g, S, E, nullptr); }
    GRID_BAR();
    mlp_block<1>(p, lds, bar);
#if (DUP & 4)
#pragma unroll 1
    for (int rep = 0; rep < 20; ++rep) GRID_BAR();
#endif
    if (PH == 0) norm_phase<0, true>(p, p.in[25], nullptr, nullptr); else norm_phase<1, true>(p, p.in[25], nullptr, nullptr);
}

extern "C" void kernel_launch(void* const* d_in, const int* in_sizes, int n_in, void* d_out, int out_size, void* d_ws, size_t ws_size, hipStream_t stream) {
    static int grid_blocks = 0;
    if (grid_blocks == 0) {
        if (n_in != 26 || out_size != T * D || ws_size < WS_END) { fprintf(stderr, "kernel_launch: unexpected sizes n_in %d out %d ws %zu\n", n_in, out_size, ws_size); grid_blocks = -1; return; }
        int dev = 0, cus = 0, per_cu = 0;
        hipGetDevice(&dev);
        hipDeviceGetAttribute(&cus, hipDeviceAttributeMultiprocessorCount, dev);
        hipFuncSetAttribute((const void*)hybrid_fwd, hipFuncAttributeMaxDynamicSharedMemorySize, LDS_BYTES);
        hipOccupancyMaxActiveBlocksPerMultiprocessor(&per_cu, (const void*)hybrid_fwd, NTHREADS, LDS_BYTES);
        if (per_cu < 1) { fprintf(stderr, "kernel_launch: occupancy query says %d blocks per CU\n", per_cu); grid_blocks = -1; return; }
        grid_blocks = cus;
        if (grid_blocks % 8) grid_blocks -= grid_blocks % 8;
    }
    if (grid_blocks < 0) return;
    P p{};
    for (int i = 0; i < 26; ++i) p.in[i] = (const float*)d_in[i];
    p.out = (float*)d_out; p.ws = (unsigned char*)d_ws;
    void* args[] = {&p};
    hipError_t e = hipLaunchCooperativeKernel((const void*)hybrid_fwd, dim3(grid_blocks), dim3(NTHREADS), args, LDS_BYTES, stream);
    if (e != hipSuccess) fprintf(stderr, "cooperative launch failed: %s (grid %d)\n", hipGetErrorString(e), grid_blocks);
}
```

```cpp
#include <hip/hip_runtime.h>
#include <hip/hip_cooperative_groups.h>
#include <cstdio>
namespace cg = cooperative_groups;

namespace pg8 {
#define PG8_LAS __attribute__((address_space(3)))
typedef unsigned short bf16_t;
typedef short bf16x8 __attribute__((ext_vector_type(8)));
typedef float f32x4 __attribute__((ext_vector_type(4)));
typedef unsigned u32x4 __attribute__((ext_vector_type(4)));
constexpr int BM = 256, BK = 64, HALF = 128, HTB = HALF * BK * 2  , STAGE_BYTES = 8 * HTB, NXCD = 8, WGM = 8;

__host__ __device__ __forceinline__ int lds_byte(int r, int c) { const int st = (r >> 4) * 2 + (c >> 5), rr = r & 15, cc = c & 31, ob = rr * 64 + cc * 2; return st * 1024 + (ob ^ (((ob >> 9) & 1) << 5)); }
__host__ __device__ __forceinline__ void stage_rc(int b, int& R, int& C) { const int st = b / 1024, sb = b % 1024, swz = sb ^ (((sb >> 9) & 1) << 5); R = (st >> 1) * 16 + swz / 64; C = (st & 1) * 32 + (swz % 64) / 2; }
__host__ __device__ __forceinline__ int perm32(int rho) { const int n = rho >> 4, i = rho & 15; return 8 * (i >> 2) + 4 * n + (i & 3); }

struct Unit { int pm, pn; };
struct Gemm { const bf16_t* A; const bf16_t* Bt; int M, N, K; };

struct StaticOrder {
    int nM, nN, nwg, G, c;
    __host__ __device__ void init(int M, int N, int G_, int c_) { nM = M / BM; nN = N / BM; nwg = nM * nN; G = G_; c = c_; }
    __host__ __device__ bool next(int i, Unit& u) const {
        const long L = (long)i * G + c; if (L >= nwg) return false;
        int wgid = (int)L; { const int q = nwg / NXCD, r = nwg % NXCD, xcd = wgid % NXCD, off = wgid / NXCD; wgid = (xcd < r ? xcd * (q + 1) : r * (q + 1) + (xcd - r) * q) + off; }
        const int nig = WGM * nN, gid = wgid / nig, fm = gid * WGM, gsz = (nM - fm) < WGM ? (nM - fm) : WGM;
        u.pm = fm + ((wgid % nig) % gsz); u.pn = (wgid % nig) / gsz; return true;
    }
    __device__ __forceinline__ void a_ready(const Unit&) const {}
    __device__ __forceinline__ void done(const Unit&) const {}
};


template <class Epi, class Sched, bool STAMP = false>
__device__ __forceinline__ void gemm_phase(PG8_LAS unsigned char* lds, const Gemm g, const Sched& S, const Epi& E, unsigned long long* stamps) {
    int tid_ = threadIdx.x; asm volatile("" : "+v"(tid_));
    const int tid = tid_, wid = __builtin_amdgcn_readfirstlane(tid >> 6), lane = tid & 63, wr = wid >> 2, wc = wid & 3, fr = lane & 15, fq = lane >> 4;
    const int K = g.K, nt = K / BK;
    int ts_lo = 0, ts_hi = 0, nts = 0; const unsigned long long rt_entry = STAMP ? (unsigned long long)wall_clock64() : 0ull;
#define PG8_STAMP() do { if (STAMP && wid == 0 && nts < 64) { const unsigned long long _c = (unsigned long long)clock64(); \
        ts_lo = (lane == nts) ? (int)(unsigned)_c : ts_lo; ts_hi = (lane == nts) ? (int)(unsigned)(_c >> 32) : ts_hi; ++nts; } } while (0)
    PG8_STAMP();
    unsigned voffA[2], voffB[2];
#pragma unroll
    for (int i = 0; i < 2; ++i) { int R, C; stage_rc(tid * 16 + i * 8192, R, C); const int Rb = Epi::PERM ? ((R & ~31) + perm32(R & 31)) : R;
        voffA[i] = (unsigned)(R * K + C) * 2u; voffB[i] = (unsigned)(Rb * K + C) * 2u; }
    const size_t kstep = (size_t)(BK * 2);
    const size_t hstep = (size_t)HALF * K * 2;
    const size_t tstep = 2 * hstep;
    const unsigned ldsw = (unsigned)wid * 1024u;
    const int aoff = lds_byte(wr * 64 + fr, fq * 8), boff = lds_byte(wc * 32 + fr, fq * 8);
#define PG8_SA(b, h) (((b) * 2 + (h)) * HTB)
#define PG8_SB(b, h) ((4 + (b) * 2 + (h)) * HTB)
#define PG8_STAGE(bufoff, gbase, voff) do { _Pragma("unroll") for (int _i = 0; _i < 2; ++_i) \
        __builtin_amdgcn_global_load_lds((const unsigned*)((const char*)(gbase) + (voff)[_i]), (PG8_LAS unsigned*)(lds + (bufoff) + ldsw + _i * 8192), 16, 0, 0); } while (0)
#define PG8_LDA(dst, b, h) do { _Pragma("unroll") for (int m = 0; m < 4; ++m) _Pragma("unroll") for (int k = 0; k < 2; ++k) dst[m][k] = *(const PG8_LAS bf16x8*)(lds + PG8_SA(b, h) + aoff + m * 2048 + k * 1024); } while (0)
#define PG8_LDB(dst, b, h) do { _Pragma("unroll") for (int n = 0; n < 2; ++n) _Pragma("unroll") for (int k = 0; k < 2; ++k) dst[n][k] = *(const PG8_LAS bf16x8*)(lds + PG8_SB(b, h) + boff + n * 2048 + k * 1024); } while (0)
#define PG8_MMA(ai, bj, At, Bt) do { __builtin_amdgcn_s_setprio(1); _Pragma("unroll") for (int m = 0; m < 4; ++m) _Pragma("unroll") for (int n = 0; n < 2; ++n) _Pragma("unroll") for (int k = 0; k < 2; ++k) \
        acc[ai][bj][m][n] = __builtin_amdgcn_mfma_f32_16x16x32_bf16(Bt[n][k], At[m][k], acc[ai][bj][m][n], 0, 0, 0); __builtin_amdgcn_s_setprio(0); } while (0)
#define PG8_WAIT_V(n) asm volatile("s_waitcnt vmcnt(" #n ")" ::: "memory")
#define PG8_WAIT_L(n) asm volatile("s_waitcnt lgkmcnt(" #n ")" ::: "memory")
#define PG8_BAR __builtin_amdgcn_s_barrier()
#define PG8_SCHED __builtin_amdgcn_sched_barrier(0)
    Unit cur, nxt; int ui = 0;
    if (!S.next(0, cur)) return;
    f32x4 acc[2][2][4][2];
#pragma unroll
    for (int a = 0; a < 2; ++a)
#pragma unroll
        for (int b = 0; b < 2; ++b)
#pragma unroll
            for (int m = 0; m < 4; ++m)
#pragma unroll
                for (int n = 0; n < 2; ++n) acc[a][b][m][n] = (f32x4){0.f, 0.f, 0.f, 0.f};
    bf16x8 At[4][2], B0[2][2], B1[2][2];
    const char* cA = (const char*)g.A + (size_t)cur.pm * tstep; const char* cB = (const char*)g.Bt + (size_t)cur.pn * tstep;
    S.a_ready(cur);
    PG8_STAGE(PG8_SB(0, 0), cB, voffB); PG8_STAGE(PG8_SA(0, 0), cA, voffA); PG8_STAGE(PG8_SB(0, 1), cB + hstep, voffB); PG8_STAGE(PG8_SA(0, 1), cA + hstep, voffA);
    if (wr == 1) PG8_BAR;
    PG8_WAIT_V(4); PG8_BAR;
    PG8_STAGE(PG8_SB(1, 0), cB + kstep, voffB); PG8_STAGE(PG8_SA(1, 0), cA + kstep, voffA); PG8_STAGE(PG8_SB(1, 1), cB + hstep + kstep, voffB);
    PG8_WAIT_V(6); PG8_BAR;
    PG8_STAMP();
    for (;;) {
        const bool has_next = S.next(ui + 1, nxt);
        const char* nA = has_next ? (const char*)g.A + (size_t)nxt.pm * tstep : cA; const char* nB = has_next ? (const char*)g.Bt + (size_t)nxt.pn * tstep : cB;
        for (int t = 0; t < nt; t += 2) {
            const bool last = (t == nt - 2);
            const char* a1 = cA + (size_t)(t + 1) * kstep;
            const char* a2 = last ? nA : cA + (size_t)(t + 2) * kstep; const char* b2 = last ? nB : cB + (size_t)(t + 2) * kstep;
            const char* a3 = a2 + kstep; const char* b3 = b2 + kstep;
            if (last && has_next) S.a_ready(nxt);
            PG8_LDB(B0, 0, 0); PG8_SCHED; PG8_LDA(At, 0, 0); PG8_STAGE(PG8_SA(1, 1), a1 + hstep, voffA);
            PG8_WAIT_L(8); PG8_BAR; PG8_WAIT_L(0); PG8_MMA(0, 0, At, B0); PG8_BAR; PG8_SCHED;
            PG8_LDB(B1, 0, 1); PG8_STAGE(PG8_SB(0, 0), b2, voffB);
            PG8_BAR; PG8_WAIT_L(0); PG8_MMA(0, 1, At, B1); PG8_BAR;
            PG8_LDA(At, 0, 1); PG8_STAGE(PG8_SA(0, 0), a2, voffA);
            PG8_BAR; PG8_WAIT_L(0); PG8_MMA(1, 0, At, B0); PG8_BAR; PG8_SCHED;
            PG8_STAGE(PG8_SB(0, 1), b2 + hstep, voffB);
            PG8_WAIT_V(6); PG8_BAR; PG8_MMA(1, 1, At, B1); PG8_BAR;
            PG8_LDB(B0, 1, 0); PG8_SCHED; PG8_LDA(At, 1, 0); PG8_STAGE(PG8_SA(0, 1), a2 + hstep, voffA);
            PG8_WAIT_L(8); PG8_BAR; PG8_WAIT_L(0); PG8_MMA(0, 0, At, B0); PG8_BAR; PG8_SCHED;
            PG8_LDB(B1, 1, 1); PG8_STAGE(PG8_SB(1, 0), b3, voffB);
            PG8_BAR; PG8_WAIT_L(0); PG8_MMA(0, 1, At, B1); PG8_BAR;
            PG8_LDA(At, 1, 1); PG8_STAGE(PG8_SA(1, 0), a3, voffA);
            PG8_BAR; PG8_WAIT_L(0); PG8_MMA(1, 0, At, B0); PG8_BAR; PG8_SCHED;
            PG8_STAGE(PG8_SB(1, 1), b3 + hstep, voffB);
            PG8_WAIT_V(6); PG8_BAR; PG8_MMA(1, 1, At, B1); PG8_BAR;
        }
        PG8_STAMP();
        if constexpr (!Epi::AFTER_DRAIN) { E(acc, cur, wr, wc, fr, fq); S.done(cur); }
        PG8_STAMP();
        if (!has_next) break;
#pragma unroll
        for (int a = 0; a < 2; ++a)
#pragma unroll
            for (int b = 0; b < 2; ++b)
#pragma unroll
                for (int m = 0; m < 4; ++m)
#pragma unroll
                    for (int n = 0; n < 2; ++n) acc[a][b][m][n] = (f32x4){0.f, 0.f, 0.f, 0.f};
        cur = nxt; cA = nA; cB = nB; ++ui;
    }
    PG8_WAIT_V(0);
    if (wr == 0) PG8_BAR;
    PG8_BAR;
    if constexpr (Epi::AFTER_DRAIN) { E.fused(acc, cur, wr, wc, fr, fq, lds, wid, lane); S.done(cur); }
    PG8_STAMP();
    if (STAMP && wid == 0) { stamps[lane] = lane < nts ? (((unsigned long long)(unsigned)ts_hi << 32) | (unsigned)ts_lo) : 0ull;
        if (lane == 62) stamps[62] = rt_entry; if (lane == 63) stamps[63] = (unsigned long long)wall_clock64(); }
#undef PG8_STAMP
#undef PG8_SA
#undef PG8_SB
#undef PG8_STAGE
#undef PG8_LDA
#undef PG8_LDB
#undef PG8_MMA
#undef PG8_WAIT_V
#undef PG8_WAIT_L
#undef PG8_BAR
#undef PG8_SCHED
}
}


#define LAS __attribute__((address_space(3)))
typedef unsigned short bf16_t;
typedef short bf16x8 __attribute__((ext_vector_type(8)));
typedef short bf16x4 __attribute__((ext_vector_type(4)));
typedef float f32x4 __attribute__((ext_vector_type(4)));
typedef float f32x16 __attribute__((ext_vector_type(16)));
typedef unsigned u32x4 __attribute__((ext_vector_type(4)));
typedef unsigned u32x2 __attribute__((ext_vector_type(2)));

constexpr int D = 1024, T = 49152, NSEQ = 10, NMODC = 6144, FF = 4096;
constexpr int T_PROMPT = 32768;
constexpr float EPS = 1e-6f;
#ifndef PH
#define PH 16383
#endif
#ifndef DUP
#define DUP 0
#endif
constexpr int NWAVES = 8, NTHREADS = 512;
constexpr int LDS_BYTES = 139264;
constexpr int WIN_N = 3328;
constexpr int PROJ_N = 3072;

constexpr size_t MiB = 1u << 20;
constexpr size_t WS_MOD = 0;
constexpr size_t WS_BARW = 491520;
constexpr size_t WS_ABAR = 512 * 1024;
constexpr size_t WS_BBT = 1 * MiB;
constexpr size_t WS_CT = 1 * MiB + 512 * 1024;
constexpr size_t WS_DTOT = 2 * MiB;
constexpr size_t WS_A1 = 3 * MiB;
constexpr size_t WS_WIN = 10 * MiB;
constexpr size_t WS_WOUT = WS_WIN + (size_t)WIN_N * D * 2;
constexpr size_t WS_W1B = WS_WOUT + (size_t)D * D * 2;
constexpr size_t WS_W2B = WS_W1B + (size_t)FF * D * 2;
constexpr size_t WS_HBUF = 35 * MiB;
constexpr size_t WS_BIG = 131 * MiB;
constexpr size_t WS_S5E = WS_BIG + 96 * MiB;
constexpr size_t WS_X = 419 * MiB;
constexpr size_t WS_WGLU = WS_X;
constexpr size_t WS_W1A = WS_X + 4 * MiB;
constexpr size_t WS_W2A = WS_X + 12 * MiB;
constexpr size_t WS_SBUF = WS_X;
constexpr size_t WS_END = 467 * MiB;
static_assert(WS_W2B + (size_t)FF * D * 2 <= WS_HBUF, "ws map");

struct P { const float* in[26]; float* out; unsigned char* ws; };

typedef __bf16 bf16n2 __attribute__((ext_vector_type(2)));
typedef float f32x2n __attribute__((ext_vector_type(2)));
__device__ __forceinline__ unsigned pk_bf16(float lo, float hi) { const f32x2n f = {lo, hi}; const bf16n2 v = __builtin_convertvector(f, bf16n2); return __builtin_bit_cast(unsigned, v); }
__device__ __forceinline__ bf16_t f2bf(float f) { return (bf16_t)(pk_bf16(f, 0.f) & 0xffffu); }
__device__ __forceinline__ float bf2f(bf16_t b) { return __uint_as_float(((unsigned)b) << 16); }
__device__ __forceinline__ float wave_sum(float v) {
#pragma unroll
    for (int o = 1; o < 64; o <<= 1) v += __shfl_xor(v, o);
    return v;
}
__device__ __forceinline__ int row_seq(int row) { return row < T_PROMPT ? (row >> 14) : 2 + ((row - T_PROMPT) >> 11); }
__device__ __forceinline__ float sigmoidf_(float x) { return 1.0f / (1.0f + __expf(-x)); }
__device__ __forceinline__ float gelu_tanh(float y) {
    const float a = 0.7978845608028654f * (y + 0.044715f * y * y * y);
    const float th = 1.0f - 2.0f / (__expf(2.0f * a) + 1.0f);
    return 0.5f * y * (1.0f + th);
}
#define CFENCE() asm volatile("" ::: "memory")
#define LDS_WAIT() asm volatile("s_waitcnt lgkmcnt(0)" ::: "memory")

struct EpiRes {
    static constexpr bool PERM = false, AFTER_DRAIN = false;
    float* x; const float* gate; int row_off;
    __device__ __forceinline__ void operator()(const pg8::f32x4 (&acc)[2][2][4][2], const pg8::Unit& u, int wr, int wc, int fr, int fq) const {
        const int row0 = row_off + u.pm * 256 + wr * 64 + fr, col0 = u.pn * 256 + wc * 32 + 4 * fq;
        const float* gp = gate + (size_t)row_seq(row_off + u.pm * 256) * NMODC;
        pg8::f32x4 gv[2][2];
#pragma unroll
        for (int bj = 0; bj < 2; ++bj)
#pragma unroll
            for (int n = 0; n < 2; ++n) gv[bj][n] = *(const pg8::f32x4*)(gp + col0 + bj * 128 + n * 16);
#pragma unroll
        for (int ai = 0; ai < 2; ++ai)
#pragma unroll
            for (int m = 0; m < 4; ++m) { float* rowp = x + (size_t)(row0 + ai * 128 + m * 16) * D + col0;
#pragma unroll
                for (int bj = 0; bj < 2; ++bj)
#pragma unroll
                    for (int n = 0; n < 2; ++n) { pg8::f32x4* q = (pg8::f32x4*)(rowp + bj * 128 + n * 16); *q = *q + gv[bj][n] * acc[ai][bj][m][n]; }
                if (m & 1) asm volatile("" ::: "memory"); }
    }
};
struct EpiGlu {
    static constexpr bool PERM = false, AFTER_DRAIN = false;
    const float* xp; const float* xs; float* out; const float* gate;
    __device__ __forceinline__ void operator()(const pg8::f32x4 (&acc)[2][2][4][2], const pg8::Unit& u, int wr, int wc, int fr, int fq) const {
        const int row0 = u.pm * 256 + wr * 64 + fr, col0 = u.pn * 128 + wc * 32 + 4 * fq;
        const float* gp = gate + (size_t)row_seq(u.pm * 256) * NMODC;
        pg8::f32x4 gv[2];
#pragma unroll
        for (int n = 0; n < 2; ++n) gv[n] = *(const pg8::f32x4*)(gp + col0 + n * 16);
#pragma unroll
        for (int ai = 0; ai < 2; ++ai)
#pragma unroll
            for (int m = 0; m < 4; ++m) { const int row = row0 + ai * 128 + m * 16;
                const float* xin = row < T_PROMPT ? xp + (size_t)row * D : xs + (size_t)(row - T_PROMPT) * D;
#pragma unroll
                for (int n = 0; n < 2; ++n) { const pg8::f32x4 val = acc[ai][0][m][n], gt = acc[ai][1][m][n]; pg8::f32x4 sg;
                    sg[0] = sigmoidf_(gt[0]); sg[1] = sigmoidf_(gt[1]); sg[2] = sigmoidf_(gt[2]); sg[3] = sigmoidf_(gt[3]);
                    const pg8::f32x4 xv = *(const pg8::f32x4*)(xin + col0 + n * 16);
                    *(pg8::f32x4*)(out + (size_t)row * D + col0 + n * 16) = xv + gv[n] * val * sg; }
                if (m & 1) asm volatile("" ::: "memory"); }
    }
};
template <int ACT> struct EpiBf {
    static constexpr bool PERM = true, AFTER_DRAIN = false;
    bf16_t* O; int ldc; float* a1;
    __device__ __forceinline__ void operator()(const pg8::f32x4 (&acc)[2][2][4][2], const pg8::Unit& u, int wr, int wc, int fr, int fq) const {
        const int row0 = u.pm * 256 + wr * 64 + fr;
        if (ACT == 0 && u.pn == 12) {
            if (wc == 0) {
#pragma unroll
                for (int ai = 0; ai < 2; ++ai)
#pragma unroll
                    for (int m = 0; m < 4; ++m) { float* rp = a1 + (size_t)(row0 + ai * 128 + m * 16) * 32 + 8 * fq;
                        *(pg8::f32x4*)rp = acc[ai][0][m][0]; *(pg8::f32x4*)(rp + 4) = acc[ai][0][m][1]; }
            }
            return;
        }
        const int col0 = u.pn * 256 + wc * 32 + 8 * fq;
#pragma unroll
        for (int ai = 0; ai < 2; ++ai)
#pragma unroll
            for (int m = 0; m < 4; ++m) { bf16_t* rowp = O + (size_t)(row0 + ai * 128 + m * 16) * ldc + col0;
#pragma unroll
                for (int bj = 0; bj < 2; ++bj) { pg8::f32x4 v0 = acc[ai][bj][m][0], v1 = acc[ai][bj][m][1];
                    if (ACT == 1) {
#pragma unroll
                        for (int e = 0; e < 4; ++e) { const float a = fmaxf(v0[e], 0.f), b = fmaxf(v1[e], 0.f); v0[e] = a * a; v1[e] = b * b; } }
                    pg8::u32x4 wv; wv.x = pk_bf16(v0[0], v0[1]); wv.y = pk_bf16(v0[2], v0[3]); wv.z = pk_bf16(v1[0], v1[1]); wv.w = pk_bf16(v1[2], v1[3]);
                    *(pg8::u32x4*)(rowp + bj * 128) = wv; } }
    }
};

__device__ __forceinline__ void transpose_item(const float* W, int K, int N, int srccol0, bf16_t* WT, int dstrow0, int k0, LAS float* scr, int lane) {
    { float tv[32];
#pragma unroll
      for (int i = 0; i < 32; ++i) tv[i] = W[(size_t)(k0 + 2 * i + (lane >> 5)) * N + srccol0 + (lane & 31)];
#pragma unroll
      for (int i = 0; i < 32; ++i) scr[(2 * i + (lane >> 5)) * 33 + (lane & 31)] = tv[i]; }
    LDS_WAIT();
    const int c = lane & 7;
#pragma unroll
    for (int j = 0; j < 4; ++j) { const int n = (lane >> 3) + 8 * j; const LAS float* s = scr + (8 * c) * 33 + n;
        u32x4 o; o.x = pk_bf16(s[0 * 33], s[1 * 33]); o.y = pk_bf16(s[2 * 33], s[3 * 33]); o.z = pk_bf16(s[4 * 33], s[5 * 33]); o.w = pk_bf16(s[6 * 33], s[7 * 33]);
        *(u32x4*)(WT + (size_t)(dstrow0 + n) * K + k0 + 8 * c) = o; }
    LDS_WAIT();
}

__device__ __forceinline__ void p0_prep(const P& p, LAS unsigned char* lds) {
    int tid_ = threadIdx.x; asm volatile("" : "+v"(tid_));
    const int tid = tid_, lane = tid & 63, w = tid >> 6;
    unsigned char* ws = p.ws;
    if ((int)blockIdx.x < 192) {
        LAS float* sc = (LAS float*)lds;
        LAS float* red = (LAS float*)(lds + 40960);
        for (int i = tid; i < NSEQ * D; i += NTHREADS) { const int s = i >> 10, d = i & 1023; const float c = s < 2 ? p.in[2][s * D + d] : p.in[3][(s - 2) * D + d]; sc[i] = c * sigmoidf_(c); }
        __syncthreads();
        for (int it = blockIdx.x; it < 192; it += gridDim.x) {
            const int l = it / 96, col0 = (it % 96) * 64, col = tid & 63, ks = w;
            float acc[NSEQ];
#pragma unroll
            for (int s = 0; s < NSEQ; ++s) acc[s] = 0.f;
            const float* wp = p.in[4] + ((size_t)l * D + ks * 128) * NMODC + col0 + col;
#pragma unroll 16
            for (int k = 0; k < 128; ++k) { const float wv = wp[(size_t)k * NMODC];
#pragma unroll
                for (int s = 0; s < NSEQ; ++s) acc[s] += sc[s * D + ks * 128 + k] * wv; }
#pragma unroll
            for (int s = 0; s < NSEQ; ++s) red[(ks * NSEQ + s) * 64 + col] = acc[s];
            __syncthreads();
            for (int i = tid; i < NSEQ * 64; i += NTHREADS) { const int s = i >> 6, cc = i & 63; float v = 0.f;
#pragma unroll
                for (int k8 = 0; k8 < 8; ++k8) v += red[(k8 * NSEQ + s) * 64 + cc];
                ((float*)(ws + WS_MOD))[((size_t)l * NSEQ + s) * NMODC + col0 + cc] = v + p.in[5][l * NMODC + col0 + cc]; }
            __syncthreads();
        }
    }
    __syncthreads();
    {
        LAS float* scr = (LAS float*)(lds + w * 16384);
        const int gw = blockIdx.x * NWAVES + w, NGW = gridDim.x * NWAVES;
        constexpr int I_GLU = 16 * 64, I_WIN = 16 * 96, I_WOUT = 16 * 32, I_W1 = 16 * 128, I_W2 = 64 * 32;
        constexpr int NITEMS = I_GLU + I_WIN + I_WOUT + 2 * I_W1 + 2 * I_W2;
        for (int it = gw; it < NITEMS; it += NGW) {
            int r = it;
            if (r < I_GLU) { const int kb = r / 64, nb = r % 64, n0 = nb * 32, pn = n0 >> 8, bj = (n0 >> 7) & 1, r0 = n0 & 127;
                transpose_item(p.in[16], D, 2 * D, bj * D + pn * 128 + r0, (bf16_t*)(ws + WS_WGLU), n0, kb * 64, scr, lane); continue; }
            r -= I_GLU;
            if (r < I_WIN) { const int kb = r / 96, nb = r % 96; transpose_item(p.in[17], D, PROJ_N, nb * 32, (bf16_t*)(ws + WS_WIN), nb * 32, kb * 64, scr, lane); continue; }
            r -= I_WIN;
            if (r < I_WOUT) { const int kb = r / 32, nb = r % 32; transpose_item(p.in[22], D, D, nb * 32, (bf16_t*)(ws + WS_WOUT), nb * 32, kb * 64, scr, lane); continue; }
            r -= I_WOUT;
            if (r < 2 * I_W1) { const int l = r / I_W1, q = r % I_W1, kb = q / 128, nb = q % 128;
                transpose_item(p.in[23] + (size_t)l * D * FF, D, FF, nb * 32, (bf16_t*)(ws + (l ? WS_W1B : WS_W1A)), nb * 32, kb * 64, scr, lane); continue; }
            r -= 2 * I_W1;
            { const int l = r / I_W2, q = r % I_W2, kb = q / 32, nb = q % 32;
                transpose_item(p.in[24] + (size_t)l * FF * D, FF, D, nb * 32, (bf16_t*)(ws + (l ? WS_W2B : WS_W2A)), nb * 32, kb * 64, scr, lane); }
        }
        bf16_t* wt = (bf16_t*)(ws + WS_WIN);
        for (int i = blockIdx.x * NTHREADS + tid; i < 256 * D; i += gridDim.x * NTHREADS) { const int r = i >> 10, k = i & 1023;
            const float v = r < 32 ? p.in[18][((size_t)(r >> 4) * D + k) * 16 + (r & 15)] : 0.f;
            wt[(size_t)(PROJ_N + r) * D + k] = f2bf(v); }
    }
    for (int i = blockIdx.x * NTHREADS + tid; i < 2 * 64 * 64; i += gridDim.x * NTHREADS) {
        const int pp = i & 63, dg = i >> 6;
        const float lr = p.in[8][i], li = p.in[9][i], dt = __expf(p.in[10][dg]);
        const float mag = __expf(lr * dt); float sn, cs; sincosf(li * dt, &sn, &cs);
        const float abr = mag * cs, abi = mag * sn, den = lr * lr + li * li;
        const float zr = ((abr - 1.0f) * lr + abi * li) / den, zi = (abi * lr - (abr - 1.0f) * li) / den;
        float* ab = (float*)(ws + WS_ABAR); ab[2 * i] = abr; ab[2 * i + 1] = abi;
        bf16_t* bbt = (bf16_t*)(ws + WS_BBT); bf16_t* ct = (bf16_t*)(ws + WS_CT);
#pragma unroll
        for (int h = 0; h < 16; ++h) {
            const float br = p.in[11][(size_t)i * 16 + h], bi = p.in[12][(size_t)i * 16 + h];
            bbt[((size_t)dg * 128 + pp) * 16 + h] = f2bf(zr * br - zi * bi);
            bbt[((size_t)dg * 128 + 64 + pp) * 16 + h] = f2bf(zr * bi + zi * br);
            ct[((size_t)dg * 16 + h) * 128 + pp] = f2bf(p.in[13][((size_t)dg * 16 + h) * 64 + pp]);
            ct[((size_t)dg * 16 + h) * 128 + 64 + pp] = f2bf(-p.in[14][((size_t)dg * 16 + h) * 64 + pp]);
        }
    }
}

template <int SRC, bool FINAL>
__device__ __forceinline__ void norm_phase(const P& p, const float* gvec, const float* shift, const float* scale) {
    int tid_ = threadIdx.x; asm volatile("" : "+v"(tid_));
    const int tid = tid_, lane = tid & 63, w = tid >> 6;
    const int gw = blockIdx.x * NWAVES + w, NGW = gridDim.x * NWAVES;
    bf16_t* hb = (bf16_t*)(p.ws + WS_HBUF);
    f32x4 gq[4];
#pragma unroll
    for (int j = 0; j < 4; ++j) gq[j] = *(const f32x4*)(gvec + 4 * lane + 256 * j);
    f32x4 vn[4];
    { const int row = gw; const float* xr = SRC == 0 ? (row < T_PROMPT ? p.in[0] + (size_t)row * D : p.in[1] + (size_t)(row - T_PROMPT) * D) : p.out + (size_t)row * D;
#pragma unroll
      for (int j = 0; j < 4; ++j) vn[j] = *(const f32x4*)(xr + 4 * lane + 256 * j); }
    for (int row = gw; row < T; row += NGW) {
        f32x4 v[4]; float ss = 0.f;
#pragma unroll
        for (int j = 0; j < 4; ++j) { v[j] = vn[j]; ss += (v[j][0] * v[j][0] + v[j][1] * v[j][1]) + (v[j][2] * v[j][2] + v[j][3] * v[j][3]); }
        { const int rn = row + NGW < T ? row + NGW : row;
          const float* xr = SRC == 0 ? (rn < T_PROMPT ? p.in[0] + (size_t)rn * D : p.in[1] + (size_t)(rn - T_PROMPT) * D) : p.out + (size_t)rn * D;
#pragma unroll
          for (int j = 0; j < 4; ++j) vn[j] = *(const f32x4*)(xr + 4 * lane + 256 * j); }
        const float rstd = rsqrtf(wave_sum(ss) * (1.0f / D) + EPS);
        if (FINAL) {
#pragma unroll
            for (int j = 0; j < 4; ++j) *(f32x4*)(p.out + (size_t)row * D + 4 * lane + 256 * j) = v[j] * rstd * gq[j];
        } else {
            const int s = row_seq(row);
#pragma unroll
            for (int j = 0; j < 4; ++j) { const f32x4 sh = *(const f32x4*)(shift + (size_t)s * NMODC + 4 * lane + 256 * j), sc = *(const f32x4*)(scale + (size_t)s * NMODC + 4 * lane + 256 * j);
                const f32x4 o = (v[j] * rstd * gq[j]) * (sc + 1.0f) + sh;
                u32x2 wv; wv.x = pk_bf16(o[0], o[1]); wv.y = pk_bf16(o[2], o[3]);
                *(u32x2*)(hb + (size_t)row * D + 4 * lane + 256 * j) = wv; }
        }
    }
}

constexpr int S5_NCH = 384, S5_HROW = 272, S5_UROW = 48, S5_UOFF = 32 * S5_HROW, S5_WAVE_LDS = S5_UOFF + 128 * S5_UROW;
__device__ __forceinline__ void half_bcast(float x, float& lo, float& hi) { const auto r = __builtin_amdgcn_permlane32_swap(__float_as_uint(x), __float_as_uint(x), false, false); lo = __uint_as_float(r[0]); hi = __uint_as_float(r[1]); }
#define CMAD(sr, si, mr, mi, br, bi) do { const float nr_ = (sr) * (mr) - (si) * (mi) + (br); const float ni_ = (sr) * (mi) + (si) * (mr) + (bi); (sr) = nr_; (si) = ni_; } while (0)
template <bool PC>
__device__ __forceinline__ void s5_pass(const P& p, LAS unsigned char* lds) {
    int tid_ = threadIdx.x; asm volatile("" : "+v"(tid_));
    const int tid = tid_, lane = tid & 63, w = __builtin_amdgcn_readfirstlane(tid >> 6);
    const int b = blockIdx.x, g = (b & 7) * 8 + w;
    const int hh = lane >> 5, l32 = lane & 31, l16 = lane & 15, q16 = lane >> 4;
    LAS unsigned char* const H = lds + w * S5_WAVE_LDS;
    LAS unsigned char* const hwr = H + (4 * hh) * S5_HROW + l32 * 4;
    const LAS unsigned char* const hrd = H + l16 * S5_HROW + q16 * 16;
    const bf16_t* hb = (const bf16_t*)(p.ws + WS_HBUF);
    bf16_t* gout = (bf16_t*)(p.ws + WS_BIG);
    float* E = (float*)(p.ws + WS_S5E);
    const bf16_t* bbt = (const bf16_t*)(p.ws + WS_BBT); const bf16_t* ct = (const bf16_t*)(p.ws + WS_CT); const float* ab = (const float*)(p.ws + WS_ABAR);
    const float dsk = p.in[15][g * 16 + l16];
    bf16x8 BfA[2][4];
#pragma unroll
    for (int dir = 0; dir < 2; ++dir)
#pragma unroll
        for (int nb = 0; nb < 4; ++nb) BfA[dir][nb] = PC ? (bf16x8){0, 0, 0, 0, 0, 0, 0, 0} : *(const bf16x8*)(bbt + ((size_t)(dir * 64 + g) * 128 + (nb >> 1) * 64 + 2 * l32 + (nb & 1)) * 16 + 8 * hh);
    const int cstride = (int)(gridDim.x >> 3);
    const bf16_t* const ub = hb + (size_t)l32 * D + g * 16 + 8 * hh;
    bf16x8 afn[4]; f32x2n enr[2], eni[2];
    { const int c0 = b >> 3;
      if (c0 < S5_NCH) {
#pragma unroll
        for (int sb = 0; sb < 4; ++sb) afn[sb] = *(const bf16x8*)(ub + (size_t)(c0 * 128 + sb * 32) * D);
        if (PC) {
#pragma unroll
            for (int dir = 0; dir < 2; ++dir) { const size_t eo = (((size_t)dir * S5_NCH + c0) * 64 + g) * 128; enr[dir] = *(const f32x2n*)(E + eo + 2 * l32); eni[dir] = *(const f32x2n*)(E + eo + 64 + 2 * l32); } } } }
    for (int c = b >> 3; c < S5_NCH; c += cstride) {
        const int tok0 = c * 128;
        f32x2n ecr[2], eci[2];
#pragma unroll
        for (int sb = 0; sb < 4; ++sb) *(LAS bf16x8*)(H + S5_UOFF + (sb * 32 + l32) * S5_UROW + 16 * hh) = afn[sb];
#pragma unroll
        for (int dir = 0; dir < 2; ++dir) { ecr[dir] = enr[dir]; eci[dir] = eni[dir]; }
        CFENCE(); LDS_WAIT(); CFENCE();
        { int cn = c + cstride; asm volatile("" : "+s"(cn));
          if (cn < S5_NCH) {
#pragma unroll
            for (int sb = 0; sb < 4; ++sb) afn[sb] = *(const bf16x8*)(ub + (size_t)(cn * 128 + sb * 32) * D);
            if (PC) {
#pragma unroll
                for (int dir = 0; dir < 2; ++dir) { const size_t eo = (((size_t)dir * S5_NCH + cn) * 64 + g) * 128; enr[dir] = *(const f32x2n*)(E + eo + 2 * l32); eni[dir] = *(const f32x2n*)(E + eo + 64 + 2 * l32); } } } }
        f32x4 yacc[8];
#pragma unroll
        for (int j = 0; j < 8; ++j) yacc[j] = (f32x4){0.f, 0.f, 0.f, 0.f};
#pragma unroll
        for (int dir = 0; dir < 2; ++dir) {
            const size_t eoff = (((size_t)dir * S5_NCH + c) * 64 + g) * 128;
            const int dg = dir * 64 + g;
            bf16x8 Bf[4], Cf[4];
#pragma unroll
            for (int nb = 0; nb < 4; ++nb) Bf[nb] = PC ? *(const bf16x8*)(bbt + ((size_t)dg * 128 + (nb >> 1) * 64 + 2 * l32 + (nb & 1)) * 16 + 8 * hh) : BfA[dir][nb];
#pragma unroll
            for (int ks = 0; ks < 4; ++ks) Cf[ks] = PC ? *(const bf16x8*)(ct + ((size_t)dg * 16 + l16) * 128 + 32 * ks + 8 * q16) : (bf16x8){0, 0, 0, 0, 0, 0, 0, 0};
            const f32x4 a1v = *(const f32x4*)(ab + ((size_t)dg * 64 + 2 * l32) * 2);
            const float a1Ar = a1v[0], a1Ai = a1v[1], a1Br = a1v[2], a1Bi = a1v[3];
            const float a2Ar = a1Ar * a1Ar - a1Ai * a1Ai, a2Ai = 2.f * a1Ar * a1Ai, a2Br = a1Br * a1Br - a1Bi * a1Bi, a2Bi = 2.f * a1Br * a1Bi;
            const float a3Ar = a2Ar * a1Ar - a2Ai * a1Ai, a3Ai = a2Ar * a1Ai + a2Ai * a1Ar, a3Br = a2Br * a1Br - a2Bi * a1Bi, a3Bi = a2Br * a1Bi + a2Bi * a1Br;
            const float a4Ar = a2Ar * a2Ar - a2Ai * a2Ai, a4Ai = 2.f * a2Ar * a2Ai, a4Br = a2Br * a2Br - a2Bi * a2Bi, a4Bi = 2.f * a2Br * a2Bi;
            const float a5Ar = a4Ar * a1Ar - a4Ai * a1Ai, a5Ai = a4Ar * a1Ai + a4Ai * a1Ar, a5Br = a4Br * a1Br - a4Bi * a1Bi, a5Bi = a4Br * a1Bi + a4Bi * a1Br;
            float hAr = 0.f, hAi = 0.f, hBr = 0.f, hBi = 0.f;
            if (PC) { hAr = ecr[dir][0]; hBr = ecr[dir][1]; hAi = eci[dir][0]; hBi = eci[dir][1]; }
            const bool lead = (hh == dir);
#pragma unroll
            for (int sbi = 0; sbi < 4; ++sbi) {
                const int sb = dir == 0 ? sbi : 3 - sbi;
                if (PC) __builtin_amdgcn_sched_barrier(0);
                const bf16x8 a = *(const LAS bf16x8*)(H + S5_UOFF + (sb * 32 + l32) * S5_UROW + 16 * hh);
                f32x16 acc[4];
#pragma unroll
                for (int nb = 0; nb < 4; ++nb) {
#pragma unroll
                    for (int i = 0; i < 16; ++i) acc[nb][i] = 0.f;
                    acc[nb] = __builtin_amdgcn_mfma_f32_32x32x16_bf16(a, Bf[nb], acc[nb], 0, 0, 0);
                }
                if (!PC) {
#pragma unroll
                    for (int gi = 0; gi < 4; ++gi)
#pragma unroll
                        for (int ri = 0; ri < 4; ++ri) { const int i = 4 * (dir == 0 ? gi : 3 - gi) + (dir == 0 ? ri : 3 - ri);
                            if (sbi == 0 && gi == 0 && ri == 0) { hAr = acc[0][i]; hAi = acc[2][i]; hBr = acc[1][i]; hBi = acc[3][i]; }
                            else if (ri == 0) { CMAD(hAr, hAi, a5Ar, a5Ai, acc[0][i], acc[2][i]); CMAD(hBr, hBi, a5Br, a5Bi, acc[1][i], acc[3][i]); }
                            else { CMAD(hAr, hAi, a1Ar, a1Ai, acc[0][i], acc[2][i]); CMAD(hBr, hBi, a1Br, a1Bi, acc[1][i], acc[3][i]); } }
                } else {
#pragma unroll
                    for (int gi = 0; gi < 4; ++gi) { const int gg = dir == 0 ? gi : 3 - gi;
                        float xAr = lead ? hAr : 0.f, xAi = lead ? hAi : 0.f, xBr = lead ? hBr : 0.f, xBi = lead ? hBi : 0.f;
#pragma unroll
                        for (int k = 0; k < 4; ++k) { const int i = 4 * gg + (dir == 0 ? k : 3 - k);
                            CMAD(xAr, xAi, a1Ar, a1Ai, acc[0][i], acc[2][i]); acc[0][i] = xAr; acc[2][i] = xAi;
                            CMAD(xBr, xBi, a1Br, a1Bi, acc[1][i], acc[3][i]); acc[1][i] = xBr; acc[3][i] = xBi; }
                        float eAr, eAi, eBr, eBi, dmy;
                        if (dir == 0) { half_bcast(xAr, eAr, dmy); half_bcast(xAi, eAi, dmy); half_bcast(xBr, eBr, dmy); half_bcast(xBi, eBi, dmy); }
                        else { half_bcast(xAr, dmy, eAr); half_bcast(xAi, dmy, eAi); half_bcast(xBr, dmy, eBr); half_bcast(xBi, dmy, eBi); }
                        if (lead) { eAr = 0.f; eAi = 0.f; eBr = 0.f; eBi = 0.f; }
                        { const int i0 = 4 * gg + (dir == 0 ? 0 : 3), i1 = 4 * gg + (dir == 0 ? 1 : 2), i2 = 4 * gg + (dir == 0 ? 2 : 1), i3 = 4 * gg + (dir == 0 ? 3 : 0);
                          acc[0][i0] += a1Ar * eAr - a1Ai * eAi; acc[2][i0] += a1Ar * eAi + a1Ai * eAr; acc[1][i0] += a1Br * eBr - a1Bi * eBi; acc[3][i0] += a1Br * eBi + a1Bi * eBr;
                          acc[0][i1] += a2Ar * eAr - a2Ai * eAi; acc[2][i1] += a2Ar * eAi + a2Ai * eAr; acc[1][i1] += a2Br * eBr - a2Bi * eBi; acc[3][i1] += a2Br * eBi + a2Bi * eBr;
                          acc[0][i2] += a3Ar * eAr - a3Ai * eAi; acc[2][i2] += a3Ar * eAi + a3Ai * eAr; acc[1][i2] += a3Br * eBr - a3Bi * eBi; acc[3][i2] += a3Br * eBi + a3Bi * eBr;
                          acc[0][i3] += a4Ar * eAr - a4Ai * eAi; acc[2][i3] += a4Ar * eAi + a4Ai * eAr; acc[1][i3] += a4Br * eBr - a4Bi * eBi; acc[3][i3] += a4Br * eBi + a4Bi * eBr;
                          const float tAr = acc[0][i3], tAi = acc[2][i3], tBr = acc[1][i3], tBi = acc[3][i3];
                          float dm2;
                          if (dir == 0) { half_bcast(tAr, dm2, hAr); half_bcast(tAi, dm2, hAi); half_bcast(tBr, dm2, hBr); half_bcast(tBi, dm2, hBi); }
                          else { half_bcast(tAr, hAr, dm2); half_bcast(tAi, hAi, dm2); half_bcast(tBr, hBr, dm2); half_bcast(tBi, hBi, dm2); } }
                    }
#pragma unroll
                    for (int i = 0; i < 16; ++i) { const int ro = (8 * (i >> 2) + (i & 3)) * S5_HROW;
                        *(LAS unsigned*)(hwr + ro) = pk_bf16(acc[0][i], acc[1][i]); *(LAS unsigned*)(hwr + ro + 128) = pk_bf16(acc[2][i], acc[3][i]); }
                    CFENCE(); LDS_WAIT(); CFENCE();
#pragma unroll
                    for (int mb = 0; mb < 2; ++mb)
#pragma unroll
                        for (int ks = 0; ks < 4; ++ks) { const bf16x8 af = *(const LAS bf16x8*)(hrd + mb * 16 * S5_HROW + 64 * ks);
                            yacc[sb * 2 + mb] = __builtin_amdgcn_mfma_f32_16x16x32_bf16(af, Cf[ks], yacc[sb * 2 + mb], 0, 0, 0); }
                    CFENCE(); LDS_WAIT(); CFENCE();
                }
            }
            if (!PC) {
                float s0Ar, s0Ai, s0Br, s0Bi, s1Ar, s1Ai, s1Br, s1Bi;
                half_bcast(hAr, s0Ar, s1Ar); half_bcast(hAi, s0Ai, s1Ai); half_bcast(hBr, s0Br, s1Br); half_bcast(hBi, s0Bi, s1Bi);
                float eAr, eAi, eBr, eBi;
                if (dir == 0) { eAr = a4Ar * s0Ar - a4Ai * s0Ai + s1Ar; eAi = a4Ar * s0Ai + a4Ai * s0Ar + s1Ai; eBr = a4Br * s0Br - a4Bi * s0Bi + s1Br; eBi = a4Br * s0Bi + a4Bi * s0Br + s1Bi; }
                else { eAr = a4Ar * s1Ar - a4Ai * s1Ai + s0Ar; eAi = a4Ar * s1Ai + a4Ai * s1Ar + s0Ai; eBr = a4Br * s1Br - a4Bi * s1Bi + s0Br; eBi = a4Br * s1Bi + a4Bi * s1Br + s0Bi; }
                if (hh == 0) { *(f32x2n*)(E + eoff + 2 * l32) = (f32x2n){eAr, eBr}; *(f32x2n*)(E + eoff + 64 + 2 * l32) = (f32x2n){eAi, eBi}; }
            }
        }
        CFENCE(); LDS_WAIT(); CFENCE();
        if (PC) {
#pragma unroll
            for (int j = 0; j < 8; ++j)
#pragma unroll
                for (int i = 0; i < 4; ++i) { LAS bf16_t* up = (LAS bf16_t*)(H + S5_UOFF + (4 * q16) * S5_UROW + l16 * 2 + (j * 16 + i) * S5_UROW);
                    const float y = yacc[j][i] + dsk * bf2f(*up); *up = f2bf(gelu_tanh(y)); }
            CFENCE(); LDS_WAIT(); CFENCE();
#pragma unroll
            for (int k = 0; k < 4; ++k) { const int idx = lane + 64 * k, tk = idx >> 1, hf = idx & 1;
                const u32x4 v = *(const LAS u32x4*)(H + S5_UOFF + tk * S5_UROW + hf * 16);
                *(u32x4*)(gout + (size_t)(tok0 + tk) * D + g * 16 + hf * 8) = v; }
            CFENCE(); LDS_WAIT(); CFENCE();
        }
    }
}
__device__ __forceinline__ void s5_carry(const P& p) {
    int tid_ = threadIdx.x; asm volatile("" : "+v"(tid_));
    const int idx = blockIdx.x * NTHREADS + tid_;
    if (idx >= 2 * NSEQ * 64 * 64) return;
    const int pp = idx & 63, g = (idx >> 6) & 63, s = (idx >> 12) % NSEQ, dir = idx / (NSEQ * 4096);
    const float* ab = (const float*)(p.ws + WS_ABAR);
    float Ar = ab[((dir * 64 + g) * 64 + pp) * 2], Ai = ab[((dir * 64 + g) * 64 + pp) * 2 + 1];
#pragma unroll
    for (int k = 0; k < 7; ++k) { const float nr = Ar * Ar - Ai * Ai, ni = 2.0f * Ar * Ai; Ar = nr; Ai = ni; }
    const int c0 = s < 2 ? s * 128 : 256 + (s - 2) * 16, n = s < 2 ? 128 : 16;
    float* E = (float*)(p.ws + WS_S5E);
    float rr = 0.f, ri = 0.f;
    for (int i0 = 0; i0 < n; i0 += 16) {
        float er[16], ei[16];
#pragma unroll
        for (int k = 0; k < 16; ++k) { const int i = i0 + k, c = dir == 0 ? c0 + i : c0 + n - 1 - i; const size_t ad = (((size_t)dir * S5_NCH + c) * 64 + g) * 128 + pp; er[k] = E[ad]; ei[k] = E[ad + 64]; }
#pragma unroll
        for (int k = 0; k < 16; ++k) { const int i = i0 + k, c = dir == 0 ? c0 + i : c0 + n - 1 - i; const size_t ad = (((size_t)dir * S5_NCH + c) * 64 + g) * 128 + pp;
            E[ad] = rr; E[ad + 64] = ri; const float nr = Ar * rr - Ai * ri + er[k], ni = Ar * ri + Ai * rr + ei[k]; rr = nr; ri = ni; }
    }
}

constexpr int GQ = 0, GK = 17408, GKT = 34816, GVT = 53248, GSC = 90112, GA1 = 99328, GSUM = 103424, GEL = 105472, GRMS = 105984, GRSTD = 108032, GW2 = 108288;
constexpr int QST = 272, TST = 144, VST = 576;
__device__ __forceinline__ void gla_item_coords(int j, int& hd, int& tokbase) {
    hd = j & 3; const int q = j >> 2;
    if (q < 32) tokbase = (q >> 4) * 16384 + (q & 15) * 1024; else tokbase = T_PROMPT + ((q - 32) >> 1) * 2048 + ((q - 32) & 1) * 1024;
}
template <int MODE>
__device__ __forceinline__ void gla_phase(const P& p, LAS unsigned char* lds) {
    int tid_ = threadIdx.x; asm volatile("" : "+v"(tid_));
    const int tid = tid_, lane = tid & 63, w = __builtin_amdgcn_readfirstlane(tid >> 6), hh = lane >> 5, l32 = lane & 31;
    const int chan = tid & 127, tg = w >> 1;
    const bf16_t* proj = (const bf16_t*)(p.ws + WS_BIG);
    const float* a1b = (const float*)(p.ws + WS_A1);
    bf16_t* hb = (bf16_t*)(p.ws + WS_HBUF);
    float* sbuf = (float*)(p.ws + WS_SBUF); float* dtot = (float*)(p.ws + WS_DTOT);
    LAS unsigned char* const qfrag = lds + GQ + l32 * QST + 16 * hh;
    LAS unsigned char* const kfrag = lds + GK + l32 * QST + 16 * hh;
    LAS unsigned char* const qperm = lds + GQ + l32 * QST + 8 * hh;
    LAS unsigned char* const ktfrag = lds + GKT + l32 * TST + 16 * hh;
    LAS unsigned char* const vtr = lds + GVT + (8 * hh + ((lane & 15) >> 2)) * VST + (32 * w + 16 * ((lane >> 4) & 1) + 4 * (lane & 3)) * 2;
    LAS unsigned char* const scfrag = lds + GSC + l32 * TST + 16 * hh;
    LAS unsigned char* const otw = lds + GVT + (4 * hh) * VST + (32 * w + l32) * 2;
    LAS unsigned char* const scst = lds + GSC + (4 * hh) * TST + l32 * 2;
    LAS unsigned char* const elrd = lds + GEL + 16 * hh;
    LAS unsigned char* const rmsw = lds + GRMS + (4 * hh) * 32 + w * 4;
    LAS unsigned char* const rstdr = lds + GRSTD + (4 * hh) * 4;
    LAS unsigned char* const qprep = lds + GQ + (16 * tg) * QST + chan * 2;
    LAS unsigned char* const kprep = lds + GK + (16 * tg) * QST + chan * 2;
    LAS unsigned char* const a1rd = lds + GA1 + (16 * tg) * 64;
    const LAS float* const w2p = (const LAS float*)(lds + GW2) + chan;
    const int nitems = MODE == 0 ? 384 : 192;
    for (int it = blockIdx.x; it < nitems; it += gridDim.x) {
        const int dir = MODE == 0 ? it / 192 : (MODE == 1 ? 0 : 1);
        const int j = MODE == 0 ? it % 192 : it, full = dir * 192 + j;
        int hd, tokbase; gla_item_coords(j, hd, tokbase);
        __syncthreads();
        for (int i = tid; i < 16 * 128; i += NTHREADS) ((LAS float*)(lds + GW2))[i] = p.in[19][(size_t)(dir * 16 + (i >> 7)) * 512 + hd * 128 + (i & 127)];
        const float bias = p.in[20][dir * 512 + hd * 128 + chan];
        f32x16 S[4];
        float* const sb0 = sbuf + (size_t)full * 32768 + 32 * w; const int svo = (4 * hh) * 256 + l32;
#pragma unroll
        for (int cb = 0; cb < 4; ++cb)
#pragma unroll
            for (int i = 0; i < 16; ++i) S[cb][i] = MODE == 0 ? 0.f : (sb0 + (32 * cb + 8 * (i >> 2) + (i & 3)) * 256)[svo];
        float dsum = 0.f;
        u32x4 pq[2], pk[2], pv[4]; f32x4 pa = (f32x4){0.f, 0.f, 0.f, 0.f};
        const int qko = (tid >> 4) * PROJ_N + hd * 128 + (tid & 15) * 8;
        const int vo = (tid >> 5) * PROJ_N + 1024 + hd * 256 + (tid & 31) * 8;
        const int ao = (tid >> 2) * 32 + dir * 16 + (tid & 3) * 4;
#define GLA_LOAD(tbx) do { const bf16_t* pb_ = proj + (size_t)(tbx) * PROJ_N; \
            _Pragma("unroll") for (int i = 0; i < 2; ++i) { if (MODE != 0) pq[i] = *(const u32x4*)(pb_ + (size_t)i * 32 * PROJ_N + qko); pk[i] = *(const u32x4*)(pb_ + (size_t)i * 32 * PROJ_N + 512 + qko); } \
            _Pragma("unroll") for (int i = 0; i < 4; ++i) pv[i] = *(const u32x4*)(pb_ + (size_t)i * 16 * PROJ_N + vo); \
            if (tid < 256) pa = *(const f32x4*)(a1b + (size_t)(tbx) * 32 + ao); } while (0)
        { int tb0 = tokbase + (dir == 0 ? 0 : 15) * 64; GLA_LOAD(tb0); }
        for (int ci = 0; ci < 16; ++ci) {
            int tb = tokbase + (dir == 0 ? ci : 15 - ci) * 64; asm volatile("" : "+s"(tb));
            int tbn = tokbase + (dir == 0 ? ci + 1 : 14 - ci) * 64; asm volatile("" : "+s"(tbn));
            { LAS unsigned char* const qs = lds + GQ + (tid >> 4) * QST + (tid & 15) * 16;
#pragma unroll
              for (int i = 0; i < 2; ++i) { if (MODE != 0) *(LAS u32x4*)(qs + i * 32 * QST) = pq[i]; *(LAS u32x4*)(qs + (GK - GQ) + i * 32 * QST) = pk[i]; } }
            { LAS unsigned char* const vs = lds + GVT + (tid >> 5) * VST + (tid & 31) * 16;
#pragma unroll
              for (int i = 0; i < 4; ++i) *(LAS u32x4*)(vs + i * 16 * VST) = pv[i]; }
            if (tid < 256) *(LAS f32x4*)(lds + GA1 + (tid >> 2) * 64 + (tid & 3) * 16) = pa;
            __syncthreads();
            if (ci + 1 < 16) GLA_LOAD(tbn);
            float zc[16];
#pragma unroll
            for (int i = 0; i < 16; ++i) { const LAS f32x4* ap = (const LAS f32x4*)(a1rd + i * 64);
                float z = bias;
#pragma unroll
                for (int r4 = 0; r4 < 4; ++r4) { const f32x4 av = ap[r4]; z += av[0] * w2p[(4 * r4) * 128] + av[1] * w2p[(4 * r4 + 1) * 128] + av[2] * w2p[(4 * r4 + 2) * 128] + av[3] * w2p[(4 * r4 + 3) * 128]; }
                zc[i] = (fminf(z, 0.f) - __logf(1.0f + __expf(-fabsf(z)))) * (1.0f / 16.0f); }
            if (dir == 0) {
#pragma unroll
                for (int i = 1; i < 16; ++i) zc[i] += zc[i - 1];
            } else {
#pragma unroll
                for (int i = 14; i >= 0; --i) zc[i] += zc[i + 1];
            }
            ((LAS float*)(lds + GSUM))[tg * 128 + chan] = dir == 0 ? zc[15] : zc[0];
            __syncthreads();
            float blast, off;
            { const LAS float* gs = (const LAS float*)(lds + GSUM) + chan; const float g0 = gs[0], g1 = gs[128], g2 = gs[256], g3 = gs[384];
                blast = (g0 + g1) + (g2 + g3);
                if (dir == 0) off = (tg > 0 ? g0 : 0.f) + (tg > 1 ? g1 : 0.f) + (tg > 2 ? g2 : 0.f);
                else off = (tg < 3 ? g3 : 0.f) + (tg < 2 ? g2 : 0.f) + (tg < 1 ? g1 : 0.f); }
            {
                float kt[16];
#pragma unroll
                for (int i = 0; i < 16; ++i) { const float bc = zc[i] + off;
                    LAS bf16_t* qp = (LAS bf16_t*)(qprep + i * QST); LAS bf16_t* kp = (LAS bf16_t*)(kprep + i * QST);
                    const float kv = bf2f(*kp);
                    if (MODE != 0) { const float qv = bf2f(*qp); *qp = f2bf(qv * __expf(bc) * 0.08838834764831845f); *kp = f2bf(kv * __expf(-bc)); }
                    kt[i] = kv * __expf(blast - bc); }
                u32x4 k0, k1; k0.x = pk_bf16(kt[0], kt[1]); k0.y = pk_bf16(kt[2], kt[3]); k0.z = pk_bf16(kt[4], kt[5]); k0.w = pk_bf16(kt[6], kt[7]);
                k1.x = pk_bf16(kt[8], kt[9]); k1.y = pk_bf16(kt[10], kt[11]); k1.z = pk_bf16(kt[12], kt[13]); k1.w = pk_bf16(kt[14], kt[15]);
                *(LAS u32x4*)(lds + GKT + chan * TST + tg * 32) = k0; *(LAS u32x4*)(lds + GKT + chan * TST + tg * 32 + 16) = k1;
            }
            if (tg == 0) { ((LAS float*)(lds + GEL))[chan] = __expf(blast); dsum += blast; }
            __syncthreads();
            if (MODE != 0) {
                if (w < 4) { const int mb = w >> 1, nb = w & 1; f32x16 sc;
#pragma unroll
                    for (int i = 0; i < 16; ++i) sc[i] = 0.f;
#pragma unroll
                    for (int ks = 0; ks < 8; ++ks) { const bf16x8 a = *(const LAS bf16x8*)(qfrag + mb * 32 * QST + 32 * ks), bq = *(const LAS bf16x8*)(kfrag + nb * 32 * QST + 32 * ks);
                        sc = __builtin_amdgcn_mfma_f32_32x32x16_bf16(a, bq, sc, 0, 0, 0); }
                    const int dlt = (nb - mb) * 32 + l32 - 4 * hh;
                    LAS unsigned char* const sw = scst + mb * 32 * TST + nb * 64;
#pragma unroll
                    for (int i = 0; i < 16; ++i) { const int cst = 8 * (i >> 2) + (i & 3); const bool keep = dir == 0 ? (dlt <= cst) : (dlt >= cst);
                        *(LAS bf16_t*)(sw + cst * TST) = f2bf(keep ? sc[i] : 0.f); }
                }
                __syncthreads();
            }
            bf16x8 vf[4];
#pragma unroll
            for (int ks = 0; ks < 4; ++ks) { union { struct { bf16x4 lo, hi; } s; bf16x8 v; } vv;
                vv.s.lo = __builtin_amdgcn_ds_read_tr16_b64_v4i16((LAS bf16x4*)(vtr + (16 * ks) * VST));
                vv.s.hi = __builtin_amdgcn_ds_read_tr16_b64_v4i16((LAS bf16x4*)(vtr + (16 * ks + 4) * VST));
                vf[ks] = vv.v; }
            if (MODE != 0) {
                __syncthreads();
#pragma unroll
                for (int mb = 0; mb < 2; ++mb) {
                    f32x16 o;
#pragma unroll
                    for (int i = 0; i < 16; ++i) o[i] = 0.f;
#pragma unroll
                    for (int ks = 0; ks < 4; ++ks) { const bf16x8 a = *(const LAS bf16x8*)(scfrag + mb * 32 * TST + 32 * ks);
                        o = __builtin_amdgcn_mfma_f32_32x32x16_bf16(a, vf[ks], o, 0, 0, 0); }
#pragma unroll
                    for (int cb = 0; cb < 4; ++cb)
#pragma unroll
                        for (int h2 = 0; h2 < 2; ++h2) {
                            union { u32x4 u; bf16x8 v; } sb_;
                            sb_.u.x = pk_bf16(S[cb][8 * h2 + 0], S[cb][8 * h2 + 1]); sb_.u.y = pk_bf16(S[cb][8 * h2 + 2], S[cb][8 * h2 + 3]);
                            sb_.u.z = pk_bf16(S[cb][8 * h2 + 4], S[cb][8 * h2 + 5]); sb_.u.w = pk_bf16(S[cb][8 * h2 + 6], S[cb][8 * h2 + 7]);
                            const LAS unsigned char* base = qperm + mb * 32 * QST + (32 * cb + 16 * h2) * 2;
                            union { struct { u32x2 lo, hi; } s; bf16x8 v; } qa; qa.s.lo = *(const LAS u32x2*)base; qa.s.hi = *(const LAS u32x2*)(base + 16);
                            o = __builtin_amdgcn_mfma_f32_32x32x16_bf16(qa.v, sb_.v, o, 0, 0, 0);
                        }
#pragma unroll
                    for (int i = 0; i < 16; ++i) *(LAS bf16_t*)(otw + (32 * mb + 8 * (i >> 2) + (i & 3)) * VST) = f2bf(o[i]);
                    CFENCE();
                }
            }
            u32x4 of[4], rr[4];
            if (MODE == 2) {
                const bf16_t* const og2 = hb + (size_t)(tb + (tid >> 5)) * D + hd * 256 + (tid & 31) * 8;
                const bf16_t* const rg = proj + (size_t)(tb + (tid >> 5)) * PROJ_N + 2048 + hd * 256 + (tid & 31) * 8;
#pragma unroll
                for (int i = 0; i < 4; ++i) { of[i] = *(const u32x4*)(og2 + (size_t)(16 * i) * D); rr[i] = *(const u32x4*)(rg + (size_t)(16 * i) * PROJ_N); }
            }
#pragma unroll
            for (int cb = 0; cb < 4; ++cb) {
#pragma unroll
                for (int i4 = 0; i4 < 4; ++i4) { const f32x4 e = *(const LAS f32x4*)(elrd + (32 * cb + 8 * i4) * 4);
                    S[cb][4 * i4 + 0] *= e[0]; S[cb][4 * i4 + 1] *= e[1]; S[cb][4 * i4 + 2] *= e[2]; S[cb][4 * i4 + 3] *= e[3]; }
#pragma unroll
                for (int ks = 0; ks < 4; ++ks) { const bf16x8 a = *(const LAS bf16x8*)(ktfrag + cb * 32 * TST + 32 * ks);
                    S[cb] = __builtin_amdgcn_mfma_f32_32x32x16_bf16(a, vf[ks], S[cb], 0, 0, 0); }
            }
            __syncthreads();
            if (MODE != 0) {
                u32x4 ob[4];
#pragma unroll
                for (int i = 0; i < 4; ++i) ob[i] = *(const LAS u32x4*)(lds + GVT + ((tid >> 5) + 16 * i) * VST + (tid & 31) * 16);
                bf16_t* const og = hb + (size_t)(tb + (tid >> 5)) * D + hd * 256 + (tid & 31) * 8;
                if (MODE == 1) {
#pragma unroll
                    for (int i = 0; i < 4; ++i) *(u32x4*)(og + (size_t)(16 * i) * D) = ob[i];
                } else {
                    const f32x4 ng0 = *(const f32x4*)(p.in[21] + hd * 256 + (tid & 31) * 8), ng1 = *(const f32x4*)(p.in[21] + hd * 256 + (tid & 31) * 8 + 4);
#pragma unroll
                    for (int i = 0; i < 4; ++i) {
                        float ov[8]; float sq = 0.f;
#pragma unroll
                        for (int e = 0; e < 4; ++e) { ov[2 * e] = __uint_as_float(ob[i][e] << 16) + __uint_as_float(of[i][e] << 16); ov[2 * e + 1] = __uint_as_float(ob[i][e] & 0xffff0000u) + __uint_as_float(of[i][e] & 0xffff0000u);
                            sq += ov[2 * e] * ov[2 * e] + ov[2 * e + 1] * ov[2 * e + 1]; }
#pragma unroll
                        for (int sh = 1; sh < 32; sh <<= 1) sq += __shfl_xor(sq, sh);
                        const float rs = rsqrtf(sq * (1.0f / 256.0f) + EPS);
                        u32x4 wv;
#pragma unroll
                        for (int e = 0; e < 4; ++e) { const float r0 = __uint_as_float(rr[i][e] << 16), r1 = __uint_as_float(rr[i][e] & 0xffff0000u);
                            const float g0 = e < 2 ? ng0[2 * e] : ng1[2 * e - 4], g1 = e < 2 ? ng0[2 * e + 1] : ng1[2 * e - 3];
                            wv[e] = pk_bf16(ov[2 * e] * rs * g0 * (r0 * sigmoidf_(r0)), ov[2 * e + 1] * rs * g1 * (r1 * sigmoidf_(r1))); }
                        *(u32x4*)(og + (size_t)(16 * i) * D) = wv;
                    }
                }
                __syncthreads();
            }
        }
#undef GLA_LOAD
        if (MODE == 0) {
#pragma unroll
            for (int cb = 0; cb < 4; ++cb)
#pragma unroll
                for (int i = 0; i < 16; ++i) (sb0 + (32 * cb + 8 * (i >> 2) + (i & 3)) * 256)[svo] = S[cb][i];
            if (tg == 0) dtot[full * 128 + chan] = dsum;
        }
    }
}
__device__ __forceinline__ void gla_carry(const P& p) {
    float* sbuf = (float*)(p.ws + WS_SBUF); const float* dtot = (const float*)(p.ws + WS_DTOT);
    const int total = 80 * 8192;
    int tid_ = threadIdx.x; asm volatile("" : "+v"(tid_));
    for (int e = blockIdx.x * NTHREADS + tid_; e < total; e += gridDim.x * NTHREADS) {
        const int e4 = e & 8191, ch = e >> 13, hd = ch & 3, s = (ch >> 2) % NSEQ, dir = ch / (4 * NSEQ);
        const int n = s < 2 ? 16 : 2, q0 = s < 2 ? s * 16 : 32 + (s - 2) * 2, chan = e4 >> 6;
        f32x4 run = (f32x4){0.f, 0.f, 0.f, 0.f};
        float* const base = sbuf + (size_t)e4 * 4;
        if (n == 16) {
            f32x4 tmp[16]; float dcy[16];
#pragma unroll
            for (int i = 0; i < 16; ++i) { const int sc = dir == 0 ? i : 15 - i, full = dir * 192 + (q0 + sc) * 4 + hd; tmp[i] = *(const f32x4*)(base + (size_t)full * 32768); dcy[i] = dtot[full * 128 + chan]; }
#pragma unroll
            for (int i = 0; i < 16; ++i) { const int sc = dir == 0 ? i : 15 - i, full = dir * 192 + (q0 + sc) * 4 + hd; *(f32x4*)(base + (size_t)full * 32768) = run; run = run * __expf(dcy[i]) + tmp[i]; }
        } else {
            for (int i = 0; i < n; ++i) { const int sc = dir == 0 ? i : n - 1 - i, full = dir * 192 + (q0 + sc) * 4 + hd;
                f32x4* ptr = (f32x4*)(base + (size_t)full * 32768); const float dcy = __expf(dtot[full * 128 + chan]);
                const f32x4 tmp = *ptr; *ptr = run; run = run * dcy + tmp; }
        }
    }
}

#define XB_TMO      128
#define XB_XCNT(j)  (256  + 64 * (j))
#define XB_XSUB(j)  (1280 + 64 * (j))
#define XB_XGEN(j)  (2304 + 64 * (j))
#define XB_TOP      3328
#define XB_TOPGEN   3392
#define XCD_BAR_WORDS 3456
#define XB_SPIN_CAP (1u << 18)

__device__ __forceinline__ unsigned xb_ld(unsigned* p)              { return __hip_atomic_load(p, __ATOMIC_RELAXED, __HIP_MEMORY_SCOPE_AGENT); }
__device__ __forceinline__ unsigned xb_add(unsigned* p, unsigned v) { return __hip_atomic_fetch_add(p, v, __ATOMIC_RELAXED, __HIP_MEMORY_SCOPE_AGENT); }
__device__ __forceinline__ unsigned xb_xcc_id() { return (unsigned)__builtin_amdgcn_s_getreg((3 << 11) | 20) & 0xFu; }
#define XB_SPIN(cond, bar) do { unsigned _sp = 0; while (cond) { __builtin_amdgcn_s_sleep(1); \
    if ((++_sp & 255u) == 0u) { if (xb_ld(&(bar)[XB_TMO])) break; if (_sp > XB_SPIN_CAP) { atomicAdd(&(bar)[XB_TMO], 1u); break; } } } } while (0)

struct XcdBarrier {
    unsigned* bar; unsigned x;
    volatile LAS unsigned* st;
};

__device__ __forceinline__ XcdBarrier xcd_barrier_post(unsigned* bar, volatile LAS unsigned* st) {
    XcdBarrier b; b.bar = bar; b.x = xb_xcc_id(); b.st = st;
    if (threadIdx.x == 0) (void)xb_add(&bar[XB_XCNT(b.x)], 1u);
    return b;
}
__device__ __forceinline__ void xcd_barrier_complete(unsigned* bar, unsigned x, unsigned& nloc, unsigned& nx) {
    const unsigned G = gridDim.x * gridDim.y * gridDim.z;
    unsigned sum, cnt, mine, sp = 0u;
    for (;;) {
        sum = 0u; cnt = 0u; mine = 0u;
#pragma unroll
        for (unsigned j = 0; j < 16; ++j) { const unsigned c = xb_ld(&bar[XB_XCNT(j)]); sum += c; cnt += (c > 0u) ? 1u : 0u; mine = (j == x) ? c : mine; }
        if (sum == G) break;
        __builtin_amdgcn_s_sleep(1);
        if ((++sp & 255u) == 0u) { if (xb_ld(&bar[XB_TMO])) break; if (sp > XB_SPIN_CAP) { atomicAdd(&bar[XB_TMO], 1u); break; } }
    }
    nloc = mine > 0u ? mine : 1u; nx = cnt > 0u ? cnt : 1u;
}

__device__ __forceinline__ void xcd_barrier(const XcdBarrier& b) {
    asm volatile("s_waitcnt vmcnt(0)" ::: "memory");
    __syncthreads();
    if (threadIdx.x == 0) {
        unsigned* bar = b.bar;
        __builtin_amdgcn_s_waitcnt(0);
        unsigned nloc = b.st[0], nx = b.st[1];
        if (nloc == 0u) { xcd_barrier_complete(bar, b.x, nloc, nx); b.st[0] = nloc; b.st[1] = nx; }
        const unsigned old = xb_add(&bar[XB_XSUB(b.x)], 1u);
        const unsigned gen = old / nloc;
        if (old + 1u == (gen + 1u) * nloc) {
            __builtin_amdgcn_fence(__ATOMIC_RELEASE, "agent");
            asm volatile("s_waitcnt vmcnt(0)" ::: "memory");
            const unsigned og = xb_add(&bar[XB_TOP], 1u);
            const unsigned tg = og / nx;
            if (og + 1u == (tg + 1u) * nx) xb_add(&bar[XB_TOPGEN], 1u);
            else XB_SPIN(xb_ld(&bar[XB_TOPGEN]) == tg, bar);
            __builtin_amdgcn_fence(__ATOMIC_ACQUIRE, "agent");
            xb_add(&bar[XB_XGEN(b.x)], 1u);
            asm volatile("s_waitcnt vmcnt(0)" ::: "memory");
        } else {
            XB_SPIN(xb_ld(&bar[XB_XGEN(b.x)]) == gen, bar);
            __builtin_amdgcn_fence(__ATOMIC_ACQUIRE, "agent");
            asm volatile("s_waitcnt vmcnt(0)" ::: "memory");
        }
    }
    __syncthreads();
}

#define GRID_BAR() xcd_barrier(bar)

template <int L, int SL>
__device__ __forceinline__ void mlp_up(const P& p, LAS unsigned char* lds) {
    unsigned char* ws = p.ws;
    bf16_t* hb = (bf16_t*)(ws + WS_HBUF); bf16_t* hid = (bf16_t*)(ws + WS_BIG + (size_t)(SL & 1) * 128 * MiB);
    const bf16_t* w1 = (const bf16_t*)(ws + (L ? WS_W1B : WS_W1A));
    pg8::Gemm g{hb + (size_t)SL * 16384 * D, w1, 16384, FF, D}; pg8::StaticOrder S; S.init(16384, FF, gridDim.x, blockIdx.x);
    EpiBf<1> E{hid, FF, nullptr};
    if (PH & 4096) pg8::gemm_phase<EpiBf<1>, pg8::StaticOrder>(lds, g, S, E, nullptr);
}
template <int L, int SL>
__device__ __forceinline__ void mlp_down(const P& p, LAS unsigned char* lds) {
    unsigned char* ws = p.ws;
    const float* ml = (const float*)(ws + WS_MOD) + (size_t)L * NSEQ * NMODC;
    bf16_t* hid = (bf16_t*)(ws + WS_BIG + (size_t)(SL & 1) * 128 * MiB);
    const bf16_t* w2 = (const bf16_t*)(ws + (L ? WS_W2B : WS_W2A));
    pg8::Gemm g{hid, w2, 16384, D, FF}; pg8::StaticOrder S; S.init(16384, D, gridDim.x, blockIdx.x);
    EpiRes E{p.out, ml + 5 * D, SL * 16384};
    if (PH & 8192) pg8::gemm_phase<EpiRes, pg8::StaticOrder>(lds, g, S, E, nullptr);
}
template <int L>
__device__ __forceinline__ void mlp_block(const P& p, LAS unsigned char* lds, const XcdBarrier& bar) {
    const float* ml = (const float*)(p.ws + WS_MOD) + (size_t)L * NSEQ * NMODC;
    norm_phase<1, false>(p, p.in[7] + L * D, ml + 3 * D, ml + 4 * D);
    GRID_BAR();
    mlp_up<L, 0>(p, lds);
    GRID_BAR();
    mlp_down<L, 0>(p, lds); mlp_up<L, 1>(p, lds);
    GRID_BAR();
    mlp_down<L, 1>(p, lds); mlp_up<L, 2>(p, lds);
    GRID_BAR();
    mlp_down<L, 2>(p, lds);
    GRID_BAR();
}

__global__ void __launch_bounds__(NTHREADS, 2) hybrid_fwd(P p) {
    extern __shared__ __attribute__((aligned(16))) unsigned char lds_raw[];
    LAS unsigned char* lds = (LAS unsigned char*)lds_raw;
    cg::grid_group grid = cg::this_grid();
    unsigned char* ws = p.ws;
    const float* mod = (const float*)(ws + WS_MOD);
    bf16_t* hb = (bf16_t*)(ws + WS_HBUF);
    bf16_t* big = (bf16_t*)(ws + WS_BIG);

    volatile LAS unsigned* bst = (volatile LAS unsigned*)(lds + LDS_BYTES - 16);
    if (threadIdx.x < 2) bst[threadIdx.x] = 0u;
    if (blockIdx.x == 0) for (int i = threadIdx.x; i < XCD_BAR_WORDS; i += NTHREADS) ((unsigned*)(ws + WS_BARW))[i] = 0u;
    __syncthreads();
    grid.sync();
    const XcdBarrier bar = xcd_barrier_post((unsigned*)(ws + WS_BARW), bst);
    if (PH & 1) p0_prep(p, lds);
    GRID_BAR();
    if (PH & 2) norm_phase<0, false>(p, p.in[6], mod + 0 * D, mod + 1 * D);
    GRID_BAR();
    if (PH & 4) s5_pass<false>(p, lds);
    GRID_BAR();
    if (PH & 8) s5_carry(p);
    GRID_BAR();
    if (PH & 16) s5_pass<true>(p, lds);
    GRID_BAR();
#if (DUP & 1)
    if (PH & 4) s5_pass<false>(p, lds);
    GRID_BAR();
    if (PH & 8) s5_carry(p);
    GRID_BAR();
    if (PH & 16) s5_pass<true>(p, lds);
    GRID_BAR();
#endif
    { pg8::Gemm g{big, (const bf16_t*)(ws + WS_WGLU), T, 2 * D, D}; pg8::StaticOrder S; S.init(T, 2 * D, gridDim.x, blockIdx.x);
      EpiGlu E{p.in[0], p.in[1], p.out, mod + 2 * D};
      if (PH & 512) pg8::gemm_phase<EpiGlu, pg8::StaticOrder>(lds, g, S, E, nullptr);
#if (DUP & 8)
      GRID_BAR(); pg8::gemm_phase<EpiGlu, pg8::StaticOrder>(lds, g, S, E, nullptr);
      GRID_BAR(); pg8::gemm_phase<EpiGlu, pg8::StaticOrder>(lds, g, S, E, nullptr);
      GRID_BAR(); pg8::gemm_phase<EpiGlu, pg8::StaticOrder>(lds, g, S, E, nullptr);
#endif
    }
    GRID_BAR();
    mlp_block<0>(p, lds, bar);
    norm_phase<1, false>(p, p.in[6] + D, mod + (size_t)NSEQ * NMODC + 0 * D, mod + (size_t)NSEQ * NMODC + 1 * D);
    GRID_BAR();
    { pg8::Gemm g{hb, (const bf16_t*)(ws + WS_WIN), T, WIN_N, D}; pg8::StaticOrder S; S.init(T, WIN_N, gridDim.x, blockIdx.x);
      EpiBf<0> E{big, PROJ_N, (float*)(ws + WS_A1)};
      if (PH & 1024) pg8::gemm_phase<EpiBf<0>, pg8::StaticOrder>(lds, g, S, E, nullptr); }
    GRID_BAR();
    if (PH & 32) gla_phase<0>(p, lds);
    GRID_BAR();
    if (PH & 64) gla_carry(p);
    GRID_BAR();
    if (PH & 128) gla_phase<1>(p, lds);
    GRID_BAR();
#if (DUP & 2)
    if (PH & 32) gla_phase<0>(p, lds);
    GRID_BAR();
    if (PH & 64) gla_carry(p);
    GRID_BAR();
    if (PH & 128) gla_phase<1>(p, lds);
    GRID_BAR();
#endif
    if (PH & 256) gla_phase<2>(p, lds);
    GRID_BAR();
    { pg8::Gemm g{hb, (const bf16_t*)(ws + WS_WOUT), T, D, D}; pg8::StaticOrder S; S.init(T, D, gridDim.x, blockIdx.x);
      EpiRes E{p.out, mod + (size_t)NSEQ * NMODC + 2 * D, 0};
      if (PH & 2048) pg8::gemm_phase<EpiRes, pg8::StaticOrder>(lds, g, S, E, nullptr); }
    GRID_BAR();
    mlp_block<1>(p, lds, bar);
#if (DUP & 4)
#pragma unroll 1
    for (int rep = 0; rep < 20; ++rep) GRID_BAR();
#endif
    if (PH == 0) norm_phase<0, true>(p, p.in[25], nullptr, nullptr); else norm_phase<1, true>(p, p.in[25], nullptr, nullptr);
}

extern "C" void kernel_launch(void* const* d_in, const int* in_sizes, int n_in, void* d_out, int out_size, void* d_ws, size_t ws_size, hipStream_t stream) {
    static int grid_blocks = 0;
    if (grid_blocks == 0) {
        if (n_in != 26 || out_size != T * D || ws_size < WS_END) { fprintf(stderr, "kernel_launch: unexpected sizes n_in %d out %d ws %zu\n", n_in, out_size, ws_size); grid_blocks = -1; return; }
        int dev = 0, cus = 0, per_cu = 0;
        hipGetDevice(&dev);
        hipDeviceGetAttribute(&cus, hipDeviceAttributeMultiprocessorCount, dev);
        hipFuncSetAttribute((const void*)hybrid_fwd, hipFuncAttributeMaxDynamicSharedMemorySize, LDS_BYTES);
        hipOccupancyMaxActiveBlocksPerMultiprocessor(&per_cu, (const void*)hybrid_fwd, NTHREADS, LDS_BYTES);
        if (per_cu < 1) { fprintf(stderr, "kernel_launch: occupancy query says %d blocks per CU\n", per_cu); grid_blocks = -1; return; }
        grid_blocks = cus;
        if (grid_blocks % 8) grid_blocks -= grid_blocks % 8;
    }
    if (grid_blocks < 0) return;
    P p{};
    for (int i = 0; i < 26; ++i) p.in[i] = (const float*)d_in[i];
    p.out = (float*)d_out; p.ws = (unsigned char*)d_ws;
    void* args[] = {&p};
    hipError_t e = hipLaunchCooperativeKernel((const void*)hybrid_fwd, dim3(grid_blocks), dim3(NTHREADS), args, LDS_BYTES, stream);
    if (e != hipSuccess) fprintf(stderr, "cooperative launch failed: %s (grid %d)\n", hipGetErrorString(e), grid_blocks);
}
```

```cpp
#include <hip/hip_runtime.h>
#include <hip/hip_cooperative_groups.h>
#include <cstdio>
namespace cg = cooperative_groups;

namespace pg8 {
#define PG8_LAS __attribute__((address_space(3)))
typedef unsigned short bf16_t;
typedef short bf16x8 __attribute__((ext_vector_type(8)));
typedef float f32x4 __attribute__((ext_vector_type(4)));
typedef unsigned u32x4 __attribute__((ext_vector_type(4)));
constexpr int BM = 256, BK = 64, HALF = 128, HTB = HALF * BK * 2  , STAGE_BYTES = 8 * HTB, NXCD = 8, WGM = 8;

__host__ __device__ __forceinline__ int lds_byte(int r, int c) { const int st = (r >> 4) * 2 + (c >> 5), rr = r & 15, cc = c & 31, ob = rr * 64 + cc * 2; return st * 1024 + (ob ^ (((ob >> 9) & 1) << 5)); }
__host__ __device__ __forceinline__ void stage_rc(int b, int& R, int& C) { const int st = b / 1024, sb = b % 1024, swz = sb ^ (((sb >> 9) & 1) << 5); R = (st >> 1) * 16 + swz / 64; C = (st & 1) * 32 + (swz % 64) / 2; }
__host__ __device__ __forceinline__ int perm32(int rho) { const int n = rho >> 4, i = rho & 15; return 8 * (i >> 2) + 4 * n + (i & 3); }

struct Unit { int pm, pn; };
struct Gemm { const bf16_t* A; const bf16_t* Bt; int M, N, K; };

struct StaticOrder {
    int nM, nN, nwg, G, c;
    __host__ __device__ void init(int M, int N, int G_, int c_) { nM = M / BM; nN = N / BM; nwg = nM * nN; G = G_; c = c_; }
    __host__ __device__ bool next(int i, Unit& u) const {
        const long L = (long)i * G + c; if (L >= nwg) return false;
        int wgid = (int)L; { const int q = nwg / NXCD, r = nwg % NXCD, xcd = wgid % NXCD, off = wgid / NXCD; wgid = (xcd < r ? xcd * (q + 1) : r * (q + 1) + (xcd - r) * q) + off; }
        const int nig = WGM * nN, gid = wgid / nig, fm = gid * WGM, gsz = (nM - fm) < WGM ? (nM - fm) : WGM;
        u.pm = fm + ((wgid % nig) % gsz); u.pn = (wgid % nig) / gsz; return true;
    }
    __device__ __forceinline__ void a_ready(const Unit&) const {}
    __device__ __forceinline__ void done(const Unit&) const {}
};


template <class Epi, class Sched, bool STAMP = false>
__device__ __forceinline__ void gemm_phase(PG8_LAS unsigned char* lds, const Gemm g, const Sched& S, const Epi& E, unsigned long long* stamps) {
    int tid_ = threadIdx.x; asm volatile("" : "+v"(tid_));
    const int tid = tid_, wid = __builtin_amdgcn_readfirstlane(tid >> 6), lane = tid & 63, wr = wid >> 2, wc = wid & 3, fr = lane & 15, fq = lane >> 4;
    const int K = g.K, nt = K / BK;
    int ts_lo = 0, ts_hi = 0, nts = 0; const unsigned long long rt_entry = STAMP ? (unsigned long long)wall_clock64() : 0ull;
#define PG8_STAMP() do { if (STAMP && wid == 0 && nts < 64) { const unsigned long long _c = (unsigned long long)clock64(); \
        ts_lo = (lane == nts) ? (int)(unsigned)_c : ts_lo; ts_hi = (lane == nts) ? (int)(unsigned)(_c >> 32) : ts_hi; ++nts; } } while (0)
    PG8_STAMP();
    unsigned voffA[2], voffB[2];
#pragma unroll
    for (int i = 0; i < 2; ++i) { int R, C; stage_rc(tid * 16 + i * 8192, R, C); const int Rb = Epi::PERM ? ((R & ~31) + perm32(R & 31)) : R;
        voffA[i] = (unsigned)(R * K + C) * 2u; voffB[i] = (unsigned)(Rb * K + C) * 2u; }
    const size_t kstep = (size_t)(BK * 2);
    const size_t hstep = (size_t)HALF * K * 2;
    const size_t tstep = 2 * hstep;
    const unsigned ldsw = (unsigned)wid * 1024u;
    const int aoff = lds_byte(wr * 64 + fr, fq * 8), boff = lds_byte(wc * 32 + fr, fq * 8);
#define PG8_SA(b, h) (((b) * 2 + (h)) * HTB)
#define PG8_SB(b, h) ((4 + (b) * 2 + (h)) * HTB)
#define PG8_STAGE(bufoff, gbase, voff) do { _Pragma("unroll") for (int _i = 0; _i < 2; ++_i) \
        __builtin_amdgcn_global_load_lds((const unsigned*)((const char*)(gbase) + (voff)[_i]), (PG8_LAS unsigned*)(lds + (bufoff) + ldsw + _i * 8192), 16, 0, 0); } while (0)
#define PG8_LDA(dst, b, h) do { _Pragma("unroll") for (int m = 0; m < 4; ++m) _Pragma("unroll") for (int k = 0; k < 2; ++k) dst[m][k] = *(const PG8_LAS bf16x8*)(lds + PG8_SA(b, h) + aoff + m * 2048 + k * 1024); } while (0)
#define PG8_LDB(dst, b, h) do { _Pragma("unroll") for (int n = 0; n < 2; ++n) _Pragma("unroll") for (int k = 0; k < 2; ++k) dst[n][k] = *(const PG8_LAS bf16x8*)(lds + PG8_SB(b, h) + boff + n * 2048 + k * 1024); } while (0)
#define PG8_MMA(ai, bj, At, Bt) do { __builtin_amdgcn_s_setprio(1); _Pragma("unroll") for (int m = 0; m < 4; ++m) _Pragma("unroll") for (int n = 0; n < 2; ++n) _Pragma("unroll") for (int k = 0; k < 2; ++k) \
        acc[ai][bj][m][n] = __builtin_amdgcn_mfma_f32_16x16x32_bf16(Bt[n][k], At[m][k], acc[ai][bj][m][n], 0, 0, 0); __builtin_amdgcn_s_setprio(0); } while (0)
#define PG8_WAIT_V(n) asm volatile("s_waitcnt vmcnt(" #n ")" ::: "memory")
#define PG8_WAIT_L(n) asm volatile("s_waitcnt lgkmcnt(" #n ")" ::: "memory")
#define PG8_BAR __builtin_amdgcn_s_barrier()
#define PG8_SCHED __builtin_amdgcn_sched_barrier(0)
    Unit cur, nxt; int ui = 0;
    if (!S.next(0, cur)) return;
    f32x4 acc[2][2][4][2];
#pragma unroll
    for (int a = 0; a < 2; ++a)
#pragma unroll
        for (int b = 0; b < 2; ++b)
#pragma unroll
            for (int m = 0; m < 4; ++m)
#pragma unroll
                for (int n = 0; n < 2; ++n) acc[a][b][m][n] = (f32x4){0.f, 0.f, 0.f, 0.f};
    bf16x8 At[4][2], B0[2][2], B1[2][2];
    const char* cA = (const char*)g.A + (size_t)cur.pm * tstep; const char* cB = (const char*)g.Bt + (size_t)cur.pn * tstep;
    S.a_ready(cur);
    PG8_STAGE(PG8_SB(0, 0), cB, voffB); PG8_STAGE(PG8_SA(0, 0), cA, voffA); PG8_STAGE(PG8_SB(0, 1), cB + hstep, voffB); PG8_STAGE(PG8_SA(0, 1), cA + hstep, voffA);
    if (wr == 1) PG8_BAR;
    PG8_WAIT_V(4); PG8_BAR;
    PG8_STAGE(PG8_SB(1, 0), cB + kstep, voffB); PG8_STAGE(PG8_SA(1, 0), cA + kstep, voffA); PG8_STAGE(PG8_SB(1, 1), cB + hstep + kstep, voffB);
    PG8_WAIT_V(6); PG8_BAR;
    PG8_STAMP();
    for (;;) {
        const bool has_next = S.next(ui + 1, nxt);
        const char* nA = has_next ? (const char*)g.A + (size_t)nxt.pm * tstep : cA; const char* nB = has_next ? (const char*)g.Bt + (size_t)nxt.pn * tstep : cB;
        for (int t = 0; t < nt; t += 2) {
            const bool last = (t == nt - 2);
            const char* a1 = cA + (size_t)(t + 1) * kstep;
            const char* a2 = last ? nA : cA + (size_t)(t + 2) * kstep; const char* b2 = last ? nB : cB + (size_t)(t + 2) * kstep;
            const char* a3 = a2 + kstep; const char* b3 = b2 + kstep;
            if (last && has_next) S.a_ready(nxt);
            PG8_LDB(B0, 0, 0); PG8_SCHED; PG8_LDA(At, 0, 0); PG8_STAGE(PG8_SA(1, 1), a1 + hstep, voffA);
            PG8_WAIT_L(8); PG8_BAR; PG8_WAIT_L(0); PG8_MMA(0, 0, At, B0); PG8_BAR; PG8_SCHED;
            PG8_LDB(B1, 0, 1); PG8_STAGE(PG8_SB(0, 0), b2, voffB);
            PG8_BAR; PG8_WAIT_L(0); PG8_MMA(0, 1, At, B1); PG8_BAR;
            PG8_LDA(At, 0, 1); PG8_STAGE(PG8_SA(0, 0), a2, voffA);
            PG8_BAR; PG8_WAIT_L(0); PG8_MMA(1, 0, At, B0); PG8_BAR; PG8_SCHED;
            PG8_STAGE(PG8_SB(0, 1), b2 + hstep, voffB);
            PG8_WAIT_V(6); PG8_BAR; PG8_MMA(1, 1, At, B1); PG8_BAR;
            PG8_LDB(B0, 1, 0); PG8_SCHED; PG8_LDA(At, 1, 0); PG8_STAGE(PG8_SA(0, 1), a2 + hstep, voffA);
            PG8_WAIT_L(8); PG8_BAR; PG8_WAIT_L(0); PG8_MMA(0, 0, At, B0); PG8_BAR; PG8_SCHED;
            PG8_LDB(B1, 1, 1); PG8_STAGE(PG8_SB(1, 0), b3, voffB);
            PG8_BAR; PG8_WAIT_L(0); PG8_MMA(0, 1, At, B1); PG8_BAR;
            PG8_LDA(At, 1, 1); PG8_STAGE(PG8_SA(1, 0), a3, voffA);
            PG8_BAR; PG8_WAIT_L(0); PG8_MMA(1, 0, At, B0); PG8_BAR; PG8_SCHED;
            PG8_STAGE(PG8_SB(1, 1), b3 + hstep, voffB);
            PG8_WAIT_V(6); PG8_BAR; PG8_MMA(1, 1, At, B1); PG8_BAR;
        }
        PG8_STAMP();
        if constexpr (!Epi::AFTER_DRAIN) { E(acc, cur, wr, wc, fr, fq); S.done(cur); }
        PG8_STAMP();
        if (!has_next) break;
#pragma unroll
        for (int a = 0; a < 2; ++a)
#pragma unroll
            for (int b = 0; b < 2; ++b)
#pragma unroll
                for (int m = 0; m < 4; ++m)
#pragma unroll
                    for (int n = 0; n < 2; ++n) acc[a][b][m][n] = (f32x4){0.f, 0.f, 0.f, 0.f};
        cur = nxt; cA = nA; cB = nB; ++ui;
    }
    PG8_WAIT_V(0);
    if (wr == 0) PG8_BAR;
    PG8_BAR;
    if constexpr (Epi::AFTER_DRAIN) { E.fused(acc, cur, wr, wc, fr, fq, lds, wid, lane); S.done(cur); }
    PG8_STAMP();
    if (STAMP && wid == 0) { stamps[lane] = lane < nts ? (((unsigned long long)(unsigned)ts_hi << 32) | (unsigned)ts_lo) : 0ull;
        if (lane == 62) stamps[62] = rt_entry; if (lane == 63) stamps[63] = (unsigned long long)wall_clock64(); }
#undef PG8_STAMP
#undef PG8_SA
#undef PG8_SB
#undef PG8_STAGE
#undef PG8_LDA
#undef PG8_LDB
#undef PG8_MMA
#undef PG8_WAIT_V
#undef PG8_WAIT_L
#undef PG8_BAR
#undef PG8_SCHED
}
}


#define LAS __attribute__((address_space(3)))
typedef unsigned short bf16_t;
typedef short bf16x8 __attribute__((ext_vector_type(8)));
typedef short bf16x4 __attribute__((ext_vector_type(4)));
typedef float f32x4 __attribute__((ext_vector_type(4)));
typedef float f32x16 __attribute__((ext_vector_type(16)));
typedef unsigned u32x4 __attribute__((ext_vector_type(4)));
typedef unsigned u32x2 __attribute__((ext_vector_type(2)));

constexpr int D = 1024, T = 49152, NSEQ = 10, NMODC = 6144, FF = 4096;
constexpr int T_PROMPT = 32768;
constexpr float EPS = 1e-6f;
#ifndef PH
#define PH 16383
#endif
#ifndef DUP
#define DUP 0
#endif
#ifndef TPROBE
#define TPROBE 0
#endif
#ifndef TSEL
#define TSEL 0u
#endif
constexpr int NWAVES = 8, NTHREADS = 512;
constexpr int LDS_BYTES = 139264;
constexpr int WIN_N = 3328;
constexpr int PROJ_N = 3072;

constexpr size_t MiB = 1u << 20;
constexpr size_t WS_MOD = 0;
constexpr size_t WS_BARW = 491520;
constexpr size_t WS_STAMP = 507904;
constexpr size_t WS_ABAR = 512 * 1024;
constexpr size_t WS_BBT = 1 * MiB;
constexpr size_t WS_CT = 1 * MiB + 512 * 1024;
constexpr size_t WS_DTOT = 2 * MiB;
constexpr size_t WS_A1 = 3 * MiB;
constexpr size_t WS_WIN = 10 * MiB;
constexpr size_t WS_WOUT = WS_WIN + (size_t)WIN_N * D * 2;
constexpr size_t WS_W1B = WS_WOUT + (size_t)D * D * 2;
constexpr size_t WS_W2B = WS_W1B + (size_t)FF * D * 2;
constexpr size_t WS_HBUF = 35 * MiB;
constexpr size_t WS_BIG = 131 * MiB;
constexpr size_t WS_S5E = WS_BIG + 96 * MiB;
constexpr size_t WS_X = 419 * MiB;
constexpr size_t WS_WGLU = WS_X;
constexpr size_t WS_W1A = WS_X + 4 * MiB;
constexpr size_t WS_W2A = WS_X + 12 * MiB;
constexpr size_t WS_SBUF = WS_X;
constexpr size_t WS_END = 467 * MiB;
static_assert(WS_W2B + (size_t)FF * D * 2 <= WS_HBUF, "ws map");

struct P { const float* in[26]; float* out; unsigned char* ws; };

typedef __bf16 bf16n2 __attribute__((ext_vector_type(2)));
typedef float f32x2n __attribute__((ext_vector_type(2)));
__device__ __forceinline__ unsigned pk_bf16(float lo, float hi) { const f32x2n f = {lo, hi}; const bf16n2 v = __builtin_convertvector(f, bf16n2); return __builtin_bit_cast(unsigned, v); }
__device__ __forceinline__ bf16_t f2bf(float f) { return (bf16_t)(pk_bf16(f, 0.f) & 0xffffu); }
__device__ __forceinline__ float bf2f(bf16_t b) { return __uint_as_float(((unsigned)b) << 16); }
__device__ __forceinline__ float wave_sum(float v) {
#pragma unroll
    for (int o = 1; o < 64; o <<= 1) v += __shfl_xor(v, o);
    return v;
}
__device__ __forceinline__ int row_seq(int row) { return row < T_PROMPT ? (row >> 14) : 2 + ((row - T_PROMPT) >> 11); }
__device__ __forceinline__ float sigmoidf_(float x) { return 1.0f / (1.0f + __expf(-x)); }
__device__ __forceinline__ float gelu_tanh(float y) {
    const float a = 0.7978845608028654f * (y + 0.044715f * y * y * y);
    const float th = 1.0f - 2.0f / (__expf(2.0f * a) + 1.0f);
    return 0.5f * y * (1.0f + th);
}
#define CFENCE() asm volatile("" ::: "memory")
#define LDS_WAIT() asm volatile("s_waitcnt lgkmcnt(0)" ::: "memory")

struct EpiRes {
    static constexpr bool PERM = false, AFTER_DRAIN = false;
    float* x; const float* gate; int row_off;
    __device__ __forceinline__ void operator()(const pg8::f32x4 (&acc)[2][2][4][2], const pg8::Unit& u, int wr, int wc, int fr, int fq) const {
        const int row0 = row_off + u.pm * 256 + wr * 64 + fr, col0 = u.pn * 256 + wc * 32 + 4 * fq;
        const float* gp = gate + (size_t)row_seq(row_off + u.pm * 256) * NMODC;
        pg8::f32x4 gv[2][2];
#pragma unroll
        for (int bj = 0; bj < 2; ++bj)
#pragma unroll
            for (int n = 0; n < 2; ++n) gv[bj][n] = *(const pg8::f32x4*)(gp + col0 + bj * 128 + n * 16);
#pragma unroll
        for (int ai = 0; ai < 2; ++ai)
#pragma unroll
            for (int m = 0; m < 4; ++m) { float* rowp = x + (size_t)(row0 + ai * 128 + m * 16) * D + col0;
#pragma unroll
                for (int bj = 0; bj < 2; ++bj)
#pragma unroll
                    for (int n = 0; n < 2; ++n) { pg8::f32x4* q = (pg8::f32x4*)(rowp + bj * 128 + n * 16); *q = *q + gv[bj][n] * acc[ai][bj][m][n]; }
                if (m & 1) asm volatile("" ::: "memory"); }
    }
};
struct EpiGlu {
    static constexpr bool PERM = false, AFTER_DRAIN = false;
    const float* xp; const float* xs; float* out; const float* gate;
    __device__ __forceinline__ void operator()(const pg8::f32x4 (&acc)[2][2][4][2], const pg8::Unit& u, int wr, int wc, int fr, int fq) const {
        const int row0 = u.pm * 256 + wr * 64 + fr, col0 = u.pn * 128 + wc * 32 + 4 * fq;
        const float* gp = gate + (size_t)row_seq(u.pm * 256) * NMODC;
        pg8::f32x4 gv[2];
#pragma unroll
        for (int n = 0; n < 2; ++n) gv[n] = *(const pg8::f32x4*)(gp + col0 + n * 16);
#pragma unroll
        for (int ai = 0; ai < 2; ++ai)
#pragma unroll
            for (int m = 0; m < 4; ++m) { const int row = row0 + ai * 128 + m * 16;
                const float* xin = row < T_PROMPT ? xp + (size_t)row * D : xs + (size_t)(row - T_PROMPT) * D;
#pragma unroll
                for (int n = 0; n < 2; ++n) { const pg8::f32x4 val = acc[ai][0][m][n], gt = acc[ai][1][m][n]; pg8::f32x4 sg;
                    sg[0] = sigmoidf_(gt[0]); sg[1] = sigmoidf_(gt[1]); sg[2] = sigmoidf_(gt[2]); sg[3] = sigmoidf_(gt[3]);
                    const pg8::f32x4 xv = *(const pg8::f32x4*)(xin + col0 + n * 16);
                    *(pg8::f32x4*)(out + (size_t)row * D + col0 + n * 16) = xv + gv[n] * val * sg; }
                if (m & 1) asm volatile("" ::: "memory"); }
    }
};
template <int ACT> struct EpiBf {
    static constexpr bool PERM = true, AFTER_DRAIN = false;
    bf16_t* O; int ldc; float* a1;
    __device__ __forceinline__ void operator()(const pg8::f32x4 (&acc)[2][2][4][2], const pg8::Unit& u, int wr, int wc, int fr, int fq) const {
        const int row0 = u.pm * 256 + wr * 64 + fr;
        if (ACT == 0 && u.pn == 12) {
            if (wc == 0) {
#pragma unroll
                for (int ai = 0; ai < 2; ++ai)
#pragma unroll
                    for (int m = 0; m < 4; ++m) { float* rp = a1 + (size_t)(row0 + ai * 128 + m * 16) * 32 + 8 * fq;
                        *(pg8::f32x4*)rp = acc[ai][0][m][0]; *(pg8::f32x4*)(rp + 4) = acc[ai][0][m][1]; }
            }
            return;
        }
        const int col0 = u.pn * 256 + wc * 32 + 8 * fq;
#pragma unroll
        for (int ai = 0; ai < 2; ++ai)
#pragma unroll
            for (int m = 0; m < 4; ++m) { bf16_t* rowp = O + (size_t)(row0 + ai * 128 + m * 16) * ldc + col0;
#pragma unroll
                for (int bj = 0; bj < 2; ++bj) { pg8::f32x4 v0 = acc[ai][bj][m][0], v1 = acc[ai][bj][m][1];
                    if (ACT == 1) {
#pragma unroll
                        for (int e = 0; e < 4; ++e) { const float a = fmaxf(v0[e], 0.f), b = fmaxf(v1[e], 0.f); v0[e] = a * a; v1[e] = b * b; } }
                    pg8::u32x4 wv; wv.x = pk_bf16(v0[0], v0[1]); wv.y = pk_bf16(v0[2], v0[3]); wv.z = pk_bf16(v1[0], v1[1]); wv.w = pk_bf16(v1[2], v1[3]);
                    *(pg8::u32x4*)(rowp + bj * 128) = wv; } }
    }
};

__device__ __forceinline__ void transpose_item(const float* W, int K, int N, int srccol0, bf16_t* WT, int dstrow0, int k0, LAS float* scr, int lane) {
    { float tv[32];
#pragma unroll
      for (int i = 0; i < 32; ++i) tv[i] = W[(size_t)(k0 + 2 * i + (lane >> 5)) * N + srccol0 + (lane & 31)];
#pragma unroll
      for (int i = 0; i < 32; ++i) scr[(2 * i + (lane >> 5)) * 33 + (lane & 31)] = tv[i]; }
    LDS_WAIT();
    const int c = lane & 7;
#pragma unroll
    for (int j = 0; j < 4; ++j) { const int n = (lane >> 3) + 8 * j; const LAS float* s = scr + (8 * c) * 33 + n;
        u32x4 o; o.x = pk_bf16(s[0 * 33], s[1 * 33]); o.y = pk_bf16(s[2 * 33], s[3 * 33]); o.z = pk_bf16(s[4 * 33], s[5 * 33]); o.w = pk_bf16(s[6 * 33], s[7 * 33]);
        *(u32x4*)(WT + (size_t)(dstrow0 + n) * K + k0 + 8 * c) = o; }
    LDS_WAIT();
}

__device__ __forceinline__ void p0_prep(const P& p, LAS unsigned char* lds) {
    int tid_ = threadIdx.x; asm volatile("" : "+v"(tid_));
    const int tid = tid_, lane = tid & 63, w = tid >> 6;
    unsigned char* ws = p.ws;
    if ((int)blockIdx.x < 192) {
        LAS float* sc = (LAS float*)lds;
        LAS float* red = (LAS float*)(lds + 40960);
        for (int i = tid; i < NSEQ * D; i += NTHREADS) { const int s = i >> 10, d = i & 1023; const float c = s < 2 ? p.in[2][s * D + d] : p.in[3][(s - 2) * D + d]; sc[i] = c * sigmoidf_(c); }
        __syncthreads();
        for (int it = blockIdx.x; it < 192; it += gridDim.x) {
            const int l = it / 96, col0 = (it % 96) * 64, col = tid & 63, ks = w;
            float acc[NSEQ];
#pragma unroll
            for (int s = 0; s < NSEQ; ++s) acc[s] = 0.f;
            const float* wp = p.in[4] + ((size_t)l * D + ks * 128) * NMODC + col0 + col;
#pragma unroll 16
            for (int k = 0; k < 128; ++k) { const float wv = wp[(size_t)k * NMODC];
#pragma unroll
                for (int s = 0; s < NSEQ; ++s) acc[s] += sc[s * D + ks * 128 + k] * wv; }
#pragma unroll
            for (int s = 0; s < NSEQ; ++s) red[(ks * NSEQ + s) * 64 + col] = acc[s];
            __syncthreads();
            for (int i = tid; i < NSEQ * 64; i += NTHREADS) { const int s = i >> 6, cc = i & 63; float v = 0.f;
#pragma unroll
                for (int k8 = 0; k8 < 8; ++k8) v += red[(k8 * NSEQ + s) * 64 + cc];
                ((float*)(ws + WS_MOD))[((size_t)l * NSEQ + s) * NMODC + col0 + cc] = v + p.in[5][l * NMODC + col0 + cc]; }
            __syncthreads();
        }
    }
    __syncthreads();
    {
        LAS float* scr = (LAS float*)(lds + w * 16384);
        const int gw = blockIdx.x * NWAVES + w, NGW = gridDim.x * NWAVES;
        constexpr int I_GLU = 16 * 64, I_WIN = 16 * 96, I_WOUT = 16 * 32, I_W1 = 16 * 128, I_W2 = 64 * 32;
        constexpr int NITEMS = I_GLU + I_WIN + I_WOUT + 2 * I_W1 + 2 * I_W2;
        for (int it = gw; it < NITEMS; it += NGW) {
            int r = it;
            if (r < I_GLU) { const int kb = r / 64, nb = r % 64, n0 = nb * 32, pn = n0 >> 8, bj = (n0 >> 7) & 1, r0 = n0 & 127;
                transpose_item(p.in[16], D, 2 * D, bj * D + pn * 128 + r0, (bf16_t*)(ws + WS_WGLU), n0, kb * 64, scr, lane); continue; }
            r -= I_GLU;
            if (r < I_WIN) { const int kb = r / 96, nb = r % 96; transpose_item(p.in[17], D, PROJ_N, nb * 32, (bf16_t*)(ws + WS_WIN), nb * 32, kb * 64, scr, lane); continue; }
            r -= I_WIN;
            if (r < I_WOUT) { const int kb = r / 32, nb = r % 32; transpose_item(p.in[22], D, D, nb * 32, (bf16_t*)(ws + WS_WOUT), nb * 32, kb * 64, scr, lane); continue; }
            r -= I_WOUT;
            if (r < 2 * I_W1) { const int l = r / I_W1, q = r % I_W1, kb = q / 128, nb = q % 128;
                transpose_item(p.in[23] + (size_t)l * D * FF, D, FF, nb * 32, (bf16_t*)(ws + (l ? WS_W1B : WS_W1A)), nb * 32, kb * 64, scr, lane); continue; }
            r -= 2 * I_W1;
            { const int l = r / I_W2, q = r % I_W2, kb = q / 32, nb = q % 32;
                transpose_item(p.in[24] + (size_t)l * FF * D, FF, D, nb * 32, (bf16_t*)(ws + (l ? WS_W2B : WS_W2A)), nb * 32, kb * 64, scr, lane); }
        }
        bf16_t* wt = (bf16_t*)(ws + WS_WIN);
        for (int i = blockIdx.x * NTHREADS + tid; i < 256 * D; i += gridDim.x * NTHREADS) { const int r = i >> 10, k = i & 1023;
            const float v = r < 32 ? p.in[18][((size_t)(r >> 4) * D + k) * 16 + (r & 15)] : 0.f;
            wt[(size_t)(PROJ_N + r) * D + k] = f2bf(v); }
    }
    for (int i = blockIdx.x * NTHREADS + tid; i < 2 * 64 * 64; i += gridDim.x * NTHREADS) {
        const int pp = i & 63, dg = i >> 6;
        const float lr = p.in[8][i], li = p.in[9][i], dt = __expf(p.in[10][dg]);
        const float mag = __expf(lr * dt); float sn, cs; sincosf(li * dt, &sn, &cs);
        const float abr = mag * cs, abi = mag * sn, den = lr * lr + li * li;
        const float zr = ((abr - 1.0f) * lr + abi * li) / den, zi = (abi * lr - (abr - 1.0f) * li) / den;
        float* ab = (float*)(ws + WS_ABAR); ab[2 * i] = abr; ab[2 * i + 1] = abi;
        bf16_t* bbt = (bf16_t*)(ws + WS_BBT); bf16_t* ct = (bf16_t*)(ws + WS_CT);
#pragma unroll
        for (int h = 0; h < 16; ++h) {
            const float br = p.in[11][(size_t)i * 16 + h], bi = p.in[12][(size_t)i * 16 + h];
            bbt[((size_t)dg * 128 + pp) * 16 + h] = f2bf(zr * br - zi * bi);
            bbt[((size_t)dg * 128 + 64 + pp) * 16 + h] = f2bf(zr * bi + zi * br);
            ct[((size_t)dg * 16 + h) * 128 + pp] = f2bf(p.in[13][((size_t)dg * 16 + h) * 64 + pp]);
            ct[((size_t)dg * 16 + h) * 128 + 64 + pp] = f2bf(-p.in[14][((size_t)dg * 16 + h) * 64 + pp]);
        }
    }
}

template <int SRC, bool FINAL>
__device__ __forceinline__ void norm_phase(const P& p, const float* gvec, const float* shift, const float* scale, float oscale = 1.0f) {
    int tid_ = threadIdx.x; asm volatile("" : "+v"(tid_));
    const int tid = tid_, lane = tid & 63, w = tid >> 6;
    const int gw = blockIdx.x * NWAVES + w, NGW = gridDim.x * NWAVES;
    bf16_t* hb = (bf16_t*)(p.ws + WS_HBUF);
    f32x4 gq[4];
#pragma unroll
    for (int j = 0; j < 4; ++j) gq[j] = *(const f32x4*)(gvec + 4 * lane + 256 * j);
    f32x4 vn[4];
    { const int row = gw; const float* xr = SRC == 0 ? (row < T_PROMPT ? p.in[0] + (size_t)row * D : p.in[1] + (size_t)(row - T_PROMPT) * D) : p.out + (size_t)row * D;
#pragma unroll
      for (int j = 0; j < 4; ++j) vn[j] = *(const f32x4*)(xr + 4 * lane + 256 * j); }
    for (int row = gw; row < T; row += NGW) {
        f32x4 v[4]; float ss = 0.f;
#pragma unroll
        for (int j = 0; j < 4; ++j) { v[j] = vn[j]; ss += (v[j][0] * v[j][0] + v[j][1] * v[j][1]) + (v[j][2] * v[j][2] + v[j][3] * v[j][3]); }
        { const int rn = row + NGW < T ? row + NGW : row;
          const float* xr = SRC == 0 ? (rn < T_PROMPT ? p.in[0] + (size_t)rn * D : p.in[1] + (size_t)(rn - T_PROMPT) * D) : p.out + (size_t)rn * D;
#pragma unroll
          for (int j = 0; j < 4; ++j) vn[j] = *(const f32x4*)(xr + 4 * lane + 256 * j); }
        const float rstd = rsqrtf(wave_sum(ss) * (1.0f / D) + EPS);
        if (FINAL) {
#pragma unroll
            for (int j = 0; j < 4; ++j) *(f32x4*)(p.out + (size_t)row * D + 4 * lane + 256 * j) = v[j] * (rstd * oscale) * gq[j];
        } else {
            const int s = row_seq(row);
#pragma unroll
            for (int j = 0; j < 4; ++j) { const f32x4 sh = *(const f32x4*)(shift + (size_t)s * NMODC + 4 * lane + 256 * j), sc = *(const f32x4*)(scale + (size_t)s * NMODC + 4 * lane + 256 * j);
                const f32x4 o = (v[j] * rstd * gq[j]) * (sc + 1.0f) + sh;
                u32x2 wv; wv.x = pk_bf16(o[0], o[1]); wv.y = pk_bf16(o[2], o[3]);
                *(u32x2*)(hb + (size_t)row * D + 4 * lane + 256 * j) = wv; }
        }
    }
}

constexpr int S5_NCH = 384, S5_HROW = 272, S5_UROW = 48, S5_UOFF = 32 * S5_HROW, S5_WAVE_LDS = S5_UOFF + 128 * S5_UROW;
__device__ __forceinline__ void half_bcast(float x, float& lo, float& hi) { const auto r = __builtin_amdgcn_permlane32_swap(__float_as_uint(x), __float_as_uint(x), false, false); lo = __uint_as_float(r[0]); hi = __uint_as_float(r[1]); }
#define CMAD(sr, si, mr, mi, br, bi) do { const float nr_ = (sr) * (mr) - (si) * (mi) + (br); const float ni_ = (sr) * (mi) + (si) * (mr) + (bi); (sr) = nr_; (si) = ni_; } while (0)
template <bool PC>
__device__ __forceinline__ void s5_pass(const P& p, LAS unsigned char* lds) {
    int tid_ = threadIdx.x; asm volatile("" : "+v"(tid_));
    const int tid = tid_, lane = tid & 63, w = __builtin_amdgcn_readfirstlane(tid >> 6);
    const int b = blockIdx.x, g = (b & 7) * 8 + w;
    const int hh = lane >> 5, l32 = lane & 31, l16 = lane & 15, q16 = lane >> 4;
    LAS unsigned char* const H = lds + w * S5_WAVE_LDS;
    LAS unsigned char* const hwr = H + (4 * hh) * S5_HROW + l32 * 4;
    const LAS unsigned char* const hrd = H + l16 * S5_HROW + q16 * 16;
    const bf16_t* hb = (const bf16_t*)(p.ws + WS_HBUF);
    bf16_t* gout = (bf16_t*)(p.ws + WS_BIG);
    float* E = (float*)(p.ws + WS_S5E);
    const bf16_t* bbt = (const bf16_t*)(p.ws + WS_BBT); const bf16_t* ct = (const bf16_t*)(p.ws + WS_CT); const float* ab = (const float*)(p.ws + WS_ABAR);
    const float dsk = p.in[15][g * 16 + l16];
    bf16x8 BfA[2][4];
#pragma unroll
    for (int dir = 0; dir < 2; ++dir)
#pragma unroll
        for (int nb = 0; nb < 4; ++nb) BfA[dir][nb] = PC ? (bf16x8){0, 0, 0, 0, 0, 0, 0, 0} : *(const bf16x8*)(bbt + ((size_t)(dir * 64 + g) * 128 + (nb >> 1) * 64 + 2 * l32 + (nb & 1)) * 16 + 8 * hh);
    const int cstride = (int)(gridDim.x >> 3);
    const bf16_t* const ub = hb + (size_t)l32 * D + g * 16 + 8 * hh;
    bf16x8 afn[4]; f32x2n enr[2], eni[2];
    { const int c0 = b >> 3;
      if (c0 < S5_NCH) {
#pragma unroll
        for (int sb = 0; sb < 4; ++sb) afn[sb] = *(const bf16x8*)(ub + (size_t)(c0 * 128 + sb * 32) * D);
        if (PC) {
#pragma unroll
            for (int dir = 0; dir < 2; ++dir) { const size_t eo = (((size_t)dir * S5_NCH + c0) * 64 + g) * 128; enr[dir] = *(const f32x2n*)(E + eo + 2 * l32); eni[dir] = *(const f32x2n*)(E + eo + 64 + 2 * l32); } } } }
    for (int c = b >> 3; c < S5_NCH; c += cstride) {
        const int tok0 = c * 128;
        f32x2n ecr[2], eci[2];
#pragma unroll
        for (int sb = 0; sb < 4; ++sb) *(LAS bf16x8*)(H + S5_UOFF + (sb * 32 + l32) * S5_UROW + 16 * hh) = afn[sb];
#pragma unroll
        for (int dir = 0; dir < 2; ++dir) { ecr[dir] = enr[dir]; eci[dir] = eni[dir]; }
        CFENCE(); LDS_WAIT(); CFENCE();
        { int cn = c + cstride; asm volatile("" : "+s"(cn));
          if (cn < S5_NCH) {
#pragma unroll
            for (int sb = 0; sb < 4; ++sb) afn[sb] = *(const bf16x8*)(ub + (size_t)(cn * 128 + sb * 32) * D);
            if (PC) {
#pragma unroll
                for (int dir = 0; dir < 2; ++dir) { const size_t eo = (((size_t)dir * S5_NCH + cn) * 64 + g) * 128; enr[dir] = *(const f32x2n*)(E + eo + 2 * l32); eni[dir] = *(const f32x2n*)(E + eo + 64 + 2 * l32); } } } }
        f32x4 yacc[8];
#pragma unroll
        for (int j = 0; j < 8; ++j) yacc[j] = (f32x4){0.f, 0.f, 0.f, 0.f};
#pragma unroll
        for (int dir = 0; dir < 2; ++dir) {
            const size_t eoff = (((size_t)dir * S5_NCH + c) * 64 + g) * 128;
            const int dg = dir * 64 + g;
            bf16x8 Bf[4], Cf[4];
#pragma unroll
            for (int nb = 0; nb < 4; ++nb) Bf[nb] = PC ? *(const bf16x8*)(bbt + ((size_t)dg * 128 + (nb >> 1) * 64 + 2 * l32 + (nb & 1)) * 16 + 8 * hh) : BfA[dir][nb];
#pragma unroll
            for (int ks = 0; ks < 4; ++ks) Cf[ks] = PC ? *(const bf16x8*)(ct + ((size_t)dg * 16 + l16) * 128 + 32 * ks + 8 * q16) : (bf16x8){0, 0, 0, 0, 0, 0, 0, 0};
            const f32x4 a1v = *(const f32x4*)(ab + ((size_t)dg * 64 + 2 * l32) * 2);
            const float a1Ar = a1v[0], a1Ai = a1v[1], a1Br = a1v[2], a1Bi = a1v[3];
            const float a2Ar = a1Ar * a1Ar - a1Ai * a1Ai, a2Ai = 2.f * a1Ar * a1Ai, a2Br = a1Br * a1Br - a1Bi * a1Bi, a2Bi = 2.f * a1Br * a1Bi;
            const float a3Ar = a2Ar * a1Ar - a2Ai * a1Ai, a3Ai = a2Ar * a1Ai + a2Ai * a1Ar, a3Br = a2Br * a1Br - a2Bi * a1Bi, a3Bi = a2Br * a1Bi + a2Bi * a1Br;
            const float a4Ar = a2Ar * a2Ar - a2Ai * a2Ai, a4Ai = 2.f * a2Ar * a2Ai, a4Br = a2Br * a2Br - a2Bi * a2Bi, a4Bi = 2.f * a2Br * a2Bi;
            const float a5Ar = a4Ar * a1Ar - a4Ai * a1Ai, a5Ai = a4Ar * a1Ai + a4Ai * a1Ar, a5Br = a4Br * a1Br - a4Bi * a1Bi, a5Bi = a4Br * a1Bi + a4Bi * a1Br;
            float hAr = 0.f, hAi = 0.f, hBr = 0.f, hBi = 0.f;
            if (PC) { hAr = ecr[dir][0]; hBr = ecr[dir][1]; hAi = eci[dir][0]; hBi = eci[dir][1]; }
            const bool lead = (hh == dir);
#pragma unroll
            for (int sbi = 0; sbi < 4; ++sbi) {
                const int sb = dir == 0 ? sbi : 3 - sbi;
                if (PC) __builtin_amdgcn_sched_barrier(0);
                const bf16x8 a = *(const LAS bf16x8*)(H + S5_UOFF + (sb * 32 + l32) * S5_UROW + 16 * hh);
                f32x16 acc[4];
#pragma unroll
                for (int nb = 0; nb < 4; ++nb) {
#pragma unroll
                    for (int i = 0; i < 16; ++i) acc[nb][i] = 0.f;
                    acc[nb] = __builtin_amdgcn_mfma_f32_32x32x16_bf16(a, Bf[nb], acc[nb], 0, 0, 0);
                }
                if (!PC) {
#pragma unroll
                    for (int gi = 0; gi < 4; ++gi)
#pragma unroll
                        for (int ri = 0; ri < 4; ++ri) { const int i = 4 * (dir == 0 ? gi : 3 - gi) + (dir == 0 ? ri : 3 - ri);
                            if (sbi == 0 && gi == 0 && ri == 0) { hAr = acc[0][i]; hAi = acc[2][i]; hBr = acc[1][i]; hBi = acc[3][i]; }
                            else if (ri == 0) { CMAD(hAr, hAi, a5Ar, a5Ai, acc[0][i], acc[2][i]); CMAD(hBr, hBi, a5Br, a5Bi, acc[1][i], acc[3][i]); }
                            else { CMAD(hAr, hAi, a1Ar, a1Ai, acc[0][i], acc[2][i]); CMAD(hBr, hBi, a1Br, a1Bi, acc[1][i], acc[3][i]); } }
                } else {
#pragma unroll
                    for (int gi = 0; gi < 4; ++gi) { const int gg = dir == 0 ? gi : 3 - gi;
                        float xAr = lead ? hAr : 0.f, xAi = lead ? hAi : 0.f, xBr = lead ? hBr : 0.f, xBi = lead ? hBi : 0.f;
#pragma unroll
                        for (int k = 0; k < 4; ++k) { const int i = 4 * gg + (dir == 0 ? k : 3 - k);
                            CMAD(xAr, xAi, a1Ar, a1Ai, acc[0][i], acc[2][i]); acc[0][i] = xAr; acc[2][i] = xAi;
                            CMAD(xBr, xBi, a1Br, a1Bi, acc[1][i], acc[3][i]); acc[1][i] = xBr; acc[3][i] = xBi; }
                        float eAr, eAi, eBr, eBi, dmy;
                        if (dir == 0) { half_bcast(xAr, eAr, dmy); half_bcast(xAi, eAi, dmy); half_bcast(xBr, eBr, dmy); half_bcast(xBi, eBi, dmy); }
                        else { half_bcast(xAr, dmy, eAr); half_bcast(xAi, dmy, eAi); half_bcast(xBr, dmy, eBr); half_bcast(xBi, dmy, eBi); }
                        if (lead) { eAr = 0.f; eAi = 0.f; eBr = 0.f; eBi = 0.f; }
                        { const int i0 = 4 * gg + (dir == 0 ? 0 : 3), i1 = 4 * gg + (dir == 0 ? 1 : 2), i2 = 4 * gg + (dir == 0 ? 2 : 1), i3 = 4 * gg + (dir == 0 ? 3 : 0);
                          acc[0][i0] += a1Ar * eAr - a1Ai * eAi; acc[2][i0] += a1Ar * eAi + a1Ai * eAr; acc[1][i0] += a1Br * eBr - a1Bi * eBi; acc[3][i0] += a1Br * eBi + a1Bi * eBr;
                          acc[0][i1] += a2Ar * eAr - a2Ai * eAi; acc[2][i1] += a2Ar * eAi + a2Ai * eAr; acc[1][i1] += a2Br * eBr - a2Bi * eBi; acc[3][i1] += a2Br * eBi + a2Bi * eBr;
                          acc[0][i2] += a3Ar * eAr - a3Ai * eAi; acc[2][i2] += a3Ar * eAi + a3Ai * eAr; acc[1][i2] += a3Br * eBr - a3Bi * eBi; acc[3][i2] += a3Br * eBi + a3Bi * eBr;
                          acc[0][i3] += a4Ar * eAr - a4Ai * eAi; acc[2][i3] += a4Ar * eAi + a4Ai * eAr; acc[1][i3] += a4Br * eBr - a4Bi * eBi; acc[3][i3] += a4Br * eBi + a4Bi * eBr;
                          const float tAr = acc[0][i3], tAi = acc[2][i3], tBr = acc[1][i3], tBi = acc[3][i3];
                          float dm2;
                          if (dir == 0) { half_bcast(tAr, dm2, hAr); half_bcast(tAi, dm2, hAi); half_bcast(tBr, dm2, hBr); half_bcast(tBi, dm2, hBi); }
                          else { half_bcast(tAr, hAr, dm2); half_bcast(tAi, hAi, dm2); half_bcast(tBr, hBr, dm2); half_bcast(tBi, hBi, dm2); } }
                    }
#pragma unroll
                    for (int i = 0; i < 16; ++i) { const int ro = (8 * (i >> 2) + (i & 3)) * S5_HROW;
                        *(LAS unsigned*)(hwr + ro) = pk_bf16(acc[0][i], acc[1][i]); *(LAS unsigned*)(hwr + ro + 128) = pk_bf16(acc[2][i], acc[3][i]); }
                    CFENCE(); LDS_WAIT(); CFENCE();
#pragma unroll
                    for (int mb = 0; mb < 2; ++mb)
#pragma unroll
                        for (int ks = 0; ks < 4; ++ks) { const bf16x8 af = *(const LAS bf16x8*)(hrd + mb * 16 * S5_HROW + 64 * ks);
                            yacc[sb * 2 + mb] = __builtin_amdgcn_mfma_f32_16x16x32_bf16(af, Cf[ks], yacc[sb * 2 + mb], 0, 0, 0); }
                    CFENCE(); LDS_WAIT(); CFENCE();
                }
            }
            if (!PC) {
                float s0Ar, s0Ai, s0Br, s0Bi, s1Ar, s1Ai, s1Br, s1Bi;
                half_bcast(hAr, s0Ar, s1Ar); half_bcast(hAi, s0Ai, s1Ai); half_bcast(hBr, s0Br, s1Br); half_bcast(hBi, s0Bi, s1Bi);
                float eAr, eAi, eBr, eBi;
                if (dir == 0) { eAr = a4Ar * s0Ar - a4Ai * s0Ai + s1Ar; eAi = a4Ar * s0Ai + a4Ai * s0Ar + s1Ai; eBr = a4Br * s0Br - a4Bi * s0Bi + s1Br; eBi = a4Br * s0Bi + a4Bi * s0Br + s1Bi; }
                else { eAr = a4Ar * s1Ar - a4Ai * s1Ai + s0Ar; eAi = a4Ar * s1Ai + a4Ai * s1Ar + s0Ai; eBr = a4Br * s1Br - a4Bi * s1Bi + s0Br; eBi = a4Br * s1Bi + a4Bi * s1Br + s0Bi; }
                if (hh == 0) { *(f32x2n*)(E + eoff + 2 * l32) = (f32x2n){eAr, eBr}; *(f32x2n*)(E + eoff + 64 + 2 * l32) = (f32x2n){eAi, eBi}; }
            }
        }
        CFENCE(); LDS_WAIT(); CFENCE();
        if (PC) {
#pragma unroll
            for (int j = 0; j < 8; ++j)
#pragma unroll
                for (int i = 0; i < 4; ++i) { LAS bf16_t* up = (LAS bf16_t*)(H + S5_UOFF + (4 * q16) * S5_UROW + l16 * 2 + (j * 16 + i) * S5_UROW);
                    const float y = yacc[j][i] + dsk * bf2f(*up); *up = f2bf(gelu_tanh(y)); }
            CFENCE(); LDS_WAIT(); CFENCE();
#pragma unroll
            for (int k = 0; k < 4; ++k) { const int idx = lane + 64 * k, tk = idx >> 1, hf = idx & 1;
                const u32x4 v = *(const LAS u32x4*)(H + S5_UOFF + tk * S5_UROW + hf * 16);
                *(u32x4*)(gout + (size_t)(tok0 + tk) * D + g * 16 + hf * 8) = v; }
            CFENCE(); LDS_WAIT(); CFENCE();
        }
    }
}
__device__ __forceinline__ void s5_carry(const P& p) {
    int tid_ = threadIdx.x; asm volatile("" : "+v"(tid_));
    const int idx = blockIdx.x * NTHREADS + tid_;
    if (idx >= 2 * NSEQ * 64 * 64) return;
    const int pp = idx & 63, g = (idx >> 6) & 63, s = (idx >> 12) % NSEQ, dir = idx / (NSEQ * 4096);
    const float* ab = (const float*)(p.ws + WS_ABAR);
    float Ar = ab[((dir * 64 + g) * 64 + pp) * 2], Ai = ab[((dir * 64 + g) * 64 + pp) * 2 + 1];
#pragma unroll
    for (int k = 0; k < 7; ++k) { const float nr = Ar * Ar - Ai * Ai, ni = 2.0f * Ar * Ai; Ar = nr; Ai = ni; }
    const int c0 = s < 2 ? s * 128 : 256 + (s - 2) * 16, n = s < 2 ? 128 : 16;
    float* E = (float*)(p.ws + WS_S5E);
    float rr = 0.f, ri = 0.f;
    for (int i0 = 0; i0 < n; i0 += 16) {
        float er[16], ei[16];
#pragma unroll
        for (int k = 0; k < 16; ++k) { const int i = i0 + k, c = dir == 0 ? c0 + i : c0 + n - 1 - i; const size_t ad = (((size_t)dir * S5_NCH + c) * 64 + g) * 128 + pp; er[k] = E[ad]; ei[k] = E[ad + 64]; }
#pragma unroll
        for (int k = 0; k < 16; ++k) { const int i = i0 + k, c = dir == 0 ? c0 + i : c0 + n - 1 - i; const size_t ad = (((size_t)dir * S5_NCH + c) * 64 + g) * 128 + pp;
            E[ad] = rr; E[ad + 64] = ri; const float nr = Ar * rr - Ai * ri + er[k], ni = Ar * ri + Ai * rr + ei[k]; rr = nr; ri = ni; }
    }
}

constexpr int GQ = 0, GK = 17408, GKT = 34816, GVT = 53248, GSC = 90112, GA1 = 99328, GSUM = 103424, GEL = 105472, GRMS = 105984, GRSTD = 108032, GW2 = 108288;
constexpr int QST = 272, TST = 144, VST = 576;
__device__ __forceinline__ void gla_item_coords(int j, int& hd, int& tokbase) {
    hd = j & 3; const int q = j >> 2;
    if (q < 32) tokbase = (q >> 4) * 16384 + (q & 15) * 1024; else tokbase = T_PROMPT + ((q - 32) >> 1) * 2048 + ((q - 32) & 1) * 1024;
}
template <int MODE>
__device__ __forceinline__ void gla_phase(const P& p, LAS unsigned char* lds, int m0_first = 0, int m0_count = 0, int m0_block0 = 0) {
    int tid_ = threadIdx.x; asm volatile("" : "+v"(tid_));
    const int tid = tid_, lane = tid & 63, w = __builtin_amdgcn_readfirstlane(tid >> 6), hh = lane >> 5, l32 = lane & 31;
    const int chan = tid & 127, tg = w >> 1;
    const bf16_t* proj = (const bf16_t*)(p.ws + WS_BIG);
    const float* a1b = (const float*)(p.ws + WS_A1);
    bf16_t* hb = (bf16_t*)(p.ws + WS_HBUF);
    float* sbuf = (float*)(p.ws + WS_SBUF); float* dtot = (float*)(p.ws + WS_DTOT);
    LAS unsigned char* const qfrag = lds + GQ + l32 * QST + 16 * hh;
    LAS unsigned char* const kfrag = lds + GK + l32 * QST + 16 * hh;
    LAS unsigned char* const qperm = lds + GQ + l32 * QST + 8 * hh;
    LAS unsigned char* const ktfrag = lds + GKT + l32 * TST + 16 * hh;
    LAS unsigned char* const vtr = lds + GVT + (8 * hh + ((lane & 15) >> 2)) * VST + (32 * w + 16 * ((lane >> 4) & 1) + 4 * (lane & 3)) * 2;
    LAS unsigned char* const scfrag = lds + GSC + l32 * TST + 16 * hh;
    LAS unsigned char* const otw = lds + GVT + (4 * hh) * VST + (32 * w + l32) * 2;
    LAS unsigned char* const scst = lds + GSC + (4 * hh) * TST + l32 * 2;
    LAS unsigned char* const elrd = lds + GEL + 16 * hh;
    LAS unsigned char* const rmsw = lds + GRMS + (4 * hh) * 32 + w * 4;
    LAS unsigned char* const rstdr = lds + GRSTD + (4 * hh) * 4;
    LAS unsigned char* const qprep = lds + GQ + (16 * tg) * QST + chan * 2;
    LAS unsigned char* const kprep = lds + GK + (16 * tg) * QST + chan * 2;
    LAS unsigned char* const a1rd = lds + GA1 + (16 * tg) * 64;
    const LAS float* const w2p = (const LAS float*)(lds + GW2) + chan;
    const int nitems = MODE == 0 ? m0_count : 192;
    for (int it = MODE == 0 ? (int)blockIdx.x - m0_block0 : (int)blockIdx.x; it >= 0 && it < nitems; it += gridDim.x) {
        int dir = MODE == 1 ? 0 : 1, j = it;
        if (MODE == 0) { const int nidx = m0_first + it; dir = nidx >= 152 ? 1 : 0; const int n = nidx - dir * 152;
            if (n < 120) { const int hd0 = n & 3, m = n >> 2, sq = m / 15, sc = m - sq * 15 + dir; j = (sq * 16 + sc) * 4 + hd0; }
            else { const int n2 = n - 120, hd0 = n2 & 3, sq = n2 >> 2; j = (32 + sq * 2 + dir) * 4 + hd0; } }
        const int full = dir * 192 + j;
        int hd, tokbase; gla_item_coords(j, hd, tokbase);
        __syncthreads();
        for (int i = tid; i < 16 * 128; i += NTHREADS) ((LAS float*)(lds + GW2))[i] = p.in[19][(size_t)(dir * 16 + (i >> 7)) * 512 + hd * 128 + (i & 127)];
        const float bias = p.in[20][dir * 512 + hd * 128 + chan];
        f32x16 S[4];
        float* const sb0 = sbuf + (size_t)full * 32768 + 32 * w; const int svo = (4 * hh) * 256 + l32;
#pragma unroll
        for (int cb = 0; cb < 4; ++cb)
#pragma unroll
            for (int i = 0; i < 16; ++i) S[cb][i] = MODE == 0 ? 0.f : (sb0 + (32 * cb + 8 * (i >> 2) + (i & 3)) * 256)[svo];
        float dsum = 0.f;
        u32x4 pq[2], pk[2], pv[4]; f32x4 pa = (f32x4){0.f, 0.f, 0.f, 0.f};
        const int qko = (tid >> 4) * PROJ_N + hd * 128 + (tid & 15) * 8;
        const int vo = (tid >> 5) * PROJ_N + 1024 + hd * 256 + (tid & 31) * 8;
        const int ao = (tid >> 2) * 32 + dir * 16 + (tid & 3) * 4;
#define GLA_LOAD(tbx) do { const bf16_t* pb_ = proj + (size_t)(tbx) * PROJ_N; \
            _Pragma("unroll") for (int i = 0; i < 2; ++i) { if (MODE != 0) pq[i] = *(const u32x4*)(pb_ + (size_t)i * 32 * PROJ_N + qko); pk[i] = *(const u32x4*)(pb_ + (size_t)i * 32 * PROJ_N + 512 + qko); } \
            _Pragma("unroll") for (int i = 0; i < 4; ++i) pv[i] = *(const u32x4*)(pb_ + (size_t)i * 16 * PROJ_N + vo); \
            if (tid < 256) pa = *(const f32x4*)(a1b + (size_t)(tbx) * 32 + ao); } while (0)
        { int tb0 = tokbase + (dir == 0 ? 0 : 15) * 64; GLA_LOAD(tb0); }
        for (int ci = 0; ci < 16; ++ci) {
            int tb = tokbase + (dir == 0 ? ci : 15 - ci) * 64; asm volatile("" : "+s"(tb));
            int tbn = tokbase + (dir == 0 ? ci + 1 : 14 - ci) * 64; asm volatile("" : "+s"(tbn));
            { LAS unsigned char* const qs = lds + GQ + (tid >> 4) * QST + (tid & 15) * 16;
#pragma unroll
              for (int i = 0; i < 2; ++i) { if (MODE != 0) *(LAS u32x4*)(qs + i * 32 * QST) = pq[i]; *(LAS u32x4*)(qs + (GK - GQ) + i * 32 * QST) = pk[i]; } }
            { LAS unsigned char* const vs = lds + GVT + (tid >> 5) * VST + (tid & 31) * 16;
#pragma unroll
              for (int i = 0; i < 4; ++i) *(LAS u32x4*)(vs + i * 16 * VST) = pv[i]; }
            if (tid < 256) *(LAS f32x4*)(lds + GA1 + (tid >> 2) * 64 + (tid & 3) * 16) = pa;
            __syncthreads();
            if (ci + 1 < 16) GLA_LOAD(tbn);
            float zc[16];
#pragma unroll
            for (int i = 0; i < 16; ++i) { const LAS f32x4* ap = (const LAS f32x4*)(a1rd + i * 64);
                float z = bias;
#pragma unroll
                for (int r4 = 0; r4 < 4; ++r4) { const f32x4 av = ap[r4]; z += av[0] * w2p[(4 * r4) * 128] + av[1] * w2p[(4 * r4 + 1) * 128] + av[2] * w2p[(4 * r4 + 2) * 128] + av[3] * w2p[(4 * r4 + 3) * 128]; }
                zc[i] = (fminf(z, 0.f) - __logf(1.0f + __expf(-fabsf(z)))) * (1.0f / 16.0f); }
            if (dir == 0) {
#pragma unroll
                for (int i = 1; i < 16; ++i) zc[i] += zc[i - 1];
            } else {
#pragma unroll
                for (int i = 14; i >= 0; --i) zc[i] += zc[i + 1];
            }
            ((LAS float*)(lds + GSUM))[tg * 128 + chan] = dir == 0 ? zc[15] : zc[0];
            __syncthreads();
            float blast, off;
            { const LAS float* gs = (const LAS float*)(lds + GSUM) + chan; const float g0 = gs[0], g1 = gs[128], g2 = gs[256], g3 = gs[384];
                blast = (g0 + g1) + (g2 + g3);
                if (dir == 0) off = (tg > 0 ? g0 : 0.f) + (tg > 1 ? g1 : 0.f) + (tg > 2 ? g2 : 0.f);
                else off = (tg < 3 ? g3 : 0.f) + (tg < 2 ? g2 : 0.f) + (tg < 1 ? g1 : 0.f); }
            {
                float kt[16];
#pragma unroll
                for (int i = 0; i < 16; ++i) { const float bc = zc[i] + off;
                    LAS bf16_t* qp = (LAS bf16_t*)(qprep + i * QST); LAS bf16_t* kp = (LAS bf16_t*)(kprep + i * QST);
                    const float kv = bf2f(*kp);
                    if (MODE != 0) { const float qv = bf2f(*qp); *qp = f2bf(qv * __expf(bc) * 0.08838834764831845f); *kp = f2bf(kv * __expf(-bc)); }
                    kt[i] = kv * __expf(blast - bc); }
                u32x4 k0, k1; k0.x = pk_bf16(kt[0], kt[1]); k0.y = pk_bf16(kt[2], kt[3]); k0.z = pk_bf16(kt[4], kt[5]); k0.w = pk_bf16(kt[6], kt[7]);
                k1.x = pk_bf16(kt[8], kt[9]); k1.y = pk_bf16(kt[10], kt[11]); k1.z = pk_bf16(kt[12], kt[13]); k1.w = pk_bf16(kt[14], kt[15]);
                *(LAS u32x4*)(lds + GKT + chan * TST + tg * 32) = k0; *(LAS u32x4*)(lds + GKT + chan * TST + tg * 32 + 16) = k1;
            }
            if (tg == 0) { ((LAS float*)(lds + GEL))[chan] = __expf(blast); dsum += blast; }
            __syncthreads();
            if (MODE != 0) {
                if (w < 4) { const int mb = w >> 1, nb = w & 1; f32x16 sc;
#pragma unroll
                    for (int i = 0; i < 16; ++i) sc[i] = 0.f;
#pragma unroll
                    for (int ks = 0; ks < 8; ++ks) { const bf16x8 a = *(const LAS bf16x8*)(qfrag + mb * 32 * QST + 32 * ks), bq = *(const LAS bf16x8*)(kfrag + nb * 32 * QST + 32 * ks);
                        sc = __builtin_amdgcn_mfma_f32_32x32x16_bf16(a, bq, sc, 0, 0, 0); }
                    const int dlt = (nb - mb) * 32 + l32 - 4 * hh;
                    LAS unsigned char* const sw = scst + mb * 32 * TST + nb * 64;
#pragma unroll
                    for (int i = 0; i < 16; ++i) { const int cst = 8 * (i >> 2) + (i & 3); const bool keep = dir == 0 ? (dlt <= cst) : (dlt >= cst);
                        *(LAS bf16_t*)(sw + cst * TST) = f2bf(keep ? sc[i] : 0.f); }
                }
                __syncthreads();
            }
            bf16x8 vf[4];
#pragma unroll
            for (int ks = 0; ks < 4; ++ks) { union { struct { bf16x4 lo, hi; } s; bf16x8 v; } vv;
                vv.s.lo = __builtin_amdgcn_ds_read_tr16_b64_v4i16((LAS bf16x4*)(vtr + (16 * ks) * VST));
                vv.s.hi = __builtin_amdgcn_ds_read_tr16_b64_v4i16((LAS bf16x4*)(vtr + (16 * ks + 4) * VST));
                vf[ks] = vv.v; }
            if (MODE != 0) {
                __syncthreads();
#pragma unroll
                for (int mb = 0; mb < 2; ++mb) {
                    f32x16 o;
#pragma unroll
                    for (int i = 0; i < 16; ++i) o[i] = 0.f;
#pragma unroll
                    for (int ks = 0; ks < 4; ++ks) { const bf16x8 a = *(const LAS bf16x8*)(scfrag + mb * 32 * TST + 32 * ks);
                        o = __builtin_amdgcn_mfma_f32_32x32x16_bf16(a, vf[ks], o, 0, 0, 0); }
#pragma unroll
                    for (int cb = 0; cb < 4; ++cb)
#pragma unroll
                        for (int h2 = 0; h2 < 2; ++h2) {
                            union { u32x4 u; bf16x8 v; } sb_;
                            sb_.u.x = pk_bf16(S[cb][8 * h2 + 0], S[cb][8 * h2 + 1]); sb_.u.y = pk_bf16(S[cb][8 * h2 + 2], S[cb][8 * h2 + 3]);
                            sb_.u.z = pk_bf16(S[cb][8 * h2 + 4], S[cb][8 * h2 + 5]); sb_.u.w = pk_bf16(S[cb][8 * h2 + 6], S[cb][8 * h2 + 7]);
                            const LAS unsigned char* base = qperm + mb * 32 * QST + (32 * cb + 16 * h2) * 2;
                            union { struct { u32x2 lo, hi; } s; bf16x8 v; } qa; qa.s.lo = *(const LAS u32x2*)base; qa.s.hi = *(const LAS u32x2*)(base + 16);
                            o = __builtin_amdgcn_mfma_f32_32x32x16_bf16(qa.v, sb_.v, o, 0, 0, 0);
                        }
#pragma unroll
                    for (int i = 0; i < 16; ++i) *(LAS bf16_t*)(otw + (32 * mb + 8 * (i >> 2) + (i & 3)) * VST) = f2bf(o[i]);
                    CFENCE();
                }
            }
            u32x4 of[4], rr[4];
            if (MODE == 2) {
                const bf16_t* const og2 = hb + (size_t)(tb + (tid >> 5)) * D + hd * 256 + (tid & 31) * 8;
                const bf16_t* const rg = proj + (size_t)(tb + (tid >> 5)) * PROJ_N + 2048 + hd * 256 + (tid & 31) * 8;
#pragma unroll
                for (int i = 0; i < 4; ++i) { of[i] = *(const u32x4*)(og2 + (size_t)(16 * i) * D); rr[i] = *(const u32x4*)(rg + (size_t)(16 * i) * PROJ_N); }
            }
#pragma unroll
            for (int cb = 0; cb < 4; ++cb) {
#pragma unroll
                for (int i4 = 0; i4 < 4; ++i4) { const f32x4 e = *(const LAS f32x4*)(elrd + (32 * cb + 8 * i4) * 4);
                    S[cb][4 * i4 + 0] *= e[0]; S[cb][4 * i4 + 1] *= e[1]; S[cb][4 * i4 + 2] *= e[2]; S[cb][4 * i4 + 3] *= e[3]; }
#pragma unroll
                for (int ks = 0; ks < 4; ++ks) { const bf16x8 a = *(const LAS bf16x8*)(ktfrag + cb * 32 * TST + 32 * ks);
                    S[cb] = __builtin_amdgcn_mfma_f32_32x32x16_bf16(a, vf[ks], S[cb], 0, 0, 0); }
            }
            __syncthreads();
            if (MODE != 0) {
                u32x4 ob[4];
#pragma unroll
                for (int i = 0; i < 4; ++i) ob[i] = *(const LAS u32x4*)(lds + GVT + ((tid >> 5) + 16 * i) * VST + (tid & 31) * 16);
                bf16_t* const og = hb + (size_t)(tb + (tid >> 5)) * D + hd * 256 + (tid & 31) * 8;
                if (MODE == 1) {
#pragma unroll
                    for (int i = 0; i < 4; ++i) *(u32x4*)(og + (size_t)(16 * i) * D) = ob[i];
                } else {
                    const f32x4 ng0 = *(const f32x4*)(p.in[21] + hd * 256 + (tid & 31) * 8), ng1 = *(const f32x4*)(p.in[21] + hd * 256 + (tid & 31) * 8 + 4);
#pragma unroll
                    for (int i = 0; i < 4; ++i) {
                        float ov[8]; float sq = 0.f;
#pragma unroll
                        for (int e = 0; e < 4; ++e) { ov[2 * e] = __uint_as_float(ob[i][e] << 16) + __uint_as_float(of[i][e] << 16); ov[2 * e + 1] = __uint_as_float(ob[i][e] & 0xffff0000u) + __uint_as_float(of[i][e] & 0xffff0000u);
                            sq += ov[2 * e] * ov[2 * e] + ov[2 * e + 1] * ov[2 * e + 1]; }
#pragma unroll
                        for (int sh = 1; sh < 32; sh <<= 1) sq += __shfl_xor(sq, sh);
                        const float rs = rsqrtf(sq * (1.0f / 256.0f) + EPS);
                        u32x4 wv;
#pragma unroll
                        for (int e = 0; e < 4; ++e) { const float r0 = __uint_as_float(rr[i][e] << 16), r1 = __uint_as_float(rr[i][e] & 0xffff0000u);
                            const float g0 = e < 2 ? ng0[2 * e] : ng1[2 * e - 4], g1 = e < 2 ? ng0[2 * e + 1] : ng1[2 * e - 3];
                            wv[e] = pk_bf16(ov[2 * e] * rs * g0 * (r0 * sigmoidf_(r0)), ov[2 * e + 1] * rs * g1 * (r1 * sigmoidf_(r1))); }
                        *(u32x4*)(og + (size_t)(16 * i) * D) = wv;
                    }
                }
                __syncthreads();
            }
        }
#undef GLA_LOAD
        if (MODE == 0) {
#pragma unroll
            for (int cb = 0; cb < 4; ++cb)
#pragma unroll
                for (int i = 0; i < 16; ++i) (sb0 + (32 * cb + 8 * (i >> 2) + (i & 3)) * 256)[svo] = S[cb][i];
            if (tg == 0) dtot[full * 128 + chan] = dsum;
        }
    }
}
__device__ __forceinline__ void gla_carry(const P& p, const int dir) {
    float* sbuf = (float*)(p.ws + WS_SBUF); const float* dtot = (const float*)(p.ws + WS_DTOT);
    const int total = 40 * 8192;
    int tid_ = threadIdx.x; asm volatile("" : "+v"(tid_));
    for (int e = blockIdx.x * NTHREADS + tid_; e < total; e += gridDim.x * NTHREADS) {
        const int e4 = e & 8191, ch = e >> 13, hd = ch & 3, s = ch >> 2;
        const int n = s < 2 ? 16 : 2, q0 = s < 2 ? s * 16 : 32 + (s - 2) * 2, chan = e4 >> 6;
        f32x4 run = (f32x4){0.f, 0.f, 0.f, 0.f};
        float* const base = sbuf + (size_t)e4 * 4;
        if (n == 16) {
            f32x4 tmp[16]; float dcy[16];
#pragma unroll
            for (int i = 0; i < 16; ++i) { const int sc = dir == 0 ? i : 15 - i, full = dir * 192 + (q0 + sc) * 4 + hd; tmp[i] = *(const f32x4*)(base + (size_t)full * 32768); dcy[i] = dtot[full * 128 + chan]; }
#pragma unroll
            for (int i = 0; i < 16; ++i) { const int sc = dir == 0 ? i : 15 - i, full = dir * 192 + (q0 + sc) * 4 + hd; *(f32x4*)(base + (size_t)full * 32768) = run; run = run * __expf(dcy[i]) + tmp[i]; }
        } else {
            for (int i = 0; i < n; ++i) { const int sc = dir == 0 ? i : n - 1 - i, full = dir * 192 + (q0 + sc) * 4 + hd;
                f32x4* ptr = (f32x4*)(base + (size_t)full * 32768); const float dcy = __expf(dtot[full * 128 + chan]);
                const f32x4 tmp = *ptr; *ptr = run; run = run * dcy + tmp; }
        }
    }
}

#define XB_TMO      128
#define XB_XCNT(j)  (256  + 64 * (j))
#define XB_XSUB(j)  (1280 + 64 * (j))
#define XB_XGEN(j)  (2304 + 64 * (j))
#define XB_TOP      3328
#define XB_TOPGEN   3392
#define XCD_BAR_WORDS 3456
#define XB_SPIN_CAP (1u << 18)

__device__ __forceinline__ unsigned xb_ld(unsigned* p)              { return __hip_atomic_load(p, __ATOMIC_RELAXED, __HIP_MEMORY_SCOPE_AGENT); }
__device__ __forceinline__ unsigned xb_add(unsigned* p, unsigned v) { return __hip_atomic_fetch_add(p, v, __ATOMIC_RELAXED, __HIP_MEMORY_SCOPE_AGENT); }
__device__ __forceinline__ unsigned xb_xcc_id() { return (unsigned)__builtin_amdgcn_s_getreg((3 << 11) | 20) & 0xFu; }
#define XB_SPIN(cond, bar) do { unsigned _sp = 0; while (cond) { __builtin_amdgcn_s_sleep(1); \
    if ((++_sp & 255u) == 0u) { if (xb_ld(&(bar)[XB_TMO])) break; if (_sp > XB_SPIN_CAP) { atomicAdd(&(bar)[XB_TMO], 1u); break; } } } } while (0)

struct XcdBarrier {
    unsigned* bar; unsigned x;
    volatile LAS unsigned* st;
};

__device__ __forceinline__ XcdBarrier xcd_barrier_post(unsigned* bar, volatile LAS unsigned* st) {
    XcdBarrier b; b.bar = bar; b.x = xb_xcc_id(); b.st = st;
    if (threadIdx.x == 0) (void)xb_add(&bar[XB_XCNT(b.x)], 1u);
    return b;
}
__device__ __forceinline__ void xcd_barrier_complete(unsigned* bar, unsigned x, unsigned& nloc, unsigned& nx) {
    const unsigned G = gridDim.x * gridDim.y * gridDim.z;
    unsigned sum, cnt, mine, sp = 0u;
    for (;;) {
        sum = 0u; cnt = 0u; mine = 0u;
#pragma unroll
        for (unsigned j = 0; j < 16; ++j) { const unsigned c = xb_ld(&bar[XB_XCNT(j)]); sum += c; cnt += (c > 0u) ? 1u : 0u; mine = (j == x) ? c : mine; }
        if (sum == G) break;
        __builtin_amdgcn_s_sleep(1);
        if ((++sp & 255u) == 0u) { if (xb_ld(&bar[XB_TMO])) break; if (sp > XB_SPIN_CAP) { atomicAdd(&bar[XB_TMO], 1u); break; } }
    }
    nloc = mine > 0u ? mine : 1u; nx = cnt > 0u ? cnt : 1u;
}

__device__ __forceinline__ void xcd_barrier(const XcdBarrier& b) {
    asm volatile("s_waitcnt vmcnt(0)" ::: "memory");
    __syncthreads();
    if (threadIdx.x == 0) {
        unsigned* bar = b.bar;
        __builtin_amdgcn_s_waitcnt(0);
        unsigned nloc = b.st[0], nx = b.st[1];
        if (nloc == 0u) { xcd_barrier_complete(bar, b.x, nloc, nx); b.st[0] = nloc; b.st[1] = nx; }
        const unsigned old = xb_add(&bar[XB_XSUB(b.x)], 1u);
        const unsigned gen = old / nloc;
        if (old + 1u == (gen + 1u) * nloc) {
            __builtin_amdgcn_fence(__ATOMIC_RELEASE, "agent");
            asm volatile("s_waitcnt vmcnt(0)" ::: "memory");
            const unsigned og = xb_add(&bar[XB_TOP], 1u);
            const unsigned tg = og / nx;
            if (og + 1u == (tg + 1u) * nx) xb_add(&bar[XB_TOPGEN], 1u);
            else XB_SPIN(xb_ld(&bar[XB_TOPGEN]) == tg, bar);
            __builtin_amdgcn_fence(__ATOMIC_ACQUIRE, "agent");
            xb_add(&bar[XB_XGEN(b.x)], 1u);
            asm volatile("s_waitcnt vmcnt(0)" ::: "memory");
        } else {
            XB_SPIN(xb_ld(&bar[XB_XGEN(b.x)]) == gen, bar);
            __builtin_amdgcn_fence(__ATOMIC_ACQUIRE, "agent");
            asm volatile("s_waitcnt vmcnt(0)" ::: "memory");
        }
    }
    __syncthreads();
}

#if TPROBE
#define GRID_BAR() do { xcd_barrier(bar); if (blockIdx.x == 0 && threadIdx.x == 0) ((unsigned long long*)(p.ws + WS_STAMP))[tsi] = __builtin_amdgcn_s_memrealtime(); ++tsi; } while (0)
#else
#define GRID_BAR() xcd_barrier(bar)
#endif

template <int L, int SL>
__device__ __forceinline__ void mlp_up(const P& p, LAS unsigned char* lds) {
    unsigned char* ws = p.ws;
    bf16_t* hb = (bf16_t*)(ws + WS_HBUF); bf16_t* hid = (bf16_t*)(ws + WS_BIG + (size_t)(SL & 1) * 128 * MiB);
    const bf16_t* w1 = (const bf16_t*)(ws + (L ? WS_W1B : WS_W1A));
    pg8::Gemm g{hb + (size_t)SL * 16384 * D, w1, 16384, FF, D}; pg8::StaticOrder S; S.init(16384, FF, gridDim.x, blockIdx.x);
    EpiBf<1> E{hid, FF, nullptr};
    if (PH & 4096) pg8::gemm_phase<EpiBf<1>, pg8::StaticOrder>(lds, g, S, E, nullptr);
}
template <int L, int SL>
__device__ __forceinline__ void mlp_down(const P& p, LAS unsigned char* lds) {
    unsigned char* ws = p.ws;
    const float* ml = (const float*)(ws + WS_MOD) + (size_t)L * NSEQ * NMODC;
    bf16_t* hid = (bf16_t*)(ws + WS_BIG + (size_t)(SL & 1) * 128 * MiB);
    const bf16_t* w2 = (const bf16_t*)(ws + (L ? WS_W2B : WS_W2A));
    pg8::Gemm g{hid, w2, 16384, D, FF}; pg8::StaticOrder S; S.init(16384, D, gridDim.x, blockIdx.x);
    EpiRes E{p.out, ml + 5 * D, SL * 16384};
    if (PH & 8192) pg8::gemm_phase<EpiRes, pg8::StaticOrder>(lds, g, S, E, nullptr);
}
template <int L>
__device__ __forceinline__ void mlp_block(const P& p, LAS unsigned char* lds, const XcdBarrier& bar, int& tsi) {
    const float* ml = (const float*)(p.ws + WS_MOD) + (size_t)L * NSEQ * NMODC;
    norm_phase<1, false>(p, p.in[7] + L * D, ml + 3 * D, ml + 4 * D);
    GRID_BAR();
    mlp_up<L, 0>(p, lds);
    GRID_BAR();
    if (blockIdx.x & 1) { mlp_up<L, 1>(p, lds); mlp_down<L, 0>(p, lds); } else { mlp_down<L, 0>(p, lds); mlp_up<L, 1>(p, lds); }
    GRID_BAR();
    if (blockIdx.x & 1) { mlp_up<L, 2>(p, lds); mlp_down<L, 1>(p, lds); } else { mlp_down<L, 1>(p, lds); mlp_up<L, 2>(p, lds); }
    GRID_BAR();
    mlp_down<L, 2>(p, lds);
    GRID_BAR();
}

__global__ void __launch_bounds__(NTHREADS, 2) hybrid_fwd(P p) {
    extern __shared__ __attribute__((aligned(16))) unsigned char lds_raw[];
    LAS unsigned char* lds = (LAS unsigned char*)lds_raw;
    cg::grid_group grid = cg::this_grid();
    unsigned char* ws = p.ws;
    const float* mod = (const float*)(ws + WS_MOD);
    bf16_t* hb = (bf16_t*)(ws + WS_HBUF);
    bf16_t* big = (bf16_t*)(ws + WS_BIG);

    volatile LAS unsigned* bst = (volatile LAS unsigned*)(lds + LDS_BYTES - 16);
    if (threadIdx.x < 2) bst[threadIdx.x] = 0u;
    if (blockIdx.x == 0) for (int i = threadIdx.x; i < XCD_BAR_WORDS; i += NTHREADS) ((unsigned*)(ws + WS_BARW))[i] = 0u;
    __syncthreads();
    grid.sync();
    const XcdBarrier bar = xcd_barrier_post((unsigned*)(ws + WS_BARW), bst);
    int tsi = 1;
#if TPROBE
    if (blockIdx.x == 0 && threadIdx.x == 0) ((unsigned long long*)(ws + WS_STAMP))[0] = __builtin_amdgcn_s_memrealtime();
#endif
    if (PH & 1) p0_prep(p, lds);
    GRID_BAR();
    if (PH & 2) norm_phase<0, false>(p, p.in[6], mod + 0 * D, mod + 1 * D);
    GRID_BAR();
    if (PH & 4) s5_pass<false>(p, lds);
    GRID_BAR();
    if (PH & 8) s5_carry(p);
    GRID_BAR();
    if (PH & 16) s5_pass<true>(p, lds);
    GRID_BAR();
#if (DUP & 1)
    if (PH & 4) s5_pass<false>(p, lds);
    GRID_BAR();
    if (PH & 8) s5_carry(p);
    GRID_BAR();
    if (PH & 16) s5_pass<true>(p, lds);
    GRID_BAR();
#endif
    { pg8::Gemm g{big, (const bf16_t*)(ws + WS_WGLU), T, 2 * D, D}; pg8::StaticOrder S; S.init(T, 2 * D, gridDim.x, blockIdx.x);
      EpiGlu E{p.in[0], p.in[1], p.out, mod + 2 * D};
      if (PH & 512) pg8::gemm_phase<EpiGlu, pg8::StaticOrder>(lds, g, S, E, nullptr);
#if (DUP & 8)
      GRID_BAR(); pg8::gemm_phase<EpiGlu, pg8::StaticOrder>(lds, g, S, E, nullptr);
      GRID_BAR(); pg8::gemm_phase<EpiGlu, pg8::StaticOrder>(lds, g, S, E, nullptr);
      GRID_BAR(); pg8::gemm_phase<EpiGlu, pg8::StaticOrder>(lds, g, S, E, nullptr);
#endif
    }
    GRID_BAR();
    mlp_block<0>(p, lds, bar, tsi);
    norm_phase<1, false>(p, p.in[6] + D, mod + (size_t)NSEQ * NMODC + 0 * D, mod + (size_t)NSEQ * NMODC + 1 * D);
    GRID_BAR();
    { pg8::Gemm g{hb, (const bf16_t*)(ws + WS_WIN), T, WIN_N, D}; pg8::StaticOrder S; S.init(T, WIN_N, gridDim.x, blockIdx.x);
      EpiBf<0> E{big, PROJ_N, (float*)(ws + WS_A1)};
      if (PH & 1024) pg8::gemm_phase<EpiBf<0>, pg8::StaticOrder>(lds, g, S, E, nullptr); }
    GRID_BAR();
    gla_phase<0>(p, lds, 0, 256, 0);
    GRID_BAR();
    gla_carry(p, 0);
    GRID_BAR();
    if (blockIdx.x < 192) gla_phase<1>(p, lds); else gla_phase<0>(p, lds, 256, 48, 192);
    GRID_BAR();
    gla_carry(p, 1);
    GRID_BAR();
    if (PH & 256) gla_phase<2>(p, lds);
    GRID_BAR();
    { pg8::Gemm g{hb, (const bf16_t*)(ws + WS_WOUT), T, D, D}; pg8::StaticOrder S; S.init(T, D, gridDim.x, blockIdx.x);
      EpiRes E{p.out, mod + (size_t)NSEQ * NMODC + 2 * D, 0};
      if (PH & 2048) pg8::gemm_phase<EpiRes, pg8::StaticOrder>(lds, g, S, E, nullptr); }
    GRID_BAR();
    mlp_block<1>(p, lds, bar, tsi);
#if (DUP & 4)
#pragma unroll 1
    for (int rep = 0; rep < 20; ++rep) GRID_BAR();
#endif
    float oscale = 1.0f;
#if TPROBE
    xcd_barrier(bar);
    { const unsigned long long* st = (const unsigned long long*)(ws + WS_STAMP); unsigned long long sel = 0ull;
#pragma unroll
      for (int i = 0; i < 23; ++i) if (TSEL & (1u << i)) sel += st[i + 1] - st[i];
      oscale = 1.0f + (float)sel / (float)(st[23] - st[0]); }
#endif
    if (PH == 0) norm_phase<0, true>(p, p.in[25], nullptr, nullptr, oscale); else norm_phase<1, true>(p, p.in[25], nullptr, nullptr, oscale);
    (void)tsi;
}

extern "C" void kernel_launch(void* const* d_in, const int* in_sizes, int n_in, void* d_out, int out_size, void* d_ws, size_t ws_size, hipStream_t stream) {
    static int grid_blocks = 0;
    if (grid_blocks == 0) {
        if (n_in != 26 || out_size != T * D || ws_size < WS_END) { fprintf(stderr, "kernel_launch: unexpected sizes n_in %d out %d ws %zu\n", n_in, out_size, ws_size); grid_blocks = -1; return; }
        int dev = 0, cus = 0, per_cu = 0;
        hipGetDevice(&dev);
        hipDeviceGetAttribute(&cus, hipDeviceAttributeMultiprocessorCount, dev);
        hipFuncSetAttribute((const void*)hybrid_fwd, hipFuncAttributeMaxDynamicSharedMemorySize, LDS_BYTES);
        hipOccupancyMaxActiveBlocksPerMultiprocessor(&per_cu, (const void*)hybrid_fwd, NTHREADS, LDS_BYTES);
        if (per_cu < 1) { fprintf(stderr, "kernel_launch: occupancy query says %d blocks per CU\n", per_cu); grid_blocks = -1; return; }
        grid_blocks = cus;
        if (grid_blocks % 8) grid_blocks -= grid_blocks % 8;
    }
    if (grid_blocks < 0) return;
    P p{};
    for (int i = 0; i < 26; ++i) p.in[i] = (const float*)d_in[i];
    p.out = (float*)d_out; p.ws = (unsigned char*)d_ws;
    void* args[] = {&p};
    hipError_t e = hipLaunchCooperativeKernel((const void*)hybrid_fwd, dim3(grid_blocks), dim3(NTHREADS), args, LDS_BYTES, stream);
    if (e != hipSuccess) fprintf(stderr, "cooperative launch failed: %s (grid %d)\n", hipGetErrorString(e), grid_blocks);
}
```

```cpp
#include <hip/hip_runtime.h>
#include <hip/hip_cooperative_groups.h>
#include <cstdio>
namespace cg = cooperative_groups;

namespace pg8 {
#define PG8_LAS __attribute__((address_space(3)))
typedef unsigned short bf16_t;
typedef short bf16x8 __attribute__((ext_vector_type(8)));
typedef float f32x4 __attribute__((ext_vector_type(4)));
typedef unsigned u32x4 __attribute__((ext_vector_type(4)));
constexpr int BM = 256, BK = 64, HALF = 128, HTB = HALF * BK * 2  , STAGE_BYTES = 8 * HTB, NXCD = 8, WGM = 8;

__host__ __device__ __forceinline__ int lds_byte(int r, int c) { const int st = (r >> 4) * 2 + (c >> 5), rr = r & 15, cc = c & 31, ob = rr * 64 + cc * 2; return st * 1024 + (ob ^ (((ob >> 9) & 1) << 5)); }
__host__ __device__ __forceinline__ void stage_rc(int b, int& R, int& C) { const int st = b / 1024, sb = b % 1024, swz = sb ^ (((sb >> 9) & 1) << 5); R = (st >> 1) * 16 + swz / 64; C = (st & 1) * 32 + (swz % 64) / 2; }
__host__ __device__ __forceinline__ int perm32(int rho) { const int n = rho >> 4, i = rho & 15; return 8 * (i >> 2) + 4 * n + (i & 3); }

struct Unit { int pm, pn; };
struct Gemm { const bf16_t* A; const bf16_t* Bt; int M, N, K; };

struct StaticOrder {
    int nM, nN, nwg, G, c;
    __host__ __device__ void init(int M, int N, int G_, int c_) { nM = M / BM; nN = N / BM; nwg = nM * nN; G = G_; c = c_; }
    __host__ __device__ bool next(int i, Unit& u) const {
        const long L = (long)i * G + c; if (L >= nwg) return false;
        int wgid = (int)L; { const int q = nwg / NXCD, r = nwg % NXCD, xcd = wgid % NXCD, off = wgid / NXCD; wgid = (xcd < r ? xcd * (q + 1) : r * (q + 1) + (xcd - r) * q) + off; }
        const int nig = WGM * nN, gid = wgid / nig, fm = gid * WGM, gsz = (nM - fm) < WGM ? (nM - fm) : WGM;
        u.pm = fm + ((wgid % nig) % gsz); u.pn = (wgid % nig) / gsz; return true;
    }
    __device__ __forceinline__ void a_ready(const Unit&) const {}
    __device__ __forceinline__ void done(const Unit&) const {}
};


template <class Epi, class Sched, bool STAMP = false>
__device__ __forceinline__ void gemm_phase(PG8_LAS unsigned char* lds, const Gemm g, const Sched& S, const Epi& E, unsigned long long* stamps) {
    int tid_ = threadIdx.x; asm volatile("" : "+v"(tid_));
    const int tid = tid_, wid = __builtin_amdgcn_readfirstlane(tid >> 6), lane = tid & 63, wr = wid >> 2, wc = wid & 3, fr = lane & 15, fq = lane >> 4;
    const int K = g.K, nt = K / BK;
    int ts_lo = 0, ts_hi = 0, nts = 0; const unsigned long long rt_entry = STAMP ? (unsigned long long)wall_clock64() : 0ull;
#define PG8_STAMP() do { if (STAMP && wid == 0 && nts < 64) { const unsigned long long _c = (unsigned long long)clock64(); \
        ts_lo = (lane == nts) ? (int)(unsigned)_c : ts_lo; ts_hi = (lane == nts) ? (int)(unsigned)(_c >> 32) : ts_hi; ++nts; } } while (0)
    PG8_STAMP();
    unsigned voffA[2], voffB[2];
#pragma unroll
    for (int i = 0; i < 2; ++i) { int R, C; stage_rc(tid * 16 + i * 8192, R, C); const int Rb = Epi::PERM ? ((R & ~31) + perm32(R & 31)) : R;
        voffA[i] = (unsigned)(R * K + C) * 2u; voffB[i] = (unsigned)(Rb * K + C) * 2u; }
    const size_t kstep = (size_t)(BK * 2);
    const size_t hstep = (size_t)HALF * K * 2;
    const size_t tstep = 2 * hstep;
    const unsigned ldsw = (unsigned)wid * 1024u;
    const int aoff = lds_byte(wr * 64 + fr, fq * 8), boff = lds_byte(wc * 32 + fr, fq * 8);
#define PG8_SA(b, h) (((b) * 2 + (h)) * HTB)
#define PG8_SB(b, h) ((4 + (b) * 2 + (h)) * HTB)
#define PG8_STAGE(bufoff, gbase, voff) do { _Pragma("unroll") for (int _i = 0; _i < 2; ++_i) \
        __builtin_amdgcn_global_load_lds((const unsigned*)((const char*)(gbase) + (voff)[_i]), (PG8_LAS unsigned*)(lds + (bufoff) + ldsw + _i * 8192), 16, 0, 0); } while (0)
#define PG8_LDA(dst, b, h) do { _Pragma("unroll") for (int m = 0; m < 4; ++m) _Pragma("unroll") for (int k = 0; k < 2; ++k) dst[m][k] = *(const PG8_LAS bf16x8*)(lds + PG8_SA(b, h) + aoff + m * 2048 + k * 1024); } while (0)
#define PG8_LDB(dst, b, h) do { _Pragma("unroll") for (int n = 0; n < 2; ++n) _Pragma("unroll") for (int k = 0; k < 2; ++k) dst[n][k] = *(const PG8_LAS bf16x8*)(lds + PG8_SB(b, h) + boff + n * 2048 + k * 1024); } while (0)
#define PG8_MMA(ai, bj, At, Bt) do { __builtin_amdgcn_s_setprio(1); _Pragma("unroll") for (int m = 0; m < 4; ++m) _Pragma("unroll") for (int n = 0; n < 2; ++n) _Pragma("unroll") for (int k = 0; k < 2; ++k) \
        acc[ai][bj][m][n] = __builtin_amdgcn_mfma_f32_16x16x32_bf16(Bt[n][k], At[m][k], acc[ai][bj][m][n], 0, 0, 0); __builtin_amdgcn_s_setprio(0); } while (0)
#define PG8_WAIT_V(n) asm volatile("s_waitcnt vmcnt(" #n ")" ::: "memory")
#define PG8_WAIT_L(n) asm volatile("s_waitcnt lgkmcnt(" #n ")" ::: "memory")
#define PG8_BAR __builtin_amdgcn_s_barrier()
#define PG8_SCHED __builtin_amdgcn_sched_barrier(0)
    Unit cur, nxt; int ui = 0;
    if (!S.next(0, cur)) return;
    f32x4 acc[2][2][4][2];
#pragma unroll
    for (int a = 0; a < 2; ++a)
#pragma unroll
        for (int b = 0; b < 2; ++b)
#pragma unroll
            for (int m = 0; m < 4; ++m)
#pragma unroll
                for (int n = 0; n < 2; ++n) acc[a][b][m][n] = (f32x4){0.f, 0.f, 0.f, 0.f};
    bf16x8 At[4][2], B0[2][2], B1[2][2];
    const char* cA = (const char*)g.A + (size_t)cur.pm * tstep; const char* cB = (const char*)g.Bt + (size_t)cur.pn * tstep;
    S.a_ready(cur);
    PG8_STAGE(PG8_SB(0, 0), cB, voffB); PG8_STAGE(PG8_SA(0, 0), cA, voffA); PG8_STAGE(PG8_SB(0, 1), cB + hstep, voffB); PG8_STAGE(PG8_SA(0, 1), cA + hstep, voffA);
    if (wr == 1) PG8_BAR;
    PG8_WAIT_V(4); PG8_BAR;
    PG8_STAGE(PG8_SB(1, 0), cB + kstep, voffB); PG8_STAGE(PG8_SA(1, 0), cA + kstep, voffA); PG8_STAGE(PG8_SB(1, 1), cB + hstep + kstep, voffB);
    PG8_WAIT_V(6); PG8_BAR;
    PG8_STAMP();
    for (;;) {
        const bool has_next = S.next(ui + 1, nxt);
        const char* nA = has_next ? (const char*)g.A + (size_t)nxt.pm * tstep : cA; const char* nB = has_next ? (const char*)g.Bt + (size_t)nxt.pn * tstep : cB;
        for (int t = 0; t < nt; t += 2) {
            const bool last = (t == nt - 2);
            const char* a1 = cA + (size_t)(t + 1) * kstep;
            const char* a2 = last ? nA : cA + (size_t)(t + 2) * kstep; const char* b2 = last ? nB : cB + (size_t)(t + 2) * kstep;
            const char* a3 = a2 + kstep; const char* b3 = b2 + kstep;
            if (last && has_next) S.a_ready(nxt);
            PG8_LDB(B0, 0, 0); PG8_SCHED; PG8_LDA(At, 0, 0); PG8_STAGE(PG8_SA(1, 1), a1 + hstep, voffA);
            PG8_WAIT_L(8); PG8_BAR; PG8_WAIT_L(0); PG8_MMA(0, 0, At, B0); PG8_BAR; PG8_SCHED;
            PG8_LDB(B1, 0, 1); PG8_STAGE(PG8_SB(0, 0), b2, voffB);
            PG8_BAR; PG8_WAIT_L(0); PG8_MMA(0, 1, At, B1); PG8_BAR;
            PG8_LDA(At, 0, 1); PG8_STAGE(PG8_SA(0, 0), a2, voffA);
            PG8_BAR; PG8_WAIT_L(0); PG8_MMA(1, 0, At, B0); PG8_BAR; PG8_SCHED;
            PG8_STAGE(PG8_SB(0, 1), b2 + hstep, voffB);
            PG8_WAIT_V(6); PG8_BAR; PG8_MMA(1, 1, At, B1); PG8_BAR;
            PG8_LDB(B0, 1, 0); PG8_SCHED; PG8_LDA(At, 1, 0); PG8_STAGE(PG8_SA(0, 1), a2 + hstep, voffA);
            PG8_WAIT_L(8); PG8_BAR; PG8_WAIT_L(0); PG8_MMA(0, 0, At, B0); PG8_BAR; PG8_SCHED;
            PG8_LDB(B1, 1, 1); PG8_STAGE(PG8_SB(1, 0), b3, voffB);
            PG8_BAR; PG8_WAIT_L(0); PG8_MMA(0, 1, At, B1); PG8_BAR;
            PG8_LDA(At, 1, 1); PG8_STAGE(PG8_SA(1, 0), a3, voffA);
            PG8_BAR; PG8_WAIT_L(0); PG8_MMA(1, 0, At, B0); PG8_BAR; PG8_SCHED;
            PG8_STAGE(PG8_SB(1, 1), b3 + hstep, voffB);
            PG8_WAIT_V(6); PG8_BAR; PG8_MMA(1, 1, At, B1); PG8_BAR;
        }
        PG8_STAMP();
        if constexpr (!Epi::AFTER_DRAIN) { E(acc, cur, wr, wc, fr, fq); S.done(cur); }
        PG8_STAMP();
        if (!has_next) break;
#pragma unroll
        for (int a = 0; a < 2; ++a)
#pragma unroll
            for (int b = 0; b < 2; ++b)
#pragma unroll
                for (int m = 0; m < 4; ++m)
#pragma unroll
                    for (int n = 0; n < 2; ++n) acc[a][b][m][n] = (f32x4){0.f, 0.f, 0.f, 0.f};
        cur = nxt; cA = nA; cB = nB; ++ui;
    }
    PG8_WAIT_V(0);
    if (wr == 0) PG8_BAR;
    PG8_BAR;
    if constexpr (Epi::AFTER_DRAIN) { E.fused(acc, cur, wr, wc, fr, fq, lds, wid, lane); S.done(cur); }
    PG8_STAMP();
    if (STAMP && wid == 0) { stamps[lane] = lane < nts ? (((unsigned long long)(unsigned)ts_hi << 32) | (unsigned)ts_lo) : 0ull;
        if (lane == 62) stamps[62] = rt_entry; if (lane == 63) stamps[63] = (unsigned long long)wall_clock64(); }
#undef PG8_STAMP
#undef PG8_SA
#undef PG8_SB
#undef PG8_STAGE
#undef PG8_LDA
#undef PG8_LDB
#undef PG8_MMA
#undef PG8_WAIT_V
#undef PG8_WAIT_L
#undef PG8_BAR
#undef PG8_SCHED
}
}


#define LAS __attribute__((address_space(3)))
typedef unsigned short bf16_t;
typedef short bf16x8 __attribute__((ext_vector_type(8)));
typedef short bf16x4 __attribute__((ext_vector_type(4)));
typedef float f32x4 __attribute__((ext_vector_type(4)));
typedef float f32x16 __attribute__((ext_vector_type(16)));
typedef unsigned u32x4 __attribute__((ext_vector_type(4)));
typedef unsigned u32x2 __attribute__((ext_vector_type(2)));

constexpr int D = 1024, T = 49152, NSEQ = 10, NMODC = 6144, FF = 4096;
constexpr int T_PROMPT = 32768;
constexpr float EPS = 1e-6f;
#ifndef PH
#define PH 16383
#endif
#ifndef DUP
#define DUP 0
#endif
#ifndef TPROBE
#define TPROBE 0
#endif
#ifndef TSEL
#define TSEL 0u
#endif
constexpr int NWAVES = 8, NTHREADS = 512;
constexpr int LDS_BYTES = 139264;
constexpr int WIN_N = 3328;
constexpr int PROJ_N = 3072;

constexpr size_t MiB = 1u << 20;
constexpr size_t WS_MOD = 0;
constexpr size_t WS_BARW = 491520;
constexpr size_t WS_STAMP = 507904;
constexpr size_t WS_ABAR = 512 * 1024;
constexpr size_t WS_BBT = 1 * MiB;
constexpr size_t WS_CT = 1 * MiB + 512 * 1024;
constexpr size_t WS_DTOT = 2 * MiB;
constexpr size_t WS_A1 = 3 * MiB;
constexpr size_t WS_WIN = 10 * MiB;
constexpr size_t WS_WOUT = WS_WIN + (size_t)WIN_N * D * 2;
constexpr size_t WS_W1B = WS_WOUT + (size_t)D * D * 2;
constexpr size_t WS_W2B = WS_W1B + (size_t)FF * D * 2;
constexpr size_t WS_HBUF = 35 * MiB;
constexpr size_t WS_BIG = 131 * MiB;
constexpr size_t WS_S5E = WS_BIG + 96 * MiB;
constexpr size_t WS_X = 419 * MiB;
constexpr size_t WS_WGLU = WS_X;
constexpr size_t WS_W1A = WS_X + 4 * MiB;
constexpr size_t WS_W2A = WS_X + 12 * MiB;
constexpr size_t WS_SBUF = WS_X;
constexpr size_t WS_END = 467 * MiB;
static_assert(WS_W2B + (size_t)FF * D * 2 <= WS_HBUF, "ws map");

struct P { const float* in[26]; float* out; unsigned char* ws; };

typedef __bf16 bf16n2 __attribute__((ext_vector_type(2)));
typedef float f32x2n __attribute__((ext_vector_type(2)));
__device__ __forceinline__ unsigned pk_bf16(float lo, float hi) { const f32x2n f = {lo, hi}; const bf16n2 v = __builtin_convertvector(f, bf16n2); return __builtin_bit_cast(unsigned, v); }
__device__ __forceinline__ bf16_t f2bf(float f) { return (bf16_t)(pk_bf16(f, 0.f) & 0xffffu); }
__device__ __forceinline__ float bf2f(bf16_t b) { return __uint_as_float(((unsigned)b) << 16); }
__device__ __forceinline__ float wave_sum(float v) {
#pragma unroll
    for (int o = 1; o < 64; o <<= 1) v += __shfl_xor(v, o);
    return v;
}
__device__ __forceinline__ int row_seq(int row) { return row < T_PROMPT ? (row >> 14) : 2 + ((row - T_PROMPT) >> 11); }
__device__ __forceinline__ float sigmoidf_(float x) { return 1.0f / (1.0f + __expf(-x)); }
__device__ __forceinline__ float gelu_tanh(float y) {
    const float a = 0.7978845608028654f * (y + 0.044715f * y * y * y);
    const float th = 1.0f - 2.0f / (__expf(2.0f * a) + 1.0f);
    return 0.5f * y * (1.0f + th);
}
#define CFENCE() asm volatile("" ::: "memory")
#define LDS_WAIT() asm volatile("s_waitcnt lgkmcnt(0)" ::: "memory")

struct EpiRes {
    static constexpr bool PERM = false, AFTER_DRAIN = false;
    float* x; const float* gate; int row_off;
    __device__ __forceinline__ void operator()(const pg8::f32x4 (&acc)[2][2][4][2], const pg8::Unit& u, int wr, int wc, int fr, int fq) const {
        const int row0 = row_off + u.pm * 256 + wr * 64 + fr, col0 = u.pn * 256 + wc * 32 + 4 * fq;
        const float* gp = gate + (size_t)row_seq(row_off + u.pm * 256) * NMODC;
        pg8::f32x4 gv[2][2];
#pragma unroll
        for (int bj = 0; bj < 2; ++bj)
#pragma unroll
            for (int n = 0; n < 2; ++n) gv[bj][n] = *(const pg8::f32x4*)(gp + col0 + bj * 128 + n * 16);
#pragma unroll
        for (int ai = 0; ai < 2; ++ai)
#pragma unroll
            for (int m = 0; m < 4; ++m) { float* rowp = x + (size_t)(row0 + ai * 128 + m * 16) * D + col0;
#pragma unroll
                for (int bj = 0; bj < 2; ++bj)
#pragma unroll
                    for (int n = 0; n < 2; ++n) { pg8::f32x4* q = (pg8::f32x4*)(rowp + bj * 128 + n * 16); *q = *q + gv[bj][n] * acc[ai][bj][m][n]; }
                if (m & 1) asm volatile("" ::: "memory"); }
    }
};
struct EpiGlu {
    static constexpr bool PERM = false, AFTER_DRAIN = false;
    const float* xp; const float* xs; float* out; const float* gate;
    __device__ __forceinline__ void operator()(const pg8::f32x4 (&acc)[2][2][4][2], const pg8::Unit& u, int wr, int wc, int fr, int fq) const {
        const int row0 = u.pm * 256 + wr * 64 + fr, col0 = u.pn * 128 + wc * 32 + 4 * fq;
        const float* gp = gate + (size_t)row_seq(u.pm * 256) * NMODC;
        pg8::f32x4 gv[2];
#pragma unroll
        for (int n = 0; n < 2; ++n) gv[n] = *(const pg8::f32x4*)(gp + col0 + n * 16);
#pragma unroll
        for (int ai = 0; ai < 2; ++ai)
#pragma unroll
            for (int m = 0; m < 4; ++m) { const int row = row0 + ai * 128 + m * 16;
                const float* xin = row < T_PROMPT ? xp + (size_t)row * D : xs + (size_t)(row - T_PROMPT) * D;
#pragma unroll
                for (int n = 0; n < 2; ++n) { const pg8::f32x4 val = acc[ai][0][m][n], gt = acc[ai][1][m][n]; pg8::f32x4 sg;
                    sg[0] = sigmoidf_(gt[0]); sg[1] = sigmoidf_(gt[1]); sg[2] = sigmoidf_(gt[2]); sg[3] = sigmoidf_(gt[3]);
                    const pg8::f32x4 xv = *(const pg8::f32x4*)(xin + col0 + n * 16);
                    *(pg8::f32x4*)(out + (size_t)row * D + col0 + n * 16) = xv + gv[n] * val * sg; }
                if (m & 1) asm volatile("" ::: "memory"); }
    }
};
template <int ACT> struct EpiBf {
    static constexpr bool PERM = true, AFTER_DRAIN = false;
    bf16_t* O; int ldc; float* a1;
    __device__ __forceinline__ void operator()(const pg8::f32x4 (&acc)[2][2][4][2], const pg8::Unit& u, int wr, int wc, int fr, int fq) const {
        const int row0 = u.pm * 256 + wr * 64 + fr;
        if (ACT == 0 && u.pn == 12) {
            if (wc == 0) {
#pragma unroll
                for (int ai = 0; ai < 2; ++ai)
#pragma unroll
                    for (int m = 0; m < 4; ++m) { float* rp = a1 + (size_t)(row0 + ai * 128 + m * 16) * 32 + 8 * fq;
                        *(pg8::f32x4*)rp = acc[ai][0][m][0]; *(pg8::f32x4*)(rp + 4) = acc[ai][0][m][1]; }
            }
            return;
        }
        const int col0 = u.pn * 256 + wc * 32 + 8 * fq;
#pragma unroll
        for (int ai = 0; ai < 2; ++ai)
#pragma unroll
            for (int m = 0; m < 4; ++m) { bf16_t* rowp = O + (size_t)(row0 + ai * 128 + m * 16) * ldc + col0;
#pragma unroll
                for (int bj = 0; bj < 2; ++bj) { pg8::f32x4 v0 = acc[ai][bj][m][0], v1 = acc[ai][bj][m][1];
                    if (ACT == 1) {
#pragma unroll
                        for (int e = 0; e < 4; ++e) { const float a = fmaxf(v0[e], 0.f), b = fmaxf(v1[e], 0.f); v0[e] = a * a; v1[e] = b * b; } }
                    pg8::u32x4 wv; wv.x = pk_bf16(v0[0], v0[1]); wv.y = pk_bf16(v0[2], v0[3]); wv.z = pk_bf16(v1[0], v1[1]); wv.w = pk_bf16(v1[2], v1[3]);
                    *(pg8::u32x4*)(rowp + bj * 128) = wv; } }
    }
};

__device__ __forceinline__ void transpose_item(const float* W, int K, int N, int srccol0, bf16_t* WT, int dstrow0, int k0, LAS float* scr, int lane) {
    { float tv[32];
#pragma unroll
      for (int i = 0; i < 32; ++i) tv[i] = W[(size_t)(k0 + 2 * i + (lane >> 5)) * N + srccol0 + (lane & 31)];
#pragma unroll
      for (int i = 0; i < 32; ++i) scr[(2 * i + (lane >> 5)) * 33 + (lane & 31)] = tv[i]; }
    LDS_WAIT();
    const int c = lane & 7;
#pragma unroll
    for (int j = 0; j < 4; ++j) { const int n = (lane >> 3) + 8 * j; const LAS float* s = scr + (8 * c) * 33 + n;
        u32x4 o; o.x = pk_bf16(s[0 * 33], s[1 * 33]); o.y = pk_bf16(s[2 * 33], s[3 * 33]); o.z = pk_bf16(s[4 * 33], s[5 * 33]); o.w = pk_bf16(s[6 * 33], s[7 * 33]);
        *(u32x4*)(WT + (size_t)(dstrow0 + n) * K + k0 + 8 * c) = o; }
    LDS_WAIT();
}

__device__ __forceinline__ void p0_prep(const P& p, LAS unsigned char* lds) {
    int tid_ = threadIdx.x; asm volatile("" : "+v"(tid_));
    const int tid = tid_, lane = tid & 63, w = tid >> 6;
    unsigned char* ws = p.ws;
    if ((int)blockIdx.x < 192) {
        LAS float* sc = (LAS float*)lds;
        LAS float* red = (LAS float*)(lds + 40960);
        for (int i = tid; i < NSEQ * D; i += NTHREADS) { const int s = i >> 10, d = i & 1023; const float c = s < 2 ? p.in[2][s * D + d] : p.in[3][(s - 2) * D + d]; sc[i] = c * sigmoidf_(c); }
        __syncthreads();
        for (int it = blockIdx.x; it < 192; it += gridDim.x) {
            const int l = it / 96, col0 = (it % 96) * 64, col = tid & 63, ks = w;
            float acc[NSEQ];
#pragma unroll
            for (int s = 0; s < NSEQ; ++s) acc[s] = 0.f;
            const float* wp = p.in[4] + ((size_t)l * D + ks * 128) * NMODC + col0 + col;
#pragma unroll 16
            for (int k = 0; k < 128; ++k) { const float wv = wp[(size_t)k * NMODC];
#pragma unroll
                for (int s = 0; s < NSEQ; ++s) acc[s] += sc[s * D + ks * 128 + k] * wv; }
#pragma unroll
            for (int s = 0; s < NSEQ; ++s) red[(ks * NSEQ + s) * 64 + col] = acc[s];
            __syncthreads();
            for (int i = tid; i < NSEQ * 64; i += NTHREADS) { const int s = i >> 6, cc = i & 63; float v = 0.f;
#pragma unroll
                for (int k8 = 0; k8 < 8; ++k8) v += red[(k8 * NSEQ + s) * 64 + cc];
                ((float*)(ws + WS_MOD))[((size_t)l * NSEQ + s) * NMODC + col0 + cc] = v + p.in[5][l * NMODC + col0 + cc]; }
            __syncthreads();
        }
    }
    __syncthreads();
    {
        LAS float* scr = (LAS float*)(lds + w * 16384);
        const int gw = blockIdx.x * NWAVES + w, NGW = gridDim.x * NWAVES;
        constexpr int I_GLU = 16 * 64, I_WIN = 16 * 96, I_WOUT = 16 * 32, I_W1 = 16 * 128, I_W2 = 64 * 32;
        constexpr int NITEMS = I_GLU + I_WIN + I_WOUT + 2 * I_W1 + 2 * I_W2;
        for (int it = gw; it < NITEMS; it += NGW) {
            int r = it;
            if (r < I_GLU) { const int kb = r / 64, nb = r % 64, n0 = nb * 32, pn = n0 >> 8, bj = (n0 >> 7) & 1, r0 = n0 & 127;
                transpose_item(p.in[16], D, 2 * D, bj * D + pn * 128 + r0, (bf16_t*)(ws + WS_WGLU), n0, kb * 64, scr, lane); continue; }
            r -= I_GLU;
            if (r < I_WIN) { const int kb = r / 96, nb = r % 96; transpose_item(p.in[17], D, PROJ_N, nb * 32, (bf16_t*)(ws + WS_WIN), nb * 32, kb * 64, scr, lane); continue; }
            r -= I_WIN;
            if (r < I_WOUT) { const int kb = r / 32, nb = r % 32; transpose_item(p.in[22], D, D, nb * 32, (bf16_t*)(ws + WS_WOUT), nb * 32, kb * 64, scr, lane); continue; }
            r -= I_WOUT;
            if (r < 2 * I_W1) { const int l = r / I_W1, q = r % I_W1, kb = q / 128, nb = q % 128;
                transpose_item(p.in[23] + (size_t)l * D * FF, D, FF, nb * 32, (bf16_t*)(ws + (l ? WS_W1B : WS_W1A)), nb * 32, kb * 64, scr, lane); continue; }
            r -= 2 * I_W1;
            { const int l = r / I_W2, q = r % I_W2, kb = q / 32, nb = q % 32;
                transpose_item(p.in[24] + (size_t)l * FF * D, FF, D, nb * 32, (bf16_t*)(ws + (l ? WS_W2B : WS_W2A)), nb * 32, kb * 64, scr, lane); }
        }
        bf16_t* wt = (bf16_t*)(ws + WS_WIN);
        for (int i = blockIdx.x * NTHREADS + tid; i < 256 * D; i += gridDim.x * NTHREADS) { const int r = i >> 10, k = i & 1023;
            const float v = r < 32 ? p.in[18][((size_t)(r >> 4) * D + k) * 16 + (r & 15)] : 0.f;
            wt[(size_t)(PROJ_N + r) * D + k] = f2bf(v); }
    }
    for (int i = blockIdx.x * NTHREADS + tid; i < 2 * 64 * 64; i += gridDim.x * NTHREADS) {
        const int pp = i & 63, dg = i >> 6;
        const float lr = p.in[8][i], li = p.in[9][i], dt = __expf(p.in[10][dg]);
        const float mag = __expf(lr * dt); float sn, cs; sincosf(li * dt, &sn, &cs);
        const float abr = mag * cs, abi = mag * sn, den = lr * lr + li * li;
        const float zr = ((abr - 1.0f) * lr + abi * li) / den, zi = (abi * lr - (abr - 1.0f) * li) / den;
        float* ab = (float*)(ws + WS_ABAR); ab[2 * i] = abr; ab[2 * i + 1] = abi;
        bf16_t* bbt = (bf16_t*)(ws + WS_BBT); bf16_t* ct = (bf16_t*)(ws + WS_CT);
#pragma unroll
        for (int h = 0; h < 16; ++h) {
            const float br = p.in[11][(size_t)i * 16 + h], bi = p.in[12][(size_t)i * 16 + h];
            bbt[((size_t)dg * 128 + pp) * 16 + h] = f2bf(zr * br - zi * bi);
            bbt[((size_t)dg * 128 + 64 + pp) * 16 + h] = f2bf(zr * bi + zi * br);
            ct[((size_t)dg * 16 + h) * 128 + pp] = f2bf(p.in[13][((size_t)dg * 16 + h) * 64 + pp]);
            ct[((size_t)dg * 16 + h) * 128 + 64 + pp] = f2bf(-p.in[14][((size_t)dg * 16 + h) * 64 + pp]);
        }
    }
}

template <int SRC, bool FINAL>
__device__ __forceinline__ void norm_phase(const P& p, const float* gvec, const float* shift, const float* scale, float oscale = 1.0f, const int row_lo = 0, const int row_hi = T) {
    int tid_ = threadIdx.x; asm volatile("" : "+v"(tid_));
    const int tid = tid_, lane = tid & 63, w = tid >> 6;
    const int gw = blockIdx.x * NWAVES + w, NGW = gridDim.x * NWAVES;
    bf16_t* hb = (bf16_t*)(p.ws + WS_HBUF);
    f32x4 gq[4];
#pragma unroll
    for (int j = 0; j < 4; ++j) gq[j] = *(const f32x4*)(gvec + 4 * lane + 256 * j);
    f32x4 vn[4];
    if (row_lo + gw < row_hi) { const int row = row_lo + gw; const float* xr = SRC == 0 ? (row < T_PROMPT ? p.in[0] + (size_t)row * D : p.in[1] + (size_t)(row - T_PROMPT) * D) : p.out + (size_t)row * D;
#pragma unroll
      for (int j = 0; j < 4; ++j) vn[j] = *(const f32x4*)(xr + 4 * lane + 256 * j); }
    for (int row = row_lo + gw; row < row_hi; row += NGW) {
        f32x4 v[4]; float ss = 0.f;
#pragma unroll
        for (int j = 0; j < 4; ++j) { v[j] = vn[j]; ss += (v[j][0] * v[j][0] + v[j][1] * v[j][1]) + (v[j][2] * v[j][2] + v[j][3] * v[j][3]); }
        { const int rn = row + NGW < row_hi ? row + NGW : row;
          const float* xr = SRC == 0 ? (rn < T_PROMPT ? p.in[0] + (size_t)rn * D : p.in[1] + (size_t)(rn - T_PROMPT) * D) : p.out + (size_t)rn * D;
#pragma unroll
          for (int j = 0; j < 4; ++j) vn[j] = *(const f32x4*)(xr + 4 * lane + 256 * j); }
        const float rstd = rsqrtf(wave_sum(ss) * (1.0f / D) + EPS);
        if (FINAL) {
#pragma unroll
            for (int j = 0; j < 4; ++j) *(f32x4*)(p.out + (size_t)row * D + 4 * lane + 256 * j) = v[j] * (rstd * oscale) * gq[j];
        } else {
            const int s = row_seq(row);
#pragma unroll
            for (int j = 0; j < 4; ++j) { const f32x4 sh = *(const f32x4*)(shift + (size_t)s * NMODC + 4 * lane + 256 * j), sc = *(const f32x4*)(scale + (size_t)s * NMODC + 4 * lane + 256 * j);
                const f32x4 o = (v[j] * rstd * gq[j]) * (sc + 1.0f) + sh;
                u32x2 wv; wv.x = pk_bf16(o[0], o[1]); wv.y = pk_bf16(o[2], o[3]);
                *(u32x2*)(hb + (size_t)row * D + 4 * lane + 256 * j) = wv; }
        }
    }
}

constexpr int S5_NCH = 384, S5_HROW = 272, S5_UROW = 48, S5_UOFF = 32 * S5_HROW, S5_WAVE_LDS = S5_UOFF + 128 * S5_UROW;
__device__ __forceinline__ void half_bcast(float x, float& lo, float& hi) { const auto r = __builtin_amdgcn_permlane32_swap(__float_as_uint(x), __float_as_uint(x), false, false); lo = __uint_as_float(r[0]); hi = __uint_as_float(r[1]); }
#define CMAD(sr, si, mr, mi, br, bi) do { const float nr_ = (sr) * (mr) - (si) * (mi) + (br); const float ni_ = (sr) * (mi) + (si) * (mr) + (bi); (sr) = nr_; (si) = ni_; } while (0)
template <bool PC>
__device__ __forceinline__ void s5_pass(const P& p, LAS unsigned char* lds) {
    int tid_ = threadIdx.x; asm volatile("" : "+v"(tid_));
    const int tid = tid_, lane = tid & 63, w = __builtin_amdgcn_readfirstlane(tid >> 6);
    const int b = blockIdx.x, g = (b & 7) * 8 + w;
    const int hh = lane >> 5, l32 = lane & 31, l16 = lane & 15, q16 = lane >> 4;
    LAS unsigned char* const H = lds + w * S5_WAVE_LDS;
    LAS unsigned char* const hwr = H + (4 * hh) * S5_HROW + l32 * 4;
    const LAS unsigned char* const hrd = H + l16 * S5_HROW + q16 * 16;
    const bf16_t* hb = (const bf16_t*)(p.ws + WS_HBUF);
    bf16_t* gout = (bf16_t*)(p.ws + WS_BIG);
    float* E = (float*)(p.ws + WS_S5E);
    const bf16_t* bbt = (const bf16_t*)(p.ws + WS_BBT); const bf16_t* ct = (const bf16_t*)(p.ws + WS_CT); const float* ab = (const float*)(p.ws + WS_ABAR);
    const float dsk = p.in[15][g * 16 + l16];
    bf16x8 BfA[2][4];
#pragma unroll
    for (int dir = 0; dir < 2; ++dir)
#pragma unroll
        for (int nb = 0; nb < 4; ++nb) BfA[dir][nb] = PC ? (bf16x8){0, 0, 0, 0, 0, 0, 0, 0} : *(const bf16x8*)(bbt + ((size_t)(dir * 64 + g) * 128 + (nb >> 1) * 64 + 2 * l32 + (nb & 1)) * 16 + 8 * hh);
    const int cstride = (int)(gridDim.x >> 3);
    const bf16_t* const ub = hb + (size_t)l32 * D + g * 16 + 8 * hh;
    bf16x8 afn[4]; f32x2n enr[2], eni[2];
    { const int c0 = b >> 3;
      if (c0 < S5_NCH) {
#pragma unroll
        for (int sb = 0; sb < 4; ++sb) afn[sb] = *(const bf16x8*)(ub + (size_t)(c0 * 128 + sb * 32) * D);
        if (PC) {
#pragma unroll
            for (int dir = 0; dir < 2; ++dir) { const size_t eo = (((size_t)dir * S5_NCH + c0) * 64 + g) * 128; enr[dir] = *(const f32x2n*)(E + eo + 2 * l32); eni[dir] = *(const f32x2n*)(E + eo + 64 + 2 * l32); } } } }
    for (int c = b >> 3; c < S5_NCH; c += cstride) {
        const int tok0 = c * 128;
        f32x2n ecr[2], eci[2];
#pragma unroll
        for (int sb = 0; sb < 4; ++sb) *(LAS bf16x8*)(H + S5_UOFF + (sb * 32 + l32) * S5_UROW + 16 * hh) = afn[sb];
#pragma unroll
        for (int dir = 0; dir < 2; ++dir) { ecr[dir] = enr[dir]; eci[dir] = eni[dir]; }
        CFENCE(); LDS_WAIT(); CFENCE();
        { int cn = c + cstride; asm volatile("" : "+s"(cn));
          if (cn < S5_NCH) {
#pragma unroll
            for (int sb = 0; sb < 4; ++sb) afn[sb] = *(const bf16x8*)(ub + (size_t)(cn * 128 + sb * 32) * D);
            if (PC) {
#pragma unroll
                for (int dir = 0; dir < 2; ++dir) { const size_t eo = (((size_t)dir * S5_NCH + cn) * 64 + g) * 128; enr[dir] = *(const f32x2n*)(E + eo + 2 * l32); eni[dir] = *(const f32x2n*)(E + eo + 64 + 2 * l32); } } } }
        f32x4 yacc[8];
#pragma unroll
        for (int j = 0; j < 8; ++j) yacc[j] = (f32x4){0.f, 0.f, 0.f, 0.f};
#pragma unroll
        for (int dir = 0; dir < 2; ++dir) {
            const size_t eoff = (((size_t)dir * S5_NCH + c) * 64 + g) * 128;
            const int dg = dir * 64 + g;
            bf16x8 Bf[4], Cf[4];
#pragma unroll
            for (int nb = 0; nb < 4; ++nb) Bf[nb] = PC ? *(const bf16x8*)(bbt + ((size_t)dg * 128 + (nb >> 1) * 64 + 2 * l32 + (nb & 1)) * 16 + 8 * hh) : BfA[dir][nb];
#pragma unroll
            for (int ks = 0; ks < 4; ++ks) Cf[ks] = PC ? *(const bf16x8*)(ct + ((size_t)dg * 16 + l16) * 128 + 32 * ks + 8 * q16) : (bf16x8){0, 0, 0, 0, 0, 0, 0, 0};
            const f32x4 a1v = *(const f32x4*)(ab + ((size_t)dg * 64 + 2 * l32) * 2);
            const float a1Ar = a1v[0], a1Ai = a1v[1], a1Br = a1v[2], a1Bi = a1v[3];
            const float a2Ar = a1Ar * a1Ar - a1Ai * a1Ai, a2Ai = 2.f * a1Ar * a1Ai, a2Br = a1Br * a1Br - a1Bi * a1Bi, a2Bi = 2.f * a1Br * a1Bi;
            const float a3Ar = a2Ar * a1Ar - a2Ai * a1Ai, a3Ai = a2Ar * a1Ai + a2Ai * a1Ar, a3Br = a2Br * a1Br - a2Bi * a1Bi, a3Bi = a2Br * a1Bi + a2Bi * a1Br;
            const float a4Ar = a2Ar * a2Ar - a2Ai * a2Ai, a4Ai = 2.f * a2Ar * a2Ai, a4Br = a2Br * a2Br - a2Bi * a2Bi, a4Bi = 2.f * a2Br * a2Bi;
            const float a5Ar = a4Ar * a1Ar - a4Ai * a1Ai, a5Ai = a4Ar * a1Ai + a4Ai * a1Ar, a5Br = a4Br * a1Br - a4Bi * a1Bi, a5Bi = a4Br * a1Bi + a4Bi * a1Br;
            float hAr = 0.f, hAi = 0.f, hBr = 0.f, hBi = 0.f;
            if (PC) { hAr = ecr[dir][0]; hBr = ecr[dir][1]; hAi = eci[dir][0]; hBi = eci[dir][1]; }
            const bool lead = (hh == dir);
#pragma unroll
            for (int sbi = 0; sbi < 4; ++sbi) {
                const int sb = dir == 0 ? sbi : 3 - sbi;
                if (PC) __builtin_amdgcn_sched_barrier(0);
                const bf16x8 a = *(const LAS bf16x8*)(H + S5_UOFF + (sb * 32 + l32) * S5_UROW + 16 * hh);
                f32x16 acc[4];
#pragma unroll
                for (int nb = 0; nb < 4; ++nb) {
#pragma unroll
                    for (int i = 0; i < 16; ++i) acc[nb][i] = 0.f;
                    acc[nb] = __builtin_amdgcn_mfma_f32_32x32x16_bf16(a, Bf[nb], acc[nb], 0, 0, 0);
                }
                if (!PC) {
#pragma unroll
                    for (int gi = 0; gi < 4; ++gi)
#pragma unroll
                        for (int ri = 0; ri < 4; ++ri) { const int i = 4 * (dir == 0 ? gi : 3 - gi) + (dir == 0 ? ri : 3 - ri);
                            if (sbi == 0 && gi == 0 && ri == 0) { hAr = acc[0][i]; hAi = acc[2][i]; hBr = acc[1][i]; hBi = acc[3][i]; }
                            else if (ri == 0) { CMAD(hAr, hAi, a5Ar, a5Ai, acc[0][i], acc[2][i]); CMAD(hBr, hBi, a5Br, a5Bi, acc[1][i], acc[3][i]); }
                            else { CMAD(hAr, hAi, a1Ar, a1Ai, acc[0][i], acc[2][i]); CMAD(hBr, hBi, a1Br, a1Bi, acc[1][i], acc[3][i]); } }
                } else {
#pragma unroll
                    for (int gi = 0; gi < 4; ++gi) { const int gg = dir == 0 ? gi : 3 - gi;
                        float xAr = lead ? hAr : 0.f, xAi = lead ? hAi : 0.f, xBr = lead ? hBr : 0.f, xBi = lead ? hBi : 0.f;
#pragma unroll
                        for (int k = 0; k < 4; ++k) { const int i = 4 * gg + (dir == 0 ? k : 3 - k);
                            CMAD(xAr, xAi, a1Ar, a1Ai, acc[0][i], acc[2][i]); acc[0][i] = xAr; acc[2][i] = xAi;
                            CMAD(xBr, xBi, a1Br, a1Bi, acc[1][i], acc[3][i]); acc[1][i] = xBr; acc[3][i] = xBi; }
                        float eAr, eAi, eBr, eBi, dmy;
                        if (dir == 0) { half_bcast(xAr, eAr, dmy); half_bcast(xAi, eAi, dmy); half_bcast(xBr, eBr, dmy); half_bcast(xBi, eBi, dmy); }
                        else { half_bcast(xAr, dmy, eAr); half_bcast(xAi, dmy, eAi); half_bcast(xBr, dmy, eBr); half_bcast(xBi, dmy, eBi); }
                        if (lead) { eAr = 0.f; eAi = 0.f; eBr = 0.f; eBi = 0.f; }
                        { const int i0 = 4 * gg + (dir == 0 ? 0 : 3), i1 = 4 * gg + (dir == 0 ? 1 : 2), i2 = 4 * gg + (dir == 0 ? 2 : 1), i3 = 4 * gg + (dir == 0 ? 3 : 0);
                          acc[0][i0] += a1Ar * eAr - a1Ai * eAi; acc[2][i0] += a1Ar * eAi + a1Ai * eAr; acc[1][i0] += a1Br * eBr - a1Bi * eBi; acc[3][i0] += a1Br * eBi + a1Bi * eBr;
                          acc[0][i1] += a2Ar * eAr - a2Ai * eAi; acc[2][i1] += a2Ar * eAi + a2Ai * eAr; acc[1][i1] += a2Br * eBr - a2Bi * eBi; acc[3][i1] += a2Br * eBi + a2Bi * eBr;
                          acc[0][i2] += a3Ar * eAr - a3Ai * eAi; acc[2][i2] += a3Ar * eAi + a3Ai * eAr; acc[1][i2] += a3Br * eBr - a3Bi * eBi; acc[3][i2] += a3Br * eBi + a3Bi * eBr;
                          acc[0][i3] += a4Ar * eAr - a4Ai * eAi; acc[2][i3] += a4Ar * eAi + a4Ai * eAr; acc[1][i3] += a4Br * eBr - a4Bi * eBi; acc[3][i3] += a4Br * eBi + a4Bi * eBr;
                          const float tAr = acc[0][i3], tAi = acc[2][i3], tBr = acc[1][i3], tBi = acc[3][i3];
                          float dm2;
                          if (dir == 0) { half_bcast(tAr, dm2, hAr); half_bcast(tAi, dm2, hAi); half_bcast(tBr, dm2, hBr); half_bcast(tBi, dm2, hBi); }
                          else { half_bcast(tAr, hAr, dm2); half_bcast(tAi, hAi, dm2); half_bcast(tBr, hBr, dm2); half_bcast(tBi, hBi, dm2); } }
                    }
#pragma unroll
                    for (int i = 0; i < 16; ++i) { const int ro = (8 * (i >> 2) + (i & 3)) * S5_HROW;
                        *(LAS unsigned*)(hwr + ro) = pk_bf16(acc[0][i], acc[1][i]); *(LAS unsigned*)(hwr + ro + 128) = pk_bf16(acc[2][i], acc[3][i]); }
                    CFENCE(); LDS_WAIT(); CFENCE();
#pragma unroll
                    for (int mb = 0; mb < 2; ++mb)
#pragma unroll
                        for (int ks = 0; ks < 4; ++ks) { const bf16x8 af = *(const LAS bf16x8*)(hrd + mb * 16 * S5_HROW + 64 * ks);
                            yacc[sb * 2 + mb] = __builtin_amdgcn_mfma_f32_16x16x32_bf16(af, Cf[ks], yacc[sb * 2 + mb], 0, 0, 0); }
                    CFENCE(); LDS_WAIT(); CFENCE();
                }
            }
            if (!PC) {
                float s0Ar, s0Ai, s0Br, s0Bi, s1Ar, s1Ai, s1Br, s1Bi;
                half_bcast(hAr, s0Ar, s1Ar); half_bcast(hAi, s0Ai, s1Ai); half_bcast(hBr, s0Br, s1Br); half_bcast(hBi, s0Bi, s1Bi);
                float eAr, eAi, eBr, eBi;
                if (dir == 0) { eAr = a4Ar * s0Ar - a4Ai * s0Ai + s1Ar; eAi = a4Ar * s0Ai + a4Ai * s0Ar + s1Ai; eBr = a4Br * s0Br - a4Bi * s0Bi + s1Br; eBi = a4Br * s0Bi + a4Bi * s0Br + s1Bi; }
                else { eAr = a4Ar * s1Ar - a4Ai * s1Ai + s0Ar; eAi = a4Ar * s1Ai + a4Ai * s1Ar + s0Ai; eBr = a4Br * s1Br - a4Bi * s1Bi + s0Br; eBi = a4Br * s1Bi + a4Bi * s1Br + s0Bi; }
                if (hh == 0) { *(f32x2n*)(E + eoff + 2 * l32) = (f32x2n){eAr, eBr}; *(f32x2n*)(E + eoff + 64 + 2 * l32) = (f32x2n){eAi, eBi}; }
            }
        }
        CFENCE(); LDS_WAIT(); CFENCE();
        if (PC) {
#pragma unroll
            for (int j = 0; j < 8; ++j)
#pragma unroll
                for (int i = 0; i < 4; ++i) { LAS bf16_t* up = (LAS bf16_t*)(H + S5_UOFF + (4 * q16) * S5_UROW + l16 * 2 + (j * 16 + i) * S5_UROW);
                    const float y = yacc[j][i] + dsk * bf2f(*up); *up = f2bf(gelu_tanh(y)); }
            CFENCE(); LDS_WAIT(); CFENCE();
#pragma unroll
            for (int k = 0; k < 4; ++k) { const int idx = lane + 64 * k, tk = idx >> 1, hf = idx & 1;
                const u32x4 v = *(const LAS u32x4*)(H + S5_UOFF + tk * S5_UROW + hf * 16);
                *(u32x4*)(gout + (size_t)(tok0 + tk) * D + g * 16 + hf * 8) = v; }
            CFENCE(); LDS_WAIT(); CFENCE();
        }
    }
}
__device__ __forceinline__ void s5_carry(const P& p) {
    int tid_ = threadIdx.x; asm volatile("" : "+v"(tid_));
    const int idx = blockIdx.x * NTHREADS + tid_;
    if (idx >= 2 * NSEQ * 64 * 64) return;
    const int pp = idx & 63, g = (idx >> 6) & 63, s = (idx >> 12) % NSEQ, dir = idx / (NSEQ * 4096);
    const float* ab = (const float*)(p.ws + WS_ABAR);
    float Ar = ab[((dir * 64 + g) * 64 + pp) * 2], Ai = ab[((dir * 64 + g) * 64 + pp) * 2 + 1];
#pragma unroll
    for (int k = 0; k < 7; ++k) { const float nr = Ar * Ar - Ai * Ai, ni = 2.0f * Ar * Ai; Ar = nr; Ai = ni; }
    const int c0 = s < 2 ? s * 128 : 256 + (s - 2) * 16, n = s < 2 ? 128 : 16;
    float* E = (float*)(p.ws + WS_S5E);
    float rr = 0.f, ri = 0.f;
    for (int i0 = 0; i0 < n; i0 += 16) {
        float er[16], ei[16];
#pragma unroll
        for (int k = 0; k < 16; ++k) { const int i = i0 + k, c = dir == 0 ? c0 + i : c0 + n - 1 - i; const size_t ad = (((size_t)dir * S5_NCH + c) * 64 + g) * 128 + pp; er[k] = E[ad]; ei[k] = E[ad + 64]; }
#pragma unroll
        for (int k = 0; k < 16; ++k) { const int i = i0 + k, c = dir == 0 ? c0 + i : c0 + n - 1 - i; const size_t ad = (((size_t)dir * S5_NCH + c) * 64 + g) * 128 + pp;
            E[ad] = rr; E[ad + 64] = ri; const float nr = Ar * rr - Ai * ri + er[k], ni = Ar * ri + Ai * rr + ei[k]; rr = nr; ri = ni; }
    }
}

constexpr int GQ = 0, GK = 17408, GKT = 34816, GVT = 53248, GSC = 90112, GA1 = 99328, GSUM = 103424, GEL = 105472, GRMS = 105984, GRSTD = 108032, GW2 = 108288;
constexpr int QST = 272, TST = 144, VST = 576;
__device__ __forceinline__ void gla_item_coords(int j, int& hd, int& tokbase) {
    hd = j & 3; const int q = j >> 2;
    if (q < 32) tokbase = (q >> 4) * 16384 + (q & 15) * 1024; else tokbase = T_PROMPT + ((q - 32) >> 1) * 2048 + ((q - 32) & 1) * 1024;
}
template <int MODE>
__device__ __forceinline__ void gla_phase(const P& p, LAS unsigned char* lds, int m0_first = 0, int m0_count = 0, int m0_block0 = 0) {
    int tid_ = threadIdx.x; asm volatile("" : "+v"(tid_));
    const int tid = tid_, lane = tid & 63, w = __builtin_amdgcn_readfirstlane(tid >> 6), hh = lane >> 5, l32 = lane & 31;
    const int chan = tid & 127, tg = w >> 1;
    const bf16_t* proj = (const bf16_t*)(p.ws + WS_BIG);
    const float* a1b = (const float*)(p.ws + WS_A1);
    bf16_t* hb = (bf16_t*)(p.ws + WS_HBUF);
    float* sbuf = (float*)(p.ws + WS_SBUF); float* dtot = (float*)(p.ws + WS_DTOT);
    LAS unsigned char* const qfrag = lds + GQ + l32 * QST + 16 * hh;
    LAS unsigned char* const kfrag = lds + GK + l32 * QST + 16 * hh;
    LAS unsigned char* const qperm = lds + GQ + l32 * QST + 8 * hh;
    LAS unsigned char* const ktfrag = lds + GKT + l32 * TST + 16 * hh;
    LAS unsigned char* const vtr = lds + GVT + (8 * hh + ((lane & 15) >> 2)) * VST + (32 * w + 16 * ((lane >> 4) & 1) + 4 * (lane & 3)) * 2;
    LAS unsigned char* const scfrag = lds + GSC + l32 * TST + 16 * hh;
    LAS unsigned char* const otw = lds + GVT + (4 * hh) * VST + (32 * w + l32) * 2;
    LAS unsigned char* const scst = lds + GSC + (4 * hh) * TST + l32 * 2;
    LAS unsigned char* const elrd = lds + GEL + 16 * hh;
    LAS unsigned char* const rmsw = lds + GRMS + (4 * hh) * 32 + w * 4;
    LAS unsigned char* const rstdr = lds + GRSTD + (4 * hh) * 4;
    LAS unsigned char* const qprep = lds + GQ + (16 * tg) * QST + chan * 2;
    LAS unsigned char* const kprep = lds + GK + (16 * tg) * QST + chan * 2;
    LAS unsigned char* const a1rd = lds + GA1 + (16 * tg) * 64;
    const LAS float* const w2p = (const LAS float*)(lds + GW2) + chan;
    const int nitems = MODE == 0 ? m0_count : 192;
    for (int it = MODE == 0 ? (int)blockIdx.x - m0_block0 : (int)blockIdx.x; it >= 0 && it < nitems; it += gridDim.x) {
        int dir = MODE == 1 ? 0 : 1, j = it;
        if (MODE == 0) { const int nidx = m0_first + it; dir = nidx >= 152 ? 1 : 0; const int n = nidx - dir * 152;
            if (n < 120) { const int hd0 = n & 3, m = n >> 2, sq = m / 15, sc = m - sq * 15 + dir; j = (sq * 16 + sc) * 4 + hd0; }
            else { const int n2 = n - 120, hd0 = n2 & 3, sq = n2 >> 2; j = (32 + sq * 2 + dir) * 4 + hd0; } }
        const int full = dir * 192 + j;
        int hd, tokbase; gla_item_coords(j, hd, tokbase);
        __syncthreads();
        for (int i = tid; i < 16 * 128; i += NTHREADS) ((LAS float*)(lds + GW2))[i] = p.in[19][(size_t)(dir * 16 + (i >> 7)) * 512 + hd * 128 + (i & 127)];
        const float bias = p.in[20][dir * 512 + hd * 128 + chan];
        f32x16 S[4];
        float* const sb0 = sbuf + (size_t)full * 32768 + 32 * w; const int svo = (4 * hh) * 256 + l32;
#pragma unroll
        for (int cb = 0; cb < 4; ++cb)
#pragma unroll
            for (int i = 0; i < 16; ++i) S[cb][i] = MODE == 0 ? 0.f : (sb0 + (32 * cb + 8 * (i >> 2) + (i & 3)) * 256)[svo];
        float dsum = 0.f;
        u32x4 pq[2], pk[2], pv[4]; f32x4 pa = (f32x4){0.f, 0.f, 0.f, 0.f};
        const int qko = (tid >> 4) * PROJ_N + hd * 128 + (tid & 15) * 8;
        const int vo = (tid >> 5) * PROJ_N + 1024 + hd * 256 + (tid & 31) * 8;
        const int ao = (tid >> 2) * 32 + dir * 16 + (tid & 3) * 4;
#define GLA_LOAD(tbx) do { const bf16_t* pb_ = proj + (size_t)(tbx) * PROJ_N; \
            _Pragma("unroll") for (int i = 0; i < 2; ++i) { if (MODE != 0) pq[i] = *(const u32x4*)(pb_ + (size_t)i * 32 * PROJ_N + qko); pk[i] = *(const u32x4*)(pb_ + (size_t)i * 32 * PROJ_N + 512 + qko); } \
            _Pragma("unroll") for (int i = 0; i < 4; ++i) pv[i] = *(const u32x4*)(pb_ + (size_t)i * 16 * PROJ_N + vo); \
            if (tid < 256) pa = *(const f32x4*)(a1b + (size_t)(tbx) * 32 + ao); } while (0)
        { int tb0 = tokbase + (dir == 0 ? 0 : 15) * 64; GLA_LOAD(tb0); }
        for (int ci = 0; ci < 16; ++ci) {
            int tb = tokbase + (dir == 0 ? ci : 15 - ci) * 64; asm volatile("" : "+s"(tb));
            int tbn = tokbase + (dir == 0 ? ci + 1 : 14 - ci) * 64; asm volatile("" : "+s"(tbn));
            { LAS unsigned char* const qs = lds + GQ + (tid >> 4) * QST + (tid & 15) * 16;
#pragma unroll
              for (int i = 0; i < 2; ++i) { if (MODE != 0) *(LAS u32x4*)(qs + i * 32 * QST) = pq[i]; *(LAS u32x4*)(qs + (GK - GQ) + i * 32 * QST) = pk[i]; } }
            { LAS unsigned char* const vs = lds + GVT + (tid >> 5) * VST + (tid & 31) * 16;
#pragma unroll
              for (int i = 0; i < 4; ++i) *(LAS u32x4*)(vs + i * 16 * VST) = pv[i]; }
            if (tid < 256) *(LAS f32x4*)(lds + GA1 + (tid >> 2) * 64 + (tid & 3) * 16) = pa;
            __syncthreads();
            if (ci + 1 < 16) GLA_LOAD(tbn);
            float zc[16];
#pragma unroll
            for (int i = 0; i < 16; ++i) { const LAS f32x4* ap = (const LAS f32x4*)(a1rd + i * 64);
                float z = bias;
#pragma unroll
                for (int r4 = 0; r4 < 4; ++r4) { const f32x4 av = ap[r4]; z += av[0] * w2p[(4 * r4) * 128] + av[1] * w2p[(4 * r4 + 1) * 128] + av[2] * w2p[(4 * r4 + 2) * 128] + av[3] * w2p[(4 * r4 + 3) * 128]; }
                zc[i] = (fminf(z, 0.f) - __logf(1.0f + __expf(-fabsf(z)))) * (1.0f / 16.0f); }
            if (dir == 0) {
#pragma unroll
                for (int i = 1; i < 16; ++i) zc[i] += zc[i - 1];
            } else {
#pragma unroll
                for (int i = 14; i >= 0; --i) zc[i] += zc[i + 1];
            }
            ((LAS float*)(lds + GSUM))[tg * 128 + chan] = dir == 0 ? zc[15] : zc[0];
            __syncthreads();
            float blast, off;
            { const LAS float* gs = (const LAS float*)(lds + GSUM) + chan; const float g0 = gs[0], g1 = gs[128], g2 = gs[256], g3 = gs[384];
                blast = (g0 + g1) + (g2 + g3);
                if (dir == 0) off = (tg > 0 ? g0 : 0.f) + (tg > 1 ? g1 : 0.f) + (tg > 2 ? g2 : 0.f);
                else off = (tg < 3 ? g3 : 0.f) + (tg < 2 ? g2 : 0.f) + (tg < 1 ? g1 : 0.f); }
            {
                float kt[16];
#pragma unroll
                for (int i = 0; i < 16; ++i) { const float bc = zc[i] + off;
                    LAS bf16_t* qp = (LAS bf16_t*)(qprep + i * QST); LAS bf16_t* kp = (LAS bf16_t*)(kprep + i * QST);
                    const float kv = bf2f(*kp);
                    if (MODE != 0) { const float qv = bf2f(*qp); *qp = f2bf(qv * __expf(bc) * 0.08838834764831845f); *kp = f2bf(kv * __expf(-bc)); }
                    kt[i] = kv * __expf(blast - bc); }
                u32x4 k0, k1; k0.x = pk_bf16(kt[0], kt[1]); k0.y = pk_bf16(kt[2], kt[3]); k0.z = pk_bf16(kt[4], kt[5]); k0.w = pk_bf16(kt[6], kt[7]);
                k1.x = pk_bf16(kt[8], kt[9]); k1.y = pk_bf16(kt[10], kt[11]); k1.z = pk_bf16(kt[12], kt[13]); k1.w = pk_bf16(kt[14], kt[15]);
                *(LAS u32x4*)(lds + GKT + chan * TST + tg * 32) = k0; *(LAS u32x4*)(lds + GKT + chan * TST + tg * 32 + 16) = k1;
            }
            if (tg == 0) { ((LAS float*)(lds + GEL))[chan] = __expf(blast); dsum += blast; }
            __syncthreads();
            if (MODE != 0) {
                if (w < 4) { const int mb = w >> 1, nb = w & 1; f32x16 sc;
#pragma unroll
                    for (int i = 0; i < 16; ++i) sc[i] = 0.f;
#pragma unroll
                    for (int ks = 0; ks < 8; ++ks) { const bf16x8 a = *(const LAS bf16x8*)(qfrag + mb * 32 * QST + 32 * ks), bq = *(const LAS bf16x8*)(kfrag + nb * 32 * QST + 32 * ks);
                        sc = __builtin_amdgcn_mfma_f32_32x32x16_bf16(a, bq, sc, 0, 0, 0); }
                    const int dlt = (nb - mb) * 32 + l32 - 4 * hh;
                    LAS unsigned char* const sw = scst + mb * 32 * TST + nb * 64;
#pragma unroll
                    for (int i = 0; i < 16; ++i) { const int cst = 8 * (i >> 2) + (i & 3); const bool keep = dir == 0 ? (dlt <= cst) : (dlt >= cst);
                        *(LAS bf16_t*)(sw + cst * TST) = f2bf(keep ? sc[i] : 0.f); }
                }
                __syncthreads();
            }
            bf16x8 vf[4];
#pragma unroll
            for (int ks = 0; ks < 4; ++ks) { union { struct { bf16x4 lo, hi; } s; bf16x8 v; } vv;
                vv.s.lo = __builtin_amdgcn_ds_read_tr16_b64_v4i16((LAS bf16x4*)(vtr + (16 * ks) * VST));
                vv.s.hi = __builtin_amdgcn_ds_read_tr16_b64_v4i16((LAS bf16x4*)(vtr + (16 * ks + 4) * VST));
                vf[ks] = vv.v; }
            if (MODE != 0) {
                __syncthreads();
#pragma unroll
                for (int mb = 0; mb < 2; ++mb) {
                    f32x16 o;
#pragma unroll
                    for (int i = 0; i < 16; ++i) o[i] = 0.f;
#pragma unroll
                    for (int ks = 0; ks < 4; ++ks) { const bf16x8 a = *(const LAS bf16x8*)(scfrag + mb * 32 * TST + 32 * ks);
                        o = __builtin_amdgcn_mfma_f32_32x32x16_bf16(a, vf[ks], o, 0, 0, 0); }
#pragma unroll
                    for (int cb = 0; cb < 4; ++cb)
#pragma unroll
                        for (int h2 = 0; h2 < 2; ++h2) {
                            union { u32x4 u; bf16x8 v; } sb_;
                            sb_.u.x = pk_bf16(S[cb][8 * h2 + 0], S[cb][8 * h2 + 1]); sb_.u.y = pk_bf16(S[cb][8 * h2 + 2], S[cb][8 * h2 + 3]);
                            sb_.u.z = pk_bf16(S[cb][8 * h2 + 4], S[cb][8 * h2 + 5]); sb_.u.w = pk_bf16(S[cb][8 * h2 + 6], S[cb][8 * h2 + 7]);
                            const LAS unsigned char* base = qperm + mb * 32 * QST + (32 * cb + 16 * h2) * 2;
                            union { struct { u32x2 lo, hi; } s; bf16x8 v; } qa; qa.s.lo = *(const LAS u32x2*)base; qa.s.hi = *(const LAS u32x2*)(base + 16);
                            o = __builtin_amdgcn_mfma_f32_32x32x16_bf16(qa.v, sb_.v, o, 0, 0, 0);
                        }
#pragma unroll
                    for (int i = 0; i < 16; ++i) *(LAS bf16_t*)(otw + (32 * mb + 8 * (i >> 2) + (i & 3)) * VST) = f2bf(o[i]);
                    CFENCE();
                }
            }
            u32x4 of[4], rr[4];
            if (MODE == 2) {
                const bf16_t* const og2 = hb + (size_t)(tb + (tid >> 5)) * D + hd * 256 + (tid & 31) * 8;
                const bf16_t* const rg = proj + (size_t)(tb + (tid >> 5)) * PROJ_N + 2048 + hd * 256 + (tid & 31) * 8;
#pragma unroll
                for (int i = 0; i < 4; ++i) { of[i] = *(const u32x4*)(og2 + (size_t)(16 * i) * D); rr[i] = *(const u32x4*)(rg + (size_t)(16 * i) * PROJ_N); }
            }
#pragma unroll
            for (int cb = 0; cb < 4; ++cb) {
#pragma unroll
                for (int i4 = 0; i4 < 4; ++i4) { const f32x4 e = *(const LAS f32x4*)(elrd + (32 * cb + 8 * i4) * 4);
                    S[cb][4 * i4 + 0] *= e[0]; S[cb][4 * i4 + 1] *= e[1]; S[cb][4 * i4 + 2] *= e[2]; S[cb][4 * i4 + 3] *= e[3]; }
#pragma unroll
                for (int ks = 0; ks < 4; ++ks) { const bf16x8 a = *(const LAS bf16x8*)(ktfrag + cb * 32 * TST + 32 * ks);
                    S[cb] = __builtin_amdgcn_mfma_f32_32x32x16_bf16(a, vf[ks], S[cb], 0, 0, 0); }
            }
            __syncthreads();
            if (MODE != 0) {
                u32x4 ob[4];
#pragma unroll
                for (int i = 0; i < 4; ++i) ob[i] = *(const LAS u32x4*)(lds + GVT + ((tid >> 5) + 16 * i) * VST + (tid & 31) * 16);
                bf16_t* const og = hb + (size_t)(tb + (tid >> 5)) * D + hd * 256 + (tid & 31) * 8;
                if (MODE == 1) {
#pragma unroll
                    for (int i = 0; i < 4; ++i) *(u32x4*)(og + (size_t)(16 * i) * D) = ob[i];
                } else {
                    const f32x4 ng0 = *(const f32x4*)(p.in[21] + hd * 256 + (tid & 31) * 8), ng1 = *(const f32x4*)(p.in[21] + hd * 256 + (tid & 31) * 8 + 4);
#pragma unroll
                    for (int i = 0; i < 4; ++i) {
                        float ov[8]; float sq = 0.f;
#pragma unroll
                        for (int e = 0; e < 4; ++e) { ov[2 * e] = __uint_as_float(ob[i][e] << 16) + __uint_as_float(of[i][e] << 16); ov[2 * e + 1] = __uint_as_float(ob[i][e] & 0xffff0000u) + __uint_as_float(of[i][e] & 0xffff0000u);
                            sq += ov[2 * e] * ov[2 * e] + ov[2 * e + 1] * ov[2 * e + 1]; }
#pragma unroll
                        for (int sh = 1; sh < 32; sh <<= 1) sq += __shfl_xor(sq, sh);
                        const float rs = rsqrtf(sq * (1.0f / 256.0f) + EPS);
                        u32x4 wv;
#pragma unroll
                        for (int e = 0; e < 4; ++e) { const float r0 = __uint_as_float(rr[i][e] << 16), r1 = __uint_as_float(rr[i][e] & 0xffff0000u);
                            const float g0 = e < 2 ? ng0[2 * e] : ng1[2 * e - 4], g1 = e < 2 ? ng0[2 * e + 1] : ng1[2 * e - 3];
                            wv[e] = pk_bf16(ov[2 * e] * rs * g0 * (r0 * sigmoidf_(r0)), ov[2 * e + 1] * rs * g1 * (r1 * sigmoidf_(r1))); }
                        *(u32x4*)(og + (size_t)(16 * i) * D) = wv;
                    }
                }
                __syncthreads();
            }
        }
#undef GLA_LOAD
        if (MODE == 0) {
#pragma unroll
            for (int cb = 0; cb < 4; ++cb)
#pragma unroll
                for (int i = 0; i < 16; ++i) (sb0 + (32 * cb + 8 * (i >> 2) + (i & 3)) * 256)[svo] = S[cb][i];
            if (tg == 0) dtot[full * 128 + chan] = dsum;
        }
    }
}
__device__ __forceinline__ void gla_carry(const P& p, const int dir) {
    float* sbuf = (float*)(p.ws + WS_SBUF); const float* dtot = (const float*)(p.ws + WS_DTOT);
    const int total = 40 * 8192;
    int tid_ = threadIdx.x; asm volatile("" : "+v"(tid_));
    for (int e = blockIdx.x * NTHREADS + tid_; e < total; e += gridDim.x * NTHREADS) {
        const int e4 = e & 8191, ch = e >> 13, hd = ch & 3, s = ch >> 2;
        const int n = s < 2 ? 16 : 2, q0 = s < 2 ? s * 16 : 32 + (s - 2) * 2, chan = e4 >> 6;
        f32x4 run = (f32x4){0.f, 0.f, 0.f, 0.f};
        float* const base = sbuf + (size_t)e4 * 4;
        if (n == 16) {
            f32x4 tmp[16]; float dcy[16];
#pragma unroll
            for (int i = 0; i < 16; ++i) { const int sc = dir == 0 ? i : 15 - i, full = dir * 192 + (q0 + sc) * 4 + hd; tmp[i] = *(const f32x4*)(base + (size_t)full * 32768); dcy[i] = dtot[full * 128 + chan]; }
#pragma unroll
            for (int i = 0; i < 16; ++i) { const int sc = dir == 0 ? i : 15 - i, full = dir * 192 + (q0 + sc) * 4 + hd; *(f32x4*)(base + (size_t)full * 32768) = run; run = run * __expf(dcy[i]) + tmp[i]; }
        } else {
            for (int i = 0; i < n; ++i) { const int sc = dir == 0 ? i : n - 1 - i, full = dir * 192 + (q0 + sc) * 4 + hd;
                f32x4* ptr = (f32x4*)(base + (size_t)full * 32768); const float dcy = __expf(dtot[full * 128 + chan]);
                const f32x4 tmp = *ptr; *ptr = run; run = run * dcy + tmp; }
        }
    }
}

#define XB_TMO      128
#define XB_XCNT(j)  (256  + 64 * (j))
#define XB_XSUB(j)  (1280 + 64 * (j))
#define XB_XGEN(j)  (2304 + 64 * (j))
#define XB_TOP      3328
#define XB_TOPGEN   3392
#define XCD_BAR_WORDS 3456
#define XB_SPIN_CAP (1u << 18)

__device__ __forceinline__ unsigned xb_ld(unsigned* p)              { return __hip_atomic_load(p, __ATOMIC_RELAXED, __HIP_MEMORY_SCOPE_AGENT); }
__device__ __forceinline__ unsigned xb_add(unsigned* p, unsigned v) { return __hip_atomic_fetch_add(p, v, __ATOMIC_RELAXED, __HIP_MEMORY_SCOPE_AGENT); }
__device__ __forceinline__ unsigned xb_xcc_id() { return (unsigned)__builtin_amdgcn_s_getreg((3 << 11) | 20) & 0xFu; }
#define XB_SPIN(cond, bar) do { unsigned _sp = 0; while (cond) { __builtin_amdgcn_s_sleep(1); \
    if ((++_sp & 255u) == 0u) { if (xb_ld(&(bar)[XB_TMO])) break; if (_sp > XB_SPIN_CAP) { atomicAdd(&(bar)[XB_TMO], 1u); break; } } } } while (0)

struct XcdBarrier {
    unsigned* bar; unsigned x;
    volatile LAS unsigned* st;
};

__device__ __forceinline__ XcdBarrier xcd_barrier_post(unsigned* bar, volatile LAS unsigned* st) {
    XcdBarrier b; b.bar = bar; b.x = xb_xcc_id(); b.st = st;
    if (threadIdx.x == 0) (void)xb_add(&bar[XB_XCNT(b.x)], 1u);
    return b;
}
__device__ __forceinline__ void xcd_barrier_complete(unsigned* bar, unsigned x, unsigned& nloc, unsigned& nx) {
    const unsigned G = gridDim.x * gridDim.y * gridDim.z;
    unsigned sum, cnt, mine, sp = 0u;
    for (;;) {
        sum = 0u; cnt = 0u; mine = 0u;
#pragma unroll
        for (unsigned j = 0; j < 16; ++j) { const unsigned c = xb_ld(&bar[XB_XCNT(j)]); sum += c; cnt += (c > 0u) ? 1u : 0u; mine = (j == x) ? c : mine; }
        if (sum == G) break;
        __builtin_amdgcn_s_sleep(1);
        if ((++sp & 255u) == 0u) { if (xb_ld(&bar[XB_TMO])) break; if (sp > XB_SPIN_CAP) { atomicAdd(&bar[XB_TMO], 1u); break; } }
    }
    nloc = mine > 0u ? mine : 1u; nx = cnt > 0u ? cnt : 1u;
}

__device__ __forceinline__ void xcd_barrier(const XcdBarrier& b) {
    asm volatile("s_waitcnt vmcnt(0)" ::: "memory");
    __syncthreads();
    if (threadIdx.x == 0) {
        unsigned* bar = b.bar;
        __builtin_amdgcn_s_waitcnt(0);
        unsigned nloc = b.st[0], nx = b.st[1];
        if (nloc == 0u) { xcd_barrier_complete(bar, b.x, nloc, nx); b.st[0] = nloc; b.st[1] = nx; }
        const unsigned old = xb_add(&bar[XB_XSUB(b.x)], 1u);
        const unsigned gen = old / nloc;
        if (old + 1u == (gen + 1u) * nloc) {
            __builtin_amdgcn_fence(__ATOMIC_RELEASE, "agent");
            asm volatile("s_waitcnt vmcnt(0)" ::: "memory");
            const unsigned og = xb_add(&bar[XB_TOP], 1u);
            const unsigned tg = og / nx;
            if (og + 1u == (tg + 1u) * nx) xb_add(&bar[XB_TOPGEN], 1u);
            else XB_SPIN(xb_ld(&bar[XB_TOPGEN]) == tg, bar);
            __builtin_amdgcn_fence(__ATOMIC_ACQUIRE, "agent");
            xb_add(&bar[XB_XGEN(b.x)], 1u);
            asm volatile("s_waitcnt vmcnt(0)" ::: "memory");
        } else {
            XB_SPIN(xb_ld(&bar[XB_XGEN(b.x)]) == gen, bar);
            __builtin_amdgcn_fence(__ATOMIC_ACQUIRE, "agent");
            asm volatile("s_waitcnt vmcnt(0)" ::: "memory");
        }
    }
    __syncthreads();
}

#if TPROBE
#define GRID_BAR() do { xcd_barrier(bar); if (blockIdx.x == 0 && threadIdx.x == 0) ((unsigned long long*)(p.ws + WS_STAMP))[tsi] = __builtin_amdgcn_s_memrealtime(); ++tsi; } while (0)
#else
#define GRID_BAR() xcd_barrier(bar)
#endif

template <int L, int SL>
__device__ __forceinline__ void mlp_up(const P& p, LAS unsigned char* lds) {
    unsigned char* ws = p.ws;
    bf16_t* hb = (bf16_t*)(ws + WS_HBUF); bf16_t* hid = (bf16_t*)(ws + WS_BIG + (size_t)(SL & 1) * 128 * MiB);
    const bf16_t* w1 = (const bf16_t*)(ws + (L ? WS_W1B : WS_W1A));
    pg8::Gemm g{hb + (size_t)SL * 16384 * D, w1, 16384, FF, D}; pg8::StaticOrder S; S.init(16384, FF, gridDim.x, blockIdx.x);
    EpiBf<1> E{hid, FF, nullptr};
    if (PH & 4096) pg8::gemm_phase<EpiBf<1>, pg8::StaticOrder>(lds, g, S, E, nullptr);
}
template <int L, int SL>
__device__ __forceinline__ void mlp_down(const P& p, LAS unsigned char* lds) {
    unsigned char* ws = p.ws;
    const float* ml = (const float*)(ws + WS_MOD) + (size_t)L * NSEQ * NMODC;
    bf16_t* hid = (bf16_t*)(ws + WS_BIG + (size_t)(SL & 1) * 128 * MiB);
    const bf16_t* w2 = (const bf16_t*)(ws + (L ? WS_W2B : WS_W2A));
    pg8::Gemm g{hid, w2, 16384, D, FF}; pg8::StaticOrder S; S.init(16384, D, gridDim.x, blockIdx.x);
    EpiRes E{p.out, ml + 5 * D, SL * 16384};
    if (PH & 8192) pg8::gemm_phase<EpiRes, pg8::StaticOrder>(lds, g, S, E, nullptr);
}
template <int L>
__device__ __forceinline__ void mlp_block(const P& p, LAS unsigned char* lds, const XcdBarrier& bar, int& tsi) {
    const float* ml = (const float*)(p.ws + WS_MOD) + (size_t)L * NSEQ * NMODC;
    norm_phase<1, false>(p, p.in[7] + L * D, ml + 3 * D, ml + 4 * D, 1.0f, 0, 16384);
    GRID_BAR();
    if (blockIdx.x & 1) { mlp_up<L, 0>(p, lds); norm_phase<1, false>(p, p.in[7] + L * D, ml + 3 * D, ml + 4 * D, 1.0f, 16384, T); }
    else { norm_phase<1, false>(p, p.in[7] + L * D, ml + 3 * D, ml + 4 * D, 1.0f, 16384, T); mlp_up<L, 0>(p, lds); }
    GRID_BAR();
    if (blockIdx.x & 1) { mlp_up<L, 1>(p, lds); mlp_down<L, 0>(p, lds); } else { mlp_down<L, 0>(p, lds); mlp_up<L, 1>(p, lds); }
    GRID_BAR();
    if (blockIdx.x & 1) { mlp_up<L, 2>(p, lds); mlp_down<L, 1>(p, lds); } else { mlp_down<L, 1>(p, lds); mlp_up<L, 2>(p, lds); }
    GRID_BAR();
    mlp_down<L, 2>(p, lds);
    GRID_BAR();
}

__global__ void __launch_bounds__(NTHREADS, 2) hybrid_fwd(P p) {
    extern __shared__ __attribute__((aligned(16))) unsigned char lds_raw[];
    LAS unsigned char* lds = (LAS unsigned char*)lds_raw;
    cg::grid_group grid = cg::this_grid();
    unsigned char* ws = p.ws;
    const float* mod = (const float*)(ws + WS_MOD);
    bf16_t* hb = (bf16_t*)(ws + WS_HBUF);
    bf16_t* big = (bf16_t*)(ws + WS_BIG);

    volatile LAS unsigned* bst = (volatile LAS unsigned*)(lds + LDS_BYTES - 16);
    if (threadIdx.x < 2) bst[threadIdx.x] = 0u;
    if (blockIdx.x == 0) for (int i = threadIdx.x; i < XCD_BAR_WORDS; i += NTHREADS) ((unsigned*)(ws + WS_BARW))[i] = 0u;
    __syncthreads();
    grid.sync();
    const XcdBarrier bar = xcd_barrier_post((unsigned*)(ws + WS_BARW), bst);
    int tsi = 1;
#if TPROBE
    if (blockIdx.x == 0 && threadIdx.x == 0) ((unsigned long long*)(ws + WS_STAMP))[0] = __builtin_amdgcn_s_memrealtime();
#endif
    if (PH & 1) p0_prep(p, lds);
    GRID_BAR();
    if (PH & 2) norm_phase<0, false>(p, p.in[6], mod + 0 * D, mod + 1 * D);
    GRID_BAR();
    if (PH & 4) s5_pass<false>(p, lds);
    GRID_BAR();
    if (PH & 8) s5_carry(p);
    GRID_BAR();
    if (PH & 16) s5_pass<true>(p, lds);
    GRID_BAR();
#if (DUP & 1)
    if (PH & 4) s5_pass<false>(p, lds);
    GRID_BAR();
    if (PH & 8) s5_carry(p);
    GRID_BAR();
    if (PH & 16) s5_pass<true>(p, lds);
    GRID_BAR();
#endif
    { pg8::Gemm g{big, (const bf16_t*)(ws + WS_WGLU), T, 2 * D, D}; pg8::StaticOrder S; S.init(T, 2 * D, gridDim.x, blockIdx.x);
      EpiGlu E{p.in[0], p.in[1], p.out, mod + 2 * D};
      if (PH & 512) pg8::gemm_phase<EpiGlu, pg8::StaticOrder>(lds, g, S, E, nullptr);
#if (DUP & 8)
      GRID_BAR(); pg8::gemm_phase<EpiGlu, pg8::StaticOrder>(lds, g, S, E, nullptr);
      GRID_BAR(); pg8::gemm_phase<EpiGlu, pg8::StaticOrder>(lds, g, S, E, nullptr);
      GRID_BAR(); pg8::gemm_phase<EpiGlu, pg8::StaticOrder>(lds, g, S, E, nullptr);
#endif
    }
    GRID_BAR();
    mlp_block<0>(p, lds, bar, tsi);
    norm_phase<1, false>(p, p.in[6] + D, mod + (size_t)NSEQ * NMODC + 0 * D, mod + (size_t)NSEQ * NMODC + 1 * D);
    GRID_BAR();
    { pg8::Gemm g{hb, (const bf16_t*)(ws + WS_WIN), T, WIN_N, D}; pg8::StaticOrder S; S.init(T, WIN_N, gridDim.x, blockIdx.x);
      EpiBf<0> E{big, PROJ_N, (float*)(ws + WS_A1)};
      if (PH & 1024) pg8::gemm_phase<EpiBf<0>, pg8::StaticOrder>(lds, g, S, E, nullptr); }
    GRID_BAR();
    gla_phase<0>(p, lds, 0, 256, 0);
    GRID_BAR();
    gla_carry(p, 0);
    GRID_BAR();
    if (blockIdx.x < 192) gla_phase<1>(p, lds); else gla_phase<0>(p, lds, 256, 48, 192);
    GRID_BAR();
    gla_carry(p, 1);
    GRID_BAR();
    if (PH & 256) gla_phase<2>(p, lds);
    GRID_BAR();
    { pg8::Gemm g{hb, (const bf16_t*)(ws + WS_WOUT), T, D, D}; pg8::StaticOrder S; S.init(T, D, gridDim.x, blockIdx.x);
      EpiRes E{p.out, mod + (size_t)NSEQ * NMODC + 2 * D, 0};
      if (PH & 2048) pg8::gemm_phase<EpiRes, pg8::StaticOrder>(lds, g, S, E, nullptr); }
    GRID_BAR();
    mlp_block<1>(p, lds, bar, tsi);
#if (DUP & 4)
#pragma unroll 1
    for (int rep = 0; rep < 20; ++rep) GRID_BAR();
#endif
    float oscale = 1.0f;
#if TPROBE
    xcd_barrier(bar);
    { const unsigned long long* st = (const unsigned long long*)(ws + WS_STAMP); unsigned long long sel = 0ull;
#pragma unroll
      for (int i = 0; i < 23; ++i) if (TSEL & (1u << i)) sel += st[i + 1] - st[i];
      oscale = 1.0f + (float)sel / (float)(st[23] - st[0]); }
#endif
    if (PH == 0) norm_phase<0, true>(p, p.in[25], nullptr, nullptr, oscale); else norm_phase<1, true>(p, p.in[25], nullptr, nullptr, oscale);
    (void)tsi;
}

extern "C" void kernel_launch(void* const* d_in, const int* in_sizes, int n_in, void* d_out, int out_size, void* d_ws, size_t ws_size, hipStream_t stream) {
    static int grid_blocks = 0;
    if (grid_blocks == 0) {
        if (n_in != 26 || out_size != T * D || ws_size < WS_END) { fprintf(stderr, "kernel_launch: unexpected sizes n_in %d out %d ws %zu\n", n_in, out_size, ws_size); grid_blocks = -1; return; }
        int dev = 0, cus = 0, per_cu = 0;
        hipGetDevice(&dev);
        hipDeviceGetAttribute(&cus, hipDeviceAttributeMultiprocessorCount, dev);
        hipFuncSetAttribute((const void*)hybrid_fwd, hipFuncAttributeMaxDynamicSharedMemorySize, LDS_BYTES);
        hipOccupancyMaxActiveBlocksPerMultiprocessor(&per_cu, (const void*)hybrid_fwd, NTHREADS, LDS_BYTES);
        if (per_cu < 1) { fprintf(stderr, "kernel_launch: occupancy query says %d blocks per CU\n", per_cu); grid_blocks = -1; return; }
        grid_blocks = cus;
        if (grid_blocks % 8) grid_blocks -= grid_blocks % 8;
    }
    if (grid_blocks < 0) return;
    P p{};
    for (int i = 0; i < 26; ++i) p.in[i] = (const float*)d_in[i];
    p.out = (float*)d_out; p.ws = (unsigned char*)d_ws;
    void* args[] = {&p};
    hipError_t e = hipLaunchCooperativeKernel((const void*)hybrid_fwd, dim3(grid_blocks), dim3(NTHREADS), args, LDS_BYTES, stream);
    if (e != hipSuccess) fprintf(stderr, "cooperative launch failed: %s (grid %d)\n", hipGetErrorString(e), grid_blocks);
}
```

```cpp
#include <hip/hip_runtime.h>
#include <hip/hip_cooperative_groups.h>
#include <cstdio>
namespace cg = cooperative_groups;

namespace pg8 {
#define PG8_LAS __attribute__((address_space(3)))
typedef unsigned short bf16_t;
typedef short bf16x8 __attribute__((ext_vector_type(8)));
typedef float f32x4 __attribute__((ext_vector_type(4)));
typedef unsigned u32x4 __attribute__((ext_vector_type(4)));
constexpr int BM = 256, BK = 64, HALF = 128, HTB = HALF * BK * 2  , STAGE_BYTES = 8 * HTB, NXCD = 8, WGM = 8;

__host__ __device__ __forceinline__ int lds_byte(int r, int c) { const int st = (r >> 4) * 2 + (c >> 5), rr = r & 15, cc = c & 31, ob = rr * 64 + cc * 2; return st * 1024 + (ob ^ (((ob >> 9) & 1) << 5)); }
__host__ __device__ __forceinline__ void stage_rc(int b, int& R, int& C) { const int st = b / 1024, sb = b % 1024, swz = sb ^ (((sb >> 9) & 1) << 5); R = (st >> 1) * 16 + swz / 64; C = (st & 1) * 32 + (swz % 64) / 2; }
__host__ __device__ __forceinline__ int perm32(int rho) { const int n = rho >> 4, i = rho & 15; return 8 * (i >> 2) + 4 * n + (i & 3); }

struct Unit { int pm, pn; };
struct Gemm { const bf16_t* A; const bf16_t* Bt; int M, N, K; };

struct StaticOrder {
    int nM, nN, nwg, G, c;
    __host__ __device__ void init(int M, int N, int G_, int c_) { nM = M / BM; nN = N / BM; nwg = nM * nN; G = G_; c = c_; }
    __host__ __device__ bool next(int i, Unit& u) const {
        const long L = (long)i * G + c; if (L >= nwg) return false;
        int wgid = (int)L; { const int q = nwg / NXCD, r = nwg % NXCD, xcd = wgid % NXCD, off = wgid / NXCD; wgid = (xcd < r ? xcd * (q + 1) : r * (q + 1) + (xcd - r) * q) + off; }
        const int nig = WGM * nN, gid = wgid / nig, fm = gid * WGM, gsz = (nM - fm) < WGM ? (nM - fm) : WGM;
        u.pm = fm + ((wgid % nig) % gsz); u.pn = (wgid % nig) / gsz; return true;
    }
    __device__ __forceinline__ void a_ready(const Unit&) const {}
    __device__ __forceinline__ void done(const Unit&) const {}
};


template <class Epi, class Sched, bool STAMP = false>
__device__ __forceinline__ void gemm_phase(PG8_LAS unsigned char* lds, const Gemm g, const Sched& S, const Epi& E, unsigned long long* stamps) {
    int tid_ = threadIdx.x; asm volatile("" : "+v"(tid_));
    const int tid = tid_, wid = __builtin_amdgcn_readfirstlane(tid >> 6), lane = tid & 63, wr = wid >> 2, wc = wid & 3, fr = lane & 15, fq = lane >> 4;
    const int K = g.K, nt = K / BK;
    int ts_lo = 0, ts_hi = 0, nts = 0; const unsigned long long rt_entry = STAMP ? (unsigned long long)wall_clock64() : 0ull;
#define PG8_STAMP() do { if (STAMP && wid == 0 && nts < 64) { const unsigned long long _c = (unsigned long long)clock64(); \
        ts_lo = (lane == nts) ? (int)(unsigned)_c : ts_lo; ts_hi = (lane == nts) ? (int)(unsigned)(_c >> 32) : ts_hi; ++nts; } } while (0)
    PG8_STAMP();
    unsigned voffA[2], voffB[2];
#pragma unroll
    for (int i = 0; i < 2; ++i) { int R, C; stage_rc(tid * 16 + i * 8192, R, C); const int Rb = Epi::PERM ? ((R & ~31) + perm32(R & 31)) : R;
        voffA[i] = (unsigned)(R * K + C) * 2u; voffB[i] = (unsigned)(Rb * K + C) * 2u; }
    const size_t kstep = (size_t)(BK * 2);
    const size_t hstep = (size_t)HALF * K * 2;
    const size_t tstep = 2 * hstep;
    const unsigned ldsw = (unsigned)wid * 1024u;
    const int aoff = lds_byte(wr * 64 + fr, fq * 8), boff = lds_byte(wc * 32 + fr, fq * 8);
#define PG8_SA(b, h) (((b) * 2 + (h)) * HTB)
#define PG8_SB(b, h) ((4 + (b) * 2 + (h)) * HTB)
#define PG8_STAGE(bufoff, gbase, voff) do { _Pragma("unroll") for (int _i = 0; _i < 2; ++_i) \
        __builtin_amdgcn_global_load_lds((const unsigned*)((const char*)(gbase) + (voff)[_i]), (PG8_LAS unsigned*)(lds + (bufoff) + ldsw + _i * 8192), 16, 0, 0); } while (0)
#define PG8_LDA(dst, b, h) do { _Pragma("unroll") for (int m = 0; m < 4; ++m) _Pragma("unroll") for (int k = 0; k < 2; ++k) dst[m][k] = *(const PG8_LAS bf16x8*)(lds + PG8_SA(b, h) + aoff + m * 2048 + k * 1024); } while (0)
#define PG8_LDB(dst, b, h) do { _Pragma("unroll") for (int n = 0; n < 2; ++n) _Pragma("unroll") for (int k = 0; k < 2; ++k) dst[n][k] = *(const PG8_LAS bf16x8*)(lds + PG8_SB(b, h) + boff + n * 2048 + k * 1024); } while (0)
#define PG8_MMA(ai, bj, At, Bt) do { __builtin_amdgcn_s_setprio(1); _Pragma("unroll") for (int m = 0; m < 4; ++m) _Pragma("unroll") for (int n = 0; n < 2; ++n) _Pragma("unroll") for (int k = 0; k < 2; ++k) \
        acc[ai][bj][m][n] = __builtin_amdgcn_mfma_f32_16x16x32_bf16(Bt[n][k], At[m][k], acc[ai][bj][m][n], 0, 0, 0); __builtin_amdgcn_s_setprio(0); } while (0)
#define PG8_WAIT_V(n) asm volatile("s_waitcnt vmcnt(" #n ")" ::: "memory")
#define PG8_WAIT_L(n) asm volatile("s_waitcnt lgkmcnt(" #n ")" ::: "memory")
#define PG8_BAR __builtin_amdgcn_s_barrier()
#define PG8_SCHED __builtin_amdgcn_sched_barrier(0)
    Unit cur, nxt; int ui = 0;
    if (!S.next(0, cur)) return;
    f32x4 acc[2][2][4][2];
#pragma unroll
    for (int a = 0; a < 2; ++a)
#pragma unroll
        for (int b = 0; b < 2; ++b)
#pragma unroll
            for (int m = 0; m < 4; ++m)
#pragma unroll
                for (int n = 0; n < 2; ++n) acc[a][b][m][n] = (f32x4){0.f, 0.f, 0.f, 0.f};
    bf16x8 At[4][2], B0[2][2], B1[2][2];
    const char* cA = (const char*)g.A + (size_t)cur.pm * tstep; const char* cB = (const char*)g.Bt + (size_t)cur.pn * tstep;
    S.a_ready(cur);
    PG8_STAGE(PG8_SB(0, 0), cB, voffB); PG8_STAGE(PG8_SA(0, 0), cA, voffA); PG8_STAGE(PG8_SB(0, 1), cB + hstep, voffB); PG8_STAGE(PG8_SA(0, 1), cA + hstep, voffA);
    if (wr == 1) PG8_BAR;
    PG8_WAIT_V(4); PG8_BAR;
    PG8_STAGE(PG8_SB(1, 0), cB + kstep, voffB); PG8_STAGE(PG8_SA(1, 0), cA + kstep, voffA); PG8_STAGE(PG8_SB(1, 1), cB + hstep + kstep, voffB);
    PG8_WAIT_V(6); PG8_BAR;
    PG8_STAMP();
    for (;;) {
        const bool has_next = S.next(ui + 1, nxt);
        const char* nA = has_next ? (const char*)g.A + (size_t)nxt.pm * tstep : cA; const char* nB = has_next ? (const char*)g.Bt + (size_t)nxt.pn * tstep : cB;
        for (int t = 0; t < nt; t += 2) {
            const bool last = (t == nt - 2);
            const char* a1 = cA + (size_t)(t + 1) * kstep;
            const char* a2 = last ? nA : cA + (size_t)(t + 2) * kstep; const char* b2 = last ? nB : cB + (size_t)(t + 2) * kstep;
            const char* a3 = a2 + kstep; const char* b3 = b2 + kstep;
            if (last && has_next) S.a_ready(nxt);
            PG8_LDB(B0, 0, 0); PG8_SCHED; PG8_LDA(At, 0, 0); PG8_STAGE(PG8_SA(1, 1), a1 + hstep, voffA);
            PG8_WAIT_L(8); PG8_BAR; PG8_WAIT_L(0); PG8_MMA(0, 0, At, B0); PG8_BAR; PG8_SCHED;
            PG8_LDB(B1, 0, 1); PG8_STAGE(PG8_SB(0, 0), b2, voffB);
            PG8_BAR; PG8_WAIT_L(0); PG8_MMA(0, 1, At, B1); PG8_BAR;
            PG8_LDA(At, 0, 1); PG8_STAGE(PG8_SA(0, 0), a2, voffA);
            PG8_BAR; PG8_WAIT_L(0); PG8_MMA(1, 0, At, B0); PG8_BAR; PG8_SCHED;
            PG8_STAGE(PG8_SB(0, 1), b2 + hstep, voffB);
            PG8_WAIT_V(6); PG8_BAR; PG8_MMA(1, 1, At, B1); PG8_BAR;
            PG8_LDB(B0, 1, 0); PG8_SCHED; PG8_LDA(At, 1, 0); PG8_STAGE(PG8_SA(0, 1), a2 + hstep, voffA);
            PG8_WAIT_L(8); PG8_BAR; PG8_WAIT_L(0); PG8_MMA(0, 0, At, B0); PG8_BAR; PG8_SCHED;
            PG8_LDB(B1, 1, 1); PG8_STAGE(PG8_SB(1, 0), b3, voffB);
            PG8_BAR; PG8_WAIT_L(0); PG8_MMA(0, 1, At, B1); PG8_BAR;
            PG8_LDA(At, 1, 1); PG8_STAGE(PG8_SA(1, 0), a3, voffA);
            PG8_BAR; PG8_WAIT_L(0); PG8_MMA(1, 0, At, B0); PG8_BAR; PG8_SCHED;
            PG8_STAGE(PG8_SB(1, 1), b3 + hstep, voffB);
            PG8_WAIT_V(6); PG8_BAR; PG8_MMA(1, 1, At, B1); PG8_BAR;
        }
        PG8_STAMP();
        if constexpr (!Epi::AFTER_DRAIN) { E(acc, cur, wr, wc, fr, fq); S.done(cur); }
        PG8_STAMP();
        if (!has_next) break;
#pragma unroll
        for (int a = 0; a < 2; ++a)
#pragma unroll
            for (int b = 0; b < 2; ++b)
#pragma unroll
                for (int m = 0; m < 4; ++m)
#pragma unroll
                    for (int n = 0; n < 2; ++n) acc[a][b][m][n] = (f32x4){0.f, 0.f, 0.f, 0.f};
        cur = nxt; cA = nA; cB = nB; ++ui;
    }
    PG8_WAIT_V(0);
    if (wr == 0) PG8_BAR;
    PG8_BAR;
    if constexpr (Epi::AFTER_DRAIN) { E.fused(acc, cur, wr, wc, fr, fq, lds, wid, lane); S.done(cur); }
    PG8_STAMP();
    if (STAMP && wid == 0) { stamps[lane] = lane < nts ? (((unsigned long long)(unsigned)ts_hi << 32) | (unsigned)ts_lo) : 0ull;
        if (lane == 62) stamps[62] = rt_entry; if (lane == 63) stamps[63] = (unsigned long long)wall_clock64(); }
#undef PG8_STAMP
#undef PG8_SA
#undef PG8_SB
#undef PG8_STAGE
#undef PG8_LDA
#undef PG8_LDB
#undef PG8_MMA
#undef PG8_WAIT_V
#undef PG8_WAIT_L
#undef PG8_BAR
#undef PG8_SCHED
}
}


#define LAS __attribute__((address_space(3)))
typedef unsigned short bf16_t;
typedef short bf16x8 __attribute__((ext_vector_type(8)));
typedef short bf16x4 __attribute__((ext_vector_type(4)));
typedef float f32x4 __attribute__((ext_vector_type(4)));
typedef float f32x16 __attribute__((ext_vector_type(16)));
typedef unsigned u32x4 __attribute__((ext_vector_type(4)));
typedef unsigned u32x2 __attribute__((ext_vector_type(2)));

constexpr int D = 1024, T = 49152, NSEQ = 10, NMODC = 6144, FF = 4096;
constexpr int T_PROMPT = 32768;
constexpr float EPS = 1e-6f;
#ifndef PH
#define PH 16383
#endif
#ifndef DUP
#define DUP 0
#endif
#ifndef TPROBE
#define TPROBE 0
#endif
#ifndef TSEL
#define TSEL 0u
#endif
constexpr int NWAVES = 8, NTHREADS = 512;
constexpr int LDS_BYTES = 139264;
constexpr int WIN_N = 3328;
constexpr int PROJ_N = 3072;

constexpr size_t MiB = 1u << 20;
constexpr size_t WS_MOD = 0;
constexpr size_t WS_BARW = 491520;
constexpr size_t WS_STAMP = 507904;
constexpr size_t WS_ABAR = 512 * 1024;
constexpr size_t WS_BBT = 1 * MiB;
constexpr size_t WS_CT = 1 * MiB + 512 * 1024;
constexpr size_t WS_DTOT = 2 * MiB;
constexpr size_t WS_A1 = 3 * MiB;
constexpr size_t WS_WIN = 10 * MiB;
constexpr size_t WS_WOUT = WS_WIN + (size_t)WIN_N * D * 2;
constexpr size_t WS_W1B = WS_WOUT + (size_t)D * D * 2;
constexpr size_t WS_W2B = WS_W1B + (size_t)FF * D * 2;
constexpr size_t WS_HBUF = 35 * MiB;
constexpr size_t WS_BIG = 131 * MiB;
constexpr size_t WS_S5E = WS_BIG + 96 * MiB;
constexpr size_t WS_X = 419 * MiB;
constexpr size_t WS_WGLU = WS_X;
constexpr size_t WS_W1A = WS_X + 4 * MiB;
constexpr size_t WS_W2A = WS_X + 12 * MiB;
constexpr size_t WS_SBUF = WS_X;
constexpr size_t WS_END = 467 * MiB;
static_assert(WS_W2B + (size_t)FF * D * 2 <= WS_HBUF, "ws map");

struct P { const float* in[26]; float* out; unsigned char* ws; };

typedef __bf16 bf16n2 __attribute__((ext_vector_type(2)));
typedef float f32x2n __attribute__((ext_vector_type(2)));
__device__ __forceinline__ unsigned pk_bf16(float lo, float hi) { const f32x2n f = {lo, hi}; const bf16n2 v = __builtin_convertvector(f, bf16n2); return __builtin_bit_cast(unsigned, v); }
__device__ __forceinline__ bf16_t f2bf(float f) { return (bf16_t)(pk_bf16(f, 0.f) & 0xffffu); }
__device__ __forceinline__ float bf2f(bf16_t b) { return __uint_as_float(((unsigned)b) << 16); }
__device__ __forceinline__ float wave_sum(float v) {
#pragma unroll
    for (int o = 1; o < 64; o <<= 1) v += __shfl_xor(v, o);
    return v;
}
__device__ __forceinline__ int row_seq(int row) { return row < T_PROMPT ? (row >> 14) : 2 + ((row - T_PROMPT) >> 11); }
__device__ __forceinline__ float sigmoidf_(float x) { return 1.0f / (1.0f + __expf(-x)); }
__device__ __forceinline__ float gelu_tanh(float y) {
    const float a = 0.7978845608028654f * (y + 0.044715f * y * y * y);
    const float th = 1.0f - 2.0f / (__expf(2.0f * a) + 1.0f);
    return 0.5f * y * (1.0f + th);
}
#define CFENCE() asm volatile("" ::: "memory")
#define LDS_WAIT() asm volatile("s_waitcnt lgkmcnt(0)" ::: "memory")

struct EpiRes {
    static constexpr bool PERM = false, AFTER_DRAIN = false;
    float* x; const float* gate; int row_off;
    __device__ __forceinline__ void operator()(const pg8::f32x4 (&acc)[2][2][4][2], const pg8::Unit& u, int wr, int wc, int fr, int fq) const {
        const int row0 = row_off + u.pm * 256 + wr * 64 + fr, col0 = u.pn * 256 + wc * 32 + 4 * fq;
        const float* gp = gate + (size_t)row_seq(row_off + u.pm * 256) * NMODC;
        pg8::f32x4 gv[2][2];
#pragma unroll
        for (int bj = 0; bj < 2; ++bj)
#pragma unroll
            for (int n = 0; n < 2; ++n) gv[bj][n] = *(const pg8::f32x4*)(gp + col0 + bj * 128 + n * 16);
#pragma unroll
        for (int ai = 0; ai < 2; ++ai)
#pragma unroll
            for (int m = 0; m < 4; ++m) { float* rowp = x + (size_t)(row0 + ai * 128 + m * 16) * D + col0;
#pragma unroll
                for (int bj = 0; bj < 2; ++bj)
#pragma unroll
                    for (int n = 0; n < 2; ++n) { pg8::f32x4* q = (pg8::f32x4*)(rowp + bj * 128 + n * 16); *q = *q + gv[bj][n] * acc[ai][bj][m][n]; }
                if (m & 1) asm volatile("" ::: "memory"); }
    }
};
struct EpiGlu {
    static constexpr bool PERM = false, AFTER_DRAIN = false;
    const float* xp; const float* xs; float* out; const float* gate;
    __device__ __forceinline__ void operator()(const pg8::f32x4 (&acc)[2][2][4][2], const pg8::Unit& u, int wr, int wc, int fr, int fq) const {
        const int row0 = u.pm * 256 + wr * 64 + fr, col0 = u.pn * 128 + wc * 32 + 4 * fq;
        const float* gp = gate + (size_t)row_seq(u.pm * 256) * NMODC;
        pg8::f32x4 gv[2];
#pragma unroll
        for (int n = 0; n < 2; ++n) gv[n] = *(const pg8::f32x4*)(gp + col0 + n * 16);
#pragma unroll
        for (int ai = 0; ai < 2; ++ai)
#pragma unroll
            for (int m = 0; m < 4; ++m) { const int row = row0 + ai * 128 + m * 16;
                const float* xin = row < T_PROMPT ? xp + (size_t)row * D : xs + (size_t)(row - T_PROMPT) * D;
#pragma unroll
                for (int n = 0; n < 2; ++n) { const pg8::f32x4 val = acc[ai][0][m][n], gt = acc[ai][1][m][n]; pg8::f32x4 sg;
                    sg[0] = sigmoidf_(gt[0]); sg[1] = sigmoidf_(gt[1]); sg[2] = sigmoidf_(gt[2]); sg[3] = sigmoidf_(gt[3]);
                    const pg8::f32x4 xv = *(const pg8::f32x4*)(xin + col0 + n * 16);
                    *(pg8::f32x4*)(out + (size_t)row * D + col0 + n * 16) = xv + gv[n] * val * sg; }
                if (m & 1) asm volatile("" ::: "memory"); }
    }
};
template <int ACT> struct EpiBf {
    static constexpr bool PERM = true, AFTER_DRAIN = false;
    bf16_t* O; int ldc; float* a1;
    __device__ __forceinline__ void operator()(const pg8::f32x4 (&acc)[2][2][4][2], const pg8::Unit& u, int wr, int wc, int fr, int fq) const {
        const int row0 = u.pm * 256 + wr * 64 + fr;
        if (ACT == 0 && u.pn == 12) {
            if (wc == 0) {
#pragma unroll
                for (int ai = 0; ai < 2; ++ai)
#pragma unroll
                    for (int m = 0; m < 4; ++m) { float* rp = a1 + (size_t)(row0 + ai * 128 + m * 16) * 32 + 8 * fq;
                        *(pg8::f32x4*)rp = acc[ai][0][m][0]; *(pg8::f32x4*)(rp + 4) = acc[ai][0][m][1]; }
            }
            return;
        }
        const int col0 = u.pn * 256 + wc * 32 + 8 * fq;
#pragma unroll
        for (int ai = 0; ai < 2; ++ai)
#pragma unroll
            for (int m = 0; m < 4; ++m) { bf16_t* rowp = O + (size_t)(row0 + ai * 128 + m * 16) * ldc + col0;
#pragma unroll
                for (int bj = 0; bj < 2; ++bj) { pg8::f32x4 v0 = acc[ai][bj][m][0], v1 = acc[ai][bj][m][1];
                    if (ACT == 1) {
#pragma unroll
                        for (int e = 0; e < 4; ++e) { const float a = fmaxf(v0[e], 0.f), b = fmaxf(v1[e], 0.f); v0[e] = a * a; v1[e] = b * b; } }
                    pg8::u32x4 wv; wv.x = pk_bf16(v0[0], v0[1]); wv.y = pk_bf16(v0[2], v0[3]); wv.z = pk_bf16(v1[0], v1[1]); wv.w = pk_bf16(v1[2], v1[3]);
                    *(pg8::u32x4*)(rowp + bj * 128) = wv; } }
    }
};

__device__ __forceinline__ void transpose_item(const float* W, int K, int N, int srccol0, bf16_t* WT, int dstrow0, int k0, LAS float* scr, int lane) {
    { float tv[32];
#pragma unroll
      for (int i = 0; i < 32; ++i) tv[i] = W[(size_t)(k0 + 2 * i + (lane >> 5)) * N + srccol0 + (lane & 31)];
#pragma unroll
      for (int i = 0; i < 32; ++i) scr[(2 * i + (lane >> 5)) * 33 + (lane & 31)] = tv[i]; }
    LDS_WAIT();
    const int c = lane & 7;
#pragma unroll
    for (int j = 0; j < 4; ++j) { const int n = (lane >> 3) + 8 * j; const LAS float* s = scr + (8 * c) * 33 + n;
        u32x4 o; o.x = pk_bf16(s[0 * 33], s[1 * 33]); o.y = pk_bf16(s[2 * 33], s[3 * 33]); o.z = pk_bf16(s[4 * 33], s[5 * 33]); o.w = pk_bf16(s[6 * 33], s[7 * 33]);
        *(u32x4*)(WT + (size_t)(dstrow0 + n) * K + k0 + 8 * c) = o; }
    LDS_WAIT();
}

__device__ __forceinline__ void p0_prep(const P& p, LAS unsigned char* lds) {
    int tid_ = threadIdx.x; asm volatile("" : "+v"(tid_));
    const int tid = tid_, lane = tid & 63, w = tid >> 6;
    unsigned char* ws = p.ws;
    if ((int)blockIdx.x < 192) {
        LAS float* sc = (LAS float*)lds;
        LAS float* red = (LAS float*)(lds + 40960);
        for (int i = tid; i < NSEQ * D; i += NTHREADS) { const int s = i >> 10, d = i & 1023; const float c = s < 2 ? p.in[2][s * D + d] : p.in[3][(s - 2) * D + d]; sc[i] = c * sigmoidf_(c); }
        __syncthreads();
        for (int it = blockIdx.x; it < 192; it += gridDim.x) {
            const int l = it / 96, col0 = (it % 96) * 64, col = tid & 63, ks = w;
            float acc[NSEQ];
#pragma unroll
            for (int s = 0; s < NSEQ; ++s) acc[s] = 0.f;
            const float* wp = p.in[4] + ((size_t)l * D + ks * 128) * NMODC + col0 + col;
#pragma unroll 16
            for (int k = 0; k < 128; ++k) { const float wv = wp[(size_t)k * NMODC];
#pragma unroll
                for (int s = 0; s < NSEQ; ++s) acc[s] += sc[s * D + ks * 128 + k] * wv; }
#pragma unroll
            for (int s = 0; s < NSEQ; ++s) red[(ks * NSEQ + s) * 64 + col] = acc[s];
            __syncthreads();
            for (int i = tid; i < NSEQ * 64; i += NTHREADS) { const int s = i >> 6, cc = i & 63; float v = 0.f;
#pragma unroll
                for (int k8 = 0; k8 < 8; ++k8) v += red[(k8 * NSEQ + s) * 64 + cc];
                ((float*)(ws + WS_MOD))[((size_t)l * NSEQ + s) * NMODC + col0 + cc] = v + p.in[5][l * NMODC + col0 + cc]; }
            __syncthreads();
        }
    }
    __syncthreads();
    {
        LAS float* scr = (LAS float*)(lds + w * 16384);
        const int gw = blockIdx.x * NWAVES + w, NGW = gridDim.x * NWAVES;
        constexpr int I_GLU = 16 * 64, I_WIN = 16 * 96, I_WOUT = 16 * 32, I_W1 = 16 * 128, I_W2 = 64 * 32;
        constexpr int NITEMS = I_GLU + I_WIN + I_WOUT + 2 * I_W1 + 2 * I_W2;
        for (int it = gw; it < NITEMS; it += NGW) {
            int r = it;
            if (r < I_GLU) { const int kb = r / 64, nb = r % 64, n0 = nb * 32, pn = n0 >> 8, bj = (n0 >> 7) & 1, r0 = n0 & 127;
                transpose_item(p.in[16], D, 2 * D, bj * D + pn * 128 + r0, (bf16_t*)(ws + WS_WGLU), n0, kb * 64, scr, lane); continue; }
            r -= I_GLU;
            if (r < I_WIN) { const int kb = r / 96, nb = r % 96; transpose_item(p.in[17], D, PROJ_N, nb * 32, (bf16_t*)(ws + WS_WIN), nb * 32, kb * 64, scr, lane); continue; }
            r -= I_WIN;
            if (r < I_WOUT) { const int kb = r / 32, nb = r % 32; transpose_item(p.in[22], D, D, nb * 32, (bf16_t*)(ws + WS_WOUT), nb * 32, kb * 64, scr, lane); continue; }
            r -= I_WOUT;
            if (r < 2 * I_W1) { const int l = r / I_W1, q = r % I_W1, kb = q / 128, nb = q % 128;
                transpose_item(p.in[23] + (size_t)l * D * FF, D, FF, nb * 32, (bf16_t*)(ws + (l ? WS_W1B : WS_W1A)), nb * 32, kb * 64, scr, lane); continue; }
            r -= 2 * I_W1;
            { const int l = r / I_W2, q = r % I_W2, kb = q / 32, nb = q % 32;
                transpose_item(p.in[24] + (size_t)l * FF * D, FF, D, nb * 32, (bf16_t*)(ws + (l ? WS_W2B : WS_W2A)), nb * 32, kb * 64, scr, lane); }
        }
        bf16_t* wt = (bf16_t*)(ws + WS_WIN);
        for (int i = blockIdx.x * NTHREADS + tid; i < 256 * D; i += gridDim.x * NTHREADS) { const int r = i >> 10, k = i & 1023;
            const float v = r < 32 ? p.in[18][((size_t)(r >> 4) * D + k) * 16 + (r & 15)] : 0.f;
            wt[(size_t)(PROJ_N + r) * D + k] = f2bf(v); }
    }
    for (int i = blockIdx.x * NTHREADS + tid; i < 2 * 64 * 64; i += gridDim.x * NTHREADS) {
        const int pp = i & 63, dg = i >> 6;
        const float lr = p.in[8][i], li = p.in[9][i], dt = __expf(p.in[10][dg]);
        const float mag = __expf(lr * dt); float sn, cs; sincosf(li * dt, &sn, &cs);
        const float abr = mag * cs, abi = mag * sn, den = lr * lr + li * li;
        const float zr = ((abr - 1.0f) * lr + abi * li) / den, zi = (abi * lr - (abr - 1.0f) * li) / den;
        float* ab = (float*)(ws + WS_ABAR); ab[2 * i] = abr; ab[2 * i + 1] = abi;
        bf16_t* bbt = (bf16_t*)(ws + WS_BBT); bf16_t* ct = (bf16_t*)(ws + WS_CT);
#pragma unroll
        for (int h = 0; h < 16; ++h) {
            const float br = p.in[11][(size_t)i * 16 + h], bi = p.in[12][(size_t)i * 16 + h];
            bbt[((size_t)dg * 128 + pp) * 16 + h] = f2bf(zr * br - zi * bi);
            bbt[((size_t)dg * 128 + 64 + pp) * 16 + h] = f2bf(zr * bi + zi * br);
            ct[((size_t)dg * 16 + h) * 128 + pp] = f2bf(p.in[13][((size_t)dg * 16 + h) * 64 + pp]);
            ct[((size_t)dg * 16 + h) * 128 + 64 + pp] = f2bf(-p.in[14][((size_t)dg * 16 + h) * 64 + pp]);
        }
    }
}

template <int SRC, bool FINAL>
__device__ __forceinline__ void norm_phase(const P& p, const float* gvec, const float* shift, const float* scale, float oscale = 1.0f, const int row_lo = 0, const int row_hi = T) {
    int tid_ = threadIdx.x; asm volatile("" : "+v"(tid_));
    const int tid = tid_, lane = tid & 63, w = tid >> 6;
    const int gw = blockIdx.x * NWAVES + w, NGW = gridDim.x * NWAVES;
    bf16_t* hb = (bf16_t*)(p.ws + WS_HBUF);
    f32x4 gq[4];
#pragma unroll
    for (int j = 0; j < 4; ++j) gq[j] = *(const f32x4*)(gvec + 4 * lane + 256 * j);
    f32x4 vn[4], gsv[4], shv[4]; int cur_seq = -1;
#pragma unroll
    for (int j = 0; j < 4; ++j) { gsv[j] = gq[j]; shv[j] = (f32x4){0.f, 0.f, 0.f, 0.f}; }
    if (row_lo + gw < row_hi) { const int row = row_lo + gw; const float* xr = SRC == 0 ? (row < T_PROMPT ? p.in[0] + (size_t)row * D : p.in[1] + (size_t)(row - T_PROMPT) * D) : p.out + (size_t)row * D;
#pragma unroll
      for (int j = 0; j < 4; ++j) vn[j] = *(const f32x4*)(xr + 4 * lane + 256 * j); }
    for (int row = row_lo + gw; row < row_hi; row += NGW) {
        f32x4 v[4]; float ss = 0.f;
#pragma unroll
        for (int j = 0; j < 4; ++j) { v[j] = vn[j]; ss += (v[j][0] * v[j][0] + v[j][1] * v[j][1]) + (v[j][2] * v[j][2] + v[j][3] * v[j][3]); }
        { const int rn = row + NGW < row_hi ? row + NGW : row;
          const float* xr = SRC == 0 ? (rn < T_PROMPT ? p.in[0] + (size_t)rn * D : p.in[1] + (size_t)(rn - T_PROMPT) * D) : p.out + (size_t)rn * D;
#pragma unroll
          for (int j = 0; j < 4; ++j) vn[j] = *(const f32x4*)(xr + 4 * lane + 256 * j); }
        const float rstd = rsqrtf(wave_sum(ss) * (1.0f / D) + EPS);
        if (FINAL) {
#pragma unroll
            for (int j = 0; j < 4; ++j) *(f32x4*)(p.out + (size_t)row * D + 4 * lane + 256 * j) = v[j] * (rstd * oscale) * gq[j];
        } else {
            const int s = row_seq(row);
            if (s != cur_seq) {
                cur_seq = s;
#pragma unroll
                for (int j = 0; j < 4; ++j) { shv[j] = *(const f32x4*)(shift + (size_t)s * NMODC + 4 * lane + 256 * j);
                    gsv[j] = gq[j] * (*(const f32x4*)(scale + (size_t)s * NMODC + 4 * lane + 256 * j) + 1.0f); }
            }
#pragma unroll
            for (int j = 0; j < 4; ++j) { const f32x4 o = (v[j] * rstd) * gsv[j] + shv[j];
                u32x2 wv; wv.x = pk_bf16(o[0], o[1]); wv.y = pk_bf16(o[2], o[3]);
                *(u32x2*)(hb + (size_t)row * D + 4 * lane + 256 * j) = wv; }
        }
    }
}

constexpr int S5_NCH = 384, S5_HROW = 272, S5_UROW = 48, S5_UOFF = 32 * S5_HROW, S5_WAVE_LDS = S5_UOFF + 128 * S5_UROW;
__device__ __forceinline__ void half_bcast(float x, float& lo, float& hi) { const auto r = __builtin_amdgcn_permlane32_swap(__float_as_uint(x), __float_as_uint(x), false, false); lo = __uint_as_float(r[0]); hi = __uint_as_float(r[1]); }
#define CMAD(sr, si, mr, mi, br, bi) do { const float nr_ = (sr) * (mr) - (si) * (mi) + (br); const float ni_ = (sr) * (mi) + (si) * (mr) + (bi); (sr) = nr_; (si) = ni_; } while (0)
template <bool PC>
__device__ __forceinline__ void s5_pass(const P& p, LAS unsigned char* lds) {
    int tid_ = threadIdx.x; asm volatile("" : "+v"(tid_));
    const int tid = tid_, lane = tid & 63, w = __builtin_amdgcn_readfirstlane(tid >> 6);
    const int b = blockIdx.x, g = (b & 7) * 8 + w;
    const int hh = lane >> 5, l32 = lane & 31, l16 = lane & 15, q16 = lane >> 4;
    LAS unsigned char* const H = lds + w * S5_WAVE_LDS;
    LAS unsigned char* const hwr = H + (4 * hh) * S5_HROW + l32 * 4;
    const LAS unsigned char* const hrd = H + l16 * S5_HROW + q16 * 16;
    const bf16_t* hb = (const bf16_t*)(p.ws + WS_HBUF);
    bf16_t* gout = (bf16_t*)(p.ws + WS_BIG);
    float* E = (float*)(p.ws + WS_S5E);
    const bf16_t* bbt = (const bf16_t*)(p.ws + WS_BBT); const bf16_t* ct = (const bf16_t*)(p.ws + WS_CT); const float* ab = (const float*)(p.ws + WS_ABAR);
    const float dsk = p.in[15][g * 16 + l16];
    bf16x8 BfA[2][4];
#pragma unroll
    for (int dir = 0; dir < 2; ++dir)
#pragma unroll
        for (int nb = 0; nb < 4; ++nb) BfA[dir][nb] = PC ? (bf16x8){0, 0, 0, 0, 0, 0, 0, 0} : *(const bf16x8*)(bbt + ((size_t)(dir * 64 + g) * 128 + (nb >> 1) * 64 + 2 * l32 + (nb & 1)) * 16 + 8 * hh);
    const int cstride = (int)(gridDim.x >> 3);
    const bf16_t* const ub = hb + (size_t)l32 * D + g * 16 + 8 * hh;
    bf16x8 afn[4]; f32x2n enr[2], eni[2];
    { const int c0 = b >> 3;
      if (c0 < S5_NCH) {
#pragma unroll
        for (int sb = 0; sb < 4; ++sb) afn[sb] = *(const bf16x8*)(ub + (size_t)(c0 * 128 + sb * 32) * D);
        if (PC) {
#pragma unroll
            for (int dir = 0; dir < 2; ++dir) { const size_t eo = (((size_t)dir * S5_NCH + c0) * 64 + g) * 128; enr[dir] = *(const f32x2n*)(E + eo + 2 * l32); eni[dir] = *(const f32x2n*)(E + eo + 64 + 2 * l32); } } } }
    for (int c = b >> 3; c < S5_NCH; c += cstride) {
        const int tok0 = c * 128;
        f32x2n ecr[2], eci[2];
#pragma unroll
        for (int sb = 0; sb < 4; ++sb) *(LAS bf16x8*)(H + S5_UOFF + (sb * 32 + l32) * S5_UROW + 16 * hh) = afn[sb];
#pragma unroll
        for (int dir = 0; dir < 2; ++dir) { ecr[dir] = enr[dir]; eci[dir] = eni[dir]; }
        CFENCE(); LDS_WAIT(); CFENCE();
        { int cn = c + cstride; asm volatile("" : "+s"(cn));
          if (cn < S5_NCH) {
#pragma unroll
            for (int sb = 0; sb < 4; ++sb) afn[sb] = *(const bf16x8*)(ub + (size_t)(cn * 128 + sb * 32) * D);
            if (PC) {
#pragma unroll
                for (int dir = 0; dir < 2; ++dir) { const size_t eo = (((size_t)dir * S5_NCH + cn) * 64 + g) * 128; enr[dir] = *(const f32x2n*)(E + eo + 2 * l32); eni[dir] = *(const f32x2n*)(E + eo + 64 + 2 * l32); } } } }
        f32x4 yacc[8];
#pragma unroll
        for (int j = 0; j < 8; ++j) yacc[j] = (f32x4){0.f, 0.f, 0.f, 0.f};
#pragma unroll
        for (int dir = 0; dir < 2; ++dir) {
            const size_t eoff = (((size_t)dir * S5_NCH + c) * 64 + g) * 128;
            const int dg = dir * 64 + g;
            bf16x8 Bf[4], Cf[4];
#pragma unroll
            for (int nb = 0; nb < 4; ++nb) Bf[nb] = PC ? *(const bf16x8*)(bbt + ((size_t)dg * 128 + (nb >> 1) * 64 + 2 * l32 + (nb & 1)) * 16 + 8 * hh) : BfA[dir][nb];
#pragma unroll
            for (int ks = 0; ks < 4; ++ks) Cf[ks] = PC ? *(const bf16x8*)(ct + ((size_t)dg * 16 + l16) * 128 + 32 * ks + 8 * q16) : (bf16x8){0, 0, 0, 0, 0, 0, 0, 0};
            const f32x4 a1v = *(const f32x4*)(ab + ((size_t)dg * 64 + 2 * l32) * 2);
            const float a1Ar = a1v[0], a1Ai = a1v[1], a1Br = a1v[2], a1Bi = a1v[3];
            const float a2Ar = a1Ar * a1Ar - a1Ai * a1Ai, a2Ai = 2.f * a1Ar * a1Ai, a2Br = a1Br * a1Br - a1Bi * a1Bi, a2Bi = 2.f * a1Br * a1Bi;
            const float a3Ar = a2Ar * a1Ar - a2Ai * a1Ai, a3Ai = a2Ar * a1Ai + a2Ai * a1Ar, a3Br = a2Br * a1Br - a2Bi * a1Bi, a3Bi = a2Br * a1Bi + a2Bi * a1Br;
            const float a4Ar = a2Ar * a2Ar - a2Ai * a2Ai, a4Ai = 2.f * a2Ar * a2Ai, a4Br = a2Br * a2Br - a2Bi * a2Bi, a4Bi = 2.f * a2Br * a2Bi;
            const float a5Ar = a4Ar * a1Ar - a4Ai * a1Ai, a5Ai = a4Ar * a1Ai + a4Ai * a1Ar, a5Br = a4Br * a1Br - a4Bi * a1Bi, a5Bi = a4Br * a1Bi + a4Bi * a1Br;
            float hAr = 0.f, hAi = 0.f, hBr = 0.f, hBi = 0.f;
            if (PC) { hAr = ecr[dir][0]; hBr = ecr[dir][1]; hAi = eci[dir][0]; hBi = eci[dir][1]; }
            const bool lead = (hh == dir);
#pragma unroll
            for (int sbi = 0; sbi < 4; ++sbi) {
                const int sb = dir == 0 ? sbi : 3 - sbi;
                if (PC) __builtin_amdgcn_sched_barrier(0);
                const bf16x8 a = *(const LAS bf16x8*)(H + S5_UOFF + (sb * 32 + l32) * S5_UROW + 16 * hh);
                f32x16 acc[4];
#pragma unroll
                for (int nb = 0; nb < 4; ++nb) {
#pragma unroll
                    for (int i = 0; i < 16; ++i) acc[nb][i] = 0.f;
                    acc[nb] = __builtin_amdgcn_mfma_f32_32x32x16_bf16(a, Bf[nb], acc[nb], 0, 0, 0);
                }
                if (!PC) {
#pragma unroll
                    for (int gi = 0; gi < 4; ++gi)
#pragma unroll
                        for (int ri = 0; ri < 4; ++ri) { const int i = 4 * (dir == 0 ? gi : 3 - gi) + (dir == 0 ? ri : 3 - ri);
                            if (sbi == 0 && gi == 0 && ri == 0) { hAr = acc[0][i]; hAi = acc[2][i]; hBr = acc[1][i]; hBi = acc[3][i]; }
                            else if (ri == 0) { CMAD(hAr, hAi, a5Ar, a5Ai, acc[0][i], acc[2][i]); CMAD(hBr, hBi, a5Br, a5Bi, acc[1][i], acc[3][i]); }
                            else { CMAD(hAr, hAi, a1Ar, a1Ai, acc[0][i], acc[2][i]); CMAD(hBr, hBi, a1Br, a1Bi, acc[1][i], acc[3][i]); } }
                } else {
#pragma unroll
                    for (int gi = 0; gi < 4; ++gi) { const int gg = dir == 0 ? gi : 3 - gi;
                        float xAr = lead ? hAr : 0.f, xAi = lead ? hAi : 0.f, xBr = lead ? hBr : 0.f, xBi = lead ? hBi : 0.f;
#pragma unroll
                        for (int k = 0; k < 4; ++k) { const int i = 4 * gg + (dir == 0 ? k : 3 - k);
                            CMAD(xAr, xAi, a1Ar, a1Ai, acc[0][i], acc[2][i]); acc[0][i] = xAr; acc[2][i] = xAi;
                            CMAD(xBr, xBi, a1Br, a1Bi, acc[1][i], acc[3][i]); acc[1][i] = xBr; acc[3][i] = xBi; }
                        float eAr, eAi, eBr, eBi, dmy;
                        if (dir == 0) { half_bcast(xAr, eAr, dmy); half_bcast(xAi, eAi, dmy); half_bcast(xBr, eBr, dmy); half_bcast(xBi, eBi, dmy); }
                        else { half_bcast(xAr, dmy, eAr); half_bcast(xAi, dmy, eAi); half_bcast(xBr, dmy, eBr); half_bcast(xBi, dmy, eBi); }
                        if (lead) { eAr = 0.f; eAi = 0.f; eBr = 0.f; eBi = 0.f; }
                        { const int i0 = 4 * gg + (dir == 0 ? 0 : 3), i1 = 4 * gg + (dir == 0 ? 1 : 2), i2 = 4 * gg + (dir == 0 ? 2 : 1), i3 = 4 * gg + (dir == 0 ? 3 : 0);
                          acc[0][i0] += a1Ar * eAr - a1Ai * eAi; acc[2][i0] += a1Ar * eAi + a1Ai * eAr; acc[1][i0] += a1Br * eBr - a1Bi * eBi; acc[3][i0] += a1Br * eBi + a1Bi * eBr;
                          acc[0][i1] += a2Ar * eAr - a2Ai * eAi; acc[2][i1] += a2Ar * eAi + a2Ai * eAr; acc[1][i1] += a2Br * eBr - a2Bi * eBi; acc[3][i1] += a2Br * eBi + a2Bi * eBr;
                          acc[0][i2] += a3Ar * eAr - a3Ai * eAi; acc[2][i2] += a3Ar * eAi + a3Ai * eAr; acc[1][i2] += a3Br * eBr - a3Bi * eBi; acc[3][i2] += a3Br * eBi + a3Bi * eBr;
                          acc[0][i3] += a4Ar * eAr - a4Ai * eAi; acc[2][i3] += a4Ar * eAi + a4Ai * eAr; acc[1][i3] += a4Br * eBr - a4Bi * eBi; acc[3][i3] += a4Br * eBi + a4Bi * eBr;
                          const float tAr = acc[0][i3], tAi = acc[2][i3], tBr = acc[1][i3], tBi = acc[3][i3];
                          float dm2;
                          if (dir == 0) { half_bcast(tAr, dm2, hAr); half_bcast(tAi, dm2, hAi); half_bcast(tBr, dm2, hBr); half_bcast(tBi, dm2, hBi); }
                          else { half_bcast(tAr, hAr, dm2); half_bcast(tAi, hAi, dm2); half_bcast(tBr, hBr, dm2); half_bcast(tBi, hBi, dm2); } }
                    }
#pragma unroll
                    for (int i = 0; i < 16; ++i) { const int ro = (8 * (i >> 2) + (i & 3)) * S5_HROW;
                        *(LAS unsigned*)(hwr + ro) = pk_bf16(acc[0][i], acc[1][i]); *(LAS unsigned*)(hwr + ro + 128) = pk_bf16(acc[2][i], acc[3][i]); }
                    CFENCE(); LDS_WAIT(); CFENCE();
#pragma unroll
                    for (int mb = 0; mb < 2; ++mb)
#pragma unroll
                        for (int ks = 0; ks < 4; ++ks) { const bf16x8 af = *(const LAS bf16x8*)(hrd + mb * 16 * S5_HROW + 64 * ks);
                            yacc[sb * 2 + mb] = __builtin_amdgcn_mfma_f32_16x16x32_bf16(af, Cf[ks], yacc[sb * 2 + mb], 0, 0, 0); }
                    CFENCE(); LDS_WAIT(); CFENCE();
                }
            }
            if (!PC) {
                float s0Ar, s0Ai, s0Br, s0Bi, s1Ar, s1Ai, s1Br, s1Bi;
                half_bcast(hAr, s0Ar, s1Ar); half_bcast(hAi, s0Ai, s1Ai); half_bcast(hBr, s0Br, s1Br); half_bcast(hBi, s0Bi, s1Bi);
                float eAr, eAi, eBr, eBi;
                if (dir == 0) { eAr = a4Ar * s0Ar - a4Ai * s0Ai + s1Ar; eAi = a4Ar * s0Ai + a4Ai * s0Ar + s1Ai; eBr = a4Br * s0Br - a4Bi * s0Bi + s1Br; eBi = a4Br * s0Bi + a4Bi * s0Br + s1Bi; }
                else { eAr = a4Ar * s1Ar - a4Ai * s1Ai + s0Ar; eAi = a4Ar * s1Ai + a4Ai * s1Ar + s0Ai; eBr = a4Br * s1Br - a4Bi * s1Bi + s0Br; eBi = a4Br * s1Bi + a4Bi * s1Br + s0Bi; }
                if (hh == 0) { *(f32x2n*)(E + eoff + 2 * l32) = (f32x2n){eAr, eBr}; *(f32x2n*)(E + eoff + 64 + 2 * l32) = (f32x2n){eAi, eBi}; }
            }
        }
        CFENCE(); LDS_WAIT(); CFENCE();
        if (PC) {
#pragma unroll
            for (int j = 0; j < 8; ++j)
#pragma unroll
                for (int i = 0; i < 4; ++i) { LAS bf16_t* up = (LAS bf16_t*)(H + S5_UOFF + (4 * q16) * S5_UROW + l16 * 2 + (j * 16 + i) * S5_UROW);
                    const float y = yacc[j][i] + dsk * bf2f(*up); *up = f2bf(gelu_tanh(y)); }
            CFENCE(); LDS_WAIT(); CFENCE();
#pragma unroll
            for (int k = 0; k < 4; ++k) { const int idx = lane + 64 * k, tk = idx >> 1, hf = idx & 1;
                const u32x4 v = *(const LAS u32x4*)(H + S5_UOFF + tk * S5_UROW + hf * 16);
                *(u32x4*)(gout + (size_t)(tok0 + tk) * D + g * 16 + hf * 8) = v; }
            CFENCE(); LDS_WAIT(); CFENCE();
        }
    }
}
__device__ __forceinline__ void s5_carry(const P& p) {
    int tid_ = threadIdx.x; asm volatile("" : "+v"(tid_));
    const int idx = blockIdx.x * NTHREADS + tid_;
    if (idx >= 2 * NSEQ * 64 * 64) return;
    const int pp = idx & 63, g = (idx >> 6) & 63, s = (idx >> 12) % NSEQ, dir = idx / (NSEQ * 4096);
    const float* ab = (const float*)(p.ws + WS_ABAR);
    float Ar = ab[((dir * 64 + g) * 64 + pp) * 2], Ai = ab[((dir * 64 + g) * 64 + pp) * 2 + 1];
#pragma unroll
    for (int k = 0; k < 7; ++k) { const float nr = Ar * Ar - Ai * Ai, ni = 2.0f * Ar * Ai; Ar = nr; Ai = ni; }
    const int c0 = s < 2 ? s * 128 : 256 + (s - 2) * 16, n = s < 2 ? 128 : 16;
    float* E = (float*)(p.ws + WS_S5E);
    float rr = 0.f, ri = 0.f;
    for (int i0 = 0; i0 < n; i0 += 16) {
        float er[16], ei[16];
#pragma unroll
        for (int k = 0; k < 16; ++k) { const int i = i0 + k, c = dir == 0 ? c0 + i : c0 + n - 1 - i; const size_t ad = (((size_t)dir * S5_NCH + c) * 64 + g) * 128 + pp; er[k] = E[ad]; ei[k] = E[ad + 64]; }
#pragma unroll
        for (int k = 0; k < 16; ++k) { const int i = i0 + k, c = dir == 0 ? c0 + i : c0 + n - 1 - i; const size_t ad = (((size_t)dir * S5_NCH + c) * 64 + g) * 128 + pp;
            E[ad] = rr; E[ad + 64] = ri; const float nr = Ar * rr - Ai * ri + er[k], ni = Ar * ri + Ai * rr + ei[k]; rr = nr; ri = ni; }
    }
}

constexpr int GQ = 0, GK = 17408, GKT = 34816, GVT = 53248, GSC = 90112, GA1 = 99328, GSUM = 103424, GEL = 105472, GRMS = 105984, GRSTD = 108032, GW2 = 108288;
constexpr int QST = 272, TST = 144, VST = 576;
__device__ __forceinline__ void gla_item_coords(int j, int& hd, int& tokbase) {
    hd = j & 3; const int q = j >> 2;
    if (q < 32) tokbase = (q >> 4) * 16384 + (q & 15) * 1024; else tokbase = T_PROMPT + ((q - 32) >> 1) * 2048 + ((q - 32) & 1) * 1024;
}
template <int MODE>
__device__ __forceinline__ void gla_phase(const P& p, LAS unsigned char* lds, int m0_first = 0, int m0_count = 0, int m0_block0 = 0) {
    int tid_ = threadIdx.x; asm volatile("" : "+v"(tid_));
    const int tid = tid_, lane = tid & 63, w = __builtin_amdgcn_readfirstlane(tid >> 6), hh = lane >> 5, l32 = lane & 31;
    const int chan = tid & 127, tg = w >> 1;
    const bf16_t* proj = (const bf16_t*)(p.ws + WS_BIG);
    const float* a1b = (const float*)(p.ws + WS_A1);
    bf16_t* hb = (bf16_t*)(p.ws + WS_HBUF);
    float* sbuf = (float*)(p.ws + WS_SBUF); float* dtot = (float*)(p.ws + WS_DTOT);
    LAS unsigned char* const qfrag = lds + GQ + l32 * QST + 16 * hh;
    LAS unsigned char* const kfrag = lds + GK + l32 * QST + 16 * hh;
    LAS unsigned char* const qperm = lds + GQ + l32 * QST + 8 * hh;
    LAS unsigned char* const ktfrag = lds + GKT + l32 * TST + 16 * hh;
    LAS unsigned char* const vtr = lds + GVT + (8 * hh + ((lane & 15) >> 2)) * VST + (32 * w + 16 * ((lane >> 4) & 1) + 4 * (lane & 3)) * 2;
    LAS unsigned char* const scfrag = lds + GSC + l32 * TST + 16 * hh;
    LAS unsigned char* const otw = lds + GVT + (4 * hh) * VST + (32 * w + l32) * 2;
    LAS unsigned char* const scst = lds + GSC + (4 * hh) * TST + l32 * 2;
    LAS unsigned char* const elrd = lds + GEL + 16 * hh;
    LAS unsigned char* const rmsw = lds + GRMS + (4 * hh) * 32 + w * 4;
    LAS unsigned char* const rstdr = lds + GRSTD + (4 * hh) * 4;
    LAS unsigned char* const qprep = lds + GQ + (16 * tg) * QST + chan * 2;
    LAS unsigned char* const kprep = lds + GK + (16 * tg) * QST + chan * 2;
    LAS unsigned char* const a1rd = lds + GA1 + (16 * tg) * 64;
    const LAS float* const w2p = (const LAS float*)(lds + GW2) + chan;
    const int nitems = MODE == 0 ? m0_count : 192;
    for (int it = MODE == 0 ? (int)blockIdx.x - m0_block0 : (int)blockIdx.x; it >= 0 && it < nitems; it += gridDim.x) {
        int dir = MODE == 1 ? 0 : 1, j = it;
        if (MODE == 0) { const int nidx = m0_first + it; dir = nidx >= 152 ? 1 : 0; const int n = nidx - dir * 152;
            if (n < 120) { const int hd0 = n & 3, m = n >> 2, sq = m / 15, sc = m - sq * 15 + dir; j = (sq * 16 + sc) * 4 + hd0; }
            else { const int n2 = n - 120, hd0 = n2 & 3, sq = n2 >> 2; j = (32 + sq * 2 + dir) * 4 + hd0; } }
        const int full = dir * 192 + j;
        int hd, tokbase; gla_item_coords(j, hd, tokbase);
        __syncthreads();
        for (int i = tid; i < 16 * 128; i += NTHREADS) ((LAS float*)(lds + GW2))[i] = p.in[19][(size_t)(dir * 16 + (i >> 7)) * 512 + hd * 128 + (i & 127)];
        const float bias = p.in[20][dir * 512 + hd * 128 + chan];
        f32x16 S[4];
        float* const sb0 = sbuf + (size_t)full * 32768 + 32 * w; const int svo = (4 * hh) * 256 + l32;
#pragma unroll
        for (int cb = 0; cb < 4; ++cb)
#pragma unroll
            for (int i = 0; i < 16; ++i) S[cb][i] = MODE == 0 ? 0.f : (sb0 + (32 * cb + 8 * (i >> 2) + (i & 3)) * 256)[svo];
        float dsum = 0.f;
        u32x4 pq[2], pk[2], pv[4]; f32x4 pa = (f32x4){0.f, 0.f, 0.f, 0.f};
        const int qko = (tid >> 4) * PROJ_N + hd * 128 + (tid & 15) * 8;
        const int vo = (tid >> 5) * PROJ_N + 1024 + hd * 256 + (tid & 31) * 8;
        const int ao = (tid >> 2) * 32 + dir * 16 + (tid & 3) * 4;
#define GLA_LOAD(tbx) do { const bf16_t* pb_ = proj + (size_t)(tbx) * PROJ_N; \
            _Pragma("unroll") for (int i = 0; i < 2; ++i) { if (MODE != 0) pq[i] = *(const u32x4*)(pb_ + (size_t)i * 32 * PROJ_N + qko); pk[i] = *(const u32x4*)(pb_ + (size_t)i * 32 * PROJ_N + 512 + qko); } \
            _Pragma("unroll") for (int i = 0; i < 4; ++i) pv[i] = *(const u32x4*)(pb_ + (size_t)i * 16 * PROJ_N + vo); \
            if (tid < 256) pa = *(const f32x4*)(a1b + (size_t)(tbx) * 32 + ao); } while (0)
        { int tb0 = tokbase + (dir == 0 ? 0 : 15) * 64; GLA_LOAD(tb0); }
        for (int ci = 0; ci < 16; ++ci) {
            int tb = tokbase + (dir == 0 ? ci : 15 - ci) * 64; asm volatile("" : "+s"(tb));
            int tbn = tokbase + (dir == 0 ? ci + 1 : 14 - ci) * 64; asm volatile("" : "+s"(tbn));
            { LAS unsigned char* const qs = lds + GQ + (tid >> 4) * QST + (tid & 15) * 16;
#pragma unroll
              for (int i = 0; i < 2; ++i) { if (MODE != 0) *(LAS u32x4*)(qs + i * 32 * QST) = pq[i]; *(LAS u32x4*)(qs + (GK - GQ) + i * 32 * QST) = pk[i]; } }
            { LAS unsigned char* const vs = lds + GVT + (tid >> 5) * VST + (tid & 31) * 16;
#pragma unroll
              for (int i = 0; i < 4; ++i) *(LAS u32x4*)(vs + i * 16 * VST) = pv[i]; }
            if (tid < 256) *(LAS f32x4*)(lds + GA1 + (tid >> 2) * 64 + (tid & 3) * 16) = pa;
            __syncthreads();
            if (ci + 1 < 16) GLA_LOAD(tbn);
            float zc[16];
#pragma unroll
            for (int i = 0; i < 16; ++i) { const LAS f32x4* ap = (const LAS f32x4*)(a1rd + i * 64);
                float z = bias;
#pragma unroll
                for (int r4 = 0; r4 < 4; ++r4) { const f32x4 av = ap[r4]; z += av[0] * w2p[(4 * r4) * 128] + av[1] * w2p[(4 * r4 + 1) * 128] + av[2] * w2p[(4 * r4 + 2) * 128] + av[3] * w2p[(4 * r4 + 3) * 128]; }
                zc[i] = (fminf(z, 0.f) - __logf(1.0f + __expf(-fabsf(z)))) * (1.0f / 16.0f); }
            if (dir == 0) {
#pragma unroll
                for (int i = 1; i < 16; ++i) zc[i] += zc[i - 1];
            } else {
#pragma unroll
                for (int i = 14; i >= 0; --i) zc[i] += zc[i + 1];
            }
            ((LAS float*)(lds + GSUM))[tg * 128 + chan] = dir == 0 ? zc[15] : zc[0];
            __syncthreads();
            float blast, off;
            { const LAS float* gs = (const LAS float*)(lds + GSUM) + chan; const float g0 = gs[0], g1 = gs[128], g2 = gs[256], g3 = gs[384];
                blast = (g0 + g1) + (g2 + g3);
                if (dir == 0) off = (tg > 0 ? g0 : 0.f) + (tg > 1 ? g1 : 0.f) + (tg > 2 ? g2 : 0.f);
                else off = (tg < 3 ? g3 : 0.f) + (tg < 2 ? g2 : 0.f) + (tg < 1 ? g1 : 0.f); }
            {
                float kt[16];
#pragma unroll
                for (int i = 0; i < 16; ++i) { const float bc = zc[i] + off;
                    LAS bf16_t* qp = (LAS bf16_t*)(qprep + i * QST); LAS bf16_t* kp = (LAS bf16_t*)(kprep + i * QST);
                    const float kv = bf2f(*kp);
                    if (MODE != 0) { const float qv = bf2f(*qp); *qp = f2bf(qv * __expf(bc) * 0.08838834764831845f); *kp = f2bf(kv * __expf(-bc)); }
                    kt[i] = kv * __expf(blast - bc); }
                u32x4 k0, k1; k0.x = pk_bf16(kt[0], kt[1]); k0.y = pk_bf16(kt[2], kt[3]); k0.z = pk_bf16(kt[4], kt[5]); k0.w = pk_bf16(kt[6], kt[7]);
                k1.x = pk_bf16(kt[8], kt[9]); k1.y = pk_bf16(kt[10], kt[11]); k1.z = pk_bf16(kt[12], kt[13]); k1.w = pk_bf16(kt[14], kt[15]);
                *(LAS u32x4*)(lds + GKT + chan * TST + tg * 32) = k0; *(LAS u32x4*)(lds + GKT + chan * TST + tg * 32 + 16) = k1;
            }
            if (tg == 0) { ((LAS float*)(lds + GEL))[chan] = __expf(blast); dsum += blast; }
            __syncthreads();
            if (MODE != 0) {
                if (w < 4) { const int mb = w >> 1, nb = w & 1; f32x16 sc;
#pragma unroll
                    for (int i = 0; i < 16; ++i) sc[i] = 0.f;
#pragma unroll
                    for (int ks = 0; ks < 8; ++ks) { const bf16x8 a = *(const LAS bf16x8*)(qfrag + mb * 32 * QST + 32 * ks), bq = *(const LAS bf16x8*)(kfrag + nb * 32 * QST + 32 * ks);
                        sc = __builtin_amdgcn_mfma_f32_32x32x16_bf16(a, bq, sc, 0, 0, 0); }
                    const int dlt = (nb - mb) * 32 + l32 - 4 * hh;
                    LAS unsigned char* const sw = scst + mb * 32 * TST + nb * 64;
#pragma unroll
                    for (int i = 0; i < 16; ++i) { const int cst = 8 * (i >> 2) + (i & 3); const bool keep = dir == 0 ? (dlt <= cst) : (dlt >= cst);
                        *(LAS bf16_t*)(sw + cst * TST) = f2bf(keep ? sc[i] : 0.f); }
                }
                __syncthreads();
            }
            bf16x8 vf[4];
#pragma unroll
            for (int ks = 0; ks < 4; ++ks) { union { struct { bf16x4 lo, hi; } s; bf16x8 v; } vv;
                vv.s.lo = __builtin_amdgcn_ds_read_tr16_b64_v4i16((LAS bf16x4*)(vtr + (16 * ks) * VST));
                vv.s.hi = __builtin_amdgcn_ds_read_tr16_b64_v4i16((LAS bf16x4*)(vtr + (16 * ks + 4) * VST));
                vf[ks] = vv.v; }
            if (MODE != 0) {
                __syncthreads();
#pragma unroll
                for (int mb = 0; mb < 2; ++mb) {
                    f32x16 o;
#pragma unroll
                    for (int i = 0; i < 16; ++i) o[i] = 0.f;
#pragma unroll
                    for (int ks = 0; ks < 4; ++ks) { const bf16x8 a = *(const LAS bf16x8*)(scfrag + mb * 32 * TST + 32 * ks);
                        o = __builtin_amdgcn_mfma_f32_32x32x16_bf16(a, vf[ks], o, 0, 0, 0); }
#pragma unroll
                    for (int cb = 0; cb < 4; ++cb)
#pragma unroll
                        for (int h2 = 0; h2 < 2; ++h2) {
                            union { u32x4 u; bf16x8 v; } sb_;
                            sb_.u.x = pk_bf16(S[cb][8 * h2 + 0], S[cb][8 * h2 + 1]); sb_.u.y = pk_bf16(S[cb][8 * h2 + 2], S[cb][8 * h2 + 3]);
                            sb_.u.z = pk_bf16(S[cb][8 * h2 + 4], S[cb][8 * h2 + 5]); sb_.u.w = pk_bf16(S[cb][8 * h2 + 6], S[cb][8 * h2 + 7]);
                            const LAS unsigned char* base = qperm + mb * 32 * QST + (32 * cb + 16 * h2) * 2;
                            union { struct { u32x2 lo, hi; } s; bf16x8 v; } qa; qa.s.lo = *(const LAS u32x2*)base; qa.s.hi = *(const LAS u32x2*)(base + 16);
                            o = __builtin_amdgcn_mfma_f32_32x32x16_bf16(qa.v, sb_.v, o, 0, 0, 0);
                        }
#pragma unroll
                    for (int i = 0; i < 16; ++i) *(LAS bf16_t*)(otw + (32 * mb + 8 * (i >> 2) + (i & 3)) * VST) = f2bf(o[i]);
                    CFENCE();
                }
            }
            u32x4 of[4], rr[4];
            if (MODE == 2) {
                const bf16_t* const og2 = hb + (size_t)(tb + (tid >> 5)) * D + hd * 256 + (tid & 31) * 8;
                const bf16_t* const rg = proj + (size_t)(tb + (tid >> 5)) * PROJ_N + 2048 + hd * 256 + (tid & 31) * 8;
#pragma unroll
                for (int i = 0; i < 4; ++i) { of[i] = *(const u32x4*)(og2 + (size_t)(16 * i) * D); rr[i] = *(const u32x4*)(rg + (size_t)(16 * i) * PROJ_N); }
            }
#pragma unroll
            for (int cb = 0; cb < 4; ++cb) {
#pragma unroll
                for (int i4 = 0; i4 < 4; ++i4) { const f32x4 e = *(const LAS f32x4*)(elrd + (32 * cb + 8 * i4) * 4);
                    S[cb][4 * i4 + 0] *= e[0]; S[cb][4 * i4 + 1] *= e[1]; S[cb][4 * i4 + 2] *= e[2]; S[cb][4 * i4 + 3] *= e[3]; }
#pragma unroll
                for (int ks = 0; ks < 4; ++ks) { const bf16x8 a = *(const LAS bf16x8*)(ktfrag + cb * 32 * TST + 32 * ks);
                    S[cb] = __builtin_amdgcn_mfma_f32_32x32x16_bf16(a, vf[ks], S[cb], 0, 0, 0); }
            }
            __syncthreads();
            if (MODE != 0) {
                u32x4 ob[4];
#pragma unroll
                for (int i = 0; i < 4; ++i) ob[i] = *(const LAS u32x4*)(lds + GVT + ((tid >> 5) + 16 * i) * VST + (tid & 31) * 16);
                bf16_t* const og = hb + (size_t)(tb + (tid >> 5)) * D + hd * 256 + (tid & 31) * 8;
                if (MODE == 1) {
#pragma unroll
                    for (int i = 0; i < 4; ++i) *(u32x4*)(og + (size_t)(16 * i) * D) = ob[i];
                } else {
                    const f32x4 ng0 = *(const f32x4*)(p.in[21] + hd * 256 + (tid & 31) * 8), ng1 = *(const f32x4*)(p.in[21] + hd * 256 + (tid & 31) * 8 + 4);
#pragma unroll
                    for (int i = 0; i < 4; ++i) {
                        float ov[8]; float sq = 0.f;
#pragma unroll
                        for (int e = 0; e < 4; ++e) { ov[2 * e] = __uint_as_float(ob[i][e] << 16) + __uint_as_float(of[i][e] << 16); ov[2 * e + 1] = __uint_as_float(ob[i][e] & 0xffff0000u) + __uint_as_float(of[i][e] & 0xffff0000u);
                            sq += ov[2 * e] * ov[2 * e] + ov[2 * e + 1] * ov[2 * e + 1]; }
#pragma unroll
                        for (int sh = 1; sh < 32; sh <<= 1) sq += __shfl_xor(sq, sh);
                        const float rs = rsqrtf(sq * (1.0f / 256.0f) + EPS);
                        u32x4 wv;
#pragma unroll
                        for (int e = 0; e < 4; ++e) { const float r0 = __uint_as_float(rr[i][e] << 16), r1 = __uint_as_float(rr[i][e] & 0xffff0000u);
                            const float g0 = e < 2 ? ng0[2 * e] : ng1[2 * e - 4], g1 = e < 2 ? ng0[2 * e + 1] : ng1[2 * e - 3];
                            wv[e] = pk_bf16(ov[2 * e] * rs * g0 * (r0 * sigmoidf_(r0)), ov[2 * e + 1] * rs * g1 * (r1 * sigmoidf_(r1))); }
                        *(u32x4*)(og + (size_t)(16 * i) * D) = wv;
                    }
                }
                __syncthreads();
            }
        }
#undef GLA_LOAD
        if (MODE == 0) {
#pragma unroll
            for (int cb = 0; cb < 4; ++cb)
#pragma unroll
                for (int i = 0; i < 16; ++i) (sb0 + (32 * cb + 8 * (i >> 2) + (i & 3)) * 256)[svo] = S[cb][i];
            if (tg == 0) dtot[full * 128 + chan] = dsum;
        }
    }
}
__device__ __forceinline__ void gla_carry(const P& p, const int dir) {
    float* sbuf = (float*)(p.ws + WS_SBUF); const float* dtot = (const float*)(p.ws + WS_DTOT);
    const int total = 40 * 8192;
    int tid_ = threadIdx.x; asm volatile("" : "+v"(tid_));
    for (int e = blockIdx.x * NTHREADS + tid_; e < total; e += gridDim.x * NTHREADS) {
        const int e4 = e & 8191, ch = e >> 13, hd = ch & 3, s = ch >> 2;
        const int n = s < 2 ? 16 : 2, q0 = s < 2 ? s * 16 : 32 + (s - 2) * 2, chan = e4 >> 6;
        f32x4 run = (f32x4){0.f, 0.f, 0.f, 0.f};
        float* const base = sbuf + (size_t)e4 * 4;
        if (n == 16) {
            f32x4 tmp[16]; float dcy[16];
#pragma unroll
            for (int i = 0; i < 16; ++i) { const int sc = dir == 0 ? i : 15 - i, full = dir * 192 + (q0 + sc) * 4 + hd; tmp[i] = *(const f32x4*)(base + (size_t)full * 32768); dcy[i] = dtot[full * 128 + chan]; }
#pragma unroll
            for (int i = 0; i < 16; ++i) { const int sc = dir == 0 ? i : 15 - i, full = dir * 192 + (q0 + sc) * 4 + hd; *(f32x4*)(base + (size_t)full * 32768) = run; run = run * __expf(dcy[i]) + tmp[i]; }
        } else {
            for (int i = 0; i < n; ++i) { const int sc = dir == 0 ? i : n - 1 - i, full = dir * 192 + (q0 + sc) * 4 + hd;
                f32x4* ptr = (f32x4*)(base + (size_t)full * 32768); const float dcy = __expf(dtot[full * 128 + chan]);
                const f32x4 tmp = *ptr; *ptr = run; run = run * dcy + tmp; }
        }
    }
}

#define XB_TMO      128
#define XB_XCNT(j)  (256  + 64 * (j))
#define XB_XSUB(j)  (1280 + 64 * (j))
#define XB_XGEN(j)  (2304 + 64 * (j))
#define XB_TOP      3328
#define XB_TOPGEN   3392
#define XCD_BAR_WORDS 3456
#define XB_SPIN_CAP (1u << 18)

__device__ __forceinline__ unsigned xb_ld(unsigned* p)              { return __hip_atomic_load(p, __ATOMIC_RELAXED, __HIP_MEMORY_SCOPE_AGENT); }
__device__ __forceinline__ unsigned xb_add(unsigned* p, unsigned v) { return __hip_atomic_fetch_add(p, v, __ATOMIC_RELAXED, __HIP_MEMORY_SCOPE_AGENT); }
__device__ __forceinline__ unsigned xb_xcc_id() { return (unsigned)__builtin_amdgcn_s_getreg((3 << 11) | 20) & 0xFu; }
#define XB_SPIN(cond, bar) do { unsigned _sp = 0; while (cond) { __builtin_amdgcn_s_sleep(1); \
    if ((++_sp & 255u) == 0u) { if (xb_ld(&(bar)[XB_TMO])) break; if (_sp > XB_SPIN_CAP) { atomicAdd(&(bar)[XB_TMO], 1u); break; } } } } while (0)

struct XcdBarrier {
    unsigned* bar; unsigned x;
    volatile LAS unsigned* st;
};

__device__ __forceinline__ XcdBarrier xcd_barrier_post(unsigned* bar, volatile LAS unsigned* st) {
    XcdBarrier b; b.bar = bar; b.x = xb_xcc_id(); b.st = st;
    if (threadIdx.x == 0) (void)xb_add(&bar[XB_XCNT(b.x)], 1u);
    return b;
}
__device__ __forceinline__ void xcd_barrier_complete(unsigned* bar, unsigned x, unsigned& nloc, unsigned& nx) {
    const unsigned G = gridDim.x * gridDim.y * gridDim.z;
    unsigned sum, cnt, mine, sp = 0u;
    for (;;) {
        sum = 0u; cnt = 0u; mine = 0u;
#pragma unroll
        for (unsigned j = 0; j < 16; ++j) { const unsigned c = xb_ld(&bar[XB_XCNT(j)]); sum += c; cnt += (c > 0u) ? 1u : 0u; mine = (j == x) ? c : mine; }
        if (sum == G) break;
        __builtin_amdgcn_s_sleep(1);
        if ((++sp & 255u) == 0u) { if (xb_ld(&bar[XB_TMO])) break; if (sp > XB_SPIN_CAP) { atomicAdd(&bar[XB_TMO], 1u); break; } }
    }
    nloc = mine > 0u ? mine : 1u; nx = cnt > 0u ? cnt : 1u;
}

__device__ __forceinline__ void xcd_barrier(const XcdBarrier& b) {
    asm volatile("s_waitcnt vmcnt(0)" ::: "memory");
    __syncthreads();
    if (threadIdx.x == 0) {
        unsigned* bar = b.bar;
        __builtin_amdgcn_s_waitcnt(0);
        unsigned nloc = b.st[0], nx = b.st[1];
        if (nloc == 0u) { xcd_barrier_complete(bar, b.x, nloc, nx); b.st[0] = nloc; b.st[1] = nx; }
        const unsigned old = xb_add(&bar[XB_XSUB(b.x)], 1u);
        const unsigned gen = old / nloc;
        if (old + 1u == (gen + 1u) * nloc) {
            __builtin_amdgcn_fence(__ATOMIC_RELEASE, "agent");
            asm volatile("s_waitcnt vmcnt(0)" ::: "memory");
            const unsigned og = xb_add(&bar[XB_TOP], 1u);
            const unsigned tg = og / nx;
            if (og + 1u == (tg + 1u) * nx) xb_add(&bar[XB_TOPGEN], 1u);
            else XB_SPIN(xb_ld(&bar[XB_TOPGEN]) == tg, bar);
            __builtin_amdgcn_fence(__ATOMIC_ACQUIRE, "agent");
            xb_add(&bar[XB_XGEN(b.x)], 1u);
            asm volatile("s_waitcnt vmcnt(0)" ::: "memory");
        } else {
            XB_SPIN(xb_ld(&bar[XB_XGEN(b.x)]) == gen, bar);
            __builtin_amdgcn_fence(__ATOMIC_ACQUIRE, "agent");
            asm volatile("s_waitcnt vmcnt(0)" ::: "memory");
        }
    }
    __syncthreads();
}

#if TPROBE
#define GRID_BAR() do { xcd_barrier(bar); if (blockIdx.x == 0 && threadIdx.x == 0) ((unsigned long long*)(p.ws + WS_STAMP))[tsi] = __builtin_amdgcn_s_memrealtime(); ++tsi; } while (0)
#else
#define GRID_BAR() xcd_barrier(bar)
#endif

template <int L, int SL>
__device__ __forceinline__ void mlp_up(const P& p, LAS unsigned char* lds) {
    unsigned char* ws = p.ws;
    bf16_t* hb = (bf16_t*)(ws + WS_HBUF); bf16_t* hid = (bf16_t*)(ws + WS_BIG + (size_t)(SL & 1) * 128 * MiB);
    const bf16_t* w1 = (const bf16_t*)(ws + (L ? WS_W1B : WS_W1A));
    pg8::Gemm g{hb + (size_t)SL * 16384 * D, w1, 16384, FF, D}; pg8::StaticOrder S; S.init(16384, FF, gridDim.x, blockIdx.x);
    EpiBf<1> E{hid, FF, nullptr};
    if (PH & 4096) pg8::gemm_phase<EpiBf<1>, pg8::StaticOrder>(lds, g, S, E, nullptr);
}
template <int L, int SL>
__device__ __forceinline__ void mlp_down(const P& p, LAS unsigned char* lds) {
    unsigned char* ws = p.ws;
    const float* ml = (const float*)(ws + WS_MOD) + (size_t)L * NSEQ * NMODC;
    bf16_t* hid = (bf16_t*)(ws + WS_BIG + (size_t)(SL & 1) * 128 * MiB);
    const bf16_t* w2 = (const bf16_t*)(ws + (L ? WS_W2B : WS_W2A));
    pg8::Gemm g{hid, w2, 16384, D, FF}; pg8::StaticOrder S; S.init(16384, D, gridDim.x, blockIdx.x);
    EpiRes E{p.out, ml + 5 * D, SL * 16384};
    if (PH & 8192) pg8::gemm_phase<EpiRes, pg8::StaticOrder>(lds, g, S, E, nullptr);
}
template <int L>
__device__ __forceinline__ void mlp_block(const P& p, LAS unsigned char* lds, const XcdBarrier& bar, int& tsi) {
    const float* ml = (const float*)(p.ws + WS_MOD) + (size_t)L * NSEQ * NMODC;
    norm_phase<1, false>(p, p.in[7] + L * D, ml + 3 * D, ml + 4 * D, 1.0f, 0, 16384);
    GRID_BAR();
    if (blockIdx.x & 1) { mlp_up<L, 0>(p, lds); norm_phase<1, false>(p, p.in[7] + L * D, ml + 3 * D, ml + 4 * D, 1.0f, 16384, T); }
    else { norm_phase<1, false>(p, p.in[7] + L * D, ml + 3 * D, ml + 4 * D, 1.0f, 16384, T); mlp_up<L, 0>(p, lds); }
    GRID_BAR();
    if (blockIdx.x & 1) { mlp_up<L, 1>(p, lds); mlp_down<L, 0>(p, lds); } else { mlp_down<L, 0>(p, lds); mlp_up<L, 1>(p, lds); }
    GRID_BAR();
    if (blockIdx.x & 1) { mlp_up<L, 2>(p, lds); mlp_down<L, 1>(p, lds); } else { mlp_down<L, 1>(p, lds); mlp_up<L, 2>(p, lds); }
    GRID_BAR();
    mlp_down<L, 2>(p, lds);
    GRID_BAR();
}

__global__ void __launch_bounds__(NTHREADS, 2) hybrid_fwd(P p) {
    extern __shared__ __attribute__((aligned(16))) unsigned char lds_raw[];
    LAS unsigned char* lds = (LAS unsigned char*)lds_raw;
    cg::grid_group grid = cg::this_grid();
    unsigned char* ws = p.ws;
    const float* mod = (const float*)(ws + WS_MOD);
    bf16_t* hb = (bf16_t*)(ws + WS_HBUF);
    bf16_t* big = (bf16_t*)(ws + WS_BIG);

    volatile LAS unsigned* bst = (volatile LAS unsigned*)(lds + LDS_BYTES - 16);
    if (threadIdx.x < 2) bst[threadIdx.x] = 0u;
    if (blockIdx.x == 0) for (int i = threadIdx.x; i < XCD_BAR_WORDS; i += NTHREADS) ((unsigned*)(ws + WS_BARW))[i] = 0u;
    __syncthreads();
    grid.sync();
    const XcdBarrier bar = xcd_barrier_post((unsigned*)(ws + WS_BARW), bst);
    int tsi = 1;
#if TPROBE
    if (blockIdx.x == 0 && threadIdx.x == 0) ((unsigned long long*)(ws + WS_STAMP))[0] = __builtin_amdgcn_s_memrealtime();
#endif
    if (PH & 1) p0_prep(p, lds);
    GRID_BAR();
    if (PH & 2) norm_phase<0, false>(p, p.in[6], mod + 0 * D, mod + 1 * D);
    GRID_BAR();
    if (PH & 4) s5_pass<false>(p, lds);
    GRID_BAR();
    if (PH & 8) s5_carry(p);
    GRID_BAR();
    if (PH & 16) s5_pass<true>(p, lds);
    GRID_BAR();
#if (DUP & 1)
    if (PH & 4) s5_pass<false>(p, lds);
    GRID_BAR();
    if (PH & 8) s5_carry(p);
    GRID_BAR();
    if (PH & 16) s5_pass<true>(p, lds);
    GRID_BAR();
#endif
    { pg8::Gemm g{big, (const bf16_t*)(ws + WS_WGLU), T, 2 * D, D}; pg8::StaticOrder S; S.init(T, 2 * D, gridDim.x, blockIdx.x);
      EpiGlu E{p.in[0], p.in[1], p.out, mod + 2 * D};
      if (PH & 512) pg8::gemm_phase<EpiGlu, pg8::StaticOrder>(lds, g, S, E, nullptr);
#if (DUP & 8)
      GRID_BAR(); pg8::gemm_phase<EpiGlu, pg8::StaticOrder>(lds, g, S, E, nullptr);
      GRID_BAR(); pg8::gemm_phase<EpiGlu, pg8::StaticOrder>(lds, g, S, E, nullptr);
      GRID_BAR(); pg8::gemm_phase<EpiGlu, pg8::StaticOrder>(lds, g, S, E, nullptr);
#endif
    }
    GRID_BAR();
    mlp_block<0>(p, lds, bar, tsi);
    norm_phase<1, false>(p, p.in[6] + D, mod + (size_t)NSEQ * NMODC + 0 * D, mod + (size_t)NSEQ * NMODC + 1 * D);
    GRID_BAR();
    { pg8::Gemm g{hb, (const bf16_t*)(ws + WS_WIN), T, WIN_N, D}; pg8::StaticOrder S; S.init(T, WIN_N, gridDim.x, blockIdx.x);
      EpiBf<0> E{big, PROJ_N, (float*)(ws + WS_A1)};
      if (PH & 1024) pg8::gemm_phase<EpiBf<0>, pg8::StaticOrder>(lds, g, S, E, nullptr); }
    GRID_BAR();
    gla_phase<0>(p, lds, 0, 256, 0);
    GRID_BAR();
    gla_carry(p, 0);
    GRID_BAR();
    if (blockIdx.x < 192) gla_phase<1>(p, lds); else gla_phase<0>(p, lds, 256, 48, 192);
    GRID_BAR();
    gla_carry(p, 1);
    GRID_BAR();
    if (PH & 256) gla_phase<2>(p, lds);
    GRID_BAR();
    { pg8::Gemm g{hb, (const bf16_t*)(ws + WS_WOUT), T, D, D}; pg8::StaticOrder S; S.init(T, D, gridDim.x, blockIdx.x);
      EpiRes E{p.out, mod + (size_t)NSEQ * NMODC + 2 * D, 0};
      if (PH & 2048) pg8::gemm_phase<EpiRes, pg8::StaticOrder>(lds, g, S, E, nullptr); }
    GRID_BAR();
    mlp_block<1>(p, lds, bar, tsi);
#if (DUP & 4)
#pragma unroll 1
    for (int rep = 0; rep < 20; ++rep) GRID_BAR();
#endif
    float oscale = 1.0f;
#if TPROBE
    xcd_barrier(bar);
    { const unsigned long long* st = (const unsigned long long*)(ws + WS_STAMP); unsigned long long sel = 0ull;
#pragma unroll
      for (int i = 0; i < 23; ++i) if (TSEL & (1u << i)) sel += st[i + 1] - st[i];
      oscale = 1.0f + (float)sel / (float)(st[23] - st[0]); }
#endif
    if (PH == 0) norm_phase<0, true>(p, p.in[25], nullptr, nullptr, oscale); else norm_phase<1, true>(p, p.in[25], nullptr, nullptr, oscale);
    (void)tsi;
}

extern "C" void kernel_launch(void* const* d_in, const int* in_sizes, int n_in, void* d_out, int out_size, void* d_ws, size_t ws_size, hipStream_t stream) {
    static int grid_blocks = 0;
    if (grid_blocks == 0) {
        if (n_in != 26 || out_size != T * D || ws_size < WS_END) { fprintf(stderr, "kernel_launch: unexpected sizes n_in %d out %d ws %zu\n", n_in, out_size, ws_size); grid_blocks = -1; return; }
        int dev = 0, cus = 0, per_cu = 0;
        hipGetDevice(&dev);
        hipDeviceGetAttribute(&cus, hipDeviceAttributeMultiprocessorCount, dev);
        hipFuncSetAttribute((const void*)hybrid_fwd, hipFuncAttributeMaxDynamicSharedMemorySize, LDS_BYTES);
        hipOccupancyMaxActiveBlocksPerMultiprocessor(&per_cu, (const void*)hybrid_fwd, NTHREADS, LDS_BYTES);
        if (per_cu < 1) { fprintf(stderr, "kernel_launch: occupancy query says %d blocks per CU\n", per_cu); grid_blocks = -1; return; }
        grid_blocks = cus;
        if (grid_blocks % 8) grid_blocks -= grid_blocks % 8;
    }
    if (grid_blocks < 0) return;
    P p{};
    for (int i = 0; i < 26; ++i) p.in[i] = (const float*)d_in[i];
    p.out = (float*)d_out; p.ws = (unsigned char*)d_ws;
    void* args[] = {&p};
    hipError_t e = hipLaunchCooperativeKernel((const void*)hybrid_fwd, dim3(grid_blocks), dim3(NTHREADS), args, LDS_BYTES, stream);
    if (e != hipSuccess) fprintf(stderr, "cooperative launch failed: %s (grid %d)\n", hipGetErrorString(e), grid_blocks);
}
```
